# Optimizing an MI355X kernel written in HIP

```python
import jax, jax.numpy as jnp
from jax import lax
import numpy as np

D_MODEL = 2048
BATCH = 4
SEQ = 2048
DEPTH = 1
DEC_BATCH = 128
DEC_SEQ = 8
PAST_LEN = 16384
PAGE_SIZE = 128

HEAD_SIZE = 64
RWKV_WIDTH = D_MODEL // 2
RWKV_HEADS = RWKV_WIDTH // HEAD_SIZE
DECAY_LORA = D_MODEL // 32
AAA_LORA = D_MODEL // 32
GATE_LORA = D_MODEL // 16
CHUNK = 128
MLP_WIDTH = D_MODEL // 2
MLP_GROUPS = 8
MLP_GROUP_DIM = MLP_WIDTH // MLP_GROUPS
N_BRANCH = 2
D_FF = ((-(-8 * D_MODEL // 3)) + 255) // 256 * 256
C_SHIFT = 3 * RWKV_WIDTH + DECAY_LORA + AAA_LORA + GATE_LORA
C_IN = C_SHIFT + 2 * MLP_WIDTH + N_BRANCH * D_MODEL
NORM_EPS = 1e-6
GN_EPS = 64e-5
LN_EPS = 1e-5

kernel_name = "rwkv7_chunk_gmlp_gated_hybrid_step"


def rms_norm(x, g):
    xf = x.astype(jnp.float32)
    return xf * lax.rsqrt(jnp.mean(xf * xf, -1, keepdims=True) + NORM_EPS) * g.astype(jnp.float32)


def layer_norm(x, g, b):
    mu = jnp.mean(x, -1, keepdims=True)
    var = jnp.mean(jnp.square(x - mu), -1, keepdims=True)
    return (x - mu) * lax.rsqrt(var + LN_EPS) * g.astype(jnp.float32) + b.astype(jnp.float32)


def wkv7_scan(state, r, decay, k, v, kk, kka):
    def step(S, inp):
        r_t, w_t, k_t, v_t, kk_t, kka_t = inp
        sa = jnp.einsum('bhvk,bhk->bhv', S, -kk_t)
        S = S * w_t[:, :, None, :] + sa[..., None] * kka_t[:, :, None, :] + v_t[..., None] * k_t[:, :, None, :]
        o = jnp.einsum('bhvk,bhk->bhv', S, r_t)
        return S, o
    xs = tuple(jnp.swapaxes(a, 0, 1) for a in (r, decay, k, v, kk, kka))
    S, o = lax.scan(step, state, xs)
    return S, jnp.swapaxes(o, 0, 1)


def hybrid_layer(x, c, shift_state, wkv_state,
                 w_ada, b_ada, norm_mix_g, w_in, mu_shift, w0, w_decay_up, a0, w_aaa_up,
                 w_gate_up, k_k, k_a, r_k, gn_g, gn_b, ln_v_g, ln_v_b, w_spatial, b_spatial,
                 w_branch_a, w_branch_b, w_out, norm_ffn_g, w_ffn_in, w_ffn_out):
    f32 = jnp.float32
    dt = x.dtype
    B, T, _ = x.shape
    H, N = RWKV_HEADS, HEAD_SIZE
    mod = (jax.nn.silu(c.astype(f32)) @ w_ada.astype(f32) + b_ada.astype(f32)).reshape(B, 6, D_MODEL)
    shift_m, scale_m, gate_m = mod[:, 0], mod[:, 1], mod[:, 2]
    shift_f, scale_f, gate_f = mod[:, 3], mod[:, 4], mod[:, 5]

    h = (rms_norm(x, norm_mix_g) * (1.0 + scale_m[:, None]) + shift_m[:, None]).astype(dt)
    z = h @ w_in
    z_rw, z_u, z_v, z_gate = jnp.split(z, [C_SHIFT, C_SHIFT + MLP_WIDTH, C_SHIFT + 2 * MLP_WIDTH], axis=-1)

    prev = jnp.concatenate([shift_state[:, None].astype(dt), z_rw[:, :-1]], axis=1)
    zs = (z_rw + (prev - z_rw) * mu_shift.astype(dt)).astype(f32)
    new_shift = z_rw[:, -1]
    r, k, v, wd, ad, gd = jnp.split(zs, [RWKV_WIDTH, 2 * RWKV_WIDTH, 3 * RWKV_WIDTH,
                                         3 * RWKV_WIDTH + DECAY_LORA,
                                         3 * RWKV_WIDTH + DECAY_LORA + AAA_LORA], axis=-1)
    w_raw = w0.astype(f32) + jnp.tanh(wd) @ w_decay_up.astype(f32)
    decay = jnp.exp(-jnp.exp(-jax.nn.softplus(-w_raw) - 0.5))
    a = jax.nn.sigmoid(a0.astype(f32) + ad @ w_aaa_up.astype(f32))
    g = jax.nn.sigmoid(gd) @ w_gate_up.astype(f32)
    kk = (k * k_k.astype(f32)).reshape(B, T, H, N)
    kk = kk / jnp.maximum(jnp.sqrt(jnp.sum(kk * kk, -1, keepdims=True)), 1e-12)
    k = k * (1.0 + (a - 1.0) * k_a.astype(f32))
    r4, k4, v4 = r.reshape(B, T, H, N), k.reshape(B, T, H, N), v.reshape(B, T, H, N)
    a4, w4 = a.reshape(B, T, H, N), decay.reshape(B, T, H, N)
    S, o = wkv7_scan(wkv_state.astype(f32), r4, w4, k4, v4, kk, kk * a4)
    mu = jnp.mean(o, -1, keepdims=True)
    var = jnp.mean(jnp.square(o - mu), -1, keepdims=True)
    o = ((o - mu) * lax.rsqrt(var + GN_EPS)).reshape(B, T, RWKV_WIDTH) * gn_g.astype(f32) + gn_b.astype(f32)
    bonus = jnp.sum(r4 * k4 * r_k.astype(f32), -1, keepdims=True) * v4
    o_a = (o + bonus.reshape(B, T, RWKV_WIDTH)) * g
    y_a = o_a.astype(dt) @ w_branch_a

    u = jax.nn.gelu(z_u.astype(f32))
    vn = layer_norm(jax.nn.gelu(z_v.astype(f32)), ln_v_g, ln_v_b)
    n_chunks = -(-T // CHUNK)
    pad = n_chunks * CHUNK - T
    vp = jnp.pad(vn, ((0, 0), (0, pad), (0, 0))).reshape(B, n_chunks, CHUNK, MLP_GROUPS, MLP_GROUP_DIM)
    causal = jnp.tril(jnp.ones((CHUNK, CHUNK), dtype=bool))
    ws = jnp.where(causal[None], w_spatial.astype(f32), 0.0)
    mixed = jnp.einsum('gts,bcsgd->bctgd', ws, vp) + jnp.transpose(b_spatial.astype(f32))[:, :, None]
    mixed = mixed.reshape(B, n_chunks * CHUNK, MLP_WIDTH)[:, :T]
    y_b = (u * mixed).astype(dt) @ w_branch_b

    gates = jax.nn.sigmoid(z_gate.astype(f32)).reshape(B, T, N_BRANCH, D_MODEL)
    merged = gates[:, :, 0] * y_a.astype(f32) + gates[:, :, 1] * y_b.astype(f32)
    mix_out = merged.astype(dt) @ w_out
    x = x + (gate_m[:, None] * mix_out.astype(f32)).astype(dt)

    h2 = (rms_norm(x, norm_ffn_g) * (1.0 + scale_f[:, None]) + shift_f[:, None]).astype(dt)
    gt, up = jnp.split(h2 @ w_ffn_in, [D_FF], axis=-1)
    f = (jax.nn.silu(gt) * up) @ w_ffn_out
    x = x + (gate_f[:, None] * f.astype(f32)).astype(dt)
    return x, S.astype(wkv_state.dtype), new_shift, vn.astype(dt)


def setup_inputs(seed: int = 0) -> dict:
    key = jax.random.key(seed)
    ks = iter(jax.random.split(key, 48))
    nrm = lambda shape, s: jax.random.normal(next(ks), shape, jnp.float32) * s
    L, D = DEPTH, D_MODEL
    return {
        "x_prompt": nrm((BATCH, SEQ, D), 1.0),
        "x_sample": nrm((DEC_BATCH, DEC_SEQ, D), 1.0),
        "state_wkv": nrm((L, DEC_BATCH, RWKV_HEADS, HEAD_SIZE, HEAD_SIZE), 0.5),
        "state_shift": nrm((L, DEC_BATCH, C_SHIFT), 1.0),
        "c_prompt": nrm((BATCH, D), 1.0),
        "c_sample": nrm((DEC_BATCH, D), 1.0),
        "w_ada": nrm((L, D, 6 * D), 0.5 * D ** -0.5),
        "b_ada": nrm((L, 6 * D), 0.02),
        "norm_mix_g": 1.0 + nrm((L, D), 0.02),
        "w_in": nrm((L, D, C_IN), D ** -0.5),
        "mu_shift": jax.random.uniform(next(ks), (L, C_SHIFT), jnp.float32),
        "w0": jax.random.uniform(next(ks), (L, RWKV_WIDTH), jnp.float32, -6.5, -1.5),
        "w_decay_up": nrm((L, DECAY_LORA, RWKV_WIDTH), 0.1 * DECAY_LORA ** -0.5),
        "a0": nrm((L, RWKV_WIDTH), 0.1),
        "w_aaa_up": nrm((L, AAA_LORA, RWKV_WIDTH), 0.1 * AAA_LORA ** -0.5),
        "w_gate_up": nrm((L, GATE_LORA, RWKV_WIDTH), GATE_LORA ** -0.5),
        "k_k": 0.85 + nrm((L, RWKV_WIDTH), 0.05),
        "k_a": 1.0 + nrm((L, RWKV_WIDTH), 0.05),
        "r_k": nrm((L, RWKV_HEADS, HEAD_SIZE), 0.1),
        "gn_g": 1.0 + nrm((L, RWKV_WIDTH), 0.02),
        "gn_b": nrm((L, RWKV_WIDTH), 0.02),
        "ln_v_g": 1.0 + nrm((L, MLP_WIDTH), 0.02),
        "ln_v_b": nrm((L, MLP_WIDTH), 0.02),
        "w_spatial": nrm((L, MLP_GROUPS, CHUNK, CHUNK), 0.5 * CHUNK ** -0.5),
        "b_spatial": 1.0 + nrm((L, MLP_GROUPS, CHUNK), 0.02),
        "w_branch_a": nrm((L, RWKV_WIDTH, D), RWKV_WIDTH ** -0.5),
        "w_branch_b": nrm((L, MLP_WIDTH, D), MLP_WIDTH ** -0.5),
        "w_out": nrm((L, D, D), D ** -0.5),
        "norm_ffn_g": 1.0 + nrm((L, D), 0.02),
        "w_ffn_in": nrm((L, D, 2 * D_FF), D ** -0.5),
        "w_ffn_out": nrm((L, D_FF, D), D_FF ** -0.5),
        "norm_final_g": 1.0 + nrm((D,), 0.02),
    }


def reference(x_prompt, x_sample, state_wkv, state_shift, c_prompt, c_sample,
              w_ada, b_ada, norm_mix_g, w_in, mu_shift, w0, w_decay_up, a0, w_aaa_up,
              w_gate_up, k_k, k_a, r_k, gn_g, gn_b, ln_v_g, ln_v_b, w_spatial, b_spatial,
              w_branch_a, w_branch_b, w_out, norm_ffn_g, w_ffn_in, w_ffn_out, norm_final_g):
    xp, xs = x_prompt, x_sample
    Bp = x_prompt.shape[0]
    wkv_p, shift_p, wkv_s, shift_s, v_s = [], [], [], [], []
    for l in range(DEPTH):
        lw = (w_ada[l], b_ada[l], norm_mix_g[l], w_in[l], mu_shift[l], w0[l], w_decay_up[l], a0[l],
              w_aaa_up[l], w_gate_up[l], k_k[l], k_a[l], r_k[l], gn_g[l], gn_b[l], ln_v_g[l], ln_v_b[l],
              w_spatial[l], b_spatial[l], w_branch_a[l], w_branch_b[l], w_out[l], norm_ffn_g[l],
              w_ffn_in[l], w_ffn_out[l])
        zero_shift = jnp.zeros((Bp, C_SHIFT), x_prompt.dtype)
        zero_wkv = jnp.zeros((Bp, RWKV_HEADS, HEAD_SIZE, HEAD_SIZE), state_wkv.dtype)
        xp, Sp, shp, _ = hybrid_layer(xp, c_prompt, zero_shift, zero_wkv, *lw)
        xs, Ss, shs, vs = hybrid_layer(xs, c_sample, state_shift[l], state_wkv[l], *lw)
        wkv_p.append(Sp); shift_p.append(shp)
        wkv_s.append(Ss); shift_s.append(shs); v_s.append(vs)
    y_prompt = rms_norm(xp, norm_final_g).astype(x_prompt.dtype)
    y_sample = rms_norm(xs, norm_final_g).astype(x_sample.dtype)
    return (y_prompt, y_sample, jnp.stack(wkv_p), jnp.stack(shift_p),
            jnp.stack(wkv_s), jnp.stack(shift_s), jnp.stack(v_s))
```

```cpp
#include <hip/hip_runtime.h>
#include <cstdio>
#include <cstdint>

typedef unsigned short bf16_t;
typedef short bf16x8 __attribute__((ext_vector_type(8)));
typedef float f32x4 __attribute__((ext_vector_type(4)));

constexpr int D = 2048, NPB = 4, TP = 2048, NSB = 128, TS = 8;
constexpr int MP = NPB * TP, MS = NSB * TS, M = MP + MS;
constexpr int RW = 1024, NH = 16, HS = 64;
constexpr int CSH = 3328, CIN = 9472, DFF = 5632, MLPW = 1024;
constexpr int C_U = CSH, C_V = CSH + 1024, C_G0 = CSH + 2048, C_G1 = C_G0 + 2048;
constexpr int NSEQ = NPB + NSB;
constexpr size_t O_YP = 0, O_YS = O_YP + (size_t)MP * D, O_WKVP = O_YS + (size_t)MS * D, O_SHP = O_WKVP + (size_t)NPB * NH * HS * HS,
                 O_WKVS = O_SHP + (size_t)NPB * CSH, O_SHS = O_WKVS + (size_t)NSB * NH * HS * HS, O_VS = O_SHS + (size_t)NSB * CSH,
                 O_END = O_VS + (size_t)MS * MLPW;
constexpr size_t WS_WIN = 0;
constexpr size_t WS_WBA = WS_WIN + (size_t)CIN * D * 2;
constexpr size_t WS_WBB = WS_WBA + (size_t)D * RW * 2;
constexpr size_t WS_WOUT = WS_WBB + (size_t)D * RW * 2;
constexpr size_t WS_WFI = WS_WOUT + (size_t)D * D * 2;
constexpr size_t WS_WFO = WS_WFI + (size_t)2 * DFF * D * 2;
constexpr size_t WS_MOD = WS_WFO + (size_t)D * DFF * 2;
constexpr size_t WS_H = WS_MOD + (size_t)NSEQ * 6 * D * 4;
constexpr size_t WS_Z = WS_H + (size_t)M * D * 2;
constexpr size_t WS_VN = WS_Z + (size_t)M * CIN * 2;
constexpr size_t WS_OA = WS_VN + (size_t)M * MLPW * 2;
constexpr size_t WS_UB = WS_OA + (size_t)M * RW * 2;
constexpr size_t WS_END = WS_UB + (size_t)M * MLPW * 2;

struct P {
    const float* in[32];
    float* out;
    unsigned char* ws;
};

__device__ __forceinline__ bf16_t f2bf(float f) { unsigned u = __float_as_uint(f); u += 0x7fffu + ((u >> 16) & 1u); return (bf16_t)(u >> 16); }
__device__ __forceinline__ float bf2f(bf16_t h) { return __uint_as_float(((unsigned)h) << 16); }
__device__ __forceinline__ float sigmoidf_(float x) { return 1.f / (1.f + __expf(-x)); }
__device__ __forceinline__ float gelu_tanh(float x) { const float u = 0.7978845608028654f * (x + 0.044715f * x * x * x); return 0.5f * x * (1.f + tanhf(u)); }
__device__ __forceinline__ float wave_sum(float v) {
#pragma unroll
    for (int o = 1; o < 64; o <<= 1) v += __shfl_xor(v, o);
    return v;
}
__device__ __forceinline__ int seq_of_row(int row) { return row < MP ? row / TP : NPB + (row - MP) / TS; }

__global__ void k_mod(P p) {
    const int col = blockIdx.x * blockDim.x + threadIdx.x, row = blockIdx.y;
    const float* c = row < NPB ? p.in[4] + (size_t)row * D : p.in[5] + (size_t)(row - NPB) * D;
    const float* w = p.in[6];
    float acc = p.in[7][col];
    for (int k = 0; k < D; ++k) { const float cv = c[k]; acc += (cv * sigmoidf_(cv)) * w[(size_t)k * (6 * D) + col]; }
    ((float*)(p.ws + WS_MOD))[(size_t)row * (6 * D) + col] = acc;
}
__global__ void k_wt(const float* W, bf16_t* Wt, int K, int N) {
    __shared__ float t[32][33];
    const int n0 = blockIdx.x * 32, k0 = blockIdx.y * 32, tx = threadIdx.x & 31, ty = threadIdx.x >> 5;
    for (int i = ty; i < 32; i += 8) t[i][tx] = W[(size_t)(k0 + i) * N + n0 + tx];
    __syncthreads();
    for (int i = ty; i < 32; i += 8) Wt[(size_t)(n0 + i) * K + k0 + tx] = f2bf(t[tx][i]);
}
__global__ void k_norm(P p, int which  ) {
    const int row = blockIdx.x, tid = threadIdx.x, sq = seq_of_row(row);
    const float* x = which == 0 ? (row < MP ? p.in[0] + (size_t)row * D : p.in[1] + (size_t)(row - MP) * D) : p.out + (size_t)row * D;
    const float* g = which == 0 ? p.in[8] : p.in[28];
    const float* mod = (const float*)(p.ws + WS_MOD) + (size_t)sq * (6 * D);
    const float* shift = mod + (which == 0 ? 0 : 3) * D; const float* scale = mod + (which == 0 ? 1 : 4) * D;
    float v[8]; float s = 0.f;
#pragma unroll
    for (int i = 0; i < 8; ++i) { v[i] = x[tid + 256 * i]; s += v[i] * v[i]; }
    __shared__ float red[4];
    s = wave_sum(s); if ((tid & 63) == 0) red[tid >> 6] = s; __syncthreads();
    const float rstd = rsqrtf((red[0] + red[1] + red[2] + red[3]) * (1.f / D) + 1e-6f);
    bf16_t* h = (bf16_t*)(p.ws + WS_H) + (size_t)row * D;
#pragma unroll
    for (int i = 0; i < 8; ++i) { const int k = tid + 256 * i; h[k] = f2bf(v[i] * rstd * g[k] * (1.f + scale[k]) + shift[k]); }
}

template <bool DUAL, class Epi>
__global__ __launch_bounds__(256) void k_gemm(const bf16_t* A1, const bf16_t* B1, const bf16_t* A2, const bf16_t* B2, int lda1, int K1, int lda2, int K2, Epi epi) {
    const int lane = threadIdx.x & 63, wid = threadIdx.x >> 6, wr = wid >> 1, wc = wid & 1, fr = lane & 15, fq = lane >> 4;
    const int row0 = blockIdx.y * 64 + wr * 32, col0 = blockIdx.x * 64 + wc * 32;
    f32x4 acc1[2][2], acc2[2][2];
#pragma unroll
    for (int i = 0; i < 2; ++i)
#pragma unroll
        for (int j = 0; j < 2; ++j) { acc1[i][j] = (f32x4){0.f, 0.f, 0.f, 0.f}; acc2[i][j] = (f32x4){0.f, 0.f, 0.f, 0.f}; }
    for (int k0 = 0; k0 < K1; k0 += 32) {
        bf16x8 a[2], b[2];
#pragma unroll
        for (int i = 0; i < 2; ++i) a[i] = *(const bf16x8*)(A1 + (size_t)(row0 + i * 16 + fr) * lda1 + k0 + fq * 8);
#pragma unroll
        for (int j = 0; j < 2; ++j) b[j] = *(const bf16x8*)(B1 + (size_t)(col0 + j * 16 + fr) * K1 + k0 + fq * 8);
#pragma unroll
        for (int i = 0; i < 2; ++i)
#pragma unroll
            for (int j = 0; j < 2; ++j) acc1[i][j] = __builtin_amdgcn_mfma_f32_16x16x32_bf16(a[i], b[j], acc1[i][j], 0, 0, 0);
    }
    if (DUAL) {
        for (int k0 = 0; k0 < K2; k0 += 32) {
            bf16x8 a[2], b[2];
#pragma unroll
            for (int i = 0; i < 2; ++i) a[i] = *(const bf16x8*)(A2 + (size_t)(row0 + i * 16 + fr) * lda2 + k0 + fq * 8);
#pragma unroll
            for (int j = 0; j < 2; ++j) b[j] = *(const bf16x8*)(B2 + (size_t)(col0 + j * 16 + fr) * K2 + k0 + fq * 8);
#pragma unroll
            for (int i = 0; i < 2; ++i)
#pragma unroll
                for (int j = 0; j < 2; ++j) acc2[i][j] = __builtin_amdgcn_mfma_f32_16x16x32_bf16(a[i], b[j], acc2[i][j], 0, 0, 0);
        }
    }
#pragma unroll
    for (int i = 0; i < 2; ++i)
#pragma unroll
        for (int j = 0; j < 2; ++j)
#pragma unroll
            for (int r = 0; r < 4; ++r) epi(row0 + i * 16 + fq * 4 + r, col0 + j * 16 + fr, acc1[i][j][r], acc2[i][j][r]);
}

struct EpiZ {
    P p;
    __device__ __forceinline__ void operator()(int row, int col, float v, float) const {
        bf16_t* z = (bf16_t*)(p.ws + WS_Z);
        float o = v;
        if (col < CSH) {
            if (row < MP) { if ((row & (TP - 1)) == TP - 1) p.out[O_SHP + (size_t)(row / TP) * CSH + col] = v; }
            else { const int rs = row - MP; if ((rs & (TS - 1)) == TS - 1) p.out[O_SHS + (size_t)(rs / TS) * CSH + col] = v; }
        } else if (col < C_G0) o = gelu_tanh(v);
        else o = sigmoidf_(v);
        z[(size_t)row * CIN + col] = f2bf(o);
    }
};
struct EpiMerge {
    P p;
    __device__ __forceinline__ void operator()(int row, int col, float ya, float yb) const {
        const bf16_t* z = (const bf16_t*)(p.ws + WS_Z) + (size_t)row * CIN;
        ((bf16_t*)(p.ws + WS_H))[(size_t)row * D + col] = f2bf(bf2f(z[C_G0 + col]) * ya + bf2f(z[C_G1 + col]) * yb);
    }
};
struct EpiRes1 {
    P p;
    __device__ __forceinline__ void operator()(int row, int col, float v, float) const {
        const float x = row < MP ? p.in[0][(size_t)row * D + col] : p.in[1][(size_t)(row - MP) * D + col];
        const float gm = ((const float*)(p.ws + WS_MOD))[(size_t)seq_of_row(row) * (6 * D) + 2 * D + col];
        p.out[(size_t)row * D + col] = x + gm * v;
    }
};
struct EpiSwiglu {
    P p;
    __device__ __forceinline__ void operator()(int row, int col, float gt, float up) const {
        ((bf16_t*)(p.ws + WS_Z))[(size_t)row * DFF + col] = f2bf(gt * sigmoidf_(gt) * up);
    }
};
struct EpiRes2 {
    P p;
    __device__ __forceinline__ void operator()(int row, int col, float v, float) const {
        const float gf = ((const float*)(p.ws + WS_MOD))[(size_t)seq_of_row(row) * (6 * D) + 5 * D + col];
        float* o = p.out + (size_t)row * D + col; *o = *o + gf * v;
    }
};

__global__ void k_lnv(P p) {
    const int row = blockIdx.x, tid = threadIdx.x;
    const bf16_t* zv = (const bf16_t*)(p.ws + WS_Z) + (size_t)row * CIN + C_V;
    float v[4]; float s = 0.f;
#pragma unroll
    for (int i = 0; i < 4; ++i) { v[i] = bf2f(zv[tid + 256 * i]); s += v[i]; }
    __shared__ float red[8];
    s = wave_sum(s); if ((tid & 63) == 0) red[tid >> 6] = s; __syncthreads();
    const float mean = (red[0] + red[1] + red[2] + red[3]) * (1.f / MLPW);
    float q = 0.f;
#pragma unroll
    for (int i = 0; i < 4; ++i) { v[i] -= mean; q += v[i] * v[i]; }
    q = wave_sum(q); if ((tid & 63) == 0) red[4 + (tid >> 6)] = q; __syncthreads();
    const float rstd = rsqrtf((red[4] + red[5] + red[6] + red[7]) * (1.f / MLPW) + 1e-5f);
    bf16_t* vn = (bf16_t*)(p.ws + WS_VN) + (size_t)row * MLPW;
#pragma unroll
    for (int i = 0; i < 4; ++i) { const int c = tid + 256 * i; const float o = v[i] * rstd * p.in[21][c] + p.in[22][c]; vn[c] = f2bf(o);
        if (row >= MP) p.out[O_VS + (size_t)(row - MP) * MLPW + c] = o; }
}

__global__ __launch_bounds__(256) void k_wkv_naive(P p) {
    const int head = blockIdx.x % NH, sq = blockIdx.x / NH, tid = threadIdx.x, lane = tid & 63, ch = head * HS + lane;
    const int vi = tid >> 2, part = tid & 3;
    const bool prompt = sq < NPB, w0 = tid < 64;
    const int T = prompt ? TP : TS, row0 = prompt ? sq * TP : MP + (sq - NPB) * TS;
    const bf16_t* z = (const bf16_t*)(p.ws + WS_Z);
    const float* mu = p.in[10];
    __shared__ float s_td[64], s_ad[64], s_gd[128], s_kk[64], s_kka[64], s_k[64], s_w[64], s_r[64], s_v[64], s_o[64];
    float S[16];
    if (prompt) {
#pragma unroll
        for (int k = 0; k < 16; ++k) S[k] = 0.f;
    } else {
        const float* st = p.in[2] + (((size_t)(sq - NPB) * NH + head) * HS + vi) * HS + part * 16;
#pragma unroll
        for (int k = 0; k < 16; ++k) S[k] = st[k];
    }
    const float* ss = p.in[3] + (size_t)(prompt ? 0 : sq - NPB) * CSH;
    float pr = prompt ? 0.f : ss[ch], pk = prompt ? 0.f : ss[RW + ch], pv = prompt ? 0.f : ss[2 * RW + ch];
    float pwd = prompt ? 0.f : ss[3072 + lane], pad = prompt ? 0.f : ss[3136 + lane], pg0 = prompt ? 0.f : ss[3200 + lane], pg1 = prompt ? 0.f : ss[3264 + lane];
    const float mur = mu[ch], muk = mu[RW + ch], muv = mu[2 * RW + ch], muwd = mu[3072 + lane], muad = mu[3136 + lane], mug0 = mu[3200 + lane], mug1 = mu[3264 + lane];
    const float w0c = p.in[11][ch], a0c = p.in[13][ch], kkc = p.in[16][ch], kac = p.in[17][ch], rkc = p.in[18][ch], gng = p.in[19][ch], gnb = p.in[20][ch];
    const float* wdu = p.in[12] + ch; const float* wau = p.in[14] + ch; const float* wgu = p.in[15] + ch;
    bf16_t* oa = (bf16_t*)(p.ws + WS_OA);
    for (int t = 0; t < T; ++t) {
        const bf16_t* zr = z + (size_t)(row0 + t) * CIN;
        float r = 0.f, k = 0.f, v = 0.f, g = 0.f, bonus = 0.f;
        if (w0) {
            float c;
            c = bf2f(zr[ch]); r = c + (pr - c) * mur; pr = c;
            c = bf2f(zr[RW + ch]); k = c + (pk - c) * muk; pk = c;
            c = bf2f(zr[2 * RW + ch]); v = c + (pv - c) * muv; pv = c;
            c = bf2f(zr[3072 + lane]); s_td[lane] = tanhf(c + (pwd - c) * muwd); pwd = c;
            c = bf2f(zr[3136 + lane]); s_ad[lane] = c + (pad - c) * muad; pad = c;
            c = bf2f(zr[3200 + lane]); s_gd[lane] = sigmoidf_(c + (pg0 - c) * mug0); pg0 = c;
            c = bf2f(zr[3264 + lane]); s_gd[64 + lane] = sigmoidf_(c + (pg1 - c) * mug1); pg1 = c;
        }
        __syncthreads();
        if (w0) {
            float wraw = w0c, apre = a0c;
#pragma unroll 4
            for (int j = 0; j < 64; ++j) { wraw += s_td[j] * wdu[(size_t)j * RW]; apre += s_ad[j] * wau[(size_t)j * RW]; }
#pragma unroll 4
            for (int j = 0; j < 128; ++j) g += s_gd[j] * wgu[(size_t)j * RW];
            const float wdec = __expf(-0.6065306597126334f * sigmoidf_(wraw));
            const float a = sigmoidf_(apre);
            float kkv = k * kkc; const float nrm = sqrtf(wave_sum(kkv * kkv)); kkv = kkv / fmaxf(nrm, 1e-12f);
            const float kmod = k * (1.f + (a - 1.f) * kac);
            bonus = wave_sum(r * kmod * rkc);
            s_kk[lane] = kkv; s_kka[lane] = kkv * a; s_k[lane] = kmod; s_w[lane] = wdec; s_r[lane] = r; s_v[lane] = v;
        }
        __syncthreads();
        {
            float sa = 0.f;
#pragma unroll
            for (int kk = 0; kk < 16; ++kk) sa -= S[kk] * s_kk[part * 16 + kk];
            sa += __shfl_xor(sa, 1); sa += __shfl_xor(sa, 2);
            const float vv = s_v[vi];
            float o = 0.f;
#pragma unroll
            for (int kk = 0; kk < 16; ++kk) { const int kx = part * 16 + kk; S[kk] = S[kk] * s_w[kx] + sa * s_kka[kx] + vv * s_k[kx]; o += S[kk] * s_r[kx]; }
            o += __shfl_xor(o, 1); o += __shfl_xor(o, 2);
            if (part == 0) s_o[vi] = o;
        }
        __syncthreads();
        if (w0) {
            const float o = s_o[lane];
            const float mean = wave_sum(o) * (1.f / HS); const float dlt = o - mean; const float var = wave_sum(dlt * dlt) * (1.f / HS);
            const float on = dlt * rsqrtf(var + 64e-5f) * gng + gnb;
            oa[(size_t)(row0 + t) * RW + ch] = f2bf((on + bonus * v) * g);
        }
    }
    float* so = (prompt ? p.out + O_WKVP + (((size_t)sq * NH + head) * HS + vi) * HS : p.out + O_WKVS + (((size_t)(sq - NPB) * NH + head) * HS + vi) * HS) + part * 16;
#pragma unroll
    for (int k = 0; k < 16; ++k) so[k] = S[k];
}

__global__ void k_mix_naive(P p) {
    const int row = blockIdx.x, tid = threadIdx.x;
    int t, rowc0;
    if (row < MP) { const int tt = row & (TP - 1); t = tt & 127; rowc0 = row - t; } else { t = (row - MP) & (TS - 1); rowc0 = row - t; }
    const bf16_t* vn = (const bf16_t*)(p.ws + WS_VN);
    const bf16_t* z = (const bf16_t*)(p.ws + WS_Z) + (size_t)row * CIN;
    bf16_t* ub = (bf16_t*)(p.ws + WS_UB) + (size_t)row * MLPW;
    for (int c = tid; c < MLPW; c += 256) {
        const int g = c >> 7; const float* wsg = p.in[23] + ((size_t)g * 128 + t) * 128;
        float acc = 0.f;
        for (int s = 0; s <= t; ++s) acc += wsg[s] * bf2f(vn[(size_t)(rowc0 + s) * MLPW + c]);
        acc += p.in[24][g * 128 + t];
        ub[c] = f2bf(bf2f(z[C_U + c]) * acc);
    }
}
__global__ void k_final(P p) {
    const int row = blockIdx.x, tid = threadIdx.x;
    float* x = p.out + (size_t)row * D;
    float v[8]; float s = 0.f;
#pragma unroll
    for (int i = 0; i < 8; ++i) { v[i] = x[tid + 256 * i]; s += v[i] * v[i]; }
    __shared__ float red[4];
    s = wave_sum(s); if ((tid & 63) == 0) red[tid >> 6] = s; __syncthreads();
    const float rstd = rsqrtf((red[0] + red[1] + red[2] + red[3]) * (1.f / D) + 1e-6f);
#pragma unroll
    for (int i = 0; i < 8; ++i) { const int k = tid + 256 * i; x[k] = v[i] * rstd * p.in[31][k]; }
}

extern "C" void kernel_launch(void* const* d_in, const int* in_sizes, int n_in, void* d_out, int out_size, void* d_ws, size_t ws_size, hipStream_t stream) {
    if (n_in != 32 || (size_t)out_size != O_END || ws_size < WS_END) { fprintf(stderr, "kernel_launch: unexpected shapes n_in=%d out=%d ws=%zu (need %zu)\n", n_in, out_size, ws_size, (size_t)WS_END); return; }
    P p{};
    for (int i = 0; i < 32; ++i) p.in[i] = (const float*)d_in[i];
    p.out = (float*)d_out; p.ws = (unsigned char*)d_ws;
    unsigned char* ws = p.ws;
    k_mod<<<dim3(6 * D / 256, NSEQ), 256, 0, stream>>>(p);
    k_wt<<<dim3(CIN / 32, D / 32), 256, 0, stream>>>(p.in[9], (bf16_t*)(ws + WS_WIN), D, CIN);
    k_wt<<<dim3(D / 32, RW / 32), 256, 0, stream>>>(p.in[25], (bf16_t*)(ws + WS_WBA), RW, D);
    k_wt<<<dim3(D / 32, RW / 32), 256, 0, stream>>>(p.in[26], (bf16_t*)(ws + WS_WBB), RW, D);
    k_wt<<<dim3(D / 32, D / 32), 256, 0, stream>>>(p.in[27], (bf16_t*)(ws + WS_WOUT), D, D);
    k_wt<<<dim3(2 * DFF / 32, D / 32), 256, 0, stream>>>(p.in[29], (bf16_t*)(ws + WS_WFI), D, 2 * DFF);
    k_wt<<<dim3(D / 32, DFF / 32), 256, 0, stream>>>(p.in[30], (bf16_t*)(ws + WS_WFO), DFF, D);
    k_norm<<<M, 256, 0, stream>>>(p, 0);
    const bf16_t* H = (const bf16_t*)(ws + WS_H);
    k_gemm<false, EpiZ><<<dim3(CIN / 64, M / 64), 256, 0, stream>>>(H, (const bf16_t*)(ws + WS_WIN), nullptr, nullptr, D, D, 0, 0, EpiZ{p});
    k_lnv<<<M, 256, 0, stream>>>(p);
    k_wkv_naive<<<NSEQ * NH, 256, 0, stream>>>(p);
    k_mix_naive<<<M, 256, 0, stream>>>(p);
    k_gemm<true, EpiMerge><<<dim3(D / 64, M / 64), 256, 0, stream>>>((const bf16_t*)(ws + WS_OA), (const bf16_t*)(ws + WS_WBA), (const bf16_t*)(ws + WS_UB), (const bf16_t*)(ws + WS_WBB), RW, RW, MLPW, RW, EpiMerge{p});
    k_gemm<false, EpiRes1><<<dim3(D / 64, M / 64), 256, 0, stream>>>(H, (const bf16_t*)(ws + WS_WOUT), nullptr, nullptr, D, D, 0, 0, EpiRes1{p});
    k_norm<<<M, 256, 0, stream>>>(p, 1);
    k_gemm<true, EpiSwiglu><<<dim3(DFF / 64, M / 64), 256, 0, stream>>>(H, (const bf16_t*)(ws + WS_WFI), H, (const bf16_t*)(ws + WS_WFI) + (size_t)DFF * D, D, D, D, D, EpiSwiglu{p});
    k_gemm<false, EpiRes2><<<dim3(D / 64, M / 64), 256, 0, stream>>>((const bf16_t*)(ws + WS_Z), (const bf16_t*)(ws + WS_WFO), nullptr, nullptr, DFF, DFF, 0, 0, EpiRes2{p});
    k_final<<<M, 256, 0, stream>>>(p);
}
```

```cpp
#include <hip/hip_runtime.h>
#include <cstdio>
#include <cstdint>

constexpr int D = 2048, NPB = 4, TP = 2048, NSB = 128, TS = 8;
constexpr int MP = NPB * TP, MS = NSB * TS, M = MP + MS;
constexpr int RW = 1024, NH = 16, HS = 64;
constexpr int CSH = 3328, CIN = 9472, DFF = 5632, MLPW = 1024;
constexpr int C_U = CSH, C_V = CSH + 1024, C_G0 = CSH + 2048, C_G1 = C_G0 + 2048;
constexpr int NSEQ = NPB + NSB;
constexpr size_t O_YP = 0, O_YS = O_YP + (size_t)MP * D, O_WKVP = O_YS + (size_t)MS * D, O_SHP = O_WKVP + (size_t)NPB * NH * HS * HS,
                 O_WKVS = O_SHP + (size_t)NPB * CSH, O_SHS = O_WKVS + (size_t)NSB * NH * HS * HS, O_VS = O_SHS + (size_t)NSB * CSH,
                 O_END = O_VS + (size_t)MS * MLPW;
constexpr size_t WS_CTL = 0, CTL_ZERO_BYTES = 1u << 20;
constexpr size_t WS_WIN = CTL_ZERO_BYTES;
constexpr size_t WS_WBA = WS_WIN + (size_t)CIN * D * 2;
constexpr size_t WS_WBB = WS_WBA + (size_t)D * RW * 2;
constexpr size_t WS_WOUT = WS_WBB + (size_t)D * RW * 2;
constexpr size_t WS_WFI = WS_WOUT + (size_t)D * D * 2;
constexpr size_t WS_WFO = WS_WFI + (size_t)2 * DFF * D * 2;
constexpr size_t WS_MOD = WS_WFO + (size_t)D * DFF * 2;
constexpr size_t WS_H = WS_MOD + (size_t)NSEQ * 6 * D * 4;
constexpr size_t WS_Z = WS_H + (size_t)M * D * 2;
constexpr size_t WS_VN = WS_Z + (size_t)M * CIN * 2;
constexpr size_t WS_OA = WS_VN + (size_t)M * MLPW * 2;
constexpr size_t WS_UB = WS_OA + (size_t)M * RW * 2;
constexpr size_t WS_END = WS_UB + (size_t)M * MLPW * 2;
constexpr int CW_BAR = 4096;

typedef float f32x2v __attribute__((ext_vector_type(2)));
typedef __bf16 bf16x2v __attribute__((ext_vector_type(2)));
typedef unsigned u32x2v __attribute__((ext_vector_type(2)));

struct P { const float* in[32]; float* out; unsigned char* ws; };

__device__ __forceinline__ unsigned pk2(float lo, float hi) { return __builtin_bit_cast(unsigned, __builtin_convertvector((f32x2v){lo, hi}, bf16x2v)); }
__device__ __forceinline__ unsigned short f2bf(float f) { return (unsigned short)(pk2(f, 0.f) & 0xffffu); }
__device__ __forceinline__ float bf2f(unsigned short h) { return __uint_as_float(((unsigned)h) << 16); }
__device__ __forceinline__ float bflo(unsigned w) { return __uint_as_float(w << 16); }
__device__ __forceinline__ float bfhi(unsigned w) { return __uint_as_float(w & 0xffff0000u); }
__device__ __forceinline__ float sigmoidf_(float x) { return 1.f / (1.f + __expf(-x)); }
__device__ __forceinline__ float gelu_tanh(float x) {
    const float u = 0.7978845608028654f * (x + 0.044715f * x * x * x); return x / (1.f + __expf(-2.f * u)); }
__device__ __forceinline__ float wave_sum(float v) {
#pragma unroll
    for (int o = 1; o < 64; o <<= 1) v += __shfl_xor(v, o);
    return v;
}
__device__ __forceinline__ int seq_of_row(int row) { return row < MP ? row / TP : NPB + (row - MP) / TS; }

namespace pg8 {
#define PG8_LAS __attribute__((address_space(3)))
typedef unsigned short bf16_t;
typedef short bf16x8 __attribute__((ext_vector_type(8)));
typedef float f32x4 __attribute__((ext_vector_type(4)));
typedef unsigned u32x4 __attribute__((ext_vector_type(4)));
constexpr int BM = 256, BK = 64, HALF = 128, HTB = HALF * BK * 2  , STAGE_BYTES = 8 * HTB, NXCD = 8, WGM = 8;

__host__ __device__ __forceinline__ int lds_byte(int r, int c) { const int st = (r >> 4) * 2 + (c >> 5), rr = r & 15, cc = c & 31, ob = rr * 64 + cc * 2; return st * 1024 + (ob ^ (((ob >> 9) & 1) << 5)); }
__host__ __device__ __forceinline__ void stage_rc(int b, int& R, int& C) { const int st = b / 1024, sb = b % 1024, swz = sb ^ (((sb >> 9) & 1) << 5); R = (st >> 1) * 16 + swz / 64; C = (st & 1) * 32 + (swz % 64) / 2; }
__host__ __device__ __forceinline__ int perm32(int rho) { const int n = rho >> 4, i = rho & 15; return 8 * (i >> 2) + 4 * n + (i & 3); }

struct Unit { int pm, pn; };
struct Gemm { const bf16_t* A; const bf16_t* Bt; int M, N, K; };

struct StaticOrder {
    int nM, nN, nwg, G, c;
    __host__ __device__ void init(int M, int N, int G_, int c_) { nM = M / BM; nN = N / BM; nwg = nM * nN; G = G_; c = c_; }
    __host__ __device__ bool next(int i, Unit& u) const {
        const long L = (long)i * G + c; if (L >= nwg) return false;
        int wgid = (int)L; { const int q = nwg / NXCD, r = nwg % NXCD, xcd = wgid % NXCD, off = wgid / NXCD; wgid = (xcd < r ? xcd * (q + 1) : r * (q + 1) + (xcd - r) * q) + off; }
        const int nig = WGM * nN, gid = wgid / nig, fm = gid * WGM, gsz = (nM - fm) < WGM ? (nM - fm) : WGM;
        u.pm = fm + ((wgid % nig) % gsz); u.pn = (wgid % nig) / gsz; return true;
    }
    __device__ __forceinline__ void a_ready(const Unit&) const {}
    __device__ __forceinline__ void done(const Unit&) const {}
};
template <class Epi, class Sched, bool ALIGN_EPI = false, bool SP2 = false>
__device__ __forceinline__ void gemm_phase(PG8_LAS unsigned char* lds, const Gemm g, const Sched& S, const Epi& E) {
    const int tid = threadIdx.x, wid = __builtin_amdgcn_readfirstlane(tid >> 6), lane = tid & 63, wr = wid >> 2, wc = wid & 3, fr = lane & 15, fq = lane >> 4;
    const int K = g.K, nt = K / BK;
    unsigned voffA[2], voffB[2];
#pragma unroll
    for (int i = 0; i < 2; ++i) { int R, C; stage_rc(tid * 16 + i * 8192, R, C); const int Rb = Epi::PERM ? ((R & ~31) + perm32(R & 31)) : R;
        voffA[i] = (unsigned)(R * K + C) * 2u; voffB[i] = (unsigned)(Rb * K + C) * 2u; }
    const size_t kstep = (size_t)(BK * 2);
    const size_t hstep = (size_t)HALF * K * 2;
    const size_t tstep = 2 * hstep;
    const unsigned ldsw = (unsigned)wid * 1024u;
    const int aoff = lds_byte(wr * 64 + fr, fq * 8), boff = lds_byte(wc * 32 + fr, fq * 8);
#define PG8_SA(b, h) (((b) * 2 + (h)) * HTB)
#define PG8_SB(b, h) ((4 + (b) * 2 + (h)) * HTB)
#define PG8_STAGE(bufoff, gbase, voff) do { _Pragma("unroll") for (int _i = 0; _i < 2; ++_i) \
        __builtin_amdgcn_global_load_lds((const unsigned*)((const char*)(gbase) + (voff)[_i]), (PG8_LAS unsigned*)(lds + (bufoff) + ldsw + _i * 8192), 16, 0, 0); } while (0)
#define PG8_LDA(dst, b, h) do { _Pragma("unroll") for (int m = 0; m < 4; ++m) _Pragma("unroll") for (int k = 0; k < 2; ++k) dst[m][k] = *(const PG8_LAS bf16x8*)(lds + PG8_SA(b, h) + aoff + m * 2048 + k * 1024); } while (0)
#define PG8_LDB(dst, b, h) do { _Pragma("unroll") for (int n = 0; n < 2; ++n) _Pragma("unroll") for (int k = 0; k < 2; ++k) dst[n][k] = *(const PG8_LAS bf16x8*)(lds + PG8_SB(b, h) + boff + n * 2048 + k * 1024); } while (0)
#define PG8_MMA(ai, bj, At, Bt) do { __builtin_amdgcn_s_setprio(1); _Pragma("unroll") for (int m = 0; m < 4; ++m) _Pragma("unroll") for (int n = 0; n < 2; ++n) _Pragma("unroll") for (int k = 0; k < 2; ++k) \
        acc[ai][bj][m][n] = __builtin_amdgcn_mfma_f32_16x16x32_bf16(Bt[n][k], At[m][k], acc[ai][bj][m][n], 0, 0, 0); __builtin_amdgcn_s_setprio(0); } while (0)
#define PG8_WAIT_V(n) asm volatile("s_waitcnt vmcnt(" #n ")" ::: "memory")
#define PG8_WAIT_L(n) asm volatile("s_waitcnt lgkmcnt(" #n ")" ::: "memory")
#define PG8_BAR __builtin_amdgcn_s_barrier()
#define PG8_SCHED __builtin_amdgcn_sched_barrier(0)
    Unit cur, nxt; int ui = 0;
    if (!S.next(0, cur)) return;
    f32x4 acc[2][2][4][2];
#pragma unroll
    for (int a = 0; a < 2; ++a)
#pragma unroll
        for (int b = 0; b < 2; ++b)
#pragma unroll
            for (int m = 0; m < 4; ++m)
#pragma unroll
                for (int n = 0; n < 2; ++n) acc[a][b][m][n] = (f32x4){0.f, 0.f, 0.f, 0.f};
    bf16x8 At[4][2], B0[2][2], B1[2][2];
    const char* cA = (const char*)g.A + (size_t)cur.pm * tstep; const char* cB = (const char*)g.Bt + (size_t)cur.pn * tstep;
    S.a_ready(cur);
    if constexpr (SP2) {
        PG8_STAGE(PG8_SB(0, 0), cB, voffB); PG8_STAGE(PG8_SB(0, 1), cB + hstep, voffB); PG8_STAGE(PG8_SA(0, 0), cA, voffA); PG8_STAGE(PG8_SA(0, 1), cA + hstep, voffA);
        if (wr == 1) PG8_BAR;
        PG8_WAIT_V(2); PG8_BAR;
        PG8_STAGE(PG8_SB(1, 0), cB + kstep, voffB); PG8_STAGE(PG8_SA(1, 0), cA + kstep, voffA); PG8_STAGE(PG8_SB(1, 1), cB + hstep + kstep, voffB);
        PG8_WAIT_V(6); PG8_BAR;
    } else {
        PG8_STAGE(PG8_SB(0, 0), cB, voffB); PG8_STAGE(PG8_SA(0, 0), cA, voffA); PG8_STAGE(PG8_SB(0, 1), cB + hstep, voffB); PG8_STAGE(PG8_SA(0, 1), cA + hstep, voffA);
        if (wr == 1) PG8_BAR;
        PG8_WAIT_V(4); PG8_BAR;
        PG8_STAGE(PG8_SB(1, 0), cB + kstep, voffB); PG8_STAGE(PG8_SA(1, 0), cA + kstep, voffA); PG8_STAGE(PG8_SB(1, 1), cB + hstep + kstep, voffB);
        PG8_WAIT_V(6); PG8_BAR;
    }
    for (;;) {
        const bool has_next = S.next(ui + 1, nxt);
        const char* nA = has_next ? (const char*)g.A + (size_t)nxt.pm * tstep : cA; const char* nB = has_next ? (const char*)g.Bt + (size_t)nxt.pn * tstep : cB;
        for (int t = 0; t < nt; t += 2) {
            const bool last = (t == nt - 2);
            const char* a1 = cA + (size_t)(t + 1) * kstep;
            const char* a2 = last ? nA : cA + (size_t)(t + 2) * kstep; const char* b2 = last ? nB : cB + (size_t)(t + 2) * kstep;
            const char* a3 = a2 + kstep; const char* b3 = b2 + kstep;
            if (last && has_next) S.a_ready(nxt);
            if constexpr (SP2) {
            PG8_LDB(B0, 0, 0); PG8_LDB(B1, 0, 1); PG8_SCHED; PG8_LDA(At, 0, 0); PG8_STAGE(PG8_SA(1, 1), a1 + hstep, voffA);
            PG8_WAIT_V(8); PG8_WAIT_L(0); PG8_BAR; PG8_MMA(0, 0, At, B0); PG8_MMA(0, 1, At, B1); PG8_BAR; PG8_SCHED;
            PG8_LDA(At, 0, 1); PG8_STAGE(PG8_SB(0, 0), b2, voffB); PG8_STAGE(PG8_SB(0, 1), b2 + hstep, voffB); PG8_STAGE(PG8_SA(0, 0), a2, voffA);
            PG8_WAIT_V(8); PG8_WAIT_L(0); PG8_BAR; PG8_MMA(1, 0, At, B0); PG8_MMA(1, 1, At, B1); PG8_BAR; PG8_SCHED;
            PG8_LDB(B0, 1, 0); PG8_LDB(B1, 1, 1); PG8_SCHED; PG8_LDA(At, 1, 0); PG8_STAGE(PG8_SA(0, 1), a2 + hstep, voffA);
            PG8_WAIT_V(8); PG8_WAIT_L(0); PG8_BAR; PG8_MMA(0, 0, At, B0); PG8_MMA(0, 1, At, B1); PG8_BAR; PG8_SCHED;
            PG8_LDA(At, 1, 1); PG8_STAGE(PG8_SB(1, 0), b3, voffB); PG8_STAGE(PG8_SB(1, 1), b3 + hstep, voffB); PG8_STAGE(PG8_SA(1, 0), a3, voffA);
            PG8_WAIT_V(8); PG8_WAIT_L(0); PG8_BAR; PG8_MMA(1, 0, At, B0); PG8_MMA(1, 1, At, B1); PG8_BAR; PG8_SCHED;
            } else {
            PG8_LDB(B0, 0, 0); PG8_SCHED; PG8_LDA(At, 0, 0); PG8_STAGE(PG8_SA(1, 1), a1 + hstep, voffA);
            PG8_WAIT_L(8); PG8_BAR; PG8_WAIT_L(0); PG8_MMA(0, 0, At, B0); PG8_BAR; PG8_SCHED;
            PG8_LDB(B1, 0, 1); PG8_STAGE(PG8_SB(0, 0), b2, voffB);
            PG8_BAR; PG8_WAIT_L(0); PG8_MMA(0, 1, At, B1); PG8_BAR;
            PG8_LDA(At, 0, 1); PG8_STAGE(PG8_SA(0, 0), a2, voffA);
            PG8_BAR; PG8_WAIT_L(0); PG8_MMA(1, 0, At, B0); PG8_BAR; PG8_SCHED;
            PG8_STAGE(PG8_SB(0, 1), b2 + hstep, voffB);
            PG8_WAIT_V(6); PG8_BAR; PG8_MMA(1, 1, At, B1); PG8_BAR;
            PG8_LDB(B0, 1, 0); PG8_SCHED; PG8_LDA(At, 1, 0); PG8_STAGE(PG8_SA(0, 1), a2 + hstep, voffA);
            PG8_WAIT_L(8); PG8_BAR; PG8_WAIT_L(0); PG8_MMA(0, 0, At, B0); PG8_BAR; PG8_SCHED;
            PG8_LDB(B1, 1, 1); PG8_STAGE(PG8_SB(1, 0), b3, voffB);
            PG8_BAR; PG8_WAIT_L(0); PG8_MMA(0, 1, At, B1); PG8_BAR;
            PG8_LDA(At, 1, 1); PG8_STAGE(PG8_SA(1, 0), a3, voffA);
            PG8_BAR; PG8_WAIT_L(0); PG8_MMA(1, 0, At, B0); PG8_BAR; PG8_SCHED;
            PG8_STAGE(PG8_SB(1, 1), b3 + hstep, voffB);
            PG8_WAIT_V(6); PG8_BAR; PG8_MMA(1, 1, At, B1); PG8_BAR;
            }
        }
        if constexpr (ALIGN_EPI) { if (wr == 0) PG8_BAR; }
        if constexpr (!Epi::AFTER_DRAIN) { E(acc, cur, wr, wc, fr, fq); S.done(cur); }
        if (!has_next) break;
#pragma unroll
        for (int a = 0; a < 2; ++a)
#pragma unroll
            for (int b = 0; b < 2; ++b)
#pragma unroll
                for (int m = 0; m < 4; ++m)
#pragma unroll
                    for (int n = 0; n < 2; ++n) acc[a][b][m][n] = (f32x4){0.f, 0.f, 0.f, 0.f};
        cur = nxt; cA = nA; cB = nB; ++ui;
        if constexpr (ALIGN_EPI) { if (wr == 1) PG8_BAR; }
    }
    PG8_WAIT_V(0);
    if constexpr (!ALIGN_EPI) { if (wr == 0) PG8_BAR; }
    PG8_BAR;
    if constexpr (Epi::AFTER_DRAIN) { E.fused(acc, cur, wr, wc, fr, fq, lds, wid, lane); S.done(cur); }
#undef PG8_SA
#undef PG8_SB
#undef PG8_STAGE
#undef PG8_LDA
#undef PG8_LDB
#undef PG8_MMA
#undef PG8_WAIT_V
#undef PG8_WAIT_L
#undef PG8_BAR
#undef PG8_SCHED
}
}
#define PG8_SP2 true
#define PG8_ALIGN true

using pg8::f32x4; using pg8::Unit; using pg8::BM; using pg8::HALF; typedef pg8::u32x4 u32x4;
typedef unsigned short bf16_t;

struct EpiZ {
    static constexpr bool PERM = true, AFTER_DRAIN = false;
    bf16_t* z; float* out;
    __device__ __forceinline__ void operator()(const f32x4 (&acc)[2][2][4][2], const Unit& u, int wr, int wc, int fr, int fq) const {
        const int colt = u.pn * BM;
        const int mode = colt < CSH ? 0 : (colt < C_G0 ? 1 : 2);
        const int row0 = u.pm * BM + wr * 64 + fr, col0 = colt + wc * 32 + 8 * fq;
#pragma unroll
        for (int ai = 0; ai < 2; ++ai)
#pragma unroll
            for (int m = 0; m < 4; ++m) {
                const int row = row0 + ai * HALF + m * 16;
                bf16_t* rowp = z + (size_t)row * CIN + col0;
                bool last; float* sh;
                if (row < MP) { last = (row & (TP - 1)) == TP - 1; sh = out + O_SHP + (size_t)(row / TP) * CSH + col0; }
                else { const int rs = row - MP; last = (rs & (TS - 1)) == TS - 1; sh = out + O_SHS + (size_t)(rs / TS) * CSH + col0; }
#pragma unroll
                for (int bj = 0; bj < 2; ++bj) {
                    f32x4 v0 = acc[ai][bj][m][0], v1 = acc[ai][bj][m][1];
                    if (mode == 0) { if (last) { *(f32x4*)(sh + bj * HALF) = v0; *(f32x4*)(sh + bj * HALF + 4) = v1; } }
                    else if (mode == 1) {
#pragma unroll
                        for (int e = 0; e < 4; ++e) { v0[e] = gelu_tanh(v0[e]); v1[e] = gelu_tanh(v1[e]); }
                    } else {
#pragma unroll
                        for (int e = 0; e < 4; ++e) { v0[e] = sigmoidf_(v0[e]); v1[e] = sigmoidf_(v1[e]); }
                    }
                    u32x4 w; w.x = pk2(v0[0], v0[1]); w.y = pk2(v0[2], v0[3]); w.z = pk2(v1[0], v1[1]); w.w = pk2(v1[2], v1[3]);
                    *(u32x4*)(rowp + bj * HALF) = w;
                }
            }
    }
};
struct EpiMerge {
    static constexpr bool PERM = true, AFTER_DRAIN = false;
    const bf16_t* z; bf16_t* mg;
    __device__ __forceinline__ void operator()(const f32x4 (&acc)[2][2][4][2], const Unit& u, int wr, int wc, int fr, int fq) const {
        const int which = u.pm >= 36 ? 1 : 0, pm = u.pm - 36 * which, pn = u.pn - 8 * which;
        const int row0 = pm * BM + wr * 64 + fr, col0 = pn * BM + wc * 32 + 8 * fq;
        const int gcol = which ? C_G1 : C_G0;
#pragma unroll
        for (int ai = 0; ai < 2; ++ai)
#pragma unroll
            for (int m = 0; m < 4; ++m) {
                const int row = row0 + ai * HALF + m * 16;
#pragma unroll
                for (int bj = 0; bj < 2; ++bj) {
                    const u32x4 gw = *(const u32x4*)(z + (size_t)row * CIN + gcol + col0 + bj * HALF);
                    bf16_t* mp = mg + (size_t)row * D + col0 + bj * HALF;
                    u32x4 pw = (u32x4){0u, 0u, 0u, 0u};
                    if (which) pw = *(const u32x4*)mp;
                    const f32x4 v0 = acc[ai][bj][m][0], v1 = acc[ai][bj][m][1];
                    u32x4 w;
                    w.x = pk2(bflo(pw.x) + bflo(gw.x) * v0[0], bfhi(pw.x) + bfhi(gw.x) * v0[1]);
                    w.y = pk2(bflo(pw.y) + bflo(gw.y) * v0[2], bfhi(pw.y) + bfhi(gw.y) * v0[3]);
                    w.z = pk2(bflo(pw.z) + bflo(gw.z) * v1[0], bfhi(pw.z) + bfhi(gw.z) * v1[1]);
                    w.w = pk2(bflo(pw.w) + bflo(gw.w) * v1[2], bfhi(pw.w) + bfhi(gw.w) * v1[3]);
                    *(u32x4*)mp = w;
                }
            }
    }
};
struct EpiRes1 {
    static constexpr bool PERM = false, AFTER_DRAIN = false;
    const float* xp; const float* xs; const float* mod; float* out;
    __device__ __forceinline__ void operator()(const f32x4 (&acc)[2][2][4][2], const Unit& u, int wr, int wc, int fr, int fq) const {
        const int row0 = u.pm * BM + wr * 64 + fr, col0 = u.pn * BM + wc * 32 + 4 * fq;
#pragma unroll
        for (int ai = 0; ai < 2; ++ai)
#pragma unroll
            for (int m = 0; m < 4; ++m) {
                const int row = row0 + ai * HALF + m * 16;
                const float* xr = (row < MP ? xp + (size_t)row * D : xs + (size_t)(row - MP) * D) + col0;
                const float* gm = mod + (size_t)seq_of_row(row) * (6 * D) + 2 * D + col0;
                float* o = out + (size_t)row * D + col0;
#pragma unroll
                for (int bj = 0; bj < 2; ++bj)
#pragma unroll
                    for (int n = 0; n < 2; ++n) { const int c = bj * HALF + n * 16;
                        *(f32x4*)(o + c) = *(const f32x4*)(xr + c) + *(const f32x4*)(gm + c) * acc[ai][bj][m][n]; }
            }
    }
};
struct EpiSwiglu {
    static constexpr bool PERM = true, AFTER_DRAIN = false;
    bf16_t* act;
    __device__ __forceinline__ void operator()(const f32x4 (&acc)[2][2][4][2], const Unit& u, int wr, int wc, int fr, int fq) const {
        const int row0 = u.pm * BM + wr * 64 + fr, col0 = u.pn * HALF + wc * 32 + 8 * fq;
#pragma unroll
        for (int ai = 0; ai < 2; ++ai)
#pragma unroll
            for (int m = 0; m < 4; ++m) {
                const int row = row0 + ai * HALF + m * 16;
                float r[8];
#pragma unroll
                for (int n = 0; n < 2; ++n)
#pragma unroll
                    for (int e = 0; e < 4; ++e) { const float g = acc[ai][0][m][n][e]; r[4 * n + e] = g * sigmoidf_(g) * acc[ai][1][m][n][e]; }
                u32x4 w; w.x = pk2(r[0], r[1]); w.y = pk2(r[2], r[3]); w.z = pk2(r[4], r[5]); w.w = pk2(r[6], r[7]);
                *(u32x4*)(act + (size_t)row * DFF + col0) = w;
            }
    }
};
struct EpiRes2 {
    static constexpr bool PERM = false, AFTER_DRAIN = false;
    const float* mod; float* out;
    __device__ __forceinline__ void operator()(const f32x4 (&acc)[2][2][4][2], const Unit& u, int wr, int wc, int fr, int fq) const {
        const int row0 = u.pm * BM + wr * 64 + fr, col0 = u.pn * BM + wc * 32 + 4 * fq;
#pragma unroll
        for (int ai = 0; ai < 2; ++ai)
#pragma unroll
            for (int m = 0; m < 4; ++m) {
                const int row = row0 + ai * HALF + m * 16;
                const float* gf = mod + (size_t)seq_of_row(row) * (6 * D) + 5 * D + col0;
                float* o = out + (size_t)row * D + col0;
#pragma unroll
                for (int bj = 0; bj < 2; ++bj)
#pragma unroll
                    for (int n = 0; n < 2; ++n) { const int c = bj * HALF + n * 16;
                        *(f32x4*)(o + c) = *(const f32x4*)(o + c) + *(const f32x4*)(gf + c) * acc[ai][bj][m][n]; }
            }
    }
};
struct BranchOrder {
    int G, c;
    __device__ bool next(int i, Unit& u) const { const int t = (i >> 1) * G + c; if (t >= (M / BM) * (D / BM)) return false; const int which = i & 1;
        u.pm = t / (D / BM) + (M / BM) * which; u.pn = t % (D / BM) + (D / BM) * which; return true; }
    __device__ __forceinline__ void a_ready(const Unit&) const {}
    __device__ __forceinline__ void done(const Unit&) const {}
};

#define GAS __attribute__((address_space(1)))
#define LAS __attribute__((address_space(3)))
typedef GAS unsigned gu32;
#define RLX_AGENT __ATOMIC_RELAXED, __HIP_MEMORY_SCOPE_AGENT
#define LDS_WAIT() asm volatile("s_waitcnt lgkmcnt(0)" ::: "memory")
#define VM_WAIT() asm volatile("s_waitcnt vmcnt(0)" ::: "memory")
#define XB_TMO      128
#define XB_XCNT(j)  (256  + 64 * (j))
#define XB_XSUB(j)  (1280 + 64 * (j))
#define XB_XGEN(j)  (2304 + 64 * (j))
#define XB_TOP      3328
#define XB_TOPGEN   3392
#define XCD_BAR_WORDS 3456
#define XB_SPIN_CAP (1u << 18)

__device__ __forceinline__ unsigned xb_ld(unsigned* p)              { return __hip_atomic_load(p, __ATOMIC_RELAXED, __HIP_MEMORY_SCOPE_AGENT); }
__device__ __forceinline__ unsigned xb_add(unsigned* p, unsigned v) { return __hip_atomic_fetch_add(p, v, __ATOMIC_RELAXED, __HIP_MEMORY_SCOPE_AGENT); }
__device__ __forceinline__ unsigned xb_xcc_id() { return (unsigned)__builtin_amdgcn_s_getreg((3 << 11) | 20) & 0xFu; }
#define XB_SPIN(cond, bar) do { unsigned _sp = 0; while (cond) { __builtin_amdgcn_s_sleep(1); \
    if ((++_sp & 255u) == 0u) { if (xb_ld(&(bar)[XB_TMO])) break; if (_sp > XB_SPIN_CAP) { atomicAdd(&(bar)[XB_TMO], 1u); break; } } } } while (0)

struct XcdBarrier {
    unsigned* bar; unsigned x;
    volatile LAS unsigned* st;
};

__device__ __forceinline__ XcdBarrier xcd_barrier_post(unsigned* bar, volatile LAS unsigned* st) {
    XcdBarrier b; b.bar = bar; b.x = xb_xcc_id(); b.st = st;
    if (threadIdx.x == 0) (void)xb_add(&bar[XB_XCNT(b.x)], 1u);
    return b;
}
__device__ __forceinline__ void xcd_barrier_complete(unsigned* bar, unsigned x, unsigned& nloc, unsigned& nx) {
    const unsigned G = gridDim.x * gridDim.y * gridDim.z;
    unsigned sum, cnt, mine, sp = 0u;
    for (;;) {
        sum = 0u; cnt = 0u; mine = 0u;
#pragma unroll
        for (unsigned j = 0; j < 16; ++j) { const unsigned c = xb_ld(&bar[XB_XCNT(j)]); sum += c; cnt += (c > 0u) ? 1u : 0u; mine = (j == x) ? c : mine; }
        if (sum == G) break;
        __builtin_amdgcn_s_sleep(1);
        if ((++sp & 255u) == 0u) { if (xb_ld(&bar[XB_TMO])) break; if (sp > XB_SPIN_CAP) { atomicAdd(&bar[XB_TMO], 1u); break; } }
    }
    nloc = mine > 0u ? mine : 1u; nx = cnt > 0u ? cnt : 1u;
}

__device__ __forceinline__ void xcd_barrier(const XcdBarrier& b) {
    asm volatile("s_waitcnt vmcnt(0)" ::: "memory");
    __syncthreads();
    if (threadIdx.x == 0) {
        unsigned* bar = b.bar;
        __builtin_amdgcn_s_waitcnt(0);
        unsigned nloc = b.st[0], nx = b.st[1];
        if (nloc == 0u) { xcd_barrier_complete(bar, b.x, nloc, nx); b.st[0] = nloc; b.st[1] = nx; }
        const unsigned old = xb_add(&bar[XB_XSUB(b.x)], 1u);
        const unsigned gen = old / nloc;
        if (old + 1u == (gen + 1u) * nloc) {
            __builtin_amdgcn_fence(__ATOMIC_RELEASE, "agent");
            asm volatile("s_waitcnt vmcnt(0)" ::: "memory");
            const unsigned og = xb_add(&bar[XB_TOP], 1u);
            const unsigned tg = og / nx;
            if (og + 1u == (tg + 1u) * nx) xb_add(&bar[XB_TOPGEN], 1u);
            else XB_SPIN(xb_ld(&bar[XB_TOPGEN]) == tg, bar);
            __builtin_amdgcn_fence(__ATOMIC_ACQUIRE, "agent");
            xb_add(&bar[XB_XGEN(b.x)], 1u);
            asm volatile("s_waitcnt vmcnt(0)" ::: "memory");
        } else {
            XB_SPIN(xb_ld(&bar[XB_XGEN(b.x)]) == gen, bar);
            __builtin_amdgcn_fence(__ATOMIC_ACQUIRE, "agent");
            asm volatile("s_waitcnt vmcnt(0)" ::: "memory");
        }
    }
    __syncthreads();
}

constexpr int NWAVES = 8, NTHR = NWAVES * 64;
constexpr int RING_BYTES = 131072, LDSCTL_OFF = RING_BYTES, MISC_OFF = LDSCTL_OFF + 320, LDS_BYTES = 147456;
typedef pg8::bf16x8 bf16x8;

__device__ __forceinline__ void p0_mod_slab(const P& p, LAS float* red, int slab, int tid, int lane, int wave) {
    for (int i = tid; i < 144 * 48; i += NTHR) red[i] = 0.f;
    __syncthreads();
    const int n0 = slab * 48, fr = lane & 15, fq = lane >> 4;
    const float* W = p.in[6];
    f32x4 acc[9][3];
#pragma unroll
    for (int a = 0; a < 9; ++a)
#pragma unroll
        for (int b = 0; b < 3; ++b) acc[a][b] = (f32x4){0.f, 0.f, 0.f, 0.f};
    for (int kb = 0; kb < 8; ++kb) {
        const int k0 = wave * 256 + kb * 32 + fq * 8;
        bf16x8 bfr[3];
#pragma unroll
        for (int nt = 0; nt < 3; ++nt) {
            const float* wp = W + (size_t)k0 * (6 * D) + n0 + nt * 16 + fr;
            u32x4 w;
            w.x = pk2(wp[0], wp[(size_t)1 * 6 * D]); w.y = pk2(wp[(size_t)2 * 6 * D], wp[(size_t)3 * 6 * D]);
            w.z = pk2(wp[(size_t)4 * 6 * D], wp[(size_t)5 * 6 * D]); w.w = pk2(wp[(size_t)6 * 6 * D], wp[(size_t)7 * 6 * D]);
            bfr[nt] = __builtin_bit_cast(bf16x8, w);
        }
#pragma unroll
        for (int mt = 0; mt < 9; ++mt) {
            const int row = mt * 16 + fr;
            u32x4 aw = (u32x4){0u, 0u, 0u, 0u};
            if (row < NSEQ) {
                const float* c = (row < NPB ? p.in[4] + (size_t)row * D : p.in[5] + (size_t)(row - NPB) * D) + k0;
                const f32x4 c0 = *(const f32x4*)c, c1 = *(const f32x4*)(c + 4);
                aw.x = pk2(c0[0] * sigmoidf_(c0[0]), c0[1] * sigmoidf_(c0[1])); aw.y = pk2(c0[2] * sigmoidf_(c0[2]), c0[3] * sigmoidf_(c0[3]));
                aw.z = pk2(c1[0] * sigmoidf_(c1[0]), c1[1] * sigmoidf_(c1[1])); aw.w = pk2(c1[2] * sigmoidf_(c1[2]), c1[3] * sigmoidf_(c1[3]));
            }
            const bf16x8 afr = __builtin_bit_cast(bf16x8, aw);
#pragma unroll
            for (int nt = 0; nt < 3; ++nt) acc[mt][nt] = __builtin_amdgcn_mfma_f32_16x16x32_bf16(afr, bfr[nt], acc[mt][nt], 0, 0, 0);
        }
    }
#pragma unroll
    for (int mt = 0; mt < 9; ++mt)
#pragma unroll
        for (int nt = 0; nt < 3; ++nt)
#pragma unroll
            for (int r = 0; r < 4; ++r) __hip_atomic_fetch_add(red + (mt * 16 + 4 * fq + r) * 48 + nt * 16 + fr, acc[mt][nt][r], __ATOMIC_RELAXED, __HIP_MEMORY_SCOPE_WORKGROUP);
    __syncthreads();
    float* mod = (float*)(p.ws + WS_MOD);
    for (int i = tid; i < NSEQ * 48; i += NTHR) { const int row = i / 48, c = i % 48; mod[(size_t)row * (6 * D) + n0 + c] = red[row * 48 + c] + p.in[7][n0 + c]; }
    __syncthreads();
}
__device__ __forceinline__ void p0_transpose_item(const float* W, int K, int N, bf16_t* WT, bool swz, LAS float* scr, int item, int lane) {
    const int nblk = N / 32, kb = item / nblk, nb = item % nblk, k0 = 64 * kb, n0 = 32 * nb;
    int r0 = n0;
    if (swz) { r0 = n0 < DFF ? 256 * (n0 >> 7) + (n0 & 127) : 256 * ((n0 - DFF) >> 7) + 128 + ((n0 - DFF) & 127); }
#pragma unroll 8
    for (int i = 0; i < 32; ++i) { const int kk = 2 * i + (lane >> 5); scr[kk * 33 + (lane & 31)] = W[(size_t)(k0 + kk) * N + n0 + (lane & 31)]; }
    LDS_WAIT(); asm volatile("" ::: "memory");
    const int c = lane & 7;
#pragma unroll
    for (int j = 0; j < 4; ++j) { const int n = (lane >> 3) + 8 * j; const LAS float* s = scr + (8 * c) * 33 + n;
        u32x4 o; o.x = pk2(s[0 * 33], s[1 * 33]); o.y = pk2(s[2 * 33], s[3 * 33]); o.z = pk2(s[4 * 33], s[5 * 33]); o.w = pk2(s[6 * 33], s[7 * 33]);
        *(u32x4*)(WT + (size_t)(r0 + n) * K + k0 + 8 * c) = o; }
    LDS_WAIT(); asm volatile("" ::: "memory");
}
__device__ __forceinline__ void p0_transposes(const P& p, LAS float* scr, int gw, int NGW, int lane) {
    constexpr int I_IN = (D / 64) * (CIN / 32), I_BA = (RW / 64) * (D / 32), I_OUT = (D / 64) * (D / 32), I_FI = (D / 64) * (2 * DFF / 32), I_FO = (DFF / 64) * (D / 32);
    constexpr int NITEMS = I_IN + 2 * I_BA + I_OUT + I_FI + I_FO;
    unsigned char* ws = p.ws;
    for (int it = gw; it < NITEMS; it += NGW) {
        int r = it;
        if (r < I_IN) { p0_transpose_item(p.in[9], D, CIN, (bf16_t*)(ws + WS_WIN), false, scr, r, lane); continue; } r -= I_IN;
        if (r < I_BA) { p0_transpose_item(p.in[25], RW, D, (bf16_t*)(ws + WS_WBA), false, scr, r, lane); continue; } r -= I_BA;
        if (r < I_BA) { p0_transpose_item(p.in[26], RW, D, (bf16_t*)(ws + WS_WBB), false, scr, r, lane); continue; } r -= I_BA;
        if (r < I_OUT) { p0_transpose_item(p.in[27], D, D, (bf16_t*)(ws + WS_WOUT), false, scr, r, lane); continue; } r -= I_OUT;
        if (r < I_FI) { p0_transpose_item(p.in[29], D, 2 * DFF, (bf16_t*)(ws + WS_WFI), true, scr, r, lane); continue; } r -= I_FI;
        p0_transpose_item(p.in[30], DFF, D, (bf16_t*)(ws + WS_WFO), false, scr, r, lane);
    }
}
__device__ __forceinline__ void norm_row(const float* x, const float* g, const float* scale, const float* shift, bf16_t* h, int lane) {
    f32x4 v[8]; float s = 0.f;
#pragma unroll
    for (int j = 0; j < 8; ++j) { v[j] = *(const f32x4*)(x + 4 * lane + 256 * j); s += (v[j][0] * v[j][0] + v[j][1] * v[j][1]) + (v[j][2] * v[j][2] + v[j][3] * v[j][3]); }
    const float rstd = rsqrtf(wave_sum(s) * (1.f / D) + 1e-6f);
#pragma unroll
    for (int j = 0; j < 8; ++j) { const int k = 4 * lane + 256 * j;
        const f32x4 gg = *(const f32x4*)(g + k), sc = *(const f32x4*)(scale + k), sh = *(const f32x4*)(shift + k);
        const f32x4 o = v[j] * rstd * gg * (sc + 1.f) + sh;
        u32x2v w; w.x = pk2(o[0], o[1]); w.y = pk2(o[2], o[3]); *(u32x2v*)(h + k) = w; }
}
__device__ __forceinline__ void phase_norm(const P& p, int which, int gw, int NGW, int lane) {
    const float* g = which == 0 ? p.in[8] : p.in[28];
    for (int row = gw; row < M; row += NGW) {
        const float* x = which == 0 ? (row < MP ? p.in[0] + (size_t)row * D : p.in[1] + (size_t)(row - MP) * D) : p.out + (size_t)row * D;
        const float* mod = (const float*)(p.ws + WS_MOD) + (size_t)seq_of_row(row) * (6 * D);
        norm_row(x, g, mod + (which == 0 ? 1 : 4) * D, mod + (which == 0 ? 0 : 3) * D, (bf16_t*)(p.ws + WS_H) + (size_t)row * D, lane);
    }
}
__device__ __forceinline__ void phase_lnv(const P& p, int gw, int NGW, int lane) {
    for (int row = gw; row < M; row += NGW) {
        const bf16_t* zv = (const bf16_t*)(p.ws + WS_Z) + (size_t)row * CIN + C_V;
        float v[16]; float s = 0.f;
#pragma unroll
        for (int j = 0; j < 2; ++j) { const u32x4 w = *(const u32x4*)(zv + 8 * lane + 512 * j);
            v[8 * j + 0] = bflo(w.x); v[8 * j + 1] = bfhi(w.x); v[8 * j + 2] = bflo(w.y); v[8 * j + 3] = bfhi(w.y);
            v[8 * j + 4] = bflo(w.z); v[8 * j + 5] = bfhi(w.z); v[8 * j + 6] = bflo(w.w); v[8 * j + 7] = bfhi(w.w); }
#pragma unroll
        for (int i = 0; i < 16; ++i) s += v[i];
        const float mean = wave_sum(s) * (1.f / MLPW);
        float q = 0.f;
#pragma unroll
        for (int i = 0; i < 16; ++i) { v[i] -= mean; q += v[i] * v[i]; }
        const float rstd = rsqrtf(wave_sum(q) * (1.f / MLPW) + 1e-5f);
        bf16_t* vn = (bf16_t*)(p.ws + WS_VN) + (size_t)row * MLPW;
#pragma unroll
        for (int j = 0; j < 2; ++j) { const int c = 8 * lane + 512 * j; float o[8];
#pragma unroll
            for (int e = 0; e < 8; ++e) o[e] = v[8 * j + e] * rstd * p.in[21][c + e] + p.in[22][c + e];
            u32x4 w; w.x = pk2(o[0], o[1]); w.y = pk2(o[2], o[3]); w.z = pk2(o[4], o[5]); w.w = pk2(o[6], o[7]);
            *(u32x4*)(vn + c) = w;
            if (row >= MP) { float* vs = p.out + O_VS + (size_t)(row - MP) * MLPW + c;
                *(f32x4*)vs = (f32x4){o[0], o[1], o[2], o[3]}; *(f32x4*)(vs + 4) = (f32x4){o[4], o[5], o[6], o[7]}; }
        }
    }
}
__device__ __forceinline__ void phase_final(const P& p, int gw, int NGW, int lane) {
    for (int row = gw; row < M; row += NGW) {
        float* x = p.out + (size_t)row * D;
        f32x4 v[8]; float s = 0.f;
#pragma unroll
        for (int j = 0; j < 8; ++j) { v[j] = *(const f32x4*)(x + 4 * lane + 256 * j); s += (v[j][0] * v[j][0] + v[j][1] * v[j][1]) + (v[j][2] * v[j][2] + v[j][3] * v[j][3]); }
        const float rstd = rsqrtf(wave_sum(s) * (1.f / D) + 1e-6f);
#pragma unroll
        for (int j = 0; j < 8; ++j) { const int k = 4 * lane + 256 * j; *(f32x4*)(x + k) = v[j] * rstd * *(const f32x4*)(p.in[31] + k); }
    }
}
__device__ __forceinline__ void wkv_naive_item(const P& p, float* sm, int item, int tid) {
    const int head = item % NH, sq = item / NH, lane = tid & 63, ch = head * HS + lane;
    const int vi = (tid >> 2) & 63, part = tid & 3;
    const bool prompt = sq < NPB, w0 = tid < 64, st_thr = tid < 256;
    const int T = prompt ? TP : TS, row0 = prompt ? sq * TP : MP + (sq - NPB) * TS;
    const bf16_t* z = (const bf16_t*)(p.ws + WS_Z);
    const float* mu = p.in[10];
    float *s_td = sm, *s_ad = sm + 64, *s_gd = sm + 128, *s_kk = sm + 256, *s_kka = sm + 320, *s_k = sm + 384, *s_w = sm + 448, *s_r = sm + 512, *s_v = sm + 576, *s_o = sm + 640;
    float S[16];
    if (prompt) {
#pragma unroll
        for (int k = 0; k < 16; ++k) S[k] = 0.f;
    } else {
        const float* st = p.in[2] + (((size_t)(sq - NPB) * NH + head) * HS + vi) * HS + part * 16;
#pragma unroll
        for (int k = 0; k < 16; ++k) S[k] = st[k];
    }
    const float* ss = p.in[3] + (size_t)(prompt ? 0 : sq - NPB) * CSH;
    float pr = prompt ? 0.f : ss[ch], pk = prompt ? 0.f : ss[RW + ch], pv = prompt ? 0.f : ss[2 * RW + ch];
    float pwd = prompt ? 0.f : ss[3072 + lane], pad = prompt ? 0.f : ss[3136 + lane], pg0 = prompt ? 0.f : ss[3200 + lane], pg1 = prompt ? 0.f : ss[3264 + lane];
    const float mur = mu[ch], muk = mu[RW + ch], muv = mu[2 * RW + ch], muwd = mu[3072 + lane], muad = mu[3136 + lane], mug0 = mu[3200 + lane], mug1 = mu[3264 + lane];
    const float w0c = p.in[11][ch], a0c = p.in[13][ch], kkc = p.in[16][ch], kac = p.in[17][ch], rkc = p.in[18][ch], gng = p.in[19][ch], gnb = p.in[20][ch];
    const float* wdu = p.in[12] + ch; const float* wau = p.in[14] + ch; const float* wgu = p.in[15] + ch;
    bf16_t* oa = (bf16_t*)(p.ws + WS_OA);
    for (int t = 0; t < T; ++t) {
        const bf16_t* zr = z + (size_t)(row0 + t) * CIN;
        float r = 0.f, k = 0.f, v = 0.f, g = 0.f, bonus = 0.f;
        if (w0) {
            float c;
            c = bf2f(zr[ch]); r = c + (pr - c) * mur; pr = c;
            c = bf2f(zr[RW + ch]); k = c + (pk - c) * muk; pk = c;
            c = bf2f(zr[2 * RW + ch]); v = c + (pv - c) * muv; pv = c;
            c = bf2f(zr[3072 + lane]); s_td[lane] = tanhf(c + (pwd - c) * muwd); pwd = c;
            c = bf2f(zr[3136 + lane]); s_ad[lane] = c + (pad - c) * muad; pad = c;
            c = bf2f(zr[3200 + lane]); s_gd[lane] = sigmoidf_(c + (pg0 - c) * mug0); pg0 = c;
            c = bf2f(zr[3264 + lane]); s_gd[64 + lane] = sigmoidf_(c + (pg1 - c) * mug1); pg1 = c;
        }
        __syncthreads();
        if (w0) {
            float wraw = w0c, apre = a0c;
#pragma unroll 4
            for (int j = 0; j < 64; ++j) { wraw += s_td[j] * wdu[(size_t)j * RW]; apre += s_ad[j] * wau[(size_t)j * RW]; }
#pragma unroll 4
            for (int j = 0; j < 128; ++j) g += s_gd[j] * wgu[(size_t)j * RW];
            const float wdec = __expf(-0.6065306597126334f * sigmoidf_(wraw));
            const float a = sigmoidf_(apre);
            float kkv = k * kkc; const float nrm = sqrtf(wave_sum(kkv * kkv)); kkv = kkv / fmaxf(nrm, 1e-12f);
            const float kmod = k * (1.f + (a - 1.f) * kac);
            bonus = wave_sum(r * kmod * rkc);
            s_kk[lane] = kkv; s_kka[lane] = kkv * a; s_k[lane] = kmod; s_w[lane] = wdec; s_r[lane] = r; s_v[lane] = v;
        }
        __syncthreads();
        if (st_thr) {
            float sa = 0.f;
#pragma unroll
            for (int kk = 0; kk < 16; ++kk) sa -= S[kk] * s_kk[part * 16 + kk];
            sa += __shfl_xor(sa, 1); sa += __shfl_xor(sa, 2);
            const float vv = s_v[vi];
            float o = 0.f;
#pragma unroll
            for (int kk = 0; kk < 16; ++kk) { const int kx = part * 16 + kk; S[kk] = S[kk] * s_w[kx] + sa * s_kka[kx] + vv * s_k[kx]; o += S[kk] * s_r[kx]; }
            o += __shfl_xor(o, 1); o += __shfl_xor(o, 2);
            if (part == 0) s_o[vi] = o;
        }
        __syncthreads();
        if (w0) {
            const float o = s_o[lane];
            const float mean = wave_sum(o) * (1.f / HS); const float dlt = o - mean; const float var = wave_sum(dlt * dlt) * (1.f / HS);
            const float on = dlt * rsqrtf(var + 64e-5f) * gng + gnb;
            oa[(size_t)(row0 + t) * RW + ch] = f2bf((on + bonus * v) * g);
        }
    }
    if (st_thr) {
        float* so = (prompt ? p.out + O_WKVP + (((size_t)sq * NH + head) * HS + vi) * HS : p.out + O_WKVS + (((size_t)(sq - NPB) * NH + head) * HS + vi) * HS) + part * 16;
#pragma unroll
        for (int k = 0; k < 16; ++k) so[k] = S[k];
    }
    __syncthreads();
}
__device__ __forceinline__ void mix_naive_row(const P& p, int row, int tid) {
    int t;
    if (row < MP) t = (row & (TP - 1)) & 127; else t = (row - MP) & (TS - 1);
    const int rowc0 = row - t;
    const bf16_t* vn = (const bf16_t*)(p.ws + WS_VN);
    const bf16_t* z = (const bf16_t*)(p.ws + WS_Z) + (size_t)row * CIN;
    bf16_t* ub = (bf16_t*)(p.ws + WS_UB) + (size_t)row * MLPW;
    for (int c = tid; c < MLPW; c += NTHR) {
        const int g = c >> 7; const float* wsg = p.in[23] + ((size_t)g * 128 + t) * 128;
        float acc = 0.f;
        for (int s = 0; s <= t; ++s) acc += wsg[s] * bf2f(vn[(size_t)(rowc0 + s) * MLPW + c]);
        acc += p.in[24][g * 128 + t];
        ub[c] = f2bf(bf2f(z[C_U + c]) * acc);
    }
}

__global__ void __launch_bounds__(NTHR, 2) mega_fwd(P p) {
    extern __shared__ __attribute__((aligned(16))) unsigned char lds_raw[];
    LAS unsigned char* lds = (LAS unsigned char*)lds_raw;
    volatile LAS unsigned* MISC = (volatile LAS unsigned*)(lds + MISC_OFF);
    const int tid = threadIdx.x, lane = tid & 63, wave = __builtin_amdgcn_readfirstlane(tid >> 6);
    const int G = gridDim.x, bx = blockIdx.x;
    const int gw = bx * NWAVES + wave, NGW = G * NWAVES;
    unsigned char* ws = p.ws;
    for (int u = tid; u < (LDS_BYTES - LDSCTL_OFF) / 4; u += NTHR) ((LAS unsigned*)(lds + LDSCTL_OFF))[u] = 0u;
    __syncthreads();
    XcdBarrier bar = xcd_barrier_post((unsigned*)(ws + WS_CTL) + CW_BAR, MISC + 8);

    for (int slab = bx; slab < 256; slab += G) p0_mod_slab(p, (LAS float*)lds, slab, tid, lane, wave);
    p0_transposes(p, (LAS float*)(lds + wave * 16384), gw, NGW, lane);
    xcd_barrier(bar);
    phase_norm(p, 0, gw, NGW, lane);
    xcd_barrier(bar);
    {
        pg8::Gemm g{(const bf16_t*)(ws + WS_H), (const bf16_t*)(ws + WS_WIN), M, CIN, D}; pg8::StaticOrder S; S.init(M, CIN, G, bx);
        EpiZ E{(bf16_t*)(ws + WS_Z), p.out};
        pg8::gemm_phase<EpiZ, pg8::StaticOrder, PG8_ALIGN, PG8_SP2>(lds, g, S, E);
    }
    xcd_barrier(bar);
    phase_lnv(p, gw, NGW, lane);
    xcd_barrier(bar);
    for (int item = bx; item < NSEQ * NH; item += G) wkv_naive_item(p, (float*)lds_raw, item, tid);
    for (int row = bx; row < M; row += G) mix_naive_row(p, row, tid);
    xcd_barrier(bar);
    {
        pg8::Gemm g{(const bf16_t*)(ws + WS_OA), (const bf16_t*)(ws + WS_WBA), 2 * M, 2 * D, RW}; BranchOrder S{G, bx};
        EpiMerge E{(const bf16_t*)(ws + WS_Z), (bf16_t*)(ws + WS_H)};
        pg8::gemm_phase<EpiMerge, BranchOrder, PG8_ALIGN, PG8_SP2>(lds, g, S, E);
    }
    xcd_barrier(bar);
    {
        pg8::Gemm g{(const bf16_t*)(ws + WS_H), (const bf16_t*)(ws + WS_WOUT), M, D, D}; pg8::StaticOrder S; S.init(M, D, G, bx);
        EpiRes1 E{p.in[0], p.in[1], (const float*)(ws + WS_MOD), p.out};
        pg8::gemm_phase<EpiRes1, pg8::StaticOrder, PG8_ALIGN, PG8_SP2>(lds, g, S, E);
    }
    xcd_barrier(bar);
    phase_norm(p, 1, gw, NGW, lane);
    xcd_barrier(bar);
    {
        pg8::Gemm g{(const bf16_t*)(ws + WS_H), (const bf16_t*)(ws + WS_WFI), M, 2 * DFF, D}; pg8::StaticOrder S; S.init(M, 2 * DFF, G, bx);
        EpiSwiglu E{(bf16_t*)(ws + WS_Z)};
        pg8::gemm_phase<EpiSwiglu, pg8::StaticOrder, PG8_ALIGN, PG8_SP2>(lds, g, S, E);
    }
    xcd_barrier(bar);
    {
        pg8::Gemm g{(const bf16_t*)(ws + WS_Z), (const bf16_t*)(ws + WS_WFO), M, D, DFF}; pg8::StaticOrder S; S.init(M, D, G, bx);
        EpiRes2 E{(const float*)(ws + WS_MOD), p.out};
        pg8::gemm_phase<EpiRes2, pg8::StaticOrder, PG8_ALIGN, PG8_SP2>(lds, g, S, E);
    }
    xcd_barrier(bar);
    phase_final(p, gw, NGW, lane);
}

extern "C" void kernel_launch(void* const* d_in, const int* in_sizes, int n_in, void* d_out, int out_size, void* d_ws, size_t ws_size, hipStream_t stream) {
    static int grid = 0;
    if (grid == 0) {
        if (n_in != 32 || (size_t)out_size != O_END || ws_size < WS_END) { fprintf(stderr, "kernel_launch: unexpected shapes n_in=%d out=%d ws=%zu (need %zu)\n", n_in, out_size, ws_size, (size_t)WS_END); grid = -1; return; }
        int dev = 0, cus = 0, per_cu = 0;
        if (hipGetDevice(&dev) != hipSuccess || hipDeviceGetAttribute(&cus, hipDeviceAttributeMultiprocessorCount, dev) != hipSuccess) { grid = -1; return; }
        if (hipFuncSetAttribute((const void*)mega_fwd, hipFuncAttributeMaxDynamicSharedMemorySize, LDS_BYTES) != hipSuccess) { fprintf(stderr, "kernel_launch: hipFuncSetAttribute failed\n"); grid = -1; return; }
        if (hipOccupancyMaxActiveBlocksPerMultiprocessor(&per_cu, (const void*)mega_fwd, NTHR, LDS_BYTES) != hipSuccess || per_cu < 1) { fprintf(stderr, "kernel_launch: occupancy query says %d blocks per CU\n", per_cu); }
        (void)hipGetLastError();
        grid = cus;
    }
    if (grid < 0) return;
    if (hipMemsetAsync((char*)d_ws + WS_CTL, 0, CTL_ZERO_BYTES, stream) != hipSuccess) { fprintf(stderr, "kernel_launch: memset failed\n"); return; }
    P p{};
    for (int i = 0; i < 32; ++i) p.in[i] = (const float*)d_in[i];
    p.out = (float*)d_out; p.ws = (unsigned char*)d_ws;
    hipLaunchKernelGGL(mega_fwd, dim3(grid), dim3(NTHR), LDS_BYTES, stream, p);
    const hipError_t le = hipPeekAtLastError();
    if (le != hipSuccess) fprintf(stderr, "kernel_launch: launch failed: %s\n", hipGetErrorName(le));
}
```

```cpp
#include <hip/hip_runtime.h>
#include <cstdio>
#include <cstdint>

constexpr int D = 2048, NPB = 4, TP = 2048, NSB = 128, TS = 8;
constexpr int MP = NPB * TP, MS = NSB * TS, M = MP + MS;
constexpr int RW = 1024, NH = 16, HS = 64;
constexpr int CSH = 3328, CIN = 9472, DFF = 5632, MLPW = 1024;
constexpr int C_U = CSH, C_V = CSH + 1024, C_G0 = CSH + 2048, C_G1 = C_G0 + 2048;
constexpr int ZUGW = CIN - CSH, ZU_U = 0, ZU_V = 1024, ZU_G0 = 2048, ZU_G1 = 4096;
constexpr int NSEQ = NPB + NSB;
constexpr size_t O_YP = 0, O_YS = O_YP + (size_t)MP * D, O_WKVP = O_YS + (size_t)MS * D, O_SHP = O_WKVP + (size_t)NPB * NH * HS * HS,
                 O_WKVS = O_SHP + (size_t)NPB * CSH, O_SHS = O_WKVS + (size_t)NSB * NH * HS * HS, O_VS = O_SHS + (size_t)NSB * CSH,
                 O_END = O_VS + (size_t)MS * MLPW;
constexpr size_t WS_CTL = 0, CTL_ZERO_BYTES = 1u << 20;
constexpr size_t WS_WIN = CTL_ZERO_BYTES;
constexpr size_t WS_WBA = WS_WIN + (size_t)CIN * D * 2;
constexpr size_t WS_WBB = WS_WBA + (size_t)D * RW * 2;
constexpr size_t WS_WOUT = WS_WBB + (size_t)D * RW * 2;
constexpr size_t WS_WFI = WS_WOUT + (size_t)D * D * 2;
constexpr size_t WS_WFO = WS_WFI + (size_t)2 * DFF * D * 2;
constexpr size_t WS_MOD = WS_WFO + (size_t)D * DFF * 2;
constexpr size_t WS_H = WS_MOD + (size_t)NSEQ * 6 * D * 4;
constexpr size_t WS_ZRW = WS_H + (size_t)M * D * 2;
constexpr size_t WS_ZUG = WS_ZRW + (size_t)M * CSH * 2;
constexpr size_t WS_VN = WS_ZUG + (size_t)M * ZUGW * 2;
constexpr size_t WS_OA = WS_VN + (size_t)M * MLPW * 2;
constexpr size_t WS_UB = WS_OA + (size_t)M * RW * 2;
constexpr size_t WS_C2 = WS_UB + (size_t)M * MLPW * 2;
constexpr size_t WS_LORA = WS_C2 + (size_t)M * RW * 2;
constexpr size_t WS_FRA_S = WS_LORA + (size_t)RW * 256 * 2;
constexpr size_t WS_FRB_S = WS_FRA_S + (size_t)NSB * NH * 4096;
constexpr size_t WS_END = WS_FRB_S + (size_t)NSB * NH * 8448;
constexpr int NREC_P = NPB * 128 * NH, NREC = NREC_P + NSB * NH;
constexpr int RECA = 4096, RECB = 8448;
static_assert((size_t)NREC_P * RECA <= (size_t)M * D * 2 && (size_t)NREC_P * RECB <= (size_t)M * D * 4, "prompt fragment records fit the H buffer / the y region of d_out");
constexpr int CW_BAR = 4096;

typedef float f32x2v __attribute__((ext_vector_type(2)));
typedef __bf16 bf16x2v __attribute__((ext_vector_type(2)));
typedef unsigned u32x2v __attribute__((ext_vector_type(2)));

struct P { const float* in[32]; float* out; unsigned char* ws; };

__device__ __forceinline__ unsigned pk2(float lo, float hi) { return __builtin_bit_cast(unsigned, __builtin_convertvector((f32x2v){lo, hi}, bf16x2v)); }
__device__ __forceinline__ unsigned short f2bf(float f) { return (unsigned short)(pk2(f, 0.f) & 0xffffu); }
__device__ __forceinline__ float bf2f(unsigned short h) { return __uint_as_float(((unsigned)h) << 16); }
__device__ __forceinline__ float bflo(unsigned w) { return __uint_as_float(w << 16); }
__device__ __forceinline__ float bfhi(unsigned w) { return __uint_as_float(w & 0xffff0000u); }
__device__ __forceinline__ float sigmoidf_(float x) { return 1.f / (1.f + __expf(-x)); }
__device__ __forceinline__ float gelu_tanh(float x) {
    const float u = 0.7978845608028654f * (x + 0.044715f * x * x * x); return x / (1.f + __expf(-2.f * u)); }
__device__ __forceinline__ float wave_sum(float v) {
#pragma unroll
    for (int o = 1; o < 64; o <<= 1) v += __shfl_xor(v, o);
    return v;
}
__device__ __forceinline__ int seq_of_row(int row) { return row < MP ? row / TP : NPB + (row - MP) / TS; }

namespace pg8 {
#define PG8_LAS __attribute__((address_space(3)))
typedef unsigned short bf16_t;
typedef short bf16x8 __attribute__((ext_vector_type(8)));
typedef float f32x4 __attribute__((ext_vector_type(4)));
typedef unsigned u32x4 __attribute__((ext_vector_type(4)));
constexpr int BM = 256, BK = 64, HALF = 128, HTB = HALF * BK * 2  , STAGE_BYTES = 8 * HTB, NXCD = 8, WGM = 8;

__host__ __device__ __forceinline__ int lds_byte(int r, int c) { const int st = (r >> 4) * 2 + (c >> 5), rr = r & 15, cc = c & 31, ob = rr * 64 + cc * 2; return st * 1024 + (ob ^ (((ob >> 9) & 1) << 5)); }
__host__ __device__ __forceinline__ void stage_rc(int b, int& R, int& C) { const int st = b / 1024, sb = b % 1024, swz = sb ^ (((sb >> 9) & 1) << 5); R = (st >> 1) * 16 + swz / 64; C = (st & 1) * 32 + (swz % 64) / 2; }
__host__ __device__ __forceinline__ int perm32(int rho) { const int n = rho >> 4, i = rho & 15; return 8 * (i >> 2) + 4 * n + (i & 3); }

struct Unit { int pm, pn; };
struct Gemm { const bf16_t* A; const bf16_t* Bt; int M, N, K; };

struct StaticOrder {
    int nM, nN, nwg, G, c;
    __host__ __device__ void init(int M, int N, int G_, int c_) { nM = M / BM; nN = N / BM; nwg = nM * nN; G = G_; c = c_; }
    __host__ __device__ bool next(int i, Unit& u) const {
        const long L = (long)i * G + c; if (L >= nwg) return false;
        int wgid = (int)L; { const int q = nwg / NXCD, r = nwg % NXCD, xcd = wgid % NXCD, off = wgid / NXCD; wgid = (xcd < r ? xcd * (q + 1) : r * (q + 1) + (xcd - r) * q) + off; }
        const int nig = WGM * nN, gid = wgid / nig, fm = gid * WGM, gsz = (nM - fm) < WGM ? (nM - fm) : WGM;
        u.pm = fm + ((wgid % nig) % gsz); u.pn = (wgid % nig) / gsz; return true;
    }
    __device__ __forceinline__ void a_ready(const Unit&) const {}
    __device__ __forceinline__ void done(const Unit&) const {}
};
template <class Epi, class Sched, bool ALIGN_EPI = false, bool SP2 = false>
__device__ __forceinline__ void gemm_phase(PG8_LAS unsigned char* lds, const Gemm g, const Sched& S, const Epi& E) {
    int tid_ = threadIdx.x; asm volatile("" : "+v"(tid_));
    const int tid = tid_, wid = __builtin_amdgcn_readfirstlane(tid >> 6), lane = tid & 63, wr = wid >> 2, wc = wid & 3, fr = lane & 15, fq = lane >> 4;
    const int K = g.K, nt = K / BK;
    unsigned voffA[2], voffB[2];
#pragma unroll
    for (int i = 0; i < 2; ++i) { int R, C; stage_rc(tid * 16 + i * 8192, R, C); const int Rb = Epi::PERM ? ((R & ~31) + perm32(R & 31)) : R;
        voffA[i] = (unsigned)(R * K + C) * 2u; voffB[i] = (unsigned)(Rb * K + C) * 2u; }
    const size_t kstep = (size_t)(BK * 2);
    const size_t hstep = (size_t)HALF * K * 2;
    const size_t tstep = 2 * hstep;
    const unsigned ldsw = (unsigned)wid * 1024u;
    const int aoff = lds_byte(wr * 64 + fr, fq * 8), boff = lds_byte(wc * 32 + fr, fq * 8);
#define PG8_SA(b, h) (((b) * 2 + (h)) * HTB)
#define PG8_SB(b, h) ((4 + (b) * 2 + (h)) * HTB)
#define PG8_STAGE(bufoff, gbase, voff) do { _Pragma("unroll") for (int _i = 0; _i < 2; ++_i) \
        __builtin_amdgcn_global_load_lds((const unsigned*)((const char*)(gbase) + (voff)[_i]), (PG8_LAS unsigned*)(lds + (bufoff) + ldsw + _i * 8192), 16, 0, 0); } while (0)
#define PG8_LDA(dst, b, h) do { _Pragma("unroll") for (int m = 0; m < 4; ++m) _Pragma("unroll") for (int k = 0; k < 2; ++k) dst[m][k] = *(const PG8_LAS bf16x8*)(lds + PG8_SA(b, h) + aoff + m * 2048 + k * 1024); } while (0)
#define PG8_LDB(dst, b, h) do { _Pragma("unroll") for (int n = 0; n < 2; ++n) _Pragma("unroll") for (int k = 0; k < 2; ++k) dst[n][k] = *(const PG8_LAS bf16x8*)(lds + PG8_SB(b, h) + boff + n * 2048 + k * 1024); } while (0)
#define PG8_MMA(ai, bj, At, Bt) do { __builtin_amdgcn_s_setprio(1); _Pragma("unroll") for (int m = 0; m < 4; ++m) _Pragma("unroll") for (int n = 0; n < 2; ++n) _Pragma("unroll") for (int k = 0; k < 2; ++k) \
        acc[ai][bj][m][n] = __builtin_amdgcn_mfma_f32_16x16x32_bf16(Bt[n][k], At[m][k], acc[ai][bj][m][n], 0, 0, 0); __builtin_amdgcn_s_setprio(0); } while (0)
#define PG8_WAIT_V(n) asm volatile("s_waitcnt vmcnt(" #n ")" ::: "memory")
#define PG8_WAIT_L(n) asm volatile("s_waitcnt lgkmcnt(" #n ")" ::: "memory")
#define PG8_BAR __builtin_amdgcn_s_barrier()
#define PG8_SCHED __builtin_amdgcn_sched_barrier(0)
    Unit cur, nxt; int ui = 0;
    if (!S.next(0, cur)) return;
    f32x4 acc[2][2][4][2];
#pragma unroll
    for (int a = 0; a < 2; ++a)
#pragma unroll
        for (int b = 0; b < 2; ++b)
#pragma unroll
            for (int m = 0; m < 4; ++m)
#pragma unroll
                for (int n = 0; n < 2; ++n) acc[a][b][m][n] = (f32x4){0.f, 0.f, 0.f, 0.f};
    bf16x8 At[4][2], B0[2][2], B1[2][2];
    const char* cA = (const char*)g.A + (size_t)cur.pm * tstep; const char* cB = (const char*)g.Bt + (size_t)cur.pn * tstep;
    S.a_ready(cur);
    if constexpr (SP2) {
        PG8_STAGE(PG8_SB(0, 0), cB, voffB); PG8_STAGE(PG8_SB(0, 1), cB + hstep, voffB); PG8_STAGE(PG8_SA(0, 0), cA, voffA); PG8_STAGE(PG8_SA(0, 1), cA + hstep, voffA);
        if (wr == 1) PG8_BAR;
        PG8_WAIT_V(2); PG8_BAR;
        PG8_STAGE(PG8_SB(1, 0), cB + kstep, voffB); PG8_STAGE(PG8_SA(1, 0), cA + kstep, voffA); PG8_STAGE(PG8_SB(1, 1), cB + hstep + kstep, voffB);
        PG8_WAIT_V(6); PG8_BAR;
    } else {
        PG8_STAGE(PG8_SB(0, 0), cB, voffB); PG8_STAGE(PG8_SA(0, 0), cA, voffA); PG8_STAGE(PG8_SB(0, 1), cB + hstep, voffB); PG8_STAGE(PG8_SA(0, 1), cA + hstep, voffA);
        if (wr == 1) PG8_BAR;
        PG8_WAIT_V(4); PG8_BAR;
        PG8_STAGE(PG8_SB(1, 0), cB + kstep, voffB); PG8_STAGE(PG8_SA(1, 0), cA + kstep, voffA); PG8_STAGE(PG8_SB(1, 1), cB + hstep + kstep, voffB);
        PG8_WAIT_V(6); PG8_BAR;
    }
    for (;;) {
        const bool has_next = S.next(ui + 1, nxt);
        const char* nA = has_next ? (const char*)g.A + (size_t)nxt.pm * tstep : cA; const char* nB = has_next ? (const char*)g.Bt + (size_t)nxt.pn * tstep : cB;
        for (int t = 0; t < nt; t += 2) {
            const bool last = (t == nt - 2);
            const char* a1 = cA + (size_t)(t + 1) * kstep;
            const char* a2 = last ? nA : cA + (size_t)(t + 2) * kstep; const char* b2 = last ? nB : cB + (size_t)(t + 2) * kstep;
            const char* a3 = a2 + kstep; const char* b3 = b2 + kstep;
            if (last && has_next) S.a_ready(nxt);
            if constexpr (SP2) {
            PG8_LDB(B0, 0, 0); PG8_LDB(B1, 0, 1); PG8_SCHED; PG8_LDA(At, 0, 0); PG8_STAGE(PG8_SA(1, 1), a1 + hstep, voffA);
            PG8_WAIT_V(8); PG8_WAIT_L(0); PG8_BAR; PG8_MMA(0, 0, At, B0); PG8_MMA(0, 1, At, B1); PG8_BAR; PG8_SCHED;
            PG8_LDA(At, 0, 1); PG8_STAGE(PG8_SB(0, 0), b2, voffB); PG8_STAGE(PG8_SB(0, 1), b2 + hstep, voffB); PG8_STAGE(PG8_SA(0, 0), a2, voffA);
            PG8_WAIT_V(8); PG8_WAIT_L(0); PG8_BAR; PG8_MMA(1, 0, At, B0); PG8_MMA(1, 1, At, B1); PG8_BAR; PG8_SCHED;
            PG8_LDB(B0, 1, 0); PG8_LDB(B1, 1, 1); PG8_SCHED; PG8_LDA(At, 1, 0); PG8_STAGE(PG8_SA(0, 1), a2 + hstep, voffA);
            PG8_WAIT_V(8); PG8_WAIT_L(0); PG8_BAR; PG8_MMA(0, 0, At, B0); PG8_MMA(0, 1, At, B1); PG8_BAR; PG8_SCHED;
            PG8_LDA(At, 1, 1); PG8_STAGE(PG8_SB(1, 0), b3, voffB); PG8_STAGE(PG8_SB(1, 1), b3 + hstep, voffB); PG8_STAGE(PG8_SA(1, 0), a3, voffA);
            PG8_WAIT_V(8); PG8_WAIT_L(0); PG8_BAR; PG8_MMA(1, 0, At, B0); PG8_MMA(1, 1, At, B1); PG8_BAR; PG8_SCHED;
            } else {
            PG8_LDB(B0, 0, 0); PG8_SCHED; PG8_LDA(At, 0, 0); PG8_STAGE(PG8_SA(1, 1), a1 + hstep, voffA);
            PG8_WAIT_L(8); PG8_BAR; PG8_WAIT_L(0); PG8_MMA(0, 0, At, B0); PG8_BAR; PG8_SCHED;
            PG8_LDB(B1, 0, 1); PG8_STAGE(PG8_SB(0, 0), b2, voffB);
            PG8_BAR; PG8_WAIT_L(0); PG8_MMA(0, 1, At, B1); PG8_BAR;
            PG8_LDA(At, 0, 1); PG8_STAGE(PG8_SA(0, 0), a2, voffA);
            PG8_BAR; PG8_WAIT_L(0); PG8_MMA(1, 0, At, B0); PG8_BAR; PG8_SCHED;
            PG8_STAGE(PG8_SB(0, 1), b2 + hstep, voffB);
            PG8_WAIT_V(6); PG8_BAR; PG8_MMA(1, 1, At, B1); PG8_BAR;
            PG8_LDB(B0, 1, 0); PG8_SCHED; PG8_LDA(At, 1, 0); PG8_STAGE(PG8_SA(0, 1), a2 + hstep, voffA);
            PG8_WAIT_L(8); PG8_BAR; PG8_WAIT_L(0); PG8_MMA(0, 0, At, B0); PG8_BAR; PG8_SCHED;
            PG8_LDB(B1, 1, 1); PG8_STAGE(PG8_SB(1, 0), b3, voffB);
            PG8_BAR; PG8_WAIT_L(0); PG8_MMA(0, 1, At, B1); PG8_BAR;
            PG8_LDA(At, 1, 1); PG8_STAGE(PG8_SA(1, 0), a3, voffA);
            PG8_BAR; PG8_WAIT_L(0); PG8_MMA(1, 0, At, B0); PG8_BAR; PG8_SCHED;
            PG8_STAGE(PG8_SB(1, 1), b3 + hstep, voffB);
            PG8_WAIT_V(6); PG8_BAR; PG8_MMA(1, 1, At, B1); PG8_BAR;
            }
        }
        if constexpr (ALIGN_EPI) { if (wr == 0) PG8_BAR; }
        if constexpr (!Epi::AFTER_DRAIN) { E(acc, cur, wr, wc, fr, fq); S.done(cur); }
        if (!has_next) break;
#pragma unroll
        for (int a = 0; a < 2; ++a)
#pragma unroll
            for (int b = 0; b < 2; ++b)
#pragma unroll
                for (int m = 0; m < 4; ++m)
#pragma unroll
                    for (int n = 0; n < 2; ++n) acc[a][b][m][n] = (f32x4){0.f, 0.f, 0.f, 0.f};
        cur = nxt; cA = nA; cB = nB; ++ui;
        if constexpr (ALIGN_EPI) { if (wr == 1) PG8_BAR; }
    }
    PG8_WAIT_V(0);
    if constexpr (!ALIGN_EPI) { if (wr == 0) PG8_BAR; }
    PG8_BAR;
    if constexpr (Epi::AFTER_DRAIN) { E.fused(acc, cur, wr, wc, fr, fq, lds, wid, lane); S.done(cur); }
#undef PG8_SA
#undef PG8_SB
#undef PG8_STAGE
#undef PG8_LDA
#undef PG8_LDB
#undef PG8_MMA
#undef PG8_WAIT_V
#undef PG8_WAIT_L
#undef PG8_BAR
#undef PG8_SCHED
}
}
#define PG8_SP2 true
#define PG8_ALIGN true

using pg8::f32x4; using pg8::Unit; using pg8::BM; using pg8::HALF; typedef pg8::u32x4 u32x4;
typedef unsigned short bf16_t;

struct EpiZ {
    static constexpr bool PERM = true, AFTER_DRAIN = false;
    bf16_t* zrw; bf16_t* zug; float* out;
    __device__ __forceinline__ void operator()(const f32x4 (&acc)[2][2][4][2], const Unit& u, int wr, int wc, int fr, int fq) const {
        const int colt = u.pn * BM;
        const int mode = colt < CSH ? 0 : (colt < C_G0 ? 1 : 2);
        const int row0 = u.pm * BM + wr * 64 + fr, col0 = colt + wc * 32 + 8 * fq;
#pragma unroll
        for (int ai = 0; ai < 2; ++ai)
#pragma unroll
            for (int m = 0; m < 4; ++m) {
                const int row = row0 + ai * HALF + m * 16;
                bf16_t* rowp = mode == 0 ? zrw + (size_t)row * CSH + col0 : zug + (size_t)row * ZUGW + (col0 - CSH);
                bool last; float* sh;
                if (row < MP) { last = (row & (TP - 1)) == TP - 1; sh = out + O_SHP + (size_t)(row / TP) * CSH + col0; }
                else { const int rs = row - MP; last = (rs & (TS - 1)) == TS - 1; sh = out + O_SHS + (size_t)(rs / TS) * CSH + col0; }
#pragma unroll
                for (int bj = 0; bj < 2; ++bj) {
                    f32x4 v0 = acc[ai][bj][m][0], v1 = acc[ai][bj][m][1];
                    if (mode == 0) { if (last) { *(f32x4*)(sh + bj * HALF) = v0; *(f32x4*)(sh + bj * HALF + 4) = v1; } }
                    else if (mode == 1) {
#pragma unroll
                        for (int e = 0; e < 4; ++e) { v0[e] = gelu_tanh(v0[e]); v1[e] = gelu_tanh(v1[e]); }
                    } else {
#pragma unroll
                        for (int e = 0; e < 4; ++e) { v0[e] = sigmoidf_(v0[e]); v1[e] = sigmoidf_(v1[e]); }
                    }
                    u32x4 w; w.x = pk2(v0[0], v0[1]); w.y = pk2(v0[2], v0[3]); w.z = pk2(v1[0], v1[1]); w.w = pk2(v1[2], v1[3]);
                    *(u32x4*)(rowp + bj * HALF) = w;
                }
            }
    }
};
struct EpiMerge {
    static constexpr bool PERM = true, AFTER_DRAIN = false;
    const bf16_t* z; bf16_t* mg;
    __device__ __forceinline__ void operator()(const f32x4 (&acc)[2][2][4][2], const Unit& u, int wr, int wc, int fr, int fq) const {
        const int which = u.pm >= 36 ? 1 : 0, pm = u.pm - 36 * which, pn = u.pn - 8 * which;
        const int row0 = pm * BM + wr * 64 + fr, col0 = pn * BM + wc * 32 + 8 * fq;
        const int gcol = which ? ZU_G1 : ZU_G0;
#pragma unroll
        for (int ai = 0; ai < 2; ++ai)
#pragma unroll
            for (int m = 0; m < 4; ++m) {
                const int row = row0 + ai * HALF + m * 16;
#pragma unroll
                for (int bj = 0; bj < 2; ++bj) {
                    const u32x4 gw = *(const u32x4*)(z + (size_t)row * ZUGW + gcol + col0 + bj * HALF);
                    bf16_t* mp = mg + (size_t)row * D + col0 + bj * HALF;
                    u32x4 pw = (u32x4){0u, 0u, 0u, 0u};
                    if (which) pw = *(const u32x4*)mp;
                    const f32x4 v0 = acc[ai][bj][m][0], v1 = acc[ai][bj][m][1];
                    u32x4 w;
                    w.x = pk2(bflo(pw.x) + bflo(gw.x) * v0[0], bfhi(pw.x) + bfhi(gw.x) * v0[1]);
                    w.y = pk2(bflo(pw.y) + bflo(gw.y) * v0[2], bfhi(pw.y) + bfhi(gw.y) * v0[3]);
                    w.z = pk2(bflo(pw.z) + bflo(gw.z) * v1[0], bfhi(pw.z) + bfhi(gw.z) * v1[1]);
                    w.w = pk2(bflo(pw.w) + bflo(gw.w) * v1[2], bfhi(pw.w) + bfhi(gw.w) * v1[3]);
                    *(u32x4*)mp = w;
                }
            }
    }
};
struct EpiRes1 {
    static constexpr bool PERM = false, AFTER_DRAIN = false;
    const float* xp; const float* xs; const float* mod; float* out;
    __device__ __forceinline__ void operator()(const f32x4 (&acc)[2][2][4][2], const Unit& u, int wr, int wc, int fr, int fq) const {
        const int row0 = u.pm * BM + wr * 64 + fr, col0 = u.pn * BM + wc * 32 + 4 * fq;
#pragma unroll
        for (int ai = 0; ai < 2; ++ai)
#pragma unroll
            for (int m = 0; m < 4; ++m) {
                const int row = row0 + ai * HALF + m * 16;
                const float* xr = (row < MP ? xp + (size_t)row * D : xs + (size_t)(row - MP) * D) + col0;
                const float* gm = mod + (size_t)seq_of_row(row) * (6 * D) + 2 * D + col0;
                float* o = out + (size_t)row * D + col0;
#pragma unroll
                for (int bj = 0; bj < 2; ++bj)
#pragma unroll
                    for (int n = 0; n < 2; ++n) { const int c = bj * HALF + n * 16;
                        *(f32x4*)(o + c) = *(const f32x4*)(xr + c) + *(const f32x4*)(gm + c) * acc[ai][bj][m][n]; }
            }
    }
};
struct EpiSwiglu {
    static constexpr bool PERM = true, AFTER_DRAIN = false;
    bf16_t* act;
    __device__ __forceinline__ void operator()(const f32x4 (&acc)[2][2][4][2], const Unit& u, int wr, int wc, int fr, int fq) const {
        const int row0 = u.pm * BM + wr * 64 + fr, col0 = u.pn * HALF + wc * 32 + 8 * fq;
#pragma unroll
        for (int ai = 0; ai < 2; ++ai)
#pragma unroll
            for (int m = 0; m < 4; ++m) {
                const int row = row0 + ai * HALF + m * 16;
                float r[8];
#pragma unroll
                for (int n = 0; n < 2; ++n)
#pragma unroll
                    for (int e = 0; e < 4; ++e) { const float g = acc[ai][0][m][n][e]; r[4 * n + e] = g * sigmoidf_(g) * acc[ai][1][m][n][e]; }
                u32x4 w; w.x = pk2(r[0], r[1]); w.y = pk2(r[2], r[3]); w.z = pk2(r[4], r[5]); w.w = pk2(r[6], r[7]);
                *(u32x4*)(act + (size_t)row * DFF + col0) = w;
            }
    }
};
struct EpiRes2 {
    static constexpr bool PERM = false, AFTER_DRAIN = false;
    const float* mod; float* out;
    __device__ __forceinline__ void operator()(const f32x4 (&acc)[2][2][4][2], const Unit& u, int wr, int wc, int fr, int fq) const {
        const int row0 = u.pm * BM + wr * 64 + fr, col0 = u.pn * BM + wc * 32 + 4 * fq;
#pragma unroll
        for (int ai = 0; ai < 2; ++ai)
#pragma unroll
            for (int m = 0; m < 4; ++m) {
                const int row = row0 + ai * HALF + m * 16;
                const float* gf = mod + (size_t)seq_of_row(row) * (6 * D) + 5 * D + col0;
                float* o = out + (size_t)row * D + col0;
#pragma unroll
                for (int bj = 0; bj < 2; ++bj)
#pragma unroll
                    for (int n = 0; n < 2; ++n) { const int c = bj * HALF + n * 16;
                        *(f32x4*)(o + c) = *(const f32x4*)(o + c) + *(const f32x4*)(gf + c) * acc[ai][bj][m][n]; }
            }
    }
};
struct BranchOrder {
    int G, c;
    __device__ bool next(int i, Unit& u) const { const int t = (i >> 1) * G + c; if (t >= (M / BM) * (D / BM)) return false; const int which = i & 1;
        u.pm = t / (D / BM) + (M / BM) * which; u.pn = t % (D / BM) + (D / BM) * which; return true; }
    __device__ __forceinline__ void a_ready(const Unit&) const {}
    __device__ __forceinline__ void done(const Unit&) const {}
};

#define GAS __attribute__((address_space(1)))
#define LAS __attribute__((address_space(3)))
typedef GAS unsigned gu32;
#define RLX_AGENT __ATOMIC_RELAXED, __HIP_MEMORY_SCOPE_AGENT
#define LDS_WAIT() asm volatile("s_waitcnt lgkmcnt(0)" ::: "memory")
#define VM_WAIT() asm volatile("s_waitcnt vmcnt(0)" ::: "memory")
#define XB_TMO      128
#define XB_XCNT(j)  (256  + 64 * (j))
#define XB_XSUB(j)  (1280 + 64 * (j))
#define XB_XGEN(j)  (2304 + 64 * (j))
#define XB_TOP      3328
#define XB_TOPGEN   3392
#define XCD_BAR_WORDS 3456
#define XB_SPIN_CAP (1u << 18)

__device__ __forceinline__ unsigned xb_ld(unsigned* p)              { return __hip_atomic_load(p, __ATOMIC_RELAXED, __HIP_MEMORY_SCOPE_AGENT); }
__device__ __forceinline__ unsigned xb_add(unsigned* p, unsigned v) { return __hip_atomic_fetch_add(p, v, __ATOMIC_RELAXED, __HIP_MEMORY_SCOPE_AGENT); }
__device__ __forceinline__ unsigned xb_xcc_id() { return (unsigned)__builtin_amdgcn_s_getreg((3 << 11) | 20) & 0xFu; }
#define XB_SPIN(cond, bar) do { unsigned _sp = 0; while (cond) { __builtin_amdgcn_s_sleep(1); \
    if ((++_sp & 255u) == 0u) { if (xb_ld(&(bar)[XB_TMO])) break; if (_sp > XB_SPIN_CAP) { atomicAdd(&(bar)[XB_TMO], 1u); break; } } } } while (0)

struct XcdBarrier {
    unsigned* bar; unsigned x;
    volatile LAS unsigned* st;
};

__device__ __forceinline__ XcdBarrier xcd_barrier_post(unsigned* bar, volatile LAS unsigned* st) {
    XcdBarrier b; b.bar = bar; b.x = xb_xcc_id(); b.st = st;
    if (threadIdx.x == 0) (void)xb_add(&bar[XB_XCNT(b.x)], 1u);
    return b;
}
__device__ __forceinline__ void xcd_barrier_complete(unsigned* bar, unsigned x, unsigned& nloc, unsigned& nx) {
    const unsigned G = gridDim.x * gridDim.y * gridDim.z;
    unsigned sum, cnt, mine, sp = 0u;
    for (;;) {
        sum = 0u; cnt = 0u; mine = 0u;
#pragma unroll
        for (unsigned j = 0; j < 16; ++j) { const unsigned c = xb_ld(&bar[XB_XCNT(j)]); sum += c; cnt += (c > 0u) ? 1u : 0u; mine = (j == x) ? c : mine; }
        if (sum == G) break;
        __builtin_amdgcn_s_sleep(1);
        if ((++sp & 255u) == 0u) { if (xb_ld(&bar[XB_TMO])) break; if (sp > XB_SPIN_CAP) { atomicAdd(&bar[XB_TMO], 1u); break; } }
    }
    nloc = mine > 0u ? mine : 1u; nx = cnt > 0u ? cnt : 1u;
}

__device__ __forceinline__ void xcd_barrier(const XcdBarrier& b) {
    asm volatile("s_waitcnt vmcnt(0)" ::: "memory");
    __syncthreads();
    if (threadIdx.x == 0) {
        unsigned* bar = b.bar;
        __builtin_amdgcn_s_waitcnt(0);
        unsigned nloc = b.st[0], nx = b.st[1];
        if (nloc == 0u) { xcd_barrier_complete(bar, b.x, nloc, nx); b.st[0] = nloc; b.st[1] = nx; }
        const unsigned old = xb_add(&bar[XB_XSUB(b.x)], 1u);
        const unsigned gen = old / nloc;
        if (old + 1u == (gen + 1u) * nloc) {
            __builtin_amdgcn_fence(__ATOMIC_RELEASE, "agent");
            asm volatile("s_waitcnt vmcnt(0)" ::: "memory");
            const unsigned og = xb_add(&bar[XB_TOP], 1u);
            const unsigned tg = og / nx;
            if (og + 1u == (tg + 1u) * nx) xb_add(&bar[XB_TOPGEN], 1u);
            else XB_SPIN(xb_ld(&bar[XB_TOPGEN]) == tg, bar);
            __builtin_amdgcn_fence(__ATOMIC_ACQUIRE, "agent");
            xb_add(&bar[XB_XGEN(b.x)], 1u);
            asm volatile("s_waitcnt vmcnt(0)" ::: "memory");
        } else {
            XB_SPIN(xb_ld(&bar[XB_XGEN(b.x)]) == gen, bar);
            __builtin_amdgcn_fence(__ATOMIC_ACQUIRE, "agent");
            asm volatile("s_waitcnt vmcnt(0)" ::: "memory");
        }
    }
    __syncthreads();
}

typedef pg8::bf16x8 bf16x8;
#define MFMA16(a, b, c) __builtin_amdgcn_mfma_f32_16x16x32_bf16((a), (b), (c), 0, 0, 0)
constexpr int RB_P1 = 0, RB_RT = 2048, RB_QP = 4096, RB_RAK = 5120, RB_VM = 6144, RB_WL = 8192;

__device__ __forceinline__ f32x4 ld_bf4(const bf16_t* p) { const u32x2v w = *(const u32x2v*)p; return (f32x4){bflo(w.x), bfhi(w.x), bflo(w.y), bfhi(w.y)}; }
__device__ __forceinline__ bf16x8 mk_frag(const f32x4 a, const f32x4 b) { u32x4 w; w.x = pk2(a[0], a[1]); w.y = pk2(a[2], a[3]); w.z = pk2(b[0], b[1]); w.w = pk2(b[2], b[3]); return __builtin_bit_cast(bf16x8, w); }
__device__ __forceinline__ unsigned char* recA_ptr(const P& p, int rec) { return rec < NREC_P ? p.ws + WS_H + (size_t)rec * RECA : p.ws + WS_FRA_S + (size_t)(rec - NREC_P) * RECA; }
__device__ __forceinline__ unsigned char* recB_ptr(const P& p, int rec) { return rec < NREC_P ? (unsigned char*)p.out + (size_t)rec * RECB : p.ws + WS_FRB_S + (size_t)(rec - NREC_P) * RECB; }
__device__ __forceinline__ f32x4 sig4(f32x4 x) { return (f32x4){sigmoidf_(x[0]), sigmoidf_(x[1]), sigmoidf_(x[2]), sigmoidf_(x[3])}; }
__device__ __forceinline__ f32x4 exp4(f32x4 x) { return (f32x4){__expf(x[0]), __expf(x[1]), __expf(x[2]), __expf(x[3])}; }

template <class T> __device__ __forceinline__ T ldu(const void* ubase, unsigned voff) { return *(const T*)((const char*)ubase + voff); }
__device__ __forceinline__ f32x4 bf4(const u32x2v w) { return (f32x4){bflo(w.x), bfhi(w.x), bflo(w.y), bfhi(w.y)}; }
struct ShiftCtx { const bf16_t* zrw; const float* ss; const float* mu; unsigned zoc, zop; bool valid, pz, ps; };
__device__ __forceinline__ f32x4 shift4(const ShiftCtx& k, int cu, unsigned lp) {
    const f32x4 z4 = (f32x4){0.f, 0.f, 0.f, 0.f};
    const f32x4 cur = k.valid ? bf4(ldu<u32x2v>(k.zrw + cu, k.zoc + lp * 2u)) : z4;
    f32x4 pv = z4;
    if (k.pz) pv = bf4(ldu<u32x2v>(k.zrw + cu, k.zop + lp * 2u)); else if (k.ps) pv = ldu<f32x4>(k.ss + cu, lp * 4u);
    return cur + (pv - cur) * ldu<f32x4>(k.mu + cu, lp * 4u);
}

__device__ __forceinline__ void prep_record(const P& p, LAS unsigned char* wl, int rec, int lane_in) {
    int lane = lane_in; asm volatile("" : "+v"(lane));
    const int head = rec & 15, chunkid = rec >> 4;
    const bool prompt = chunkid < NPB * 128;
    const int sq = prompt ? (chunkid >> 7) : NPB + (chunkid - NPB * 128);
    const int c = prompt ? (chunkid & 127) : 0;
    const int row0 = prompt ? sq * TP + c * 16 : MP + (sq - NPB) * TS;
    const int nvalid = prompt ? 16 : TS;
    const int i = lane & 15, q = lane >> 4;
    const bool valid = i < nvalid, first = (c == 0);
    const bool pz = valid && (i > 0 || !first), ps = valid && (i == 0) && first && !prompt;
    const int row = row0 + (valid ? i : 0);
    ShiftCtx K;
    K.zrw = (const bf16_t*)(p.ws + WS_ZRW); K.ss = p.in[3] + (size_t)(prompt ? 0 : sq - NPB) * CSH; K.mu = p.in[10];
    K.zoc = (unsigned)row * (unsigned)(CSH * 2); K.zop = K.zoc - (unsigned)(CSH * 2); K.valid = valid; K.pz = pz; K.ps = ps;
    const unsigned q4 = (unsigned)q * 4u, q8 = (unsigned)q * 8u;
    const unsigned wlo64 = (unsigned)(i * 64 + q * 8) * 2u, wlo128 = (unsigned)(i * 128 + q * 8) * 2u;
    const bf16_t* WDUT = (const bf16_t*)(p.ws + WS_LORA); const bf16_t* WAUT = WDUT + RW * 64; const bf16_t* WGUT = WAUT + RW * 64;
    const f32x4 z4 = (f32x4){0.f, 0.f, 0.f, 0.f};

    f32x4 accw[4], acca[4];
#pragma unroll
    for (int ct = 0; ct < 4; ++ct) { accw[ct] = z4; acca[ct] = z4; }
#pragma unroll
    for (int s = 0; s < 2; ++s) {
        const int cw = 3072 + 32 * s, ca = 3136 + 32 * s;
        f32x4 x0 = shift4(K, cw, q8), x1 = shift4(K, cw + 4, q8);
#pragma unroll
        for (int e = 0; e < 4; ++e) { x0[e] = 2.f * sigmoidf_(2.f * x0[e]) - 1.f; x1[e] = 2.f * sigmoidf_(2.f * x1[e]) - 1.f; }
        const bf16x8 td = mk_frag(x0, x1);
        const bf16x8 ad = mk_frag(shift4(K, ca, q8), shift4(K, ca + 4, q8));
#pragma unroll
        for (int ct = 0; ct < 4; ++ct) {
            const int wo = (head * 64 + 16 * ct) * 64 + 32 * s;
            accw[ct] = MFMA16(ldu<bf16x8>(WDUT + wo, wlo64), td, accw[ct]);
            acca[ct] = MFMA16(ldu<bf16x8>(WAUT + wo, wlo64), ad, acca[ct]);
        }
    }
    f32x4 lw[4], av[4], ks[4];
    float ssq = 0.f;
#pragma unroll
    for (int ct = 0; ct < 4; ++ct) {
        asm volatile("" ::: "memory");
        const int cbu = head * 64 + 16 * ct;
        lw[ct] = sig4(ldu<f32x4>(p.in[11] + cbu, q4 * 4u) + accw[ct]) * (-0.6065306597126334f);
        if (!valid) lw[ct] = z4;
        av[ct] = sig4(ldu<f32x4>(p.in[13] + cbu, q4 * 4u) + acca[ct]);
        ks[ct] = shift4(K, RW + cbu, q4);
        const f32x4 kk0 = ks[ct] * ldu<f32x4>(p.in[16] + cbu, q4 * 4u);
        ssq += (kk0[0] * kk0[0] + kk0[1] * kk0[1]) + (kk0[2] * kk0[2] + kk0[3] * kk0[3]);
    }
    ssq += __shfl_xor(ssq, 16); ssq += __shfl_xor(ssq, 32);
    const float kinv = 1.f / fmaxf(sqrtf(ssq), 1e-12f);
    f32x4 lwc[4];
#pragma unroll
    for (int ct = 0; ct < 4; ++ct) lwc[ct] = lw[ct];
#pragma unroll
    for (int d = 1; d < 16; d <<= 1)
#pragma unroll
        for (int ct = 0; ct < 4; ++ct)
#pragma unroll
            for (int e = 0; e < 4; ++e) { const float t = __shfl_up(lwc[ct][e], d, 16); if (i >= d) lwc[ct][e] += t; }
    unsigned char* rb = recB_ptr(p, rec); unsigned char* ra = recA_ptr(p, rec);
    LAS unsigned short* KT = (LAS unsigned short*)wl; LAS unsigned short* AT = KT + 1024; LAS unsigned short* KtT = KT + 2048; LAS unsigned short* VT = KT + 3072;
    LAS float* MT = (LAS float*)(wl + 8192);
    u32x2v kapP[4], alpP[4], ktP[4], rtP[4];
    float bsum = 0.f;
#pragma unroll
    for (int ct = 0; ct < 4; ++ct) {
        asm volatile("" ::: "memory");
        const int cbu = head * 64 + 16 * ct;
        const f32x4 Wt = exp4(lwc[ct]), Wtm1 = exp4(lwc[ct] - lw[ct]), Winv = exp4(-lwc[ct]);
        const f32x4 kkn = ks[ct] * ldu<f32x4>(p.in[16] + cbu, q4 * 4u) * kinv;
        const f32x4 kmod = ks[ct] * ((av[ct] - 1.f) * ldu<f32x4>(p.in[17] + cbu, q4 * 4u) + 1.f);
        const f32x4 kap = kkn * Wtm1, alp = kkn * av[ct] * Winv, kt = kmod * Winv;
        const f32x4 rs = shift4(K, cbu, q4);
        const f32x4 rt = rs * Wt;
        const f32x4 rk = rs * kmod * ldu<f32x4>(p.in[18] + cbu, q4 * 4u);
        bsum += (rk[0] + rk[1]) + (rk[2] + rk[3]);
        f32x4 wl15;
#pragma unroll
        for (int e = 0; e < 4; ++e) wl15[e] = __shfl(Wt[e], 15, 16);
        if (i == 0) *(f32x4*)(rb + RB_WL + (16 * ct + 4 * q) * 4) = wl15;
        kapP[ct].x = pk2(kap[0], kap[1]); kapP[ct].y = pk2(kap[2], kap[3]); alpP[ct].x = pk2(alp[0], alp[1]); alpP[ct].y = pk2(alp[2], alp[3]);
        ktP[ct].x = pk2(kt[0], kt[1]); ktP[ct].y = pk2(kt[2], kt[3]); rtP[ct].x = pk2(rt[0], rt[1]); rtP[ct].y = pk2(rt[2], rt[3]);
#pragma unroll
        for (int e = 0; e < 4; ++e) { const int ch = 16 * ct + 4 * q + e; const int sh = (e & 1) * 16;
            KT[ch * 16 + i] = (unsigned short)(((e < 2 ? kapP[ct].x : kapP[ct].y) >> sh) & 0xffffu);
            AT[ch * 16 + i] = (unsigned short)(((e < 2 ? alpP[ct].x : alpP[ct].y) >> sh) & 0xffffu);
            KtT[ch * 16 + i] = (unsigned short)(((e < 2 ? ktP[ct].x : ktP[ct].y) >> sh) & 0xffffu); }
    }
    bsum += __shfl_xor(bsum, 16); bsum += __shfl_xor(bsum, 32);
    {
        f32x4 accg[4];
#pragma unroll
        for (int ct = 0; ct < 4; ++ct) accg[ct] = z4;
#pragma unroll
        for (int s = 0; s < 4; ++s) {
            const int cg = 3200 + 32 * s;
            const bf16x8 gd = mk_frag(sig4(shift4(K, cg, q8)), sig4(shift4(K, cg + 4, q8)));
#pragma unroll
            for (int ct = 0; ct < 4; ++ct) accg[ct] = MFMA16(ldu<bf16x8>(WGUT + (head * 64 + 16 * ct) * 128 + 32 * s, wlo128), gd, accg[ct]);
        }
#pragma unroll
        for (int ct = 0; ct < 4; ++ct) {
            asm volatile("" ::: "memory");
            const int cbu = head * 64 + 16 * ct;
            const f32x4 vs = shift4(K, 2 * RW + cbu, q4);
            if (valid) {
                const f32x4 c1 = ldu<f32x4>(p.in[19] + cbu, q4 * 4u) * accg[ct];
                const f32x4 c2 = (ldu<f32x4>(p.in[20] + cbu, q4 * 4u) + vs * bsum) * accg[ct];
                u32x2v w1; w1.x = pk2(c1[0], c1[1]); w1.y = pk2(c1[2], c1[3]); *(u32x2v*)((char*)((bf16_t*)(p.ws + WS_OA) + cbu) + ((unsigned)row * RW + q4) * 2u) = w1;
                u32x2v w2; w2.x = pk2(c2[0], c2[1]); w2.y = pk2(c2[2], c2[3]); *(u32x2v*)((char*)((bf16_t*)(p.ws + WS_C2) + cbu) + ((unsigned)row * RW + q4) * 2u) = w2;
            }
#pragma unroll
            for (int e = 0; e < 4; ++e) VT[(16 * ct + 4 * q + e) * 16 + i] = f2bf(vs[e]);
        }
    }
    bf16x8 kapF[2], alpF[2], ktF[2], rtF[2];
#pragma unroll
    for (int s = 0; s < 2; ++s) {
        kapF[s] = __builtin_bit_cast(bf16x8, (u32x4){kapP[2 * s].x, kapP[2 * s].y, kapP[2 * s + 1].x, kapP[2 * s + 1].y});
        alpF[s] = __builtin_bit_cast(bf16x8, (u32x4){alpP[2 * s].x, alpP[2 * s].y, alpP[2 * s + 1].x, alpP[2 * s + 1].y});
        ktF[s] = __builtin_bit_cast(bf16x8, (u32x4){ktP[2 * s].x, ktP[2 * s].y, ktP[2 * s + 1].x, ktP[2 * s + 1].y});
        rtF[s] = __builtin_bit_cast(bf16x8, (u32x4){rtP[2 * s].x, rtP[2 * s].y, rtP[2 * s + 1].x, rtP[2 * s + 1].y});
    }
    f32x4 Maa = z4, Mak = z4, RAt = z4, RKt = z4;
#pragma unroll
    for (int s = 0; s < 2; ++s) {
        Maa = MFMA16(kapF[s], alpF[s], Maa); Mak = MFMA16(kapF[s], ktF[s], Mak);
        RAt = MFMA16(alpF[s], rtF[s], RAt); RKt = MFMA16(ktF[s], rtF[s], RKt);
    }
#pragma unroll
    for (int r = 0; r < 4; ++r) { const int rw_ = 4 * q + r;
        if (!(rw_ > i)) { Maa[r] = 0.f; Mak[r] = 0.f; }
        if (!(i >= rw_)) { RAt[r] = 0.f; RKt[r] = 0.f; } }
    *(LAS f32x4*)(MT + i * 16 + 4 * q) = Maa;
    *(u32x4*)(rb + RB_RT + lane * 16) = __builtin_bit_cast(u32x4, rtF[0]); *(u32x4*)(rb + RB_RT + 1024 + lane * 16) = __builtin_bit_cast(u32x4, rtF[1]);
    { u32x4 w; w.x = pk2(RAt[0], RAt[1]); w.y = pk2(RAt[2], RAt[3]); w.z = pk2(RKt[0], RKt[1]); w.w = pk2(RKt[2], RKt[3]); *(u32x4*)(rb + RB_RAK + lane * 16) = w; }
    LDS_WAIT(); asm volatile("" ::: "memory");
    float t[16];
#pragma unroll
    for (int cc = 15; cc >= 0; --cc) {
        float acc = (i == cc) ? 1.f : 0.f;
        f32x4 mrow[4];
#pragma unroll
        for (int b = 0; b < 4; ++b) mrow[b] = *(const LAS f32x4*)(MT + cc * 16 + 4 * b);
#pragma unroll
        for (int j = cc + 1; j < 16; ++j) acc -= t[j] * mrow[j >> 2][j & 3];
        t[cc] = acc;
    }
    f32x4 tsel;
#pragma unroll
    for (int e = 0; e < 4; ++e) tsel[e] = -(q == 0 ? t[e] : (q == 1 ? t[4 + e] : (q == 2 ? t[8 + e] : t[12 + e])));
    const bf16x8 Tfrag = mk_frag(tsel, z4);
    f32x4 P1E[4];
#pragma unroll
    for (int ct = 0; ct < 4; ++ct) { const u32x2v w = *(const LAS u32x2v*)(KT + (16 * ct + i) * 16 + 4 * q);
        u32x4 aw; aw.x = w.x; aw.y = w.y; aw.z = 0u; aw.w = 0u; P1E[ct] = MFMA16(__builtin_bit_cast(bf16x8, aw), Tfrag, z4); }
    *(u32x4*)(rb + RB_P1 + lane * 16) = __builtin_bit_cast(u32x4, mk_frag(P1E[0], P1E[1]));
    *(u32x4*)(rb + RB_P1 + 1024 + lane * 16) = __builtin_bit_cast(u32x4, mk_frag(P1E[2], P1E[3]));
    { const f32x4 Qt = MFMA16(mk_frag(Mak, z4), Tfrag, z4);
      u32x4 w; w.x = 0u; w.y = 0u; w.z = pk2(Qt[0], Qt[1]); w.w = pk2(Qt[2], Qt[3]); *(u32x4*)(rb + RB_QP + lane * 16) = w; }
#pragma unroll
    for (int tt = 0; tt < 4; ++tt) {
        const u32x2v a = *(const LAS u32x2v*)(AT + (16 * tt + i) * 16 + 4 * q), b = *(const LAS u32x2v*)(KtT + (16 * tt + i) * 16 + 4 * q);
        u32x4 w; w.x = a.x; w.y = a.y; w.z = b.x; w.w = b.y; *(u32x4*)(ra + tt * 1024 + lane * 16) = w;
        *(u32x2v*)(rb + RB_VM + tt * 512 + lane * 8) = *(const LAS u32x2v*)(VT + (16 * tt + i) * 16 + 4 * q);
    }
    LDS_WAIT(); asm volatile("" ::: "memory");
}

__device__ __forceinline__ void scan_chain(const P& p, int sq, int head, int vs, int lane) {
    const bool prompt = sq < NPB;
    const int nch = prompt ? TP / 16 : 1;
    const int rec0 = prompt ? sq * (TP / 16) * NH + head : NREC_P + (sq - NPB) * NH + head;
    const int row0 = prompt ? sq * TP : MP + (sq - NPB) * TS;
    const int vl = lane & 15, q = lane >> 4;
    const f32x4 z4 = (f32x4){0.f, 0.f, 0.f, 0.f};
    f32x4 St[4];
    float* sout = (prompt ? p.out + O_WKVP + ((size_t)sq * NH + head) * HS * HS : p.out + O_WKVS + ((size_t)(sq - NPB) * NH + head) * HS * HS) + (size_t)(16 * vs + vl) * HS + 4 * q;
    if (prompt) {
#pragma unroll
        for (int t = 0; t < 4; ++t) St[t] = z4;
    } else {
        const float* sin = p.in[2] + ((size_t)(sq - NPB) * NH + head) * HS * HS + (size_t)(16 * vs + vl) * HS + 4 * q;
#pragma unroll
        for (int t = 0; t < 4; ++t) St[t] = *(const f32x4*)(sin + 16 * t);
    }
    float* oraw = (float*)(p.ws + WS_ZRW);
    for (int c = 0; c < nch; ++c) {
        const int rec = rec0 + c * NH;
        const unsigned char* ra = recA_ptr(p, rec); const unsigned char* rb = recB_ptr(p, rec);
        const bf16x8 P10 = *(const bf16x8*)(rb + RB_P1 + lane * 16), P11 = *(const bf16x8*)(rb + RB_P1 + 1024 + lane * 16);
        const bf16x8 RT0 = *(const bf16x8*)(rb + RB_RT + lane * 16), RT1 = *(const bf16x8*)(rb + RB_RT + 1024 + lane * 16);
        const bf16x8 QP = *(const bf16x8*)(rb + RB_QP + lane * 16), RAK = *(const bf16x8*)(rb + RB_RAK + lane * 16);
        const u32x2v vm = *(const u32x2v*)(rb + RB_VM + vs * 512 + lane * 8);
        bf16x8 AK[4]; f32x4 WL[4];
#pragma unroll
        for (int t = 0; t < 4; ++t) { AK[t] = *(const bf16x8*)(ra + t * 1024 + lane * 16); WL[t] = *(const f32x4*)(rb + RB_WL + (16 * t + 4 * q) * 4); }
        const bf16x8 SB0 = mk_frag(St[0], St[1]), SB1 = mk_frag(St[2], St[3]);
        u32x4 vw; vw.x = 0u; vw.y = 0u; vw.z = vm.x; vw.w = vm.y;
        f32x4 U = MFMA16(QP, __builtin_bit_cast(bf16x8, vw), z4);
        U = MFMA16(P10, SB0, U); U = MFMA16(P11, SB1, U);
        u32x4 uw; uw.x = pk2(U[0], U[1]); uw.y = pk2(U[2], U[3]); uw.z = vm.x; uw.w = vm.y;
        const bf16x8 UB = __builtin_bit_cast(bf16x8, uw);
        f32x4 O = MFMA16(RT0, SB0, z4); O = MFMA16(RT1, SB1, O); O = MFMA16(RAK, UB, O);
#pragma unroll
        for (int t = 0; t < 4; ++t) St[t] = MFMA16(AK[t], UB, St[t]) * WL[t];
#pragma unroll
        for (int r = 0; r < 4; ++r) { const int tk = 4 * q + r; if (prompt || tk < TS) oraw[(size_t)(row0 + 16 * c + tk) * RW + head * HS + 16 * vs + vl] = O[r]; }
    }
#pragma unroll
    for (int t = 0; t < 4; ++t) *(f32x4*)(sout + 16 * t) = St[t];
}

__device__ __forceinline__ void post_rows(const P& p, int gw, int NGW, int lane) {
    const float* oraw = (const float*)(p.ws + WS_ZRW);
    for (int row = gw; row < M; row += NGW) {
        const size_t off = (size_t)row * RW + lane * 16;
        f32x4 o[4]; float s = 0.f;
#pragma unroll
        for (int j = 0; j < 4; ++j) { o[j] = *(const f32x4*)(oraw + off + 4 * j); s += (o[j][0] + o[j][1]) + (o[j][2] + o[j][3]); }
        s += __shfl_xor(s, 1); s += __shfl_xor(s, 2);
        const float mean = s * (1.f / HS); float qv = 0.f;
#pragma unroll
        for (int j = 0; j < 4; ++j) { o[j] = o[j] - mean; qv += (o[j][0] * o[j][0] + o[j][1] * o[j][1]) + (o[j][2] * o[j][2] + o[j][3] * o[j][3]); }
        qv += __shfl_xor(qv, 1); qv += __shfl_xor(qv, 2);
        const float rstd = rsqrtf(qv * (1.f / HS) + 64e-5f);
        bf16_t* oa = (bf16_t*)(p.ws + WS_OA) + off; const bf16_t* c2p = (const bf16_t*)(p.ws + WS_C2) + off;
#pragma unroll
        for (int h = 0; h < 2; ++h) {
            const u32x4 c1 = *(const u32x4*)(oa + 8 * h), c2 = *(const u32x4*)(c2p + 8 * h);
            const f32x4 a = o[2 * h] * rstd, b = o[2 * h + 1] * rstd;
            u32x4 w;
            w.x = pk2(a[0] * bflo(c1.x) + bflo(c2.x), a[1] * bfhi(c1.x) + bfhi(c2.x)); w.y = pk2(a[2] * bflo(c1.y) + bflo(c2.y), a[3] * bfhi(c1.y) + bfhi(c2.y));
            w.z = pk2(b[0] * bflo(c1.z) + bflo(c2.z), b[1] * bfhi(c1.z) + bfhi(c2.z)); w.w = pk2(b[2] * bflo(c1.w) + bflo(c2.w), b[3] * bfhi(c1.w) + bfhi(c2.w));
            *(u32x4*)(oa + 8 * h) = w;
        }
    }
}

constexpr int NWAVES = 8, NTHR = NWAVES * 64;
constexpr int RING_BYTES = 131072, LDSCTL_OFF = RING_BYTES, MISC_OFF = LDSCTL_OFF + 320, LDS_BYTES = 147456;

__device__ __forceinline__ void p0_mod_slab(const P& p, LAS float* red, int slab, int tid, int lane, int wave) {
    for (int i = tid; i < 144 * 48; i += NTHR) red[i] = 0.f;
    __syncthreads();
    const int n0 = slab * 48, fr = lane & 15, fq = lane >> 4;
    const float* W = p.in[6];
    f32x4 acc[9][3];
#pragma unroll
    for (int a = 0; a < 9; ++a)
#pragma unroll
        for (int b = 0; b < 3; ++b) acc[a][b] = (f32x4){0.f, 0.f, 0.f, 0.f};
    for (int kb = 0; kb < 8; ++kb) {
        const int k0 = wave * 256 + kb * 32 + fq * 8;
        bf16x8 bfr[3];
#pragma unroll
        for (int nt = 0; nt < 3; ++nt) {
            const float* wp = W + (size_t)k0 * (6 * D) + n0 + nt * 16 + fr;
            u32x4 w;
            w.x = pk2(wp[0], wp[(size_t)1 * 6 * D]); w.y = pk2(wp[(size_t)2 * 6 * D], wp[(size_t)3 * 6 * D]);
            w.z = pk2(wp[(size_t)4 * 6 * D], wp[(size_t)5 * 6 * D]); w.w = pk2(wp[(size_t)6 * 6 * D], wp[(size_t)7 * 6 * D]);
            bfr[nt] = __builtin_bit_cast(bf16x8, w);
        }
#pragma unroll
        for (int mt = 0; mt < 9; ++mt) {
            const int row = mt * 16 + fr;
            u32x4 aw = (u32x4){0u, 0u, 0u, 0u};
            if (row < NSEQ) {
                const float* c = (row < NPB ? p.in[4] + (size_t)row * D : p.in[5] + (size_t)(row - NPB) * D) + k0;
                const f32x4 c0 = *(const f32x4*)c, c1 = *(const f32x4*)(c + 4);
                aw.x = pk2(c0[0] * sigmoidf_(c0[0]), c0[1] * sigmoidf_(c0[1])); aw.y = pk2(c0[2] * sigmoidf_(c0[2]), c0[3] * sigmoidf_(c0[3]));
                aw.z = pk2(c1[0] * sigmoidf_(c1[0]), c1[1] * sigmoidf_(c1[1])); aw.w = pk2(c1[2] * sigmoidf_(c1[2]), c1[3] * sigmoidf_(c1[3]));
            }
            const bf16x8 afr = __builtin_bit_cast(bf16x8, aw);
#pragma unroll
            for (int nt = 0; nt < 3; ++nt) acc[mt][nt] = __builtin_amdgcn_mfma_f32_16x16x32_bf16(afr, bfr[nt], acc[mt][nt], 0, 0, 0);
        }
    }
#pragma unroll
    for (int mt = 0; mt < 9; ++mt)
#pragma unroll
        for (int nt = 0; nt < 3; ++nt)
#pragma unroll
            for (int r = 0; r < 4; ++r) __hip_atomic_fetch_add(red + (mt * 16 + 4 * fq + r) * 48 + nt * 16 + fr, acc[mt][nt][r], __ATOMIC_RELAXED, __HIP_MEMORY_SCOPE_WORKGROUP);
    __syncthreads();
    float* mod = (float*)(p.ws + WS_MOD);
    for (int i = tid; i < NSEQ * 48; i += NTHR) { const int row = i / 48, c = i % 48; mod[(size_t)row * (6 * D) + n0 + c] = red[row * 48 + c] + p.in[7][n0 + c]; }
    __syncthreads();
}
__device__ __forceinline__ void p0_transpose_item(const float* W, int K, int N, bf16_t* WT, bool swz, LAS float* scr, int item, int lane) {
    const int nblk = N / 32, kb = item / nblk, nb = item % nblk, k0 = 64 * kb, n0 = 32 * nb;
    int r0 = n0;
    if (swz) { r0 = n0 < DFF ? 256 * (n0 >> 7) + (n0 & 127) : 256 * ((n0 - DFF) >> 7) + 128 + ((n0 - DFF) & 127); }
#pragma unroll 8
    for (int i = 0; i < 32; ++i) { const int kk = 2 * i + (lane >> 5); scr[kk * 33 + (lane & 31)] = W[(size_t)(k0 + kk) * N + n0 + (lane & 31)]; }
    LDS_WAIT(); asm volatile("" ::: "memory");
    const int c = lane & 7;
#pragma unroll
    for (int j = 0; j < 4; ++j) { const int n = (lane >> 3) + 8 * j; const LAS float* s = scr + (8 * c) * 33 + n;
        u32x4 o; o.x = pk2(s[0 * 33], s[1 * 33]); o.y = pk2(s[2 * 33], s[3 * 33]); o.z = pk2(s[4 * 33], s[5 * 33]); o.w = pk2(s[6 * 33], s[7 * 33]);
        *(u32x4*)(WT + (size_t)(r0 + n) * K + k0 + 8 * c) = o; }
    LDS_WAIT(); asm volatile("" ::: "memory");
}
__device__ __forceinline__ void p0_transposes(const P& p, LAS float* scr, int gw, int NGW, int lane) {
    constexpr int I_IN = (D / 64) * (CIN / 32), I_BA = (RW / 64) * (D / 32), I_OUT = (D / 64) * (D / 32), I_FI = (D / 64) * (2 * DFF / 32), I_FO = (DFF / 64) * (D / 32);
    constexpr int I_L64 = (RW / 32), I_L128 = 2 * (RW / 32);
    constexpr int NITEMS = I_IN + 2 * I_BA + I_OUT + I_FI + I_FO + 2 * I_L64 + I_L128;
    unsigned char* ws = p.ws;
    for (int it = gw; it < NITEMS; it += NGW) {
        int r = it;
        if (r < I_IN) { p0_transpose_item(p.in[9], D, CIN, (bf16_t*)(ws + WS_WIN), false, scr, r, lane); continue; } r -= I_IN;
        if (r < I_BA) { p0_transpose_item(p.in[25], RW, D, (bf16_t*)(ws + WS_WBA), false, scr, r, lane); continue; } r -= I_BA;
        if (r < I_BA) { p0_transpose_item(p.in[26], RW, D, (bf16_t*)(ws + WS_WBB), false, scr, r, lane); continue; } r -= I_BA;
        if (r < I_OUT) { p0_transpose_item(p.in[27], D, D, (bf16_t*)(ws + WS_WOUT), false, scr, r, lane); continue; } r -= I_OUT;
        if (r < I_FI) { p0_transpose_item(p.in[29], D, 2 * DFF, (bf16_t*)(ws + WS_WFI), true, scr, r, lane); continue; } r -= I_FI;
        if (r < I_FO) { p0_transpose_item(p.in[30], DFF, D, (bf16_t*)(ws + WS_WFO), false, scr, r, lane); continue; } r -= I_FO;
        if (r < I_L64) { p0_transpose_item(p.in[12], 64, RW, (bf16_t*)(ws + WS_LORA), false, scr, r, lane); continue; } r -= I_L64;
        if (r < I_L64) { p0_transpose_item(p.in[14], 64, RW, (bf16_t*)(ws + WS_LORA) + RW * 64, false, scr, r, lane); continue; } r -= I_L64;
        p0_transpose_item(p.in[15], 128, RW, (bf16_t*)(ws + WS_LORA) + 2 * RW * 64, false, scr, r, lane);
    }
}
__device__ __forceinline__ void norm_row(const float* x, const float* g, const float* scale, const float* shift, bf16_t* h, int lane) {
    f32x4 v[8]; float s = 0.f;
#pragma unroll
    for (int j = 0; j < 8; ++j) { v[j] = *(const f32x4*)(x + 4 * lane + 256 * j); s += (v[j][0] * v[j][0] + v[j][1] * v[j][1]) + (v[j][2] * v[j][2] + v[j][3] * v[j][3]); }
    const float rstd = rsqrtf(wave_sum(s) * (1.f / D) + 1e-6f);
#pragma unroll
    for (int j = 0; j < 8; ++j) { const int k = 4 * lane + 256 * j;
        const f32x4 gg = *(const f32x4*)(g + k), sc = *(const f32x4*)(scale + k), sh = *(const f32x4*)(shift + k);
        const f32x4 o = v[j] * rstd * gg * (sc + 1.f) + sh;
        u32x2v w; w.x = pk2(o[0], o[1]); w.y = pk2(o[2], o[3]); *(u32x2v*)(h + k) = w; }
}
__device__ __forceinline__ void phase_norm(const P& p, int which, int gw, int NGW, int lane) {
    const float* g = which == 0 ? p.in[8] : p.in[28];
    for (int row = gw; row < M; row += NGW) {
        const float* x = which == 0 ? (row < MP ? p.in[0] + (size_t)row * D : p.in[1] + (size_t)(row - MP) * D) : p.out + (size_t)row * D;
        const float* mod = (const float*)(p.ws + WS_MOD) + (size_t)seq_of_row(row) * (6 * D);
        norm_row(x, g, mod + (which == 0 ? 1 : 4) * D, mod + (which == 0 ? 0 : 3) * D, (bf16_t*)(p.ws + WS_H) + (size_t)row * D, lane);
    }
}
__device__ __forceinline__ void phase_lnv(const P& p, int gw, int NGW, int lane) {
    for (int row = gw; row < M; row += NGW) {
        const bf16_t* zv = (const bf16_t*)(p.ws + WS_ZUG) + (size_t)row * ZUGW + ZU_V;
        float v[16]; float s = 0.f;
#pragma unroll
        for (int j = 0; j < 2; ++j) { const u32x4 w = *(const u32x4*)(zv + 8 * lane + 512 * j);
            v[8 * j + 0] = bflo(w.x); v[8 * j + 1] = bfhi(w.x); v[8 * j + 2] = bflo(w.y); v[8 * j + 3] = bfhi(w.y);
            v[8 * j + 4] = bflo(w.z); v[8 * j + 5] = bfhi(w.z); v[8 * j + 6] = bflo(w.w); v[8 * j + 7] = bfhi(w.w); }
#pragma unroll
        for (int i = 0; i < 16; ++i) s += v[i];
        const float mean = wave_sum(s) * (1.f / MLPW);
        float q = 0.f;
#pragma unroll
        for (int i = 0; i < 16; ++i) { v[i] -= mean; q += v[i] * v[i]; }
        const float rstd = rsqrtf(wave_sum(q) * (1.f / MLPW) + 1e-5f);
        bf16_t* vn = (bf16_t*)(p.ws + WS_VN) + (size_t)row * MLPW;
#pragma unroll
        for (int j = 0; j < 2; ++j) { const int c = 8 * lane + 512 * j; float o[8];
#pragma unroll
            for (int e = 0; e < 8; ++e) o[e] = v[8 * j + e] * rstd * p.in[21][c + e] + p.in[22][c + e];
            u32x4 w; w.x = pk2(o[0], o[1]); w.y = pk2(o[2], o[3]); w.z = pk2(o[4], o[5]); w.w = pk2(o[6], o[7]);
            *(u32x4*)(vn + c) = w;
            if (row >= MP) { float* vs = p.out + O_VS + (size_t)(row - MP) * MLPW + c;
                *(f32x4*)vs = (f32x4){o[0], o[1], o[2], o[3]}; *(f32x4*)(vs + 4) = (f32x4){o[4], o[5], o[6], o[7]}; }
        }
    }
}
__device__ __forceinline__ void phase_final(const P& p, int gw, int NGW, int lane) {
    for (int row = gw; row < M; row += NGW) {
        float* x = p.out + (size_t)row * D;
        f32x4 v[8]; float s = 0.f;
#pragma unroll
        for (int j = 0; j < 8; ++j) { v[j] = *(const f32x4*)(x + 4 * lane + 256 * j); s += (v[j][0] * v[j][0] + v[j][1] * v[j][1]) + (v[j][2] * v[j][2] + v[j][3] * v[j][3]); }
        const float rstd = rsqrtf(wave_sum(s) * (1.f / D) + 1e-6f);
#pragma unroll
        for (int j = 0; j < 8; ++j) { const int k = 4 * lane + 256 * j; *(f32x4*)(x + k) = v[j] * rstd * *(const f32x4*)(p.in[31] + k); }
    }
}
__device__ __forceinline__ void mix_naive_row(const P& p, int row, int tid, int nthr) {
    int t;
    if (row < MP) t = (row & (TP - 1)) & 127; else t = (row - MP) & (TS - 1);
    const int rowc0 = row - t;
    const bf16_t* vn = (const bf16_t*)(p.ws + WS_VN);
    const bf16_t* zu = (const bf16_t*)(p.ws + WS_ZUG) + (size_t)row * ZUGW + ZU_U;
    bf16_t* ub = (bf16_t*)(p.ws + WS_UB) + (size_t)row * MLPW;
    for (int c = tid; c < MLPW; c += nthr) {
        const int g = c >> 7; const float* wsg = p.in[23] + ((size_t)g * 128 + t) * 128;
        float acc = 0.f;
        for (int s = 0; s <= t; ++s) acc += wsg[s] * bf2f(vn[(size_t)(rowc0 + s) * MLPW + c]);
        acc += p.in[24][g * 128 + t];
        ub[c] = f2bf(bf2f(zu[c]) * acc);
    }
}

#define PHASE_IDS() int tid = threadIdx.x; asm volatile("" : "+v"(tid)); const int lane = tid & 63, wave = __builtin_amdgcn_readfirstlane(tid >> 6); \
    const int gw = bx * NWAVES + wave, NGW = G * NWAVES; (void)lane; (void)gw; (void)NGW
__global__ void __launch_bounds__(NTHR, 2) mega_fwd(P p) {
    extern __shared__ __attribute__((aligned(16))) unsigned char lds_raw[];
    LAS unsigned char* lds = (LAS unsigned char*)lds_raw;
    const int G = gridDim.x, bx = blockIdx.x;
    unsigned char* ws = p.ws;
    { PHASE_IDS();
      for (int u = tid; u < (LDS_BYTES - LDSCTL_OFF) / 4; u += NTHR) ((LAS unsigned*)(lds + LDSCTL_OFF))[u] = 0u; }
    __syncthreads();
    XcdBarrier bar = xcd_barrier_post((unsigned*)(ws + WS_CTL) + CW_BAR, (volatile LAS unsigned*)(lds + MISC_OFF) + 8);

    { PHASE_IDS();
      for (int slab = bx; slab < 256; slab += G) p0_mod_slab(p, (LAS float*)lds, slab, tid, lane, wave);
      p0_transposes(p, (LAS float*)(lds + wave * 16384), gw, NGW, lane); }
    xcd_barrier(bar);
    { PHASE_IDS(); phase_norm(p, 0, gw, NGW, lane); }
    xcd_barrier(bar);
    {
        pg8::Gemm g{(const bf16_t*)(ws + WS_H), (const bf16_t*)(ws + WS_WIN), M, CIN, D}; pg8::StaticOrder S; S.init(M, CIN, G, bx);
        EpiZ E{(bf16_t*)(ws + WS_ZRW), (bf16_t*)(ws + WS_ZUG), p.out};
        pg8::gemm_phase<EpiZ, pg8::StaticOrder, PG8_ALIGN, PG8_SP2>(lds, g, S, E);
    }
    xcd_barrier(bar);
    { PHASE_IDS();
      phase_lnv(p, gw, NGW, lane);
      for (int rec = gw; rec < NREC; rec += NGW) prep_record(p, lds + wave * 16384, rec, lane); }
    xcd_barrier(bar);
    { PHASE_IDS();
        const int NPC = NPB * NH;
        if (bx < NPC && wave < 4) scan_chain(p, bx >> 4, bx & 15, wave, lane);
        else {
            const int nlow = G < NPC ? G : NPC;
            const int wid = bx < NPC ? bx * 4 + (wave - 4) : nlow * 4 + (bx - NPC) * NWAVES + wave;
            const int NW = nlow * 4 + (G > NPC ? (G - NPC) * NWAVES : 0);
            for (int j = wid; j < NSB * NH * 4; j += NW) scan_chain(p, NPB + (j >> 6), (j >> 2) & 15, j & 3, lane);
            if (bx >= NPC) for (int row = bx - NPC; row < M; row += G - NPC) mix_naive_row(p, row, tid, NTHR);
        }
        if (G <= NPC) {
            for (int ch = bx + G; ch < NPC; ch += G) if (wave < 4) scan_chain(p, ch >> 4, ch & 15, wave, lane);
            for (int row = bx; row < M; row += G) mix_naive_row(p, row, tid, NTHR);
        }
    }
    xcd_barrier(bar);
    { PHASE_IDS(); post_rows(p, gw, NGW, lane); }
    xcd_barrier(bar);
    {
        pg8::Gemm g{(const bf16_t*)(ws + WS_OA), (const bf16_t*)(ws + WS_WBA), 2 * M, 2 * D, RW}; BranchOrder S{G, bx};
        EpiMerge E{(const bf16_t*)(ws + WS_ZUG), (bf16_t*)(ws + WS_H)};
        pg8::gemm_phase<EpiMerge, BranchOrder, PG8_ALIGN, PG8_SP2>(lds, g, S, E);
    }
    xcd_barrier(bar);
    {
        pg8::Gemm g{(const bf16_t*)(ws + WS_H), (const bf16_t*)(ws + WS_WOUT), M, D, D}; pg8::StaticOrder S; S.init(M, D, G, bx);
        EpiRes1 E{p.in[0], p.in[1], (const float*)(ws + WS_MOD), p.out};
        pg8::gemm_phase<EpiRes1, pg8::StaticOrder, PG8_ALIGN, PG8_SP2>(lds, g, S, E);
    }
    xcd_barrier(bar);
    { PHASE_IDS(); phase_norm(p, 1, gw, NGW, lane); }
    xcd_barrier(bar);
    {
        pg8::Gemm g{(const bf16_t*)(ws + WS_H), (const bf16_t*)(ws + WS_WFI), M, 2 * DFF, D}; pg8::StaticOrder S; S.init(M, 2 * DFF, G, bx);
        EpiSwiglu E{(bf16_t*)(ws + WS_ZUG)};
        pg8::gemm_phase<EpiSwiglu, pg8::StaticOrder, PG8_ALIGN, PG8_SP2>(lds, g, S, E);
    }
    xcd_barrier(bar);
    {
        pg8::Gemm g{(const bf16_t*)(ws + WS_ZUG), (const bf16_t*)(ws + WS_WFO), M, D, DFF}; pg8::StaticOrder S; S.init(M, D, G, bx);
        EpiRes2 E{(const float*)(ws + WS_MOD), p.out};
        pg8::gemm_phase<EpiRes2, pg8::StaticOrder, PG8_ALIGN, PG8_SP2>(lds, g, S, E);
    }
    xcd_barrier(bar);
    { PHASE_IDS(); phase_final(p, gw, NGW, lane); }
}

extern "C" void kernel_launch(void* const* d_in, const int* in_sizes, int n_in, void* d_out, int out_size, void* d_ws, size_t ws_size, hipStream_t stream) {
    static int grid = 0;
    if (grid == 0) {
        if (n_in != 32 || (size_t)out_size != O_END || ws_size < WS_END) { fprintf(stderr, "kernel_launch: unexpected shapes n_in=%d out=%d ws=%zu (need %zu)\n", n_in, out_size, ws_size, (size_t)WS_END); grid = -1; return; }
        int dev = 0, cus = 0, per_cu = 0;
        if (hipGetDevice(&dev) != hipSuccess || hipDeviceGetAttribute(&cus, hipDeviceAttributeMultiprocessorCount, dev) != hipSuccess) { grid = -1; return; }
        if (hipFuncSetAttribute((const void*)mega_fwd, hipFuncAttributeMaxDynamicSharedMemorySize, LDS_BYTES) != hipSuccess) { fprintf(stderr, "kernel_launch: hipFuncSetAttribute failed\n"); grid = -1; return; }
        if (hipOccupancyMaxActiveBlocksPerMultiprocessor(&per_cu, (const void*)mega_fwd, NTHR, LDS_BYTES) != hipSuccess || per_cu < 1) { fprintf(stderr, "kernel_launch: occupancy query says %d blocks per CU\n", per_cu); }
        (void)hipGetLastError();
        grid = cus;
    }
    if (grid < 0) return;
    if (hipMemsetAsync((char*)d_ws + WS_CTL, 0, CTL_ZERO_BYTES, stream) != hipSuccess) { fprintf(stderr, "kernel_launch: memset failed\n"); return; }
    P p{};
    for (int i = 0; i < 32; ++i) p.in[i] = (const float*)d_in[i];
    p.out = (float*)d_out; p.ws = (unsigned char*)d_ws;
    hipLaunchKernelGGL(mega_fwd, dim3(grid), dim3(NTHR), LDS_BYTES, stream, p);
    const hipError_t le = hipPeekAtLastError();
    if (le != hipSuccess) fprintf(stderr, "kernel_launch: launch failed: %s\n", hipGetErrorName(le));
}
```

```cpp
#include <hip/hip_runtime.h>
#include <cstdio>
#include <cstdint>

constexpr int D = 2048, NPB = 4, TP = 2048, NSB = 128, TS = 8;
constexpr int MP = NPB * TP, MS = NSB * TS, M = MP + MS;
constexpr int RW = 1024, NH = 16, HS = 64;
constexpr int CSH = 3328, CIN = 9472, DFF = 5632, MLPW = 1024;
constexpr int C_U = CSH, C_V = CSH + 1024, C_G0 = CSH + 2048, C_G1 = C_G0 + 2048;
constexpr int ZUGW = CIN - CSH, ZU_U = 0, ZU_V = 1024, ZU_G0 = 2048, ZU_G1 = 4096;
constexpr int NSEQ = NPB + NSB;
constexpr size_t O_YP = 0, O_YS = O_YP + (size_t)MP * D, O_WKVP = O_YS + (size_t)MS * D, O_SHP = O_WKVP + (size_t)NPB * NH * HS * HS,
                 O_WKVS = O_SHP + (size_t)NPB * CSH, O_SHS = O_WKVS + (size_t)NSB * NH * HS * HS, O_VS = O_SHS + (size_t)NSB * CSH,
                 O_END = O_VS + (size_t)MS * MLPW;
constexpr size_t WS_CTL = 0, CTL_ZERO_BYTES = 1u << 20;
constexpr size_t WS_WIN = CTL_ZERO_BYTES;
constexpr size_t WS_WBA = WS_WIN + (size_t)CIN * D * 2;
constexpr size_t WS_WBB = WS_WBA + (size_t)D * RW * 2;
constexpr size_t WS_WOUT = WS_WBB + (size_t)D * RW * 2;
constexpr size_t WS_WFI = WS_WOUT + (size_t)D * D * 2;
constexpr size_t WS_WFO = WS_WFI + (size_t)2 * DFF * D * 2;
constexpr size_t WS_MOD = WS_WFO + (size_t)D * DFF * 2;
constexpr size_t WS_H = WS_MOD + (size_t)NSEQ * 6 * D * 4;
constexpr size_t WS_ZRW = WS_H + (size_t)M * D * 2;
constexpr size_t WS_ZUG = WS_ZRW + (size_t)M * CSH * 2;
constexpr size_t WS_VN = WS_ZUG + (size_t)M * ZUGW * 2;
constexpr size_t WS_OA = WS_VN + (size_t)M * MLPW * 2;
constexpr size_t WS_UB = WS_OA + (size_t)M * RW * 2;
constexpr size_t WS_C2 = WS_UB + (size_t)M * MLPW * 2;
constexpr size_t WS_LORA = WS_C2 + (size_t)M * RW * 2;
constexpr size_t WS_FRA_S = WS_LORA + (size_t)RW * 256 * 2;
constexpr size_t WS_FRB_S = WS_FRA_S + (size_t)NSB * NH * 4096;
constexpr size_t WS_END = WS_FRB_S + (size_t)NSB * NH * 8448;
constexpr int NREC_P = NPB * 128 * NH, NREC = NREC_P + NSB * NH;
constexpr int RECA = 4096, RECB = 8448;
static_assert((size_t)NREC_P * RECA <= (size_t)M * D * 2 && (size_t)NREC_P * RECB <= (size_t)M * D * 4, "prompt fragment records fit the H buffer / the y region of d_out");
constexpr int CW_BAR = 4096;

typedef float f32x2v __attribute__((ext_vector_type(2)));
typedef __bf16 bf16x2v __attribute__((ext_vector_type(2)));
typedef unsigned u32x2v __attribute__((ext_vector_type(2)));

struct P { const float* in[32]; float* out; unsigned char* ws; };

__device__ __forceinline__ unsigned pk2(float lo, float hi) { return __builtin_bit_cast(unsigned, __builtin_convertvector((f32x2v){lo, hi}, bf16x2v)); }
__device__ __forceinline__ unsigned short f2bf(float f) { return (unsigned short)(pk2(f, 0.f) & 0xffffu); }
__device__ __forceinline__ float bf2f(unsigned short h) { return __uint_as_float(((unsigned)h) << 16); }
__device__ __forceinline__ float bflo(unsigned w) { return __uint_as_float(w << 16); }
__device__ __forceinline__ float bfhi(unsigned w) { return __uint_as_float(w & 0xffff0000u); }
__device__ __forceinline__ float sigmoidf_(float x) { return 1.f / (1.f + __expf(-x)); }
__device__ __forceinline__ float gelu_tanh(float x) {
    const float u = 0.7978845608028654f * (x + 0.044715f * x * x * x); return x / (1.f + __expf(-2.f * u)); }
__device__ __forceinline__ float wave_sum(float v) {
#pragma unroll
    for (int o = 1; o < 64; o <<= 1) v += __shfl_xor(v, o);
    return v;
}
__device__ __forceinline__ int seq_of_row(int row) { return row < MP ? row / TP : NPB + (row - MP) / TS; }

namespace pg8 {
#define PG8_LAS __attribute__((address_space(3)))
typedef unsigned short bf16_t;
typedef short bf16x8 __attribute__((ext_vector_type(8)));
typedef float f32x4 __attribute__((ext_vector_type(4)));
typedef unsigned u32x4 __attribute__((ext_vector_type(4)));
constexpr int BM = 256, BK = 64, HALF = 128, HTB = HALF * BK * 2  , STAGE_BYTES = 8 * HTB, NXCD = 8, WGM = 8;

__host__ __device__ __forceinline__ int lds_byte(int r, int c) { const int st = (r >> 4) * 2 + (c >> 5), rr = r & 15, cc = c & 31, ob = rr * 64 + cc * 2; return st * 1024 + (ob ^ (((ob >> 9) & 1) << 5)); }
__host__ __device__ __forceinline__ void stage_rc(int b, int& R, int& C) { const int st = b / 1024, sb = b % 1024, swz = sb ^ (((sb >> 9) & 1) << 5); R = (st >> 1) * 16 + swz / 64; C = (st & 1) * 32 + (swz % 64) / 2; }
__host__ __device__ __forceinline__ int perm32(int rho) { const int n = rho >> 4, i = rho & 15; return 8 * (i >> 2) + 4 * n + (i & 3); }

struct Unit { int pm, pn; };
struct Gemm { const bf16_t* A; const bf16_t* Bt; int M, N, K; };

struct StaticOrder {
    int nM, nN, nwg, G, c;
    __host__ __device__ void init(int M, int N, int G_, int c_) { nM = M / BM; nN = N / BM; nwg = nM * nN; G = G_; c = c_; }
    __host__ __device__ bool next(int i, Unit& u) const {
        const long L = (long)i * G + c; if (L >= nwg) return false;
        int wgid = (int)L; { const int q = nwg / NXCD, r = nwg % NXCD, xcd = wgid % NXCD, off = wgid / NXCD; wgid = (xcd < r ? xcd * (q + 1) : r * (q + 1) + (xcd - r) * q) + off; }
        const int nig = WGM * nN, gid = wgid / nig, fm = gid * WGM, gsz = (nM - fm) < WGM ? (nM - fm) : WGM;
        u.pm = fm + ((wgid % nig) % gsz); u.pn = (wgid % nig) / gsz; return true;
    }
    __device__ __forceinline__ void a_ready(const Unit&) const {}
    __device__ __forceinline__ void done(const Unit&) const {}
};
template <class Epi, class Sched, bool ALIGN_EPI = false, bool SP2 = false>
__device__ __forceinline__ void gemm_phase(PG8_LAS unsigned char* lds, const Gemm g, const Sched& S, const Epi& E) {
    int tid_ = threadIdx.x; asm volatile("" : "+v"(tid_));
    const int tid = tid_, wid = __builtin_amdgcn_readfirstlane(tid >> 6), lane = tid & 63, wr = wid >> 2, wc = wid & 3, fr = lane & 15, fq = lane >> 4;
    const int K = g.K, nt = K / BK;
    unsigned voffA[2], voffB[2];
#pragma unroll
    for (int i = 0; i < 2; ++i) { int R, C; stage_rc(tid * 16 + i * 8192, R, C); const int Rb = Epi::PERM ? ((R & ~31) + perm32(R & 31)) : R;
        voffA[i] = (unsigned)(R * K + C) * 2u; voffB[i] = (unsigned)(Rb * K + C) * 2u; }
    const size_t kstep = (size_t)(BK * 2);
    const size_t hstep = (size_t)HALF * K * 2;
    const size_t tstep = 2 * hstep;
    const unsigned ldsw = (unsigned)wid * 1024u;
    const int aoff = lds_byte(wr * 64 + fr, fq * 8), boff = lds_byte(wc * 32 + fr, fq * 8);
#define PG8_SA(b, h) (((b) * 2 + (h)) * HTB)
#define PG8_SB(b, h) ((4 + (b) * 2 + (h)) * HTB)
#define PG8_STAGE(bufoff, gbase, voff) do { _Pragma("unroll") for (int _i = 0; _i < 2; ++_i) \
        __builtin_amdgcn_global_load_lds((const unsigned*)((const char*)(gbase) + (voff)[_i]), (PG8_LAS unsigned*)(lds + (bufoff) + ldsw + _i * 8192), 16, 0, 0); } while (0)
#define PG8_LDA(dst, b, h) do { _Pragma("unroll") for (int m = 0; m < 4; ++m) _Pragma("unroll") for (int k = 0; k < 2; ++k) dst[m][k] = *(const PG8_LAS bf16x8*)(lds + PG8_SA(b, h) + aoff + m * 2048 + k * 1024); } while (0)
#define PG8_LDB(dst, b, h) do { _Pragma("unroll") for (int n = 0; n < 2; ++n) _Pragma("unroll") for (int k = 0; k < 2; ++k) dst[n][k] = *(const PG8_LAS bf16x8*)(lds + PG8_SB(b, h) + boff + n * 2048 + k * 1024); } while (0)
#define PG8_MMA(ai, bj, At, Bt) do { __builtin_amdgcn_s_setprio(1); _Pragma("unroll") for (int m = 0; m < 4; ++m) _Pragma("unroll") for (int n = 0; n < 2; ++n) _Pragma("unroll") for (int k = 0; k < 2; ++k) \
        acc[ai][bj][m][n] = __builtin_amdgcn_mfma_f32_16x16x32_bf16(Bt[n][k], At[m][k], acc[ai][bj][m][n], 0, 0, 0); __builtin_amdgcn_s_setprio(0); } while (0)
#define PG8_WAIT_V(n) asm volatile("s_waitcnt vmcnt(" #n ")" ::: "memory")
#define PG8_WAIT_L(n) asm volatile("s_waitcnt lgkmcnt(" #n ")" ::: "memory")
#define PG8_BAR __builtin_amdgcn_s_barrier()
#define PG8_SCHED __builtin_amdgcn_sched_barrier(0)
    Unit cur, nxt; int ui = 0;
    if (!S.next(0, cur)) return;
    f32x4 acc[2][2][4][2];
#pragma unroll
    for (int a = 0; a < 2; ++a)
#pragma unroll
        for (int b = 0; b < 2; ++b)
#pragma unroll
            for (int m = 0; m < 4; ++m)
#pragma unroll
                for (int n = 0; n < 2; ++n) acc[a][b][m][n] = (f32x4){0.f, 0.f, 0.f, 0.f};
    bf16x8 At[4][2], B0[2][2], B1[2][2];
    const char* cA = (const char*)g.A + (size_t)cur.pm * tstep; const char* cB = (const char*)g.Bt + (size_t)cur.pn * tstep;
    S.a_ready(cur);
    if constexpr (SP2) {
        PG8_STAGE(PG8_SB(0, 0), cB, voffB); PG8_STAGE(PG8_SB(0, 1), cB + hstep, voffB); PG8_STAGE(PG8_SA(0, 0), cA, voffA); PG8_STAGE(PG8_SA(0, 1), cA + hstep, voffA);
        if (wr == 1) PG8_BAR;
        PG8_WAIT_V(2); PG8_BAR;
        PG8_STAGE(PG8_SB(1, 0), cB + kstep, voffB); PG8_STAGE(PG8_SA(1, 0), cA + kstep, voffA); PG8_STAGE(PG8_SB(1, 1), cB + hstep + kstep, voffB);
        PG8_WAIT_V(6); PG8_BAR;
    } else {
        PG8_STAGE(PG8_SB(0, 0), cB, voffB); PG8_STAGE(PG8_SA(0, 0), cA, voffA); PG8_STAGE(PG8_SB(0, 1), cB + hstep, voffB); PG8_STAGE(PG8_SA(0, 1), cA + hstep, voffA);
        if (wr == 1) PG8_BAR;
        PG8_WAIT_V(4); PG8_BAR;
        PG8_STAGE(PG8_SB(1, 0), cB + kstep, voffB); PG8_STAGE(PG8_SA(1, 0), cA + kstep, voffA); PG8_STAGE(PG8_SB(1, 1), cB + hstep + kstep, voffB);
        PG8_WAIT_V(6); PG8_BAR;
    }
    for (;;) {
        const bool has_next = S.next(ui + 1, nxt);
        const char* nA = has_next ? (const char*)g.A + (size_t)nxt.pm * tstep : cA; const char* nB = has_next ? (const char*)g.Bt + (size_t)nxt.pn * tstep : cB;
        for (int t = 0; t < nt; t += 2) {
            const bool last = (t == nt - 2);
            const char* a1 = cA + (size_t)(t + 1) * kstep;
            const char* a2 = last ? nA : cA + (size_t)(t + 2) * kstep; const char* b2 = last ? nB : cB + (size_t)(t + 2) * kstep;
            const char* a3 = a2 + kstep; const char* b3 = b2 + kstep;
            if (last && has_next) S.a_ready(nxt);
            if constexpr (SP2) {
            PG8_LDB(B0, 0, 0); PG8_LDB(B1, 0, 1); PG8_SCHED; PG8_LDA(At, 0, 0); PG8_STAGE(PG8_SA(1, 1), a1 + hstep, voffA);
            PG8_WAIT_V(8); PG8_WAIT_L(0); PG8_BAR; PG8_MMA(0, 0, At, B0); PG8_MMA(0, 1, At, B1); PG8_BAR; PG8_SCHED;
            PG8_LDA(At, 0, 1); PG8_STAGE(PG8_SB(0, 0), b2, voffB); PG8_STAGE(PG8_SB(0, 1), b2 + hstep, voffB); PG8_STAGE(PG8_SA(0, 0), a2, voffA);
            PG8_WAIT_V(8); PG8_WAIT_L(0); PG8_BAR; PG8_MMA(1, 0, At, B0); PG8_MMA(1, 1, At, B1); PG8_BAR; PG8_SCHED;
            PG8_LDB(B0, 1, 0); PG8_LDB(B1, 1, 1); PG8_SCHED; PG8_LDA(At, 1, 0); PG8_STAGE(PG8_SA(0, 1), a2 + hstep, voffA);
            PG8_WAIT_V(8); PG8_WAIT_L(0); PG8_BAR; PG8_MMA(0, 0, At, B0); PG8_MMA(0, 1, At, B1); PG8_BAR; PG8_SCHED;
            PG8_LDA(At, 1, 1); PG8_STAGE(PG8_SB(1, 0), b3, voffB); PG8_STAGE(PG8_SB(1, 1), b3 + hstep, voffB); PG8_STAGE(PG8_SA(1, 0), a3, voffA);
            PG8_WAIT_V(8); PG8_WAIT_L(0); PG8_BAR; PG8_MMA(1, 0, At, B0); PG8_MMA(1, 1, At, B1); PG8_BAR; PG8_SCHED;
            } else {
            PG8_LDB(B0, 0, 0); PG8_SCHED; PG8_LDA(At, 0, 0); PG8_STAGE(PG8_SA(1, 1), a1 + hstep, voffA);
            PG8_WAIT_L(8); PG8_BAR; PG8_WAIT_L(0); PG8_MMA(0, 0, At, B0); PG8_BAR; PG8_SCHED;
            PG8_LDB(B1, 0, 1); PG8_STAGE(PG8_SB(0, 0), b2, voffB);
            PG8_BAR; PG8_WAIT_L(0); PG8_MMA(0, 1, At, B1); PG8_BAR;
            PG8_LDA(At, 0, 1); PG8_STAGE(PG8_SA(0, 0), a2, voffA);
            PG8_BAR; PG8_WAIT_L(0); PG8_MMA(1, 0, At, B0); PG8_BAR; PG8_SCHED;
            PG8_STAGE(PG8_SB(0, 1), b2 + hstep, voffB);
            PG8_WAIT_V(6); PG8_BAR; PG8_MMA(1, 1, At, B1); PG8_BAR;
            PG8_LDB(B0, 1, 0); PG8_SCHED; PG8_LDA(At, 1, 0); PG8_STAGE(PG8_SA(0, 1), a2 + hstep, voffA);
            PG8_WAIT_L(8); PG8_BAR; PG8_WAIT_L(0); PG8_MMA(0, 0, At, B0); PG8_BAR; PG8_SCHED;
            PG8_LDB(B1, 1, 1); PG8_STAGE(PG8_SB(1, 0), b3, voffB);
            PG8_BAR; PG8_WAIT_L(0); PG8_MMA(0, 1, At, B1); PG8_BAR;
            PG8_LDA(At, 1, 1); PG8_STAGE(PG8_SA(1, 0), a3, voffA);
            PG8_BAR; PG8_WAIT_L(0); PG8_MMA(1, 0, At, B0); PG8_BAR; PG8_SCHED;
            PG8_STAGE(PG8_SB(1, 1), b3 + hstep, voffB);
            PG8_WAIT_V(6); PG8_BAR; PG8_MMA(1, 1, At, B1); PG8_BAR;
            }
        }
        if constexpr (ALIGN_EPI) { if (wr == 0) PG8_BAR; }
        if constexpr (!Epi::AFTER_DRAIN) { E(acc, cur, wr, wc, fr, fq); S.done(cur); }
        if (!has_next) break;
#pragma unroll
        for (int a = 0; a < 2; ++a)
#pragma unroll
            for (int b = 0; b < 2; ++b)
#pragma unroll
                for (int m = 0; m < 4; ++m)
#pragma unroll
                    for (int n = 0; n < 2; ++n) acc[a][b][m][n] = (f32x4){0.f, 0.f, 0.f, 0.f};
        cur = nxt; cA = nA; cB = nB; ++ui;
        if constexpr (ALIGN_EPI) { if (wr == 1) PG8_BAR; }
    }
    PG8_WAIT_V(0);
    if constexpr (!ALIGN_EPI) { if (wr == 0) PG8_BAR; }
    PG8_BAR;
    if constexpr (Epi::AFTER_DRAIN) { E.fused(acc, cur, wr, wc, fr, fq, lds, wid, lane); S.done(cur); }
#undef PG8_SA
#undef PG8_SB
#undef PG8_STAGE
#undef PG8_LDA
#undef PG8_LDB
#undef PG8_MMA
#undef PG8_WAIT_V
#undef PG8_WAIT_L
#undef PG8_BAR
#undef PG8_SCHED
}
}
#define PG8_SP2 true
#define PG8_ALIGN true

using pg8::f32x4; using pg8::Unit; using pg8::BM; using pg8::HALF; typedef pg8::u32x4 u32x4;
typedef unsigned short bf16_t;

struct EpiZ {
    static constexpr bool PERM = true, AFTER_DRAIN = false;
    bf16_t* zrw; bf16_t* zug; float* out;
    __device__ __forceinline__ void operator()(const f32x4 (&acc)[2][2][4][2], const Unit& u, int wr, int wc, int fr, int fq) const {
        const int colt = u.pn * BM;
        const int mode = colt < CSH ? 0 : (colt < C_G0 ? 1 : 2);
        const int row0 = u.pm * BM + wr * 64 + fr, col0 = colt + wc * 32 + 8 * fq;
#pragma unroll
        for (int ai = 0; ai < 2; ++ai)
#pragma unroll
            for (int m = 0; m < 4; ++m) {
                const int row = row0 + ai * HALF + m * 16;
                bf16_t* rowp = mode == 0 ? zrw + (size_t)row * CSH + col0 : zug + (size_t)row * ZUGW + (col0 - CSH);
                bool last; float* sh;
                if (row < MP) { last = (row & (TP - 1)) == TP - 1; sh = out + O_SHP + (size_t)(row / TP) * CSH + col0; }
                else { const int rs = row - MP; last = (rs & (TS - 1)) == TS - 1; sh = out + O_SHS + (size_t)(rs / TS) * CSH + col0; }
#pragma unroll
                for (int bj = 0; bj < 2; ++bj) {
                    f32x4 v0 = acc[ai][bj][m][0], v1 = acc[ai][bj][m][1];
                    if (mode == 0) { if (last) { *(f32x4*)(sh + bj * HALF) = v0; *(f32x4*)(sh + bj * HALF + 4) = v1; } }
                    else if (mode == 1) {
#pragma unroll
                        for (int e = 0; e < 4; ++e) { v0[e] = gelu_tanh(v0[e]); v1[e] = gelu_tanh(v1[e]); }
                    } else {
#pragma unroll
                        for (int e = 0; e < 4; ++e) { v0[e] = sigmoidf_(v0[e]); v1[e] = sigmoidf_(v1[e]); }
                    }
                    u32x4 w; w.x = pk2(v0[0], v0[1]); w.y = pk2(v0[2], v0[3]); w.z = pk2(v1[0], v1[1]); w.w = pk2(v1[2], v1[3]);
                    *(u32x4*)(rowp + bj * HALF) = w;
                }
            }
    }
};
struct EpiMerge {
    static constexpr bool PERM = true, AFTER_DRAIN = false;
    const bf16_t* z; bf16_t* mg;
    __device__ __forceinline__ void operator()(const f32x4 (&acc)[2][2][4][2], const Unit& u, int wr, int wc, int fr, int fq) const {
        const int which = u.pm >= 36 ? 1 : 0, pm = u.pm - 36 * which, pn = u.pn - 8 * which;
        const int row0 = pm * BM + wr * 64 + fr, col0 = pn * BM + wc * 32 + 8 * fq;
        const int gcol = which ? ZU_G1 : ZU_G0;
#pragma unroll
        for (int ai = 0; ai < 2; ++ai)
#pragma unroll
            for (int m = 0; m < 4; ++m) {
                const int row = row0 + ai * HALF + m * 16;
#pragma unroll
                for (int bj = 0; bj < 2; ++bj) {
                    const u32x4 gw = *(const u32x4*)(z + (size_t)row * ZUGW + gcol + col0 + bj * HALF);
                    bf16_t* mp = mg + (size_t)row * D + col0 + bj * HALF;
                    u32x4 pw = (u32x4){0u, 0u, 0u, 0u};
                    if (which) pw = *(const u32x4*)mp;
                    const f32x4 v0 = acc[ai][bj][m][0], v1 = acc[ai][bj][m][1];
                    u32x4 w;
                    w.x = pk2(bflo(pw.x) + bflo(gw.x) * v0[0], bfhi(pw.x) + bfhi(gw.x) * v0[1]);
                    w.y = pk2(bflo(pw.y) + bflo(gw.y) * v0[2], bfhi(pw.y) + bfhi(gw.y) * v0[3]);
                    w.z = pk2(bflo(pw.z) + bflo(gw.z) * v1[0], bfhi(pw.z) + bfhi(gw.z) * v1[1]);
                    w.w = pk2(bflo(pw.w) + bflo(gw.w) * v1[2], bfhi(pw.w) + bfhi(gw.w) * v1[3]);
                    *(u32x4*)mp = w;
                }
            }
    }
};
struct EpiRes1 {
    static constexpr bool PERM = false, AFTER_DRAIN = false;
    const float* xp; const float* xs; const float* mod; float* out;
    __device__ __forceinline__ void operator()(const f32x4 (&acc)[2][2][4][2], const Unit& u, int wr, int wc, int fr, int fq) const {
        const int row0 = u.pm * BM + wr * 64 + fr, col0 = u.pn * BM + wc * 32 + 4 * fq;
#pragma unroll
        for (int ai = 0; ai < 2; ++ai)
#pragma unroll
            for (int m = 0; m < 4; ++m) {
                const int row = row0 + ai * HALF + m * 16;
                const float* xr = (row < MP ? xp + (size_t)row * D : xs + (size_t)(row - MP) * D) + col0;
                const float* gm = mod + (size_t)seq_of_row(row) * (6 * D) + 2 * D + col0;
                float* o = out + (size_t)row * D + col0;
#pragma unroll
                for (int bj = 0; bj < 2; ++bj)
#pragma unroll
                    for (int n = 0; n < 2; ++n) { const int c = bj * HALF + n * 16;
                        *(f32x4*)(o + c) = *(const f32x4*)(xr + c) + *(const f32x4*)(gm + c) * acc[ai][bj][m][n]; }
            }
    }
};
struct EpiSwiglu {
    static constexpr bool PERM = true, AFTER_DRAIN = false;
    bf16_t* act;
    __device__ __forceinline__ void operator()(const f32x4 (&acc)[2][2][4][2], const Unit& u, int wr, int wc, int fr, int fq) const {
        const int row0 = u.pm * BM + wr * 64 + fr, col0 = u.pn * HALF + wc * 32 + 8 * fq;
#pragma unroll
        for (int ai = 0; ai < 2; ++ai)
#pragma unroll
            for (int m = 0; m < 4; ++m) {
                const int row = row0 + ai * HALF + m * 16;
                float r[8];
#pragma unroll
                for (int n = 0; n < 2; ++n)
#pragma unroll
                    for (int e = 0; e < 4; ++e) { const float g = acc[ai][0][m][n][e]; r[4 * n + e] = g * sigmoidf_(g) * acc[ai][1][m][n][e]; }
                u32x4 w; w.x = pk2(r[0], r[1]); w.y = pk2(r[2], r[3]); w.z = pk2(r[4], r[5]); w.w = pk2(r[6], r[7]);
                *(u32x4*)(act + (size_t)row * DFF + col0) = w;
            }
    }
};
struct EpiRes2 {
    static constexpr bool PERM = false, AFTER_DRAIN = false;
    const float* mod; float* out;
    __device__ __forceinline__ void operator()(const f32x4 (&acc)[2][2][4][2], const Unit& u, int wr, int wc, int fr, int fq) const {
        const int row0 = u.pm * BM + wr * 64 + fr, col0 = u.pn * BM + wc * 32 + 4 * fq;
#pragma unroll
        for (int ai = 0; ai < 2; ++ai)
#pragma unroll
            for (int m = 0; m < 4; ++m) {
                const int row = row0 + ai * HALF + m * 16;
                const float* gf = mod + (size_t)seq_of_row(row) * (6 * D) + 5 * D + col0;
                float* o = out + (size_t)row * D + col0;
#pragma unroll
                for (int bj = 0; bj < 2; ++bj)
#pragma unroll
                    for (int n = 0; n < 2; ++n) { const int c = bj * HALF + n * 16;
                        *(f32x4*)(o + c) = *(const f32x4*)(o + c) + *(const f32x4*)(gf + c) * acc[ai][bj][m][n]; }
            }
    }
};
struct BranchOrder {
    int G, c;
    __device__ bool next(int i, Unit& u) const { const int t = (i >> 1) * G + c; if (t >= (M / BM) * (D / BM)) return false; const int which = i & 1;
        u.pm = t / (D / BM) + (M / BM) * which; u.pn = t % (D / BM) + (D / BM) * which; return true; }
    __device__ __forceinline__ void a_ready(const Unit&) const {}
    __device__ __forceinline__ void done(const Unit&) const {}
};

#define GAS __attribute__((address_space(1)))
#define LAS __attribute__((address_space(3)))
typedef GAS unsigned gu32;
#define RLX_AGENT __ATOMIC_RELAXED, __HIP_MEMORY_SCOPE_AGENT
#define LDS_WAIT() asm volatile("s_waitcnt lgkmcnt(0)" ::: "memory")
#define VM_WAIT() asm volatile("s_waitcnt vmcnt(0)" ::: "memory")
#define XB_TMO      128
#define XB_XCNT(j)  (256  + 64 * (j))
#define XB_XSUB(j)  (1280 + 64 * (j))
#define XB_XGEN(j)  (2304 + 64 * (j))
#define XB_TOP      3328
#define XB_TOPGEN   3392
#define XCD_BAR_WORDS 3456
#define XB_SPIN_CAP (1u << 18)

__device__ __forceinline__ unsigned xb_ld(unsigned* p)              { return __hip_atomic_load(p, __ATOMIC_RELAXED, __HIP_MEMORY_SCOPE_AGENT); }
__device__ __forceinline__ unsigned xb_add(unsigned* p, unsigned v) { return __hip_atomic_fetch_add(p, v, __ATOMIC_RELAXED, __HIP_MEMORY_SCOPE_AGENT); }
__device__ __forceinline__ unsigned xb_xcc_id() { return (unsigned)__builtin_amdgcn_s_getreg((3 << 11) | 20) & 0xFu; }
#define XB_SPIN(cond, bar) do { unsigned _sp = 0; while (cond) { __builtin_amdgcn_s_sleep(1); \
    if ((++_sp & 255u) == 0u) { if (xb_ld(&(bar)[XB_TMO])) break; if (_sp > XB_SPIN_CAP) { atomicAdd(&(bar)[XB_TMO], 1u); break; } } } } while (0)

struct XcdBarrier {
    unsigned* bar; unsigned x;
    volatile LAS unsigned* st;
};

__device__ __forceinline__ XcdBarrier xcd_barrier_post(unsigned* bar, volatile LAS unsigned* st) {
    XcdBarrier b; b.bar = bar; b.x = xb_xcc_id(); b.st = st;
    if (threadIdx.x == 0) (void)xb_add(&bar[XB_XCNT(b.x)], 1u);
    return b;
}
__device__ __forceinline__ void xcd_barrier_complete(unsigned* bar, unsigned x, unsigned& nloc, unsigned& nx) {
    const unsigned G = gridDim.x * gridDim.y * gridDim.z;
    unsigned sum, cnt, mine, sp = 0u;
    for (;;) {
        sum = 0u; cnt = 0u; mine = 0u;
#pragma unroll
        for (unsigned j = 0; j < 16; ++j) { const unsigned c = xb_ld(&bar[XB_XCNT(j)]); sum += c; cnt += (c > 0u) ? 1u : 0u; mine = (j == x) ? c : mine; }
        if (sum == G) break;
        __builtin_amdgcn_s_sleep(1);
        if ((++sp & 255u) == 0u) { if (xb_ld(&bar[XB_TMO])) break; if (sp > XB_SPIN_CAP) { atomicAdd(&bar[XB_TMO], 1u); break; } }
    }
    nloc = mine > 0u ? mine : 1u; nx = cnt > 0u ? cnt : 1u;
}

__device__ __forceinline__ void xcd_barrier(const XcdBarrier& b) {
    asm volatile("s_waitcnt vmcnt(0)" ::: "memory");
    __syncthreads();
    if (threadIdx.x == 0) {
        unsigned* bar = b.bar;
        __builtin_amdgcn_s_waitcnt(0);
        unsigned nloc = b.st[0], nx = b.st[1];
        if (nloc == 0u) { xcd_barrier_complete(bar, b.x, nloc, nx); b.st[0] = nloc; b.st[1] = nx; }
        const unsigned old = xb_add(&bar[XB_XSUB(b.x)], 1u);
        const unsigned gen = old / nloc;
        if (old + 1u == (gen + 1u) * nloc) {
            __builtin_amdgcn_fence(__ATOMIC_RELEASE, "agent");
            asm volatile("s_waitcnt vmcnt(0)" ::: "memory");
            const unsigned og = xb_add(&bar[XB_TOP], 1u);
            const unsigned tg = og / nx;
            if (og + 1u == (tg + 1u) * nx) xb_add(&bar[XB_TOPGEN], 1u);
            else XB_SPIN(xb_ld(&bar[XB_TOPGEN]) == tg, bar);
            __builtin_amdgcn_fence(__ATOMIC_ACQUIRE, "agent");
            xb_add(&bar[XB_XGEN(b.x)], 1u);
            asm volatile("s_waitcnt vmcnt(0)" ::: "memory");
        } else {
            XB_SPIN(xb_ld(&bar[XB_XGEN(b.x)]) == gen, bar);
            __builtin_amdgcn_fence(__ATOMIC_ACQUIRE, "agent");
            asm volatile("s_waitcnt vmcnt(0)" ::: "memory");
        }
    }
    __syncthreads();
}

typedef pg8::bf16x8 bf16x8;
#define MFMA16(a, b, c) __builtin_amdgcn_mfma_f32_16x16x32_bf16((a), (b), (c), 0, 0, 0)
constexpr int RB_P1 = 0, RB_RT = 2048, RB_QP = 4096, RB_RAK = 5120, RB_VM = 6144, RB_WL = 8192;

__device__ __forceinline__ f32x4 ld_bf4(const bf16_t* p) { const u32x2v w = *(const u32x2v*)p; return (f32x4){bflo(w.x), bfhi(w.x), bflo(w.y), bfhi(w.y)}; }
__device__ __forceinline__ bf16x8 mk_frag(const f32x4 a, const f32x4 b) { u32x4 w; w.x = pk2(a[0], a[1]); w.y = pk2(a[2], a[3]); w.z = pk2(b[0], b[1]); w.w = pk2(b[2], b[3]); return __builtin_bit_cast(bf16x8, w); }
__device__ __forceinline__ unsigned char* recA_ptr(const P& p, int rec) { return rec < NREC_P ? p.ws + WS_H + (size_t)rec * RECA : p.ws + WS_FRA_S + (size_t)(rec - NREC_P) * RECA; }
__device__ __forceinline__ unsigned char* recB_ptr(const P& p, int rec) { return rec < NREC_P ? (unsigned char*)p.out + (size_t)rec * RECB : p.ws + WS_FRB_S + (size_t)(rec - NREC_P) * RECB; }
__device__ __forceinline__ f32x4 sig4(f32x4 x) { return (f32x4){sigmoidf_(x[0]), sigmoidf_(x[1]), sigmoidf_(x[2]), sigmoidf_(x[3])}; }
__device__ __forceinline__ f32x4 exp4(f32x4 x) { return (f32x4){__expf(x[0]), __expf(x[1]), __expf(x[2]), __expf(x[3])}; }

template <class T> __device__ __forceinline__ T ldu(const void* ubase, unsigned voff) { return *(const T*)((const char*)ubase + voff); }
__device__ __forceinline__ f32x4 bf4(const u32x2v w) { return (f32x4){bflo(w.x), bfhi(w.x), bflo(w.y), bfhi(w.y)}; }
struct ShiftCtx { const bf16_t* zrw; const float* ss; const float* mu; unsigned zoc, zop; bool valid, pz, ps; };
__device__ __forceinline__ f32x4 shift4(const ShiftCtx& k, int cu, unsigned lp) {
    const f32x4 z4 = (f32x4){0.f, 0.f, 0.f, 0.f};
    const u32x2v cw = ldu<u32x2v>(k.zrw + cu, k.zoc + lp * 2u), pw = ldu<u32x2v>(k.zrw + cu, k.zop + lp * 2u);
    const f32x4 sv = ldu<f32x4>(k.ss + cu, lp * 4u), m = ldu<f32x4>(k.mu + cu, lp * 4u);
    const f32x4 cur = k.valid ? bf4(cw) : z4;
    const f32x4 pv = k.pz ? bf4(pw) : (k.ps ? sv : z4);
    return cur + (pv - cur) * m;
}

__device__ __forceinline__ void prep_record(const P& p, LAS unsigned char* wl, int rec, int lane_in) {
    int lane = lane_in; asm volatile("" : "+v"(lane));
    const int head = rec & 15, chunkid = rec >> 4;
    const bool prompt = chunkid < NPB * 128;
    const int sq = prompt ? (chunkid >> 7) : NPB + (chunkid - NPB * 128);
    const int c = prompt ? (chunkid & 127) : 0;
    const int row0 = prompt ? sq * TP + c * 16 : MP + (sq - NPB) * TS;
    const int nvalid = prompt ? 16 : TS;
    const int i = lane & 15, q = lane >> 4;
    const bool valid = i < nvalid, first = (c == 0);
    const bool pz = valid && (i > 0 || !first), ps = valid && (i == 0) && first && !prompt;
    const int row = row0 + (valid ? i : 0);
    ShiftCtx K;
    K.zrw = (const bf16_t*)(p.ws + WS_ZRW); K.ss = p.in[3] + (size_t)(prompt ? 0 : sq - NPB) * CSH; K.mu = p.in[10];
    K.zoc = (unsigned)row * (unsigned)(CSH * 2); K.zop = pz ? K.zoc - (unsigned)(CSH * 2) : K.zoc; K.valid = valid; K.pz = pz; K.ps = ps;
    const unsigned q4 = (unsigned)q * 4u, q8 = (unsigned)q * 8u;
    const unsigned wlo64 = (unsigned)(i * 64 + q * 8) * 2u, wlo128 = (unsigned)(i * 128 + q * 8) * 2u;
    const bf16_t* WDUT = (const bf16_t*)(p.ws + WS_LORA); const bf16_t* WAUT = WDUT + RW * 64; const bf16_t* WGUT = WAUT + RW * 64;
    const f32x4 z4 = (f32x4){0.f, 0.f, 0.f, 0.f};

    f32x4 accw[4], acca[4];
#pragma unroll
    for (int ct = 0; ct < 4; ++ct) { accw[ct] = z4; acca[ct] = z4; }
#pragma unroll
    for (int s = 0; s < 2; ++s) {
        const int cw = 3072 + 32 * s, ca = 3136 + 32 * s;
        f32x4 x0 = shift4(K, cw, q8), x1 = shift4(K, cw + 4, q8);
#pragma unroll
        for (int e = 0; e < 4; ++e) { x0[e] = 2.f * sigmoidf_(2.f * x0[e]) - 1.f; x1[e] = 2.f * sigmoidf_(2.f * x1[e]) - 1.f; }
        const bf16x8 td = mk_frag(x0, x1);
        const bf16x8 ad = mk_frag(shift4(K, ca, q8), shift4(K, ca + 4, q8));
#pragma unroll
        for (int ct = 0; ct < 4; ++ct) {
            const int wo = (head * 64 + 16 * ct) * 64 + 32 * s;
            accw[ct] = MFMA16(ldu<bf16x8>(WDUT + wo, wlo64), td, accw[ct]);
            acca[ct] = MFMA16(ldu<bf16x8>(WAUT + wo, wlo64), ad, acca[ct]);
        }
    }
    f32x4 lw[4], av[4], ks[4];
    float ssq = 0.f;
#pragma unroll
    for (int ct = 0; ct < 4; ++ct) {
        const int cbu = head * 64 + 16 * ct;
        lw[ct] = sig4(ldu<f32x4>(p.in[11] + cbu, q4 * 4u) + accw[ct]) * (-0.6065306597126334f);
        if (!valid) lw[ct] = z4;
        av[ct] = sig4(ldu<f32x4>(p.in[13] + cbu, q4 * 4u) + acca[ct]);
        ks[ct] = shift4(K, RW + cbu, q4);
        const f32x4 kk0 = ks[ct] * ldu<f32x4>(p.in[16] + cbu, q4 * 4u);
        ssq += (kk0[0] * kk0[0] + kk0[1] * kk0[1]) + (kk0[2] * kk0[2] + kk0[3] * kk0[3]);
    }
    ssq += __shfl_xor(ssq, 16); ssq += __shfl_xor(ssq, 32);
    const float kinv = 1.f / fmaxf(sqrtf(ssq), 1e-12f);
    f32x4 lwc[4];
#pragma unroll
    for (int ct = 0; ct < 4; ++ct) lwc[ct] = lw[ct];
#pragma unroll
    for (int d = 1; d < 16; d <<= 1)
#pragma unroll
        for (int ct = 0; ct < 4; ++ct)
#pragma unroll
            for (int e = 0; e < 4; ++e) { const float t = __shfl_up(lwc[ct][e], d, 16); if (i >= d) lwc[ct][e] += t; }
    unsigned char* rb = recB_ptr(p, rec); unsigned char* ra = recA_ptr(p, rec);
    LAS unsigned short* KT = (LAS unsigned short*)wl; LAS unsigned short* AT = KT + 1024; LAS unsigned short* KtT = KT + 2048; LAS unsigned short* VT = KT + 3072;
    LAS float* MT = (LAS float*)(wl + 8192);
    u32x2v kapP[4], alpP[4], ktP[4], rtP[4];
    float bsum = 0.f;
#pragma unroll
    for (int ct = 0; ct < 4; ++ct) {
        const int cbu = head * 64 + 16 * ct;
        const f32x4 Wt = exp4(lwc[ct]), Wtm1 = exp4(lwc[ct] - lw[ct]), Winv = exp4(-lwc[ct]);
        const f32x4 kkn = ks[ct] * ldu<f32x4>(p.in[16] + cbu, q4 * 4u) * kinv;
        const f32x4 kmod = ks[ct] * ((av[ct] - 1.f) * ldu<f32x4>(p.in[17] + cbu, q4 * 4u) + 1.f);
        const f32x4 kap = kkn * Wtm1, alp = kkn * av[ct] * Winv, kt = kmod * Winv;
        const f32x4 rs = shift4(K, cbu, q4);
        const f32x4 rt = rs * Wt;
        const f32x4 rk = rs * kmod * ldu<f32x4>(p.in[18] + cbu, q4 * 4u);
        bsum += (rk[0] + rk[1]) + (rk[2] + rk[3]);
        f32x4 wl15;
#pragma unroll
        for (int e = 0; e < 4; ++e) wl15[e] = __shfl(Wt[e], 15, 16);
        if (i == 0) *(f32x4*)(rb + RB_WL + (16 * ct + 4 * q) * 4) = wl15;
        kapP[ct].x = pk2(kap[0], kap[1]); kapP[ct].y = pk2(kap[2], kap[3]); alpP[ct].x = pk2(alp[0], alp[1]); alpP[ct].y = pk2(alp[2], alp[3]);
        ktP[ct].x = pk2(kt[0], kt[1]); ktP[ct].y = pk2(kt[2], kt[3]); rtP[ct].x = pk2(rt[0], rt[1]); rtP[ct].y = pk2(rt[2], rt[3]);
#pragma unroll
        for (int e = 0; e < 4; ++e) { const int ch = 16 * ct + 4 * q + e; const int sh = (e & 1) * 16;
            KT[ch * 16 + i] = (unsigned short)(((e < 2 ? kapP[ct].x : kapP[ct].y) >> sh) & 0xffffu);
            AT[ch * 16 + i] = (unsigned short)(((e < 2 ? alpP[ct].x : alpP[ct].y) >> sh) & 0xffffu);
            KtT[ch * 16 + i] = (unsigned short)(((e < 2 ? ktP[ct].x : ktP[ct].y) >> sh) & 0xffffu); }
    }
    bsum += __shfl_xor(bsum, 16); bsum += __shfl_xor(bsum, 32);
    {
        f32x4 accg[4];
#pragma unroll
        for (int ct = 0; ct < 4; ++ct) accg[ct] = z4;
#pragma unroll
        for (int s = 0; s < 4; ++s) {
            const int cg = 3200 + 32 * s;
            const bf16x8 gd = mk_frag(sig4(shift4(K, cg, q8)), sig4(shift4(K, cg + 4, q8)));
#pragma unroll
            for (int ct = 0; ct < 4; ++ct) accg[ct] = MFMA16(ldu<bf16x8>(WGUT + (head * 64 + 16 * ct) * 128 + 32 * s, wlo128), gd, accg[ct]);
        }
#pragma unroll
        for (int ct = 0; ct < 4; ++ct) {
            const int cbu = head * 64 + 16 * ct;
            const f32x4 vs = shift4(K, 2 * RW + cbu, q4);
            if (valid) {
                const f32x4 c1 = ldu<f32x4>(p.in[19] + cbu, q4 * 4u) * accg[ct];
                const f32x4 c2 = (ldu<f32x4>(p.in[20] + cbu, q4 * 4u) + vs * bsum) * accg[ct];
                u32x2v w1; w1.x = pk2(c1[0], c1[1]); w1.y = pk2(c1[2], c1[3]); *(u32x2v*)((char*)((bf16_t*)(p.ws + WS_OA) + cbu) + ((unsigned)row * RW + q4) * 2u) = w1;
                u32x2v w2; w2.x = pk2(c2[0], c2[1]); w2.y = pk2(c2[2], c2[3]); *(u32x2v*)((char*)((bf16_t*)(p.ws + WS_C2) + cbu) + ((unsigned)row * RW + q4) * 2u) = w2;
            }
#pragma unroll
            for (int e = 0; e < 4; ++e) VT[(16 * ct + 4 * q + e) * 16 + i] = f2bf(vs[e]);
        }
    }
    bf16x8 kapF[2], alpF[2], ktF[2], rtF[2];
#pragma unroll
    for (int s = 0; s < 2; ++s) {
        kapF[s] = __builtin_bit_cast(bf16x8, (u32x4){kapP[2 * s].x, kapP[2 * s].y, kapP[2 * s + 1].x, kapP[2 * s + 1].y});
        alpF[s] = __builtin_bit_cast(bf16x8, (u32x4){alpP[2 * s].x, alpP[2 * s].y, alpP[2 * s + 1].x, alpP[2 * s + 1].y});
        ktF[s] = __builtin_bit_cast(bf16x8, (u32x4){ktP[2 * s].x, ktP[2 * s].y, ktP[2 * s + 1].x, ktP[2 * s + 1].y});
        rtF[s] = __builtin_bit_cast(bf16x8, (u32x4){rtP[2 * s].x, rtP[2 * s].y, rtP[2 * s + 1].x, rtP[2 * s + 1].y});
    }
    f32x4 Maa = z4, Mak = z4, RAt = z4, RKt = z4;
#pragma unroll
    for (int s = 0; s < 2; ++s) {
        Maa = MFMA16(kapF[s], alpF[s], Maa); Mak = MFMA16(kapF[s], ktF[s], Mak);
        RAt = MFMA16(alpF[s], rtF[s], RAt); RKt = MFMA16(ktF[s], rtF[s], RKt);
    }
#pragma unroll
    for (int r = 0; r < 4; ++r) { const int rw_ = 4 * q + r;
        if (!(rw_ > i)) { Maa[r] = 0.f; Mak[r] = 0.f; }
        if (!(i >= rw_)) { RAt[r] = 0.f; RKt[r] = 0.f; } }
    *(LAS f32x4*)(MT + i * 16 + 4 * q) = Maa;
    *(u32x4*)(rb + RB_RT + lane * 16) = __builtin_bit_cast(u32x4, rtF[0]); *(u32x4*)(rb + RB_RT + 1024 + lane * 16) = __builtin_bit_cast(u32x4, rtF[1]);
    { u32x4 w; w.x = pk2(RAt[0], RAt[1]); w.y = pk2(RAt[2], RAt[3]); w.z = pk2(RKt[0], RKt[1]); w.w = pk2(RKt[2], RKt[3]); *(u32x4*)(rb + RB_RAK + lane * 16) = w; }
    LDS_WAIT(); asm volatile("" ::: "memory");
    float t[16];
#pragma unroll
    for (int cc = 15; cc >= 0; --cc) {
        float acc = (i == cc) ? 1.f : 0.f;
        f32x4 mrow[4];
#pragma unroll
        for (int b = 0; b < 4; ++b) mrow[b] = *(const LAS f32x4*)(MT + cc * 16 + 4 * b);
#pragma unroll
        for (int j = cc + 1; j < 16; ++j) acc -= t[j] * mrow[j >> 2][j & 3];
        t[cc] = acc;
    }
    f32x4 tsel;
#pragma unroll
    for (int e = 0; e < 4; ++e) tsel[e] = -(q == 0 ? t[e] : (q == 1 ? t[4 + e] : (q == 2 ? t[8 + e] : t[12 + e])));
    const bf16x8 Tfrag = mk_frag(tsel, z4);
    f32x4 P1E[4];
#pragma unroll
    for (int ct = 0; ct < 4; ++ct) { const u32x2v w = *(const LAS u32x2v*)(KT + (16 * ct + i) * 16 + 4 * q);
        u32x4 aw; aw.x = w.x; aw.y = w.y; aw.z = 0u; aw.w = 0u; P1E[ct] = MFMA16(__builtin_bit_cast(bf16x8, aw), Tfrag, z4); }
    *(u32x4*)(rb + RB_P1 + lane * 16) = __builtin_bit_cast(u32x4, mk_frag(P1E[0], P1E[1]));
    *(u32x4*)(rb + RB_P1 + 1024 + lane * 16) = __builtin_bit_cast(u32x4, mk_frag(P1E[2], P1E[3]));
    { const f32x4 Qt = MFMA16(mk_frag(Mak, z4), Tfrag, z4);
      u32x4 w; w.x = 0u; w.y = 0u; w.z = pk2(Qt[0], Qt[1]); w.w = pk2(Qt[2], Qt[3]); *(u32x4*)(rb + RB_QP + lane * 16) = w; }
#pragma unroll
    for (int tt = 0; tt < 4; ++tt) {
        const u32x2v a = *(const LAS u32x2v*)(AT + (16 * tt + i) * 16 + 4 * q), b = *(const LAS u32x2v*)(KtT + (16 * tt + i) * 16 + 4 * q);
        u32x4 w; w.x = a.x; w.y = a.y; w.z = b.x; w.w = b.y; *(u32x4*)(ra + tt * 1024 + lane * 16) = w;
        *(u32x2v*)(rb + RB_VM + tt * 512 + lane * 8) = *(const LAS u32x2v*)(VT + (16 * tt + i) * 16 + 4 * q);
    }
    LDS_WAIT(); asm volatile("" ::: "memory");
}

struct ScanFr { bf16x8 P10, P11, RT0, RT1, QP, RAK, AK0, AK1, AK2, AK3; u32x2v vm; f32x4 WL0, WL1, WL2, WL3; };
__device__ __forceinline__ void scan_load(ScanFr& f, const P& p, int rec, int vs, int lane) {
    const unsigned char* ra = recA_ptr(p, rec); const unsigned char* rb = recB_ptr(p, rec);
    const unsigned l16 = (unsigned)lane * 16u, q16 = (unsigned)(lane >> 4) * 16u;
    f.P10 = ldu<bf16x8>(rb + RB_P1, l16); f.P11 = ldu<bf16x8>(rb + RB_P1 + 1024, l16);
    f.RT0 = ldu<bf16x8>(rb + RB_RT, l16); f.RT1 = ldu<bf16x8>(rb + RB_RT + 1024, l16);
    f.QP = ldu<bf16x8>(rb + RB_QP, l16); f.RAK = ldu<bf16x8>(rb + RB_RAK, l16);
    f.vm = ldu<u32x2v>(rb + RB_VM + vs * 512, (unsigned)lane * 8u);
    f.AK0 = ldu<bf16x8>(ra, l16); f.AK1 = ldu<bf16x8>(ra + 1024, l16); f.AK2 = ldu<bf16x8>(ra + 2048, l16); f.AK3 = ldu<bf16x8>(ra + 3072, l16);
    f.WL0 = ldu<f32x4>(rb + RB_WL, q16); f.WL1 = ldu<f32x4>(rb + RB_WL + 64, q16); f.WL2 = ldu<f32x4>(rb + RB_WL + 128, q16); f.WL3 = ldu<f32x4>(rb + RB_WL + 192, q16);
}
__device__ __forceinline__ void scan_chain(const P& p, int sq, int head, int vs, int lane) {
    const bool prompt = sq < NPB;
    const int nch = prompt ? TP / 16 : 1;
    const int rec0 = prompt ? sq * (TP / 16) * NH + head : NREC_P + (sq - NPB) * NH + head;
    const int row0 = prompt ? sq * TP : MP + (sq - NPB) * TS;
    const int vl = lane & 15, q = lane >> 4;
    const f32x4 z4 = (f32x4){0.f, 0.f, 0.f, 0.f};
    f32x4 St[4];
    float* sout = (prompt ? p.out + O_WKVP + ((size_t)sq * NH + head) * HS * HS : p.out + O_WKVS + ((size_t)(sq - NPB) * NH + head) * HS * HS) + (size_t)(16 * vs + vl) * HS + 4 * q;
    ScanFr f0, f1;
    scan_load(f0, p, rec0, vs, lane);
    scan_load(f1, p, nch > 1 ? rec0 + NH : rec0, vs, lane);
    if (prompt) {
#pragma unroll
        for (int t = 0; t < 4; ++t) St[t] = z4;
    } else {
        const float* sin = p.in[2] + ((size_t)(sq - NPB) * NH + head) * HS * HS + (size_t)(16 * vs + vl) * HS + 4 * q;
#pragma unroll
        for (int t = 0; t < 4; ++t) St[t] = *(const f32x4*)(sin + 16 * t);
    }
    float* oraw = (float*)(p.ws + WS_ZRW) + (size_t)row0 * RW + head * HS + 16 * vs + vl;
    for (int c = 0; c < nch; ++c) {
        const ScanFr f = f0; f0 = f1;
        { const int cn = c + 2 < nch ? c + 2 : nch - 1; scan_load(f1, p, rec0 + cn * NH, vs, lane); }
        const bf16x8 SB0 = mk_frag(St[0], St[1]), SB1 = mk_frag(St[2], St[3]);
        u32x4 vw; vw.x = 0u; vw.y = 0u; vw.z = f.vm.x; vw.w = f.vm.y;
        f32x4 U = MFMA16(f.QP, __builtin_bit_cast(bf16x8, vw), z4);
        U = MFMA16(f.P10, SB0, U); U = MFMA16(f.P11, SB1, U);
        u32x4 uw; uw.x = pk2(U[0], U[1]); uw.y = pk2(U[2], U[3]); uw.z = f.vm.x; uw.w = f.vm.y;
        const bf16x8 UB = __builtin_bit_cast(bf16x8, uw);
        f32x4 O = MFMA16(f.RT0, SB0, z4); O = MFMA16(f.RT1, SB1, O); O = MFMA16(f.RAK, UB, O);
        St[0] = MFMA16(f.AK0, UB, St[0]) * f.WL0; St[1] = MFMA16(f.AK1, UB, St[1]) * f.WL1;
        St[2] = MFMA16(f.AK2, UB, St[2]) * f.WL2; St[3] = MFMA16(f.AK3, UB, St[3]) * f.WL3;
#pragma unroll
        for (int r = 0; r < 4; ++r) { const int tk = 4 * q + r; if (prompt || tk < TS) oraw[(size_t)(16 * c + tk) * RW] = O[r]; }
    }
#pragma unroll
    for (int t = 0; t < 4; ++t) *(f32x4*)(sout + 16 * t) = St[t];
}

__device__ __forceinline__ void mix_item(const P& p, int item, int wave, int lane) {
    const int g = item & 7, row0 = (item >> 3) * 128;
    const int dl = lane & 15, q = lane >> 4, col = g * 128 + wave * 16;
    const bf16_t* vn = (const bf16_t*)(p.ws + WS_VN) + (size_t)row0 * MLPW + col + dl;
    bf16x8 A[4];
#pragma unroll
    for (int sb = 0; sb < 4; ++sb)
#pragma unroll
        for (int j = 0; j < 8; ++j) A[sb][j] = (short)vn[(size_t)(32 * sb + 8 * q + j) * MLPW];
    const float* wsg = p.in[23] + ((size_t)g * 128 + dl) * 128 + 8 * q;
    const bf16_t* zu = (const bf16_t*)(p.ws + WS_ZUG) + (size_t)(row0 + dl) * ZUGW + ZU_U + col + 4 * q;
    bf16_t* ub = (bf16_t*)(p.ws + WS_UB) + (size_t)(row0 + dl) * MLPW + col + 4 * q;
#pragma unroll
    for (int tt = 0; tt < 8; ++tt) {
        const int t = 16 * tt + dl;
        f32x4 acc = (f32x4){0.f, 0.f, 0.f, 0.f};
#pragma unroll
        for (int sb = 0; sb <= tt / 2; ++sb) {
            const float* wr = wsg + (size_t)(16 * tt) * 128 + 32 * sb;
            f32x4 w0 = *(const f32x4*)wr, w1 = *(const f32x4*)(wr + 4);
            if (sb == tt / 2) {
#pragma unroll
                for (int e = 0; e < 4; ++e) { if (32 * sb + 8 * q + e > t) w0[e] = 0.f; if (32 * sb + 8 * q + 4 + e > t) w1[e] = 0.f; }
            }
            acc = MFMA16(A[sb], mk_frag(w0, w1), acc);
        }
        const float bias = p.in[24][g * 128 + t];
        const f32x4 u = ld_bf4(zu + (size_t)(16 * tt) * ZUGW);
        const f32x4 o = (acc + bias) * u;
        u32x2v w; w.x = pk2(o[0], o[1]); w.y = pk2(o[2], o[3]); *(u32x2v*)(ub + (size_t)(16 * tt) * MLPW) = w;
    }
}

__device__ __forceinline__ void post_rows(const P& p, int gw, int NGW, int lane) {
    const float* oraw = (const float*)(p.ws + WS_ZRW);
    for (int row = gw; row < M; row += NGW) {
        const size_t off = (size_t)row * RW + lane * 16;
        f32x4 o[4]; float s = 0.f;
#pragma unroll
        for (int j = 0; j < 4; ++j) { o[j] = *(const f32x4*)(oraw + off + 4 * j); s += (o[j][0] + o[j][1]) + (o[j][2] + o[j][3]); }
        s += __shfl_xor(s, 1); s += __shfl_xor(s, 2);
        const float mean = s * (1.f / HS); float qv = 0.f;
#pragma unroll
        for (int j = 0; j < 4; ++j) { o[j] = o[j] - mean; qv += (o[j][0] * o[j][0] + o[j][1] * o[j][1]) + (o[j][2] * o[j][2] + o[j][3] * o[j][3]); }
        qv += __shfl_xor(qv, 1); qv += __shfl_xor(qv, 2);
        const float rstd = rsqrtf(qv * (1.f / HS) + 64e-5f);
        bf16_t* oa = (bf16_t*)(p.ws + WS_OA) + off; const bf16_t* c2p = (const bf16_t*)(p.ws + WS_C2) + off;
#pragma unroll
        for (int h = 0; h < 2; ++h) {
            const u32x4 c1 = *(const u32x4*)(oa + 8 * h), c2 = *(const u32x4*)(c2p + 8 * h);
            const f32x4 a = o[2 * h] * rstd, b = o[2 * h + 1] * rstd;
            u32x4 w;
            w.x = pk2(a[0] * bflo(c1.x) + bflo(c2.x), a[1] * bfhi(c1.x) + bfhi(c2.x)); w.y = pk2(a[2] * bflo(c1.y) + bflo(c2.y), a[3] * bfhi(c1.y) + bfhi(c2.y));
            w.z = pk2(b[0] * bflo(c1.z) + bflo(c2.z), b[1] * bfhi(c1.z) + bfhi(c2.z)); w.w = pk2(b[2] * bflo(c1.w) + bflo(c2.w), b[3] * bfhi(c1.w) + bfhi(c2.w));
            *(u32x4*)(oa + 8 * h) = w;
        }
    }
}

constexpr int NWAVES = 8, NTHR = NWAVES * 64;
constexpr int RING_BYTES = 131072, LDSCTL_OFF = RING_BYTES, MISC_OFF = LDSCTL_OFF + 320, LDS_BYTES = 147456;

__device__ __forceinline__ void p0_mod_slab(const P& p, LAS float* red, int slab, int tid, int lane, int wave) {
    for (int i = tid; i < 144 * 48; i += NTHR) red[i] = 0.f;
    __syncthreads();
    const int n0 = slab * 48, fr = lane & 15, fq = lane >> 4;
    const float* W = p.in[6];
    f32x4 acc[9][3];
#pragma unroll
    for (int a = 0; a < 9; ++a)
#pragma unroll
        for (int b = 0; b < 3; ++b) acc[a][b] = (f32x4){0.f, 0.f, 0.f, 0.f};
    for (int kb = 0; kb < 8; ++kb) {
        const int k0 = wave * 256 + kb * 32 + fq * 8;
        bf16x8 bfr[3];
#pragma unroll
        for (int nt = 0; nt < 3; ++nt) {
            const float* wp = W + (size_t)k0 * (6 * D) + n0 + nt * 16 + fr;
            u32x4 w;
            w.x = pk2(wp[0], wp[(size_t)1 * 6 * D]); w.y = pk2(wp[(size_t)2 * 6 * D], wp[(size_t)3 * 6 * D]);
            w.z = pk2(wp[(size_t)4 * 6 * D], wp[(size_t)5 * 6 * D]); w.w = pk2(wp[(size_t)6 * 6 * D], wp[(size_t)7 * 6 * D]);
            bfr[nt] = __builtin_bit_cast(bf16x8, w);
        }
#pragma unroll
        for (int mt = 0; mt < 9; ++mt) {
            const int row = mt * 16 + fr;
            u32x4 aw = (u32x4){0u, 0u, 0u, 0u};
            if (row < NSEQ) {
                const float* c = (row < NPB ? p.in[4] + (size_t)row * D : p.in[5] + (size_t)(row - NPB) * D) + k0;
                const f32x4 c0 = *(const f32x4*)c, c1 = *(const f32x4*)(c + 4);
                aw.x = pk2(c0[0] * sigmoidf_(c0[0]), c0[1] * sigmoidf_(c0[1])); aw.y = pk2(c0[2] * sigmoidf_(c0[2]), c0[3] * sigmoidf_(c0[3]));
                aw.z = pk2(c1[0] * sigmoidf_(c1[0]), c1[1] * sigmoidf_(c1[1])); aw.w = pk2(c1[2] * sigmoidf_(c1[2]), c1[3] * sigmoidf_(c1[3]));
            }
            const bf16x8 afr = __builtin_bit_cast(bf16x8, aw);
#pragma unroll
            for (int nt = 0; nt < 3; ++nt) acc[mt][nt] = __builtin_amdgcn_mfma_f32_16x16x32_bf16(afr, bfr[nt], acc[mt][nt], 0, 0, 0);
        }
    }
#pragma unroll
    for (int mt = 0; mt < 9; ++mt)
#pragma unroll
        for (int nt = 0; nt < 3; ++nt)
#pragma unroll
            for (int r = 0; r < 4; ++r) __hip_atomic_fetch_add(red + (mt * 16 + 4 * fq + r) * 48 + nt * 16 + fr, acc[mt][nt][r], __ATOMIC_RELAXED, __HIP_MEMORY_SCOPE_WORKGROUP);
    __syncthreads();
    float* mod = (float*)(p.ws + WS_MOD);
    for (int i = tid; i < NSEQ * 48; i += NTHR) { const int row = i / 48, c = i % 48; mod[(size_t)row * (6 * D) + n0 + c] = red[row * 48 + c] + p.in[7][n0 + c]; }
    __syncthreads();
}
__device__ __forceinline__ void p0_transpose_item(const float* W, int K, int N, bf16_t* WT, bool swz, LAS float* scr, int item, int lane) {
    const int nblk = N / 32, kb = item / nblk, nb = item % nblk, k0 = 64 * kb, n0 = 32 * nb;
    int r0 = n0;
    if (swz) { r0 = n0 < DFF ? 256 * (n0 >> 7) + (n0 & 127) : 256 * ((n0 - DFF) >> 7) + 128 + ((n0 - DFF) & 127); }
#pragma unroll 8
    for (int i = 0; i < 32; ++i) { const int kk = 2 * i + (lane >> 5); scr[kk * 33 + (lane & 31)] = W[(size_t)(k0 + kk) * N + n0 + (lane & 31)]; }
    LDS_WAIT(); asm volatile("" ::: "memory");
    const int c = lane & 7;
#pragma unroll
    for (int j = 0; j < 4; ++j) { const int n = (lane >> 3) + 8 * j; const LAS float* s = scr + (8 * c) * 33 + n;
        u32x4 o; o.x = pk2(s[0 * 33], s[1 * 33]); o.y = pk2(s[2 * 33], s[3 * 33]); o.z = pk2(s[4 * 33], s[5 * 33]); o.w = pk2(s[6 * 33], s[7 * 33]);
        *(u32x4*)(WT + (size_t)(r0 + n) * K + k0 + 8 * c) = o; }
    LDS_WAIT(); asm volatile("" ::: "memory");
}
__device__ __forceinline__ void p0_transposes(const P& p, LAS float* scr, int gw, int NGW, int lane) {
    constexpr int I_IN = (D / 64) * (CIN / 32), I_BA = (RW / 64) * (D / 32), I_OUT = (D / 64) * (D / 32), I_FI = (D / 64) * (2 * DFF / 32), I_FO = (DFF / 64) * (D / 32);
    constexpr int I_L64 = (RW / 32), I_L128 = 2 * (RW / 32);
    constexpr int NITEMS = I_IN + 2 * I_BA + I_OUT + I_FI + I_FO + 2 * I_L64 + I_L128;
    unsigned char* ws = p.ws;
    for (int it = gw; it < NITEMS; it += NGW) {
        int r = it;
        if (r < I_IN) { p0_transpose_item(p.in[9], D, CIN, (bf16_t*)(ws + WS_WIN), false, scr, r, lane); continue; } r -= I_IN;
        if (r < I_BA) { p0_transpose_item(p.in[25], RW, D, (bf16_t*)(ws + WS_WBA), false, scr, r, lane); continue; } r -= I_BA;
        if (r < I_BA) { p0_transpose_item(p.in[26], RW, D, (bf16_t*)(ws + WS_WBB), false, scr, r, lane); continue; } r -= I_BA;
        if (r < I_OUT) { p0_transpose_item(p.in[27], D, D, (bf16_t*)(ws + WS_WOUT), false, scr, r, lane); continue; } r -= I_OUT;
        if (r < I_FI) { p0_transpose_item(p.in[29], D, 2 * DFF, (bf16_t*)(ws + WS_WFI), true, scr, r, lane); continue; } r -= I_FI;
        if (r < I_FO) { p0_transpose_item(p.in[30], DFF, D, (bf16_t*)(ws + WS_WFO), false, scr, r, lane); continue; } r -= I_FO;
        if (r < I_L64) { p0_transpose_item(p.in[12], 64, RW, (bf16_t*)(ws + WS_LORA), false, scr, r, lane); continue; } r -= I_L64;
        if (r < I_L64) { p0_transpose_item(p.in[14], 64, RW, (bf16_t*)(ws + WS_LORA) + RW * 64, false, scr, r, lane); continue; } r -= I_L64;
        p0_transpose_item(p.in[15], 128, RW, (bf16_t*)(ws + WS_LORA) + 2 * RW * 64, false, scr, r, lane);
    }
}
__device__ __forceinline__ void norm_row(const float* x, const float* g, const float* scale, const float* shift, bf16_t* h, int lane) {
    f32x4 v[8]; float s = 0.f;
#pragma unroll
    for (int j = 0; j < 8; ++j) { v[j] = *(const f32x4*)(x + 4 * lane + 256 * j); s += (v[j][0] * v[j][0] + v[j][1] * v[j][1]) + (v[j][2] * v[j][2] + v[j][3] * v[j][3]); }
    const float rstd = rsqrtf(wave_sum(s) * (1.f / D) + 1e-6f);
#pragma unroll
    for (int j = 0; j < 8; ++j) { const int k = 4 * lane + 256 * j;
        const f32x4 gg = *(const f32x4*)(g + k), sc = *(const f32x4*)(scale + k), sh = *(const f32x4*)(shift + k);
        const f32x4 o = v[j] * rstd * gg * (sc + 1.f) + sh;
        u32x2v w; w.x = pk2(o[0], o[1]); w.y = pk2(o[2], o[3]); *(u32x2v*)(h + k) = w; }
}
__device__ __forceinline__ void phase_norm(const P& p, int which, int gw, int NGW, int lane) {
    const float* g = which == 0 ? p.in[8] : p.in[28];
    for (int row = gw; row < M; row += NGW) {
        const float* x = which == 0 ? (row < MP ? p.in[0] + (size_t)row * D : p.in[1] + (size_t)(row - MP) * D) : p.out + (size_t)row * D;
        const float* mod = (const float*)(p.ws + WS_MOD) + (size_t)seq_of_row(row) * (6 * D);
        norm_row(x, g, mod + (which == 0 ? 1 : 4) * D, mod + (which == 0 ? 0 : 3) * D, (bf16_t*)(p.ws + WS_H) + (size_t)row * D, lane);
    }
}
__device__ __forceinline__ void phase_lnv(const P& p, int gw, int NGW, int lane) {
    for (int row = gw; row < M; row += NGW) {
        const bf16_t* zv = (const bf16_t*)(p.ws + WS_ZUG) + (size_t)row * ZUGW + ZU_V;
        float v[16]; float s = 0.f;
#pragma unroll
        for (int j = 0; j < 2; ++j) { const u32x4 w = *(const u32x4*)(zv + 8 * lane + 512 * j);
            v[8 * j + 0] = bflo(w.x); v[8 * j + 1] = bfhi(w.x); v[8 * j + 2] = bflo(w.y); v[8 * j + 3] = bfhi(w.y);
            v[8 * j + 4] = bflo(w.z); v[8 * j + 5] = bfhi(w.z); v[8 * j + 6] = bflo(w.w); v[8 * j + 7] = bfhi(w.w); }
#pragma unroll
        for (int i = 0; i < 16; ++i) s += v[i];
        const float mean = wave_sum(s) * (1.f / MLPW);
        float q = 0.f;
#pragma unroll
        for (int i = 0; i < 16; ++i) { v[i] -= mean; q += v[i] * v[i]; }
        const float rstd = rsqrtf(wave_sum(q) * (1.f / MLPW) + 1e-5f);
        bf16_t* vn = (bf16_t*)(p.ws + WS_VN) + (size_t)row * MLPW;
#pragma unroll
        for (int j = 0; j < 2; ++j) { const int c = 8 * lane + 512 * j; float o[8];
#pragma unroll
            for (int e = 0; e < 8; ++e) o[e] = v[8 * j + e] * rstd * p.in[21][c + e] + p.in[22][c + e];
            u32x4 w; w.x = pk2(o[0], o[1]); w.y = pk2(o[2], o[3]); w.z = pk2(o[4], o[5]); w.w = pk2(o[6], o[7]);
            *(u32x4*)(vn + c) = w;
            if (row >= MP) { float* vs = p.out + O_VS + (size_t)(row - MP) * MLPW + c;
                *(f32x4*)vs = (f32x4){o[0], o[1], o[2], o[3]}; *(f32x4*)(vs + 4) = (f32x4){o[4], o[5], o[6], o[7]}; }
        }
    }
}
__device__ __forceinline__ void phase_final(const P& p, int gw, int NGW, int lane) {
    for (int row = gw; row < M; row += NGW) {
        float* x = p.out + (size_t)row * D;
        f32x4 v[8]; float s = 0.f;
#pragma unroll
        for (int j = 0; j < 8; ++j) { v[j] = *(const f32x4*)(x + 4 * lane + 256 * j); s += (v[j][0] * v[j][0] + v[j][1] * v[j][1]) + (v[j][2] * v[j][2] + v[j][3] * v[j][3]); }
        const float rstd = rsqrtf(wave_sum(s) * (1.f / D) + 1e-6f);
#pragma unroll
        for (int j = 0; j < 8; ++j) { const int k = 4 * lane + 256 * j; *(f32x4*)(x + k) = v[j] * rstd * *(const f32x4*)(p.in[31] + k); }
    }
}
__device__ __forceinline__ void mix_naive_row(const P& p, int row, int tid, int nthr) {
    int t;
    if (row < MP) t = (row & (TP - 1)) & 127; else t = (row - MP) & (TS - 1);
    const int rowc0 = row - t;
    const bf16_t* vn = (const bf16_t*)(p.ws + WS_VN);
    const bf16_t* zu = (const bf16_t*)(p.ws + WS_ZUG) + (size_t)row * ZUGW + ZU_U;
    bf16_t* ub = (bf16_t*)(p.ws + WS_UB) + (size_t)row * MLPW;
    for (int c = tid; c < MLPW; c += nthr) {
        const int g = c >> 7; const float* wsg = p.in[23] + ((size_t)g * 128 + t) * 128;
        float acc = 0.f;
        for (int s = 0; s <= t; ++s) acc += wsg[s] * bf2f(vn[(size_t)(rowc0 + s) * MLPW + c]);
        acc += p.in[24][g * 128 + t];
        ub[c] = f2bf(bf2f(zu[c]) * acc);
    }
}

#define PHASE_IDS() int tid = threadIdx.x; asm volatile("" : "+v"(tid)); const int lane = tid & 63, wave = __builtin_amdgcn_readfirstlane(tid >> 6); \
    const int gw = bx * NWAVES + wave, NGW = G * NWAVES; (void)lane; (void)gw; (void)NGW
__global__ void __launch_bounds__(NTHR, 2) mega_fwd(P p) {
    extern __shared__ __attribute__((aligned(16))) unsigned char lds_raw[];
    LAS unsigned char* lds = (LAS unsigned char*)lds_raw;
    const int G = gridDim.x, bx = blockIdx.x;
    unsigned char* ws = p.ws;
    { PHASE_IDS();
      for (int u = tid; u < (LDS_BYTES - LDSCTL_OFF) / 4; u += NTHR) ((LAS unsigned*)(lds + LDSCTL_OFF))[u] = 0u; }
    __syncthreads();
    XcdBarrier bar = xcd_barrier_post((unsigned*)(ws + WS_CTL) + CW_BAR, (volatile LAS unsigned*)(lds + MISC_OFF) + 8);
#ifdef TSMASK
    unsigned long long* tsw = (unsigned long long*)(ws + WS_CTL + 524288); int nst = 0;
#define STAMP() do { if (bx == 0 && threadIdx.x == 0) tsw[nst] = __builtin_amdgcn_s_memrealtime(); ++nst; } while (0)
#else
#define STAMP() do { } while (0)
#endif
    STAMP();

    { PHASE_IDS();
      for (int slab = bx; slab < 256; slab += G) p0_mod_slab(p, (LAS float*)lds, slab, tid, lane, wave);
      p0_transposes(p, (LAS float*)(lds + wave * 16384), gw, NGW, lane); }
    xcd_barrier(bar); STAMP();
    { PHASE_IDS(); phase_norm(p, 0, gw, NGW, lane); }
    xcd_barrier(bar); STAMP();
    {
        pg8::Gemm g{(const bf16_t*)(ws + WS_H), (const bf16_t*)(ws + WS_WIN), M, CIN, D}; pg8::StaticOrder S; S.init(M, CIN, G, bx);
        EpiZ E{(bf16_t*)(ws + WS_ZRW), (bf16_t*)(ws + WS_ZUG), p.out};
        pg8::gemm_phase<EpiZ, pg8::StaticOrder, PG8_ALIGN, PG8_SP2>(lds, g, S, E);
    }
    xcd_barrier(bar); STAMP();
    { PHASE_IDS();
      phase_lnv(p, gw, NGW, lane);
      for (int rec = gw; rec < NREC; rec += NGW) prep_record(p, lds + wave * 16384, rec, lane); }
    xcd_barrier(bar); STAMP();
    { PHASE_IDS();
        const int NPC = NPB * NH;
        if (bx < NPC && wave < 4) scan_chain(p, bx >> 4, bx & 15, wave, lane);
        else {
            const int nlow = G < NPC ? G : NPC;
            const int wid = bx < NPC ? bx * 4 + (wave - 4) : nlow * 4 + (bx - NPC) * NWAVES + wave;
            const int NW = nlow * 4 + (G > NPC ? (G - NPC) * NWAVES : 0);
            for (int j = wid; j < NSB * NH * 4; j += NW) scan_chain(p, NPB + (j >> 6), (j >> 2) & 15, j & 3, lane);
            if (bx >= NPC) {
                for (int item = bx - NPC; item < NPB * 16 * 8; item += G - NPC) mix_item(p, item, wave, lane);
                for (int row = MP + bx - NPC; row < M; row += G - NPC) mix_naive_row(p, row, tid, NTHR);
            }
        }
        if (G <= NPC) {
            for (int ch = bx + G; ch < NPC; ch += G) if (wave < 4) scan_chain(p, ch >> 4, ch & 15, wave, lane);
            for (int item = bx; item < NPB * 16 * 8; item += G) mix_item(p, item, wave, lane);
            for (int row = MP + bx; row < M; row += G) mix_naive_row(p, row, tid, NTHR);
        }
    }
    xcd_barrier(bar); STAMP();
    { PHASE_IDS(); post_rows(p, gw, NGW, lane); }
    xcd_barrier(bar); STAMP();
    {
        pg8::Gemm g{(const bf16_t*)(ws + WS_OA), (const bf16_t*)(ws + WS_WBA), 2 * M, 2 * D, RW}; BranchOrder S{G, bx};
        EpiMerge E{(const bf16_t*)(ws + WS_ZUG), (bf16_t*)(ws + WS_H)};
        pg8::gemm_phase<EpiMerge, BranchOrder, PG8_ALIGN, PG8_SP2>(lds, g, S, E);
    }
    xcd_barrier(bar); STAMP();
    {
        pg8::Gemm g{(const bf16_t*)(ws + WS_H), (const bf16_t*)(ws + WS_WOUT), M, D, D}; pg8::StaticOrder S; S.init(M, D, G, bx);
        EpiRes1 E{p.in[0], p.in[1], (const float*)(ws + WS_MOD), p.out};
        pg8::gemm_phase<EpiRes1, pg8::StaticOrder, PG8_ALIGN, PG8_SP2>(lds, g, S, E);
    }
    xcd_barrier(bar); STAMP();
    { PHASE_IDS(); phase_norm(p, 1, gw, NGW, lane); }
    xcd_barrier(bar); STAMP();
    {
        pg8::Gemm g{(const bf16_t*)(ws + WS_H), (const bf16_t*)(ws + WS_WFI), M, 2 * DFF, D}; pg8::StaticOrder S; S.init(M, 2 * DFF, G, bx);
        EpiSwiglu E{(bf16_t*)(ws + WS_ZUG)};
        pg8::gemm_phase<EpiSwiglu, pg8::StaticOrder, PG8_ALIGN, PG8_SP2>(lds, g, S, E);
    }
    xcd_barrier(bar); STAMP();
    {
        pg8::Gemm g{(const bf16_t*)(ws + WS_ZUG), (const bf16_t*)(ws + WS_WFO), M, D, DFF}; pg8::StaticOrder S; S.init(M, D, G, bx);
        EpiRes2 E{(const float*)(ws + WS_MOD), p.out};
        pg8::gemm_phase<EpiRes2, pg8::StaticOrder, PG8_ALIGN, PG8_SP2>(lds, g, S, E);
    }
    xcd_barrier(bar); STAMP();
    { PHASE_IDS(); phase_final(p, gw, NGW, lane); }
#ifdef TSMASK
    STAMP();
    if (bx == 0 && threadIdx.x == 0) {
        unsigned long long tot = 0;
        for (int k = 0; k < nst - 1; ++k) if ((TSMASK >> k) & 1) tot += tsw[k + 1] - tsw[k];
        p.out[0] += (float)tot * (1.0f / 20000.0f);
    }
#endif
}

extern "C" void kernel_launch(void* const* d_in, const int* in_sizes, int n_in, void* d_out, int out_size, void* d_ws, size_t ws_size, hipStream_t stream) {
    static int grid = 0;
    if (grid == 0) {
        if (n_in != 32 || (size_t)out_size != O_END || ws_size < WS_END) { fprintf(stderr, "kernel_launch: unexpected shapes n_in=%d out=%d ws=%zu (need %zu)\n", n_in, out_size, ws_size, (size_t)WS_END); grid = -1; return; }
        int dev = 0, cus = 0, per_cu = 0;
        if (hipGetDevice(&dev) != hipSuccess || hipDeviceGetAttribute(&cus, hipDeviceAttributeMultiprocessorCount, dev) != hipSuccess) { grid = -1; return; }
        if (hipFuncSetAttribute((const void*)mega_fwd, hipFuncAttributeMaxDynamicSharedMemorySize, LDS_BYTES) != hipSuccess) { fprintf(stderr, "kernel_launch: hipFuncSetAttribute failed\n"); grid = -1; return; }
        if (hipOccupancyMaxActiveBlocksPerMultiprocessor(&per_cu, (const void*)mega_fwd, NTHR, LDS_BYTES) != hipSuccess || per_cu < 1) { fprintf(stderr, "kernel_launch: occupancy query says %d blocks per CU\n", per_cu); }
        (void)hipGetLastError();
        grid = cus;
    }
    if (grid < 0) return;
    if (hipMemsetAsync((char*)d_ws + WS_CTL, 0, CTL_ZERO_BYTES, stream) != hipSuccess) { fprintf(stderr, "kernel_launch: memset failed\n"); return; }
    P p{};
    for (int i = 0; i < 32; ++i) p.in[i] = (const float*)d_in[i];
    p.out = (float*)d_out; p.ws = (unsigned char*)d_ws;
    hipLaunchKernelGGL(mega_fwd, dim3(grid), dim3(NTHR), LDS_BYTES, stream, p);
    const hipError_t le = hipPeekAtLastError();
    if (le != hipSuccess) fprintf(stderr, "kernel_launch: launch failed: %s\n", hipGetErrorName(le));
}
```

```cpp
#include <hip/hip_runtime.h>
#include <cstdio>
#include <cstdint>

constexpr int D = 2048, NPB = 4, TP = 2048, NSB = 128, TS = 8;
constexpr int MP = NPB * TP, MS = NSB * TS, M = MP + MS;
constexpr int RW = 1024, NH = 16, HS = 64;
constexpr int CSH = 3328, CIN = 9472, DFF = 5632, MLPW = 1024;
constexpr int C_U = CSH, C_V = CSH + 1024, C_G0 = CSH + 2048, C_G1 = C_G0 + 2048;
constexpr int ZUGW = CIN - CSH, ZU_U = 0, ZU_V = 1024, ZU_G0 = 2048, ZU_G1 = 4096;
constexpr int NSEQ = NPB + NSB;
constexpr size_t O_YP = 0, O_YS = O_YP + (size_t)MP * D, O_WKVP = O_YS + (size_t)MS * D, O_SHP = O_WKVP + (size_t)NPB * NH * HS * HS,
                 O_WKVS = O_SHP + (size_t)NPB * CSH, O_SHS = O_WKVS + (size_t)NSB * NH * HS * HS, O_VS = O_SHS + (size_t)NSB * CSH,
                 O_END = O_VS + (size_t)MS * MLPW;
constexpr size_t WS_CTL = 0, CTL_ZERO_BYTES = 1u << 20;
constexpr size_t WS_WIN = CTL_ZERO_BYTES;
constexpr size_t WS_WBA = WS_WIN + (size_t)CIN * D * 2;
constexpr size_t WS_WBB = WS_WBA + (size_t)D * RW * 2;
constexpr size_t WS_WOUT = WS_WBB + (size_t)D * RW * 2;
constexpr size_t WS_WFI = WS_WOUT + (size_t)D * D * 2;
constexpr size_t WS_WFO = WS_WFI + (size_t)2 * DFF * D * 2;
constexpr size_t WS_MOD = WS_WFO + (size_t)D * DFF * 2;
constexpr size_t WS_H = WS_MOD + (size_t)NSEQ * 6 * D * 4;
constexpr size_t WS_ZRW = WS_H + (size_t)M * D * 2;
constexpr size_t WS_ZUG = WS_ZRW + (size_t)M * CSH * 2;
constexpr size_t WS_VN = WS_ZUG + (size_t)M * ZUGW * 2;
constexpr size_t WS_OA = WS_VN + (size_t)M * MLPW * 2;
constexpr size_t WS_UB = WS_OA + (size_t)M * RW * 2;
constexpr size_t WS_C2 = WS_UB + (size_t)M * MLPW * 2;
constexpr size_t WS_LORA = WS_C2 + (size_t)M * RW * 2;
constexpr size_t WS_FRA_S = WS_LORA + (size_t)RW * 256 * 2;
constexpr size_t WS_FRB_S = WS_FRA_S + (size_t)NSB * NH * 4096;
constexpr size_t WS_END = WS_FRB_S + (size_t)NSB * NH * 8448;
constexpr int NREC_P = NPB * 128 * NH, NREC = NREC_P + NSB * NH;
constexpr int RECA = 4096, RECB = 8448;
static_assert((size_t)NREC_P * RECA <= (size_t)M * D * 2 && (size_t)NREC_P * RECB <= (size_t)M * D * 4, "prompt fragment records fit the H buffer / the y region of d_out");
constexpr int CW_BAR = 4096;

typedef float f32x2v __attribute__((ext_vector_type(2)));
typedef __bf16 bf16x2v __attribute__((ext_vector_type(2)));
typedef unsigned u32x2v __attribute__((ext_vector_type(2)));

struct P { const float* in[32]; float* out; unsigned char* ws; };

__device__ __forceinline__ unsigned pk2(float lo, float hi) { return __builtin_bit_cast(unsigned, __builtin_convertvector((f32x2v){lo, hi}, bf16x2v)); }
__device__ __forceinline__ unsigned short f2bf(float f) { return (unsigned short)(pk2(f, 0.f) & 0xffffu); }
__device__ __forceinline__ float bf2f(unsigned short h) { return __uint_as_float(((unsigned)h) << 16); }
__device__ __forceinline__ float bflo(unsigned w) { return __uint_as_float(w << 16); }
__device__ __forceinline__ float bfhi(unsigned w) { return __uint_as_float(w & 0xffff0000u); }
__device__ __forceinline__ float sigmoidf_(float x) { return 1.f / (1.f + __expf(-x)); }
__device__ __forceinline__ float gelu_tanh(float x) {
    const float u = 0.7978845608028654f * (x + 0.044715f * x * x * x); return x / (1.f + __expf(-2.f * u)); }
__device__ __forceinline__ float wave_sum(float v) {
#pragma unroll
    for (int o = 1; o < 64; o <<= 1) v += __shfl_xor(v, o);
    return v;
}
__device__ __forceinline__ int seq_of_row(int row) { return row < MP ? row / TP : NPB + (row - MP) / TS; }

namespace pg8 {
#define PG8_LAS __attribute__((address_space(3)))
typedef unsigned short bf16_t;
typedef short bf16x8 __attribute__((ext_vector_type(8)));
typedef float f32x4 __attribute__((ext_vector_type(4)));
typedef unsigned u32x4 __attribute__((ext_vector_type(4)));
constexpr int BM = 256, BK = 64, HALF = 128, HTB = HALF * BK * 2  , STAGE_BYTES = 8 * HTB, NXCD = 8, WGM = 8;

__host__ __device__ __forceinline__ int lds_byte(int r, int c) { const int st = (r >> 4) * 2 + (c >> 5), rr = r & 15, cc = c & 31, ob = rr * 64 + cc * 2; return st * 1024 + (ob ^ (((ob >> 9) & 1) << 5)); }
__host__ __device__ __forceinline__ void stage_rc(int b, int& R, int& C) { const int st = b / 1024, sb = b % 1024, swz = sb ^ (((sb >> 9) & 1) << 5); R = (st >> 1) * 16 + swz / 64; C = (st & 1) * 32 + (swz % 64) / 2; }
__host__ __device__ __forceinline__ int perm32(int rho) { const int n = rho >> 4, i = rho & 15; return 8 * (i >> 2) + 4 * n + (i & 3); }

struct Unit { int pm, pn; };
struct Gemm { const bf16_t* A; const bf16_t* Bt; int M, N, K; };

struct StaticOrder {
    int nM, nN, nwg, G, c;
    __host__ __device__ void init(int M, int N, int G_, int c_) { nM = M / BM; nN = N / BM; nwg = nM * nN; G = G_; c = c_; }
    __host__ __device__ bool next(int i, Unit& u) const {
        const long L = (long)i * G + c; if (L >= nwg) return false;
        int wgid = (int)L; { const int q = nwg / NXCD, r = nwg % NXCD, xcd = wgid % NXCD, off = wgid / NXCD; wgid = (xcd < r ? xcd * (q + 1) : r * (q + 1) + (xcd - r) * q) + off; }
        const int nig = WGM * nN, gid = wgid / nig, fm = gid * WGM, gsz = (nM - fm) < WGM ? (nM - fm) : WGM;
        u.pm = fm + ((wgid % nig) % gsz); u.pn = (wgid % nig) / gsz; return true;
    }
    __device__ __forceinline__ void a_ready(const Unit&) const {}
    __device__ __forceinline__ void done(const Unit&) const {}
};
template <class Epi, class Sched, bool ALIGN_EPI = false, bool SP2 = false>
__device__ __forceinline__ void gemm_phase(PG8_LAS unsigned char* lds, const Gemm g, const Sched& S, const Epi& E) {
    int tid_ = threadIdx.x; asm volatile("" : "+v"(tid_));
    const int tid = tid_, wid = __builtin_amdgcn_readfirstlane(tid >> 6), lane = tid & 63, wr = wid >> 2, wc = wid & 3, fr = lane & 15, fq = lane >> 4;
    const int K = g.K, nt = K / BK;
    unsigned voffA[2], voffB[2];
#pragma unroll
    for (int i = 0; i < 2; ++i) { int R, C; stage_rc(tid * 16 + i * 8192, R, C); const int Rb = Epi::PERM ? ((R & ~31) + perm32(R & 31)) : R;
        voffA[i] = (unsigned)(R * K + C) * 2u; voffB[i] = (unsigned)(Rb * K + C) * 2u; }
    const size_t kstep = (size_t)(BK * 2);
    const size_t hstep = (size_t)HALF * K * 2;
    const size_t tstep = 2 * hstep;
    const unsigned ldsw = (unsigned)wid * 1024u;
    const int aoff = lds_byte(wr * 64 + fr, fq * 8), boff = lds_byte(wc * 32 + fr, fq * 8);
#define PG8_SA(b, h) (((b) * 2 + (h)) * HTB)
#define PG8_SB(b, h) ((4 + (b) * 2 + (h)) * HTB)
#define PG8_STAGE(bufoff, gbase, voff) do { _Pragma("unroll") for (int _i = 0; _i < 2; ++_i) \
        __builtin_amdgcn_global_load_lds((const unsigned*)((const char*)(gbase) + (voff)[_i]), (PG8_LAS unsigned*)(lds + (bufoff) + ldsw + _i * 8192), 16, 0, 0); } while (0)
#define PG8_LDA(dst, b, h) do { _Pragma("unroll") for (int m = 0; m < 4; ++m) _Pragma("unroll") for (int k = 0; k < 2; ++k) dst[m][k] = *(const PG8_LAS bf16x8*)(lds + PG8_SA(b, h) + aoff + m * 2048 + k * 1024); } while (0)
#define PG8_LDB(dst, b, h) do { _Pragma("unroll") for (int n = 0; n < 2; ++n) _Pragma("unroll") for (int k = 0; k < 2; ++k) dst[n][k] = *(const PG8_LAS bf16x8*)(lds + PG8_SB(b, h) + boff + n * 2048 + k * 1024); } while (0)
#define PG8_MMA(ai, bj, At, Bt) do { __builtin_amdgcn_s_setprio(1); _Pragma("unroll") for (int m = 0; m < 4; ++m) _Pragma("unroll") for (int n = 0; n < 2; ++n) _Pragma("unroll") for (int k = 0; k < 2; ++k) \
        acc[ai][bj][m][n] = __builtin_amdgcn_mfma_f32_16x16x32_bf16(Bt[n][k], At[m][k], acc[ai][bj][m][n], 0, 0, 0); __builtin_amdgcn_s_setprio(0); } while (0)
#define PG8_WAIT_V(n) asm volatile("s_waitcnt vmcnt(" #n ")" ::: "memory")
#define PG8_WAIT_L(n) asm volatile("s_waitcnt lgkmcnt(" #n ")" ::: "memory")
#define PG8_BAR __builtin_amdgcn_s_barrier()
#define PG8_SCHED __builtin_amdgcn_sched_barrier(0)
    Unit cur, nxt; int ui = 0;
    if (!S.next(0, cur)) return;
    f32x4 acc[2][2][4][2];
#pragma unroll
    for (int a = 0; a < 2; ++a)
#pragma unroll
        for (int b = 0; b < 2; ++b)
#pragma unroll
            for (int m = 0; m < 4; ++m)
#pragma unroll
                for (int n = 0; n < 2; ++n) acc[a][b][m][n] = (f32x4){0.f, 0.f, 0.f, 0.f};
    bf16x8 At[4][2], B0[2][2], B1[2][2];
    const char* cA = (const char*)g.A + (size_t)cur.pm * tstep; const char* cB = (const char*)g.Bt + (size_t)cur.pn * tstep;
    S.a_ready(cur);
    if constexpr (SP2) {
        PG8_STAGE(PG8_SB(0, 0), cB, voffB); PG8_STAGE(PG8_SB(0, 1), cB + hstep, voffB); PG8_STAGE(PG8_SA(0, 0), cA, voffA); PG8_STAGE(PG8_SA(0, 1), cA + hstep, voffA);
        if (wr == 1) PG8_BAR;
        PG8_WAIT_V(2); PG8_BAR;
        PG8_STAGE(PG8_SB(1, 0), cB + kstep, voffB); PG8_STAGE(PG8_SA(1, 0), cA + kstep, voffA); PG8_STAGE(PG8_SB(1, 1), cB + hstep + kstep, voffB);
        PG8_WAIT_V(6); PG8_BAR;
    } else {
        PG8_STAGE(PG8_SB(0, 0), cB, voffB); PG8_STAGE(PG8_SA(0, 0), cA, voffA); PG8_STAGE(PG8_SB(0, 1), cB + hstep, voffB); PG8_STAGE(PG8_SA(0, 1), cA + hstep, voffA);
        if (wr == 1) PG8_BAR;
        PG8_WAIT_V(4); PG8_BAR;
        PG8_STAGE(PG8_SB(1, 0), cB + kstep, voffB); PG8_STAGE(PG8_SA(1, 0), cA + kstep, voffA); PG8_STAGE(PG8_SB(1, 1), cB + hstep + kstep, voffB);
        PG8_WAIT_V(6); PG8_BAR;
    }
    for (;;) {
        const bool has_next = S.next(ui + 1, nxt);
        const char* nA = has_next ? (const char*)g.A + (size_t)nxt.pm * tstep : cA; const char* nB = has_next ? (const char*)g.Bt + (size_t)nxt.pn * tstep : cB;
        for (int t = 0; t < nt; t += 2) {
            const bool last = (t == nt - 2);
            const char* a1 = cA + (size_t)(t + 1) * kstep;
            const char* a2 = last ? nA : cA + (size_t)(t + 2) * kstep; const char* b2 = last ? nB : cB + (size_t)(t + 2) * kstep;
            const char* a3 = a2 + kstep; const char* b3 = b2 + kstep;
            if (last && has_next) S.a_ready(nxt);
            if constexpr (SP2) {
            PG8_LDB(B0, 0, 0); PG8_LDB(B1, 0, 1); PG8_SCHED; PG8_LDA(At, 0, 0); PG8_STAGE(PG8_SA(1, 1), a1 + hstep, voffA);
            PG8_WAIT_V(8); PG8_WAIT_L(0); PG8_BAR; PG8_MMA(0, 0, At, B0); PG8_MMA(0, 1, At, B1); PG8_BAR; PG8_SCHED;
            PG8_LDA(At, 0, 1); PG8_STAGE(PG8_SB(0, 0), b2, voffB); PG8_STAGE(PG8_SB(0, 1), b2 + hstep, voffB); PG8_STAGE(PG8_SA(0, 0), a2, voffA);
            PG8_WAIT_V(8); PG8_WAIT_L(0); PG8_BAR; PG8_MMA(1, 0, At, B0); PG8_MMA(1, 1, At, B1); PG8_BAR; PG8_SCHED;
            PG8_LDB(B0, 1, 0); PG8_LDB(B1, 1, 1); PG8_SCHED; PG8_LDA(At, 1, 0); PG8_STAGE(PG8_SA(0, 1), a2 + hstep, voffA);
            PG8_WAIT_V(8); PG8_WAIT_L(0); PG8_BAR; PG8_MMA(0, 0, At, B0); PG8_MMA(0, 1, At, B1); PG8_BAR; PG8_SCHED;
            PG8_LDA(At, 1, 1); PG8_STAGE(PG8_SB(1, 0), b3, voffB); PG8_STAGE(PG8_SB(1, 1), b3 + hstep, voffB); PG8_STAGE(PG8_SA(1, 0), a3, voffA);
            PG8_WAIT_V(8); PG8_WAIT_L(0); PG8_BAR; PG8_MMA(1, 0, At, B0); PG8_MMA(1, 1, At, B1); PG8_BAR; PG8_SCHED;
            } else {
            PG8_LDB(B0, 0, 0); PG8_SCHED; PG8_LDA(At, 0, 0); PG8_STAGE(PG8_SA(1, 1), a1 + hstep, voffA);
            PG8_WAIT_L(8); PG8_BAR; PG8_WAIT_L(0); PG8_MMA(0, 0, At, B0); PG8_BAR; PG8_SCHED;
            PG8_LDB(B1, 0, 1); PG8_STAGE(PG8_SB(0, 0), b2, voffB);
            PG8_BAR; PG8_WAIT_L(0); PG8_MMA(0, 1, At, B1); PG8_BAR;
            PG8_LDA(At, 0, 1); PG8_STAGE(PG8_SA(0, 0), a2, voffA);
            PG8_BAR; PG8_WAIT_L(0); PG8_MMA(1, 0, At, B0); PG8_BAR; PG8_SCHED;
            PG8_STAGE(PG8_SB(0, 1), b2 + hstep, voffB);
            PG8_WAIT_V(6); PG8_BAR; PG8_MMA(1, 1, At, B1); PG8_BAR;
            PG8_LDB(B0, 1, 0); PG8_SCHED; PG8_LDA(At, 1, 0); PG8_STAGE(PG8_SA(0, 1), a2 + hstep, voffA);
            PG8_WAIT_L(8); PG8_BAR; PG8_WAIT_L(0); PG8_MMA(0, 0, At, B0); PG8_BAR; PG8_SCHED;
            PG8_LDB(B1, 1, 1); PG8_STAGE(PG8_SB(1, 0), b3, voffB);
            PG8_BAR; PG8_WAIT_L(0); PG8_MMA(0, 1, At, B1); PG8_BAR;
            PG8_LDA(At, 1, 1); PG8_STAGE(PG8_SA(1, 0), a3, voffA);
            PG8_BAR; PG8_WAIT_L(0); PG8_MMA(1, 0, At, B0); PG8_BAR; PG8_SCHED;
            PG8_STAGE(PG8_SB(1, 1), b3 + hstep, voffB);
            PG8_WAIT_V(6); PG8_BAR; PG8_MMA(1, 1, At, B1); PG8_BAR;
            }
        }
        if constexpr (ALIGN_EPI) { if (wr == 0) PG8_BAR; }
        if constexpr (!Epi::AFTER_DRAIN) { E(acc, cur, wr, wc, fr, fq); S.done(cur); }
        if (!has_next) break;
#pragma unroll
        for (int a = 0; a < 2; ++a)
#pragma unroll
            for (int b = 0; b < 2; ++b)
#pragma unroll
                for (int m = 0; m < 4; ++m)
#pragma unroll
                    for (int n = 0; n < 2; ++n) acc[a][b][m][n] = (f32x4){0.f, 0.f, 0.f, 0.f};
        cur = nxt; cA = nA; cB = nB; ++ui;
        if constexpr (ALIGN_EPI) { if (wr == 1) PG8_BAR; }
    }
    PG8_WAIT_V(0);
    if constexpr (!ALIGN_EPI) { if (wr == 0) PG8_BAR; }
    PG8_BAR;
    if constexpr (Epi::AFTER_DRAIN) { E.fused(acc, cur, wr, wc, fr, fq, lds, wid, lane); S.done(cur); }
#undef PG8_SA
#undef PG8_SB
#undef PG8_STAGE
#undef PG8_LDA
#undef PG8_LDB
#undef PG8_MMA
#undef PG8_WAIT_V
#undef PG8_WAIT_L
#undef PG8_BAR
#undef PG8_SCHED
}
}
#define PG8_SP2 true
#define PG8_ALIGN true

using pg8::f32x4; using pg8::Unit; using pg8::BM; using pg8::HALF; typedef pg8::u32x4 u32x4;
typedef unsigned short bf16_t;

struct EpiZ {
    static constexpr bool PERM = true, AFTER_DRAIN = false;
    bf16_t* zrw; bf16_t* zug; float* out;
    __device__ __forceinline__ void operator()(const f32x4 (&acc)[2][2][4][2], const Unit& u, int wr, int wc, int fr, int fq) const {
        const int colt = u.pn * BM;
        const int mode = colt < CSH ? 0 : (colt < C_G0 ? 1 : 2);
        const int row0 = u.pm * BM + wr * 64 + fr, col0 = colt + wc * 32 + 8 * fq;
#pragma unroll
        for (int ai = 0; ai < 2; ++ai)
#pragma unroll
            for (int m = 0; m < 4; ++m) {
                const int row = row0 + ai * HALF + m * 16;
                bf16_t* rowp = mode == 0 ? zrw + (size_t)row * CSH + col0 : zug + (size_t)row * ZUGW + (col0 - CSH);
                bool last; float* sh;
                if (row < MP) { last = (row & (TP - 1)) == TP - 1; sh = out + O_SHP + (size_t)(row / TP) * CSH + col0; }
                else { const int rs = row - MP; last = (rs & (TS - 1)) == TS - 1; sh = out + O_SHS + (size_t)(rs / TS) * CSH + col0; }
#pragma unroll
                for (int bj = 0; bj < 2; ++bj) {
                    f32x4 v0 = acc[ai][bj][m][0], v1 = acc[ai][bj][m][1];
                    if (mode == 0) { if (last) { *(f32x4*)(sh + bj * HALF) = v0; *(f32x4*)(sh + bj * HALF + 4) = v1; } }
                    else if (mode == 1) {
#pragma unroll
                        for (int e = 0; e < 4; ++e) { v0[e] = gelu_tanh(v0[e]); v1[e] = gelu_tanh(v1[e]); }
                    } else {
#pragma unroll
                        for (int e = 0; e < 4; ++e) { v0[e] = sigmoidf_(v0[e]); v1[e] = sigmoidf_(v1[e]); }
                    }
                    u32x4 w; w.x = pk2(v0[0], v0[1]); w.y = pk2(v0[2], v0[3]); w.z = pk2(v1[0], v1[1]); w.w = pk2(v1[2], v1[3]);
                    *(u32x4*)(rowp + bj * HALF) = w;
                }
            }
    }
};
struct EpiMerge {
    static constexpr bool PERM = true, AFTER_DRAIN = false;
    const bf16_t* z; bf16_t* mg;
    __device__ __forceinline__ void operator()(const f32x4 (&acc)[2][2][4][2], const Unit& u, int wr, int wc, int fr, int fq) const {
        const int which = u.pm >= 36 ? 1 : 0, pm = u.pm - 36 * which, pn = u.pn - 8 * which;
        const int row0 = pm * BM + wr * 64 + fr, col0 = pn * BM + wc * 32 + 8 * fq;
        const int gcol = which ? ZU_G1 : ZU_G0;
#pragma unroll
        for (int ai = 0; ai < 2; ++ai)
#pragma unroll
            for (int m = 0; m < 4; ++m) {
                const int row = row0 + ai * HALF + m * 16;
#pragma unroll
                for (int bj = 0; bj < 2; ++bj) {
                    const u32x4 gw = *(const u32x4*)(z + (size_t)row * ZUGW + gcol + col0 + bj * HALF);
                    bf16_t* mp = mg + (size_t)row * D + col0 + bj * HALF;
                    u32x4 pw = (u32x4){0u, 0u, 0u, 0u};
                    if (which) pw = *(const u32x4*)mp;
                    const f32x4 v0 = acc[ai][bj][m][0], v1 = acc[ai][bj][m][1];
                    u32x4 w;
                    w.x = pk2(bflo(pw.x) + bflo(gw.x) * v0[0], bfhi(pw.x) + bfhi(gw.x) * v0[1]);
                    w.y = pk2(bflo(pw.y) + bflo(gw.y) * v0[2], bfhi(pw.y) + bfhi(gw.y) * v0[3]);
                    w.z = pk2(bflo(pw.z) + bflo(gw.z) * v1[0], bfhi(pw.z) + bfhi(gw.z) * v1[1]);
                    w.w = pk2(bflo(pw.w) + bflo(gw.w) * v1[2], bfhi(pw.w) + bfhi(gw.w) * v1[3]);
                    *(u32x4*)mp = w;
                }
            }
    }
};
struct EpiRes1 {
    static constexpr bool PERM = false, AFTER_DRAIN = false;
    const float* xp; const float* xs; const float* mod; float* out;
    __device__ __forceinline__ void operator()(const f32x4 (&acc)[2][2][4][2], const Unit& u, int wr, int wc, int fr, int fq) const {
        const int row0 = u.pm * BM + wr * 64 + fr, col0 = u.pn * BM + wc * 32 + 4 * fq;
#pragma unroll
        for (int ai = 0; ai < 2; ++ai)
#pragma unroll
            for (int m = 0; m < 4; ++m) {
                const int row = row0 + ai * HALF + m * 16;
                const float* xr = (row < MP ? xp + (size_t)row * D : xs + (size_t)(row - MP) * D) + col0;
                const float* gm = mod + (size_t)seq_of_row(row) * (6 * D) + 2 * D + col0;
                float* o = out + (size_t)row * D + col0;
#pragma unroll
                for (int bj = 0; bj < 2; ++bj)
#pragma unroll
                    for (int n = 0; n < 2; ++n) { const int c = bj * HALF + n * 16;
                        *(f32x4*)(o + c) = *(const f32x4*)(xr + c) + *(const f32x4*)(gm + c) * acc[ai][bj][m][n]; }
            }
    }
};
struct EpiSwiglu {
    static constexpr bool PERM = true, AFTER_DRAIN = false;
    bf16_t* act;
    __device__ __forceinline__ void operator()(const f32x4 (&acc)[2][2][4][2], const Unit& u, int wr, int wc, int fr, int fq) const {
        const int row0 = u.pm * BM + wr * 64 + fr, col0 = u.pn * HALF + wc * 32 + 8 * fq;
#pragma unroll
        for (int ai = 0; ai < 2; ++ai)
#pragma unroll
            for (int m = 0; m < 4; ++m) {
                const int row = row0 + ai * HALF + m * 16;
                float r[8];
#pragma unroll
                for (int n = 0; n < 2; ++n)
#pragma unroll
                    for (int e = 0; e < 4; ++e) { const float g = acc[ai][0][m][n][e]; r[4 * n + e] = g * sigmoidf_(g) * acc[ai][1][m][n][e]; }
                u32x4 w; w.x = pk2(r[0], r[1]); w.y = pk2(r[2], r[3]); w.z = pk2(r[4], r[5]); w.w = pk2(r[6], r[7]);
                *(u32x4*)(act + (size_t)row * DFF + col0) = w;
            }
    }
};
struct EpiRes2 {
    static constexpr bool PERM = false, AFTER_DRAIN = false;
    const float* mod; float* out;
    __device__ __forceinline__ void operator()(const f32x4 (&acc)[2][2][4][2], const Unit& u, int wr, int wc, int fr, int fq) const {
        const int row0 = u.pm * BM + wr * 64 + fr, col0 = u.pn * BM + wc * 32 + 4 * fq;
#pragma unroll
        for (int ai = 0; ai < 2; ++ai)
#pragma unroll
            for (int m = 0; m < 4; ++m) {
                const int row = row0 + ai * HALF + m * 16;
                const float* gf = mod + (size_t)seq_of_row(row) * (6 * D) + 5 * D + col0;
                float* o = out + (size_t)row * D + col0;
#pragma unroll
                for (int bj = 0; bj < 2; ++bj)
#pragma unroll
                    for (int n = 0; n < 2; ++n) { const int c = bj * HALF + n * 16;
                        *(f32x4*)(o + c) = *(const f32x4*)(o + c) + *(const f32x4*)(gf + c) * acc[ai][bj][m][n]; }
            }
    }
};
struct BranchOrder {
    int G, c;
    __device__ bool next(int i, Unit& u) const { const int t = (i >> 1) * G + c; if (t >= (M / BM) * (D / BM)) return false; const int which = i & 1;
        u.pm = t / (D / BM) + (M / BM) * which; u.pn = t % (D / BM) + (D / BM) * which; return true; }
    __device__ __forceinline__ void a_ready(const Unit&) const {}
    __device__ __forceinline__ void done(const Unit&) const {}
};

#define GAS __attribute__((address_space(1)))
#define LAS __attribute__((address_space(3)))
typedef GAS unsigned gu32;
#define RLX_AGENT __ATOMIC_RELAXED, __HIP_MEMORY_SCOPE_AGENT
#define LDS_WAIT() asm volatile("s_waitcnt lgkmcnt(0)" ::: "memory")
#define VM_WAIT() asm volatile("s_waitcnt vmcnt(0)" ::: "memory")
#define XB_TMO      128
#define XB_XCNT(j)  (256  + 64 * (j))
#define XB_XSUB(j)  (1280 + 64 * (j))
#define XB_XGEN(j)  (2304 + 64 * (j))
#define XB_TOP      3328
#define XB_TOPGEN   3392
#define XCD_BAR_WORDS 3456
#define XB_SPIN_CAP (1u << 18)

__device__ __forceinline__ unsigned xb_ld(unsigned* p)              { return __hip_atomic_load(p, __ATOMIC_RELAXED, __HIP_MEMORY_SCOPE_AGENT); }
__device__ __forceinline__ unsigned xb_add(unsigned* p, unsigned v) { return __hip_atomic_fetch_add(p, v, __ATOMIC_RELAXED, __HIP_MEMORY_SCOPE_AGENT); }
__device__ __forceinline__ unsigned xb_xcc_id() { return (unsigned)__builtin_amdgcn_s_getreg((3 << 11) | 20) & 0xFu; }
#define XB_SPIN(cond, bar) do { unsigned _sp = 0; while (cond) { __builtin_amdgcn_s_sleep(1); \
    if ((++_sp & 255u) == 0u) { if (xb_ld(&(bar)[XB_TMO])) break; if (_sp > XB_SPIN_CAP) { atomicAdd(&(bar)[XB_TMO], 1u); break; } } } } while (0)

struct XcdBarrier {
    unsigned* bar; unsigned x;
    volatile LAS unsigned* st;
};

__device__ __forceinline__ XcdBarrier xcd_barrier_post(unsigned* bar, volatile LAS unsigned* st) {
    XcdBarrier b; b.bar = bar; b.x = xb_xcc_id(); b.st = st;
    if (threadIdx.x == 0) (void)xb_add(&bar[XB_XCNT(b.x)], 1u);
    return b;
}
__device__ __forceinline__ void xcd_barrier_complete(unsigned* bar, unsigned x, unsigned& nloc, unsigned& nx) {
    const unsigned G = gridDim.x * gridDim.y * gridDim.z;
    unsigned sum, cnt, mine, sp = 0u;
    for (;;) {
        sum = 0u; cnt = 0u; mine = 0u;
#pragma unroll
        for (unsigned j = 0; j < 16; ++j) { const unsigned c = xb_ld(&bar[XB_XCNT(j)]); sum += c; cnt += (c > 0u) ? 1u : 0u; mine = (j == x) ? c : mine; }
        if (sum == G) break;
        __builtin_amdgcn_s_sleep(1);
        if ((++sp & 255u) == 0u) { if (xb_ld(&bar[XB_TMO])) break; if (sp > XB_SPIN_CAP) { atomicAdd(&bar[XB_TMO], 1u); break; } }
    }
    nloc = mine > 0u ? mine : 1u; nx = cnt > 0u ? cnt : 1u;
}

__device__ __forceinline__ void xcd_barrier(const XcdBarrier& b) {
    asm volatile("s_waitcnt vmcnt(0)" ::: "memory");
    __syncthreads();
    if (threadIdx.x == 0) {
        unsigned* bar = b.bar;
        __builtin_amdgcn_s_waitcnt(0);
        unsigned nloc = b.st[0], nx = b.st[1];
        if (nloc == 0u) { xcd_barrier_complete(bar, b.x, nloc, nx); b.st[0] = nloc; b.st[1] = nx; }
        const unsigned old = xb_add(&bar[XB_XSUB(b.x)], 1u);
        const unsigned gen = old / nloc;
        if (old + 1u == (gen + 1u) * nloc) {
            __builtin_amdgcn_fence(__ATOMIC_RELEASE, "agent");
            asm volatile("s_waitcnt vmcnt(0)" ::: "memory");
            const unsigned og = xb_add(&bar[XB_TOP], 1u);
            const unsigned tg = og / nx;
            if (og + 1u == (tg + 1u) * nx) xb_add(&bar[XB_TOPGEN], 1u);
            else XB_SPIN(xb_ld(&bar[XB_TOPGEN]) == tg, bar);
            __builtin_amdgcn_fence(__ATOMIC_ACQUIRE, "agent");
            xb_add(&bar[XB_XGEN(b.x)], 1u);
            asm volatile("s_waitcnt vmcnt(0)" ::: "memory");
        } else {
            XB_SPIN(xb_ld(&bar[XB_XGEN(b.x)]) == gen, bar);
            __builtin_amdgcn_fence(__ATOMIC_ACQUIRE, "agent");
            asm volatile("s_waitcnt vmcnt(0)" ::: "memory");
        }
    }
    __syncthreads();
}

typedef pg8::bf16x8 bf16x8;
#define MFMA16(a, b, c) __builtin_amdgcn_mfma_f32_16x16x32_bf16((a), (b), (c), 0, 0, 0)
constexpr int RB_P1 = 0, RB_RT = 2048, RB_QP = 4096, RB_RAK = 5120, RB_VM = 6144, RB_WL = 8192;

__device__ __forceinline__ f32x4 ld_bf4(const bf16_t* p) { const u32x2v w = *(const u32x2v*)p; return (f32x4){bflo(w.x), bfhi(w.x), bflo(w.y), bfhi(w.y)}; }
__device__ __forceinline__ bf16x8 mk_frag(const f32x4 a, const f32x4 b) { u32x4 w; w.x = pk2(a[0], a[1]); w.y = pk2(a[2], a[3]); w.z = pk2(b[0], b[1]); w.w = pk2(b[2], b[3]); return __builtin_bit_cast(bf16x8, w); }
__device__ __forceinline__ unsigned char* recA_ptr(const P& p, int rec) { return rec < NREC_P ? p.ws + WS_H + (size_t)rec * RECA : p.ws + WS_FRA_S + (size_t)(rec - NREC_P) * RECA; }
__device__ __forceinline__ unsigned char* recB_ptr(const P& p, int rec) { return rec < NREC_P ? (unsigned char*)p.out + (size_t)rec * RECB : p.ws + WS_FRB_S + (size_t)(rec - NREC_P) * RECB; }
__device__ __forceinline__ f32x4 sig4(f32x4 x) { return (f32x4){sigmoidf_(x[0]), sigmoidf_(x[1]), sigmoidf_(x[2]), sigmoidf_(x[3])}; }
__device__ __forceinline__ f32x4 exp4(f32x4 x) { return (f32x4){__expf(x[0]), __expf(x[1]), __expf(x[2]), __expf(x[3])}; }

template <class T> __device__ __forceinline__ T ldu(const void* ubase, unsigned voff) { return *(const T*)((const char*)ubase + voff); }
__device__ __forceinline__ f32x4 bf4(const u32x2v w) { return (f32x4){bflo(w.x), bfhi(w.x), bflo(w.y), bfhi(w.y)}; }
struct ShiftCtx { const bf16_t* zrw; const float* ss; const float* mu; unsigned zoc, zop; float fv, fpz, fps; };
__device__ __forceinline__ f32x4 shift4(const ShiftCtx& k, int cu, unsigned lp) {
    const u32x2v cw = ldu<u32x2v>(k.zrw + cu, k.zoc + lp * 2u), pw = ldu<u32x2v>(k.zrw + cu, k.zop + lp * 2u);
    const f32x4 sv = ldu<f32x4>(k.ss + cu, lp * 4u), m = ldu<f32x4>(k.mu + cu, lp * 4u);
    const f32x4 cur = bf4(cw) * k.fv;
    const f32x4 pv = bf4(pw) * k.fpz + sv * k.fps;
    return cur + (pv - cur) * m;
}

__device__ __forceinline__ void prep_record(const P& p, LAS unsigned char* wl, int rec, int lane_in) {
    int lane = lane_in; asm volatile("" : "+v"(lane));
    const int head = rec & 15, chunkid = rec >> 4;
    const bool prompt = chunkid < NPB * 128;
    const int sq = prompt ? (chunkid >> 7) : NPB + (chunkid - NPB * 128);
    const int c = prompt ? (chunkid & 127) : 0;
    const int row0 = prompt ? sq * TP + c * 16 : MP + (sq - NPB) * TS;
    const int nvalid = prompt ? 16 : TS;
    const int i = lane & 15, q = lane >> 4;
    const bool valid = i < nvalid, first = (c == 0);
    const bool pz = valid && (i > 0 || !first), ps = valid && (i == 0) && first && !prompt;
    const int row = row0 + (valid ? i : 0);
    ShiftCtx K;
    K.zrw = (const bf16_t*)(p.ws + WS_ZRW); K.ss = p.in[3] + (size_t)(prompt ? 0 : sq - NPB) * CSH; K.mu = p.in[10];
    K.zoc = (unsigned)row * (unsigned)(CSH * 2); K.zop = pz ? K.zoc - (unsigned)(CSH * 2) : K.zoc; K.fv = valid ? 1.f : 0.f; K.fpz = pz ? 1.f : 0.f; K.fps = ps ? 1.f : 0.f;
    const unsigned q4 = (unsigned)q * 4u, q8 = (unsigned)q * 8u;
    const unsigned wlo64 = (unsigned)(i * 64 + q * 8) * 2u, wlo128 = (unsigned)(i * 128 + q * 8) * 2u;
    const bf16_t* WDUT = (const bf16_t*)(p.ws + WS_LORA); const bf16_t* WAUT = WDUT + RW * 64; const bf16_t* WGUT = WAUT + RW * 64;
    const f32x4 z4 = (f32x4){0.f, 0.f, 0.f, 0.f};

    f32x4 accw[4], acca[4];
#pragma unroll
    for (int ct = 0; ct < 4; ++ct) { accw[ct] = z4; acca[ct] = z4; }
#pragma unroll
    for (int s = 0; s < 2; ++s) {
        const int cw = 3072 + 32 * s, ca = 3136 + 32 * s;
        f32x4 x0 = shift4(K, cw, q8), x1 = shift4(K, cw + 4, q8);
#pragma unroll
        for (int e = 0; e < 4; ++e) { x0[e] = 2.f * sigmoidf_(2.f * x0[e]) - 1.f; x1[e] = 2.f * sigmoidf_(2.f * x1[e]) - 1.f; }
        const bf16x8 td = mk_frag(x0, x1);
        const bf16x8 ad = mk_frag(shift4(K, ca, q8), shift4(K, ca + 4, q8));
#pragma unroll
        for (int ct = 0; ct < 4; ++ct) {
            const int wo = (head * 64 + 16 * ct) * 64 + 32 * s;
            accw[ct] = MFMA16(ldu<bf16x8>(WDUT + wo, wlo64), td, accw[ct]);
            acca[ct] = MFMA16(ldu<bf16x8>(WAUT + wo, wlo64), ad, acca[ct]);
        }
    }
    f32x4 lw[4], av[4], ks[4];
    float ssq = 0.f;
#pragma unroll
    for (int ct = 0; ct < 4; ++ct) {
        const int cbu = head * 64 + 16 * ct;
        lw[ct] = sig4(ldu<f32x4>(p.in[11] + cbu, q4 * 4u) + accw[ct]) * (-0.6065306597126334f);
        lw[ct] = lw[ct] * K.fv;
        av[ct] = sig4(ldu<f32x4>(p.in[13] + cbu, q4 * 4u) + acca[ct]);
        ks[ct] = shift4(K, RW + cbu, q4);
        const f32x4 kk0 = ks[ct] * ldu<f32x4>(p.in[16] + cbu, q4 * 4u);
        ssq += (kk0[0] * kk0[0] + kk0[1] * kk0[1]) + (kk0[2] * kk0[2] + kk0[3] * kk0[3]);
    }
    ssq += __shfl_xor(ssq, 16); ssq += __shfl_xor(ssq, 32);
    const float kinv = 1.f / fmaxf(sqrtf(ssq), 1e-12f);
    f32x4 lwc[4];
#pragma unroll
    for (int ct = 0; ct < 4; ++ct) lwc[ct] = lw[ct];
#pragma unroll
    for (int d = 1; d < 16; d <<= 1)
#pragma unroll
        for (int ct = 0; ct < 4; ++ct)
#pragma unroll
            for (int e = 0; e < 4; ++e) { const float t = __shfl_up(lwc[ct][e], d, 16); if (i >= d) lwc[ct][e] += t; }
    unsigned char* rb = recB_ptr(p, rec); unsigned char* ra = recA_ptr(p, rec);
    LAS unsigned short* KT = (LAS unsigned short*)wl; LAS unsigned short* AT = KT + 1024; LAS unsigned short* KtT = KT + 2048; LAS unsigned short* VT = KT + 3072;
    LAS float* MT = (LAS float*)(wl + 8192);
    u32x2v kapP[4], alpP[4], ktP[4], rtP[4];
    f32x4 wl15[4];
    float bsum = 0.f;
#pragma unroll
    for (int ct = 0; ct < 4; ++ct) {
        const int cbu = head * 64 + 16 * ct;
        const f32x4 Wt = exp4(lwc[ct]), Wtm1 = exp4(lwc[ct] - lw[ct]), Winv = exp4(-lwc[ct]);
        const f32x4 kkn = ks[ct] * ldu<f32x4>(p.in[16] + cbu, q4 * 4u) * kinv;
        const f32x4 kmod = ks[ct] * ((av[ct] - 1.f) * ldu<f32x4>(p.in[17] + cbu, q4 * 4u) + 1.f);
        const f32x4 kap = kkn * Wtm1, alp = kkn * av[ct] * Winv, kt = kmod * Winv;
        const f32x4 rs = shift4(K, cbu, q4);
        const f32x4 rt = rs * Wt;
        const f32x4 rk = rs * kmod * ldu<f32x4>(p.in[18] + cbu, q4 * 4u);
        bsum += (rk[0] + rk[1]) + (rk[2] + rk[3]);
#pragma unroll
        for (int e = 0; e < 4; ++e) wl15[ct][e] = __shfl(Wt[e], 15, 16);
        kapP[ct].x = pk2(kap[0], kap[1]); kapP[ct].y = pk2(kap[2], kap[3]); alpP[ct].x = pk2(alp[0], alp[1]); alpP[ct].y = pk2(alp[2], alp[3]);
        ktP[ct].x = pk2(kt[0], kt[1]); ktP[ct].y = pk2(kt[2], kt[3]); rtP[ct].x = pk2(rt[0], rt[1]); rtP[ct].y = pk2(rt[2], rt[3]);
#pragma unroll
        for (int e = 0; e < 4; ++e) { const int ch = 16 * ct + 4 * q + e; const int sh = (e & 1) * 16;
            KT[ch * 16 + i] = (unsigned short)(((e < 2 ? kapP[ct].x : kapP[ct].y) >> sh) & 0xffffu);
            AT[ch * 16 + i] = (unsigned short)(((e < 2 ? alpP[ct].x : alpP[ct].y) >> sh) & 0xffffu);
            KtT[ch * 16 + i] = (unsigned short)(((e < 2 ? ktP[ct].x : ktP[ct].y) >> sh) & 0xffffu); }
    }
    bsum += __shfl_xor(bsum, 16); bsum += __shfl_xor(bsum, 32);
    u32x2v c1P[4], c2P[4];
    {
        f32x4 accg[4];
#pragma unroll
        for (int ct = 0; ct < 4; ++ct) accg[ct] = z4;
#pragma unroll
        for (int s = 0; s < 4; ++s) {
            const int cg = 3200 + 32 * s;
            const bf16x8 gd = mk_frag(sig4(shift4(K, cg, q8)), sig4(shift4(K, cg + 4, q8)));
#pragma unroll
            for (int ct = 0; ct < 4; ++ct) accg[ct] = MFMA16(ldu<bf16x8>(WGUT + (head * 64 + 16 * ct) * 128 + 32 * s, wlo128), gd, accg[ct]);
        }
#pragma unroll
        for (int ct = 0; ct < 4; ++ct) {
            const int cbu = head * 64 + 16 * ct;
            const f32x4 c1 = ldu<f32x4>(p.in[19] + cbu, q4 * 4u) * accg[ct];
            const f32x4 vsf = shift4(K, 2 * RW + cbu, q4);
            const f32x4 c2 = (ldu<f32x4>(p.in[20] + cbu, q4 * 4u) + vsf * bsum) * accg[ct];
            c1P[ct].x = pk2(c1[0], c1[1]); c1P[ct].y = pk2(c1[2], c1[3]); c2P[ct].x = pk2(c2[0], c2[1]); c2P[ct].y = pk2(c2[2], c2[3]);
#pragma unroll
            for (int e = 0; e < 4; ++e) VT[(16 * ct + 4 * q + e) * 16 + i] = f2bf(vsf[e]);
        }
    }
    bf16x8 kapF[2], alpF[2], ktF[2], rtF[2];
#pragma unroll
    for (int s = 0; s < 2; ++s) {
        kapF[s] = __builtin_bit_cast(bf16x8, (u32x4){kapP[2 * s].x, kapP[2 * s].y, kapP[2 * s + 1].x, kapP[2 * s + 1].y});
        alpF[s] = __builtin_bit_cast(bf16x8, (u32x4){alpP[2 * s].x, alpP[2 * s].y, alpP[2 * s + 1].x, alpP[2 * s + 1].y});
        ktF[s] = __builtin_bit_cast(bf16x8, (u32x4){ktP[2 * s].x, ktP[2 * s].y, ktP[2 * s + 1].x, ktP[2 * s + 1].y});
        rtF[s] = __builtin_bit_cast(bf16x8, (u32x4){rtP[2 * s].x, rtP[2 * s].y, rtP[2 * s + 1].x, rtP[2 * s + 1].y});
    }
    f32x4 Maa = z4, Mak = z4, RAt = z4, RKt = z4;
#pragma unroll
    for (int s = 0; s < 2; ++s) {
        Maa = MFMA16(kapF[s], alpF[s], Maa); Mak = MFMA16(kapF[s], ktF[s], Mak);
        RAt = MFMA16(alpF[s], rtF[s], RAt); RKt = MFMA16(ktF[s], rtF[s], RKt);
    }
#pragma unroll
    for (int r = 0; r < 4; ++r) { const int rw_ = 4 * q + r;
        if (!(rw_ > i)) { Maa[r] = 0.f; Mak[r] = 0.f; }
        if (!(i >= rw_)) { RAt[r] = 0.f; RKt[r] = 0.f; } }
    *(LAS f32x4*)(MT + i * 16 + 4 * q) = Maa;
    u32x4 rakW; rakW.x = pk2(RAt[0], RAt[1]); rakW.y = pk2(RAt[2], RAt[3]); rakW.z = pk2(RKt[0], RKt[1]); rakW.w = pk2(RKt[2], RKt[3]);
    LDS_WAIT(); asm volatile("" ::: "memory");
    float t[16];
#pragma unroll
    for (int cc = 15; cc >= 0; --cc) {
        float acc = (i == cc) ? 1.f : 0.f;
        f32x4 mrow[4];
#pragma unroll
        for (int b = 0; b < 4; ++b) mrow[b] = *(const LAS f32x4*)(MT + cc * 16 + 4 * b);
#pragma unroll
        for (int j = cc + 1; j < 16; ++j) acc -= t[j] * mrow[j >> 2][j & 3];
        t[cc] = acc;
    }
    f32x4 tsel;
#pragma unroll
    for (int e = 0; e < 4; ++e) tsel[e] = -(q == 0 ? t[e] : (q == 1 ? t[4 + e] : (q == 2 ? t[8 + e] : t[12 + e])));
    const bf16x8 Tfrag = mk_frag(tsel, z4);
    f32x4 P1E[4];
#pragma unroll
    for (int ct = 0; ct < 4; ++ct) { const u32x2v w = *(const LAS u32x2v*)(KT + (16 * ct + i) * 16 + 4 * q);
        u32x4 aw; aw.x = w.x; aw.y = w.y; aw.z = 0u; aw.w = 0u; P1E[ct] = MFMA16(__builtin_bit_cast(bf16x8, aw), Tfrag, z4); }
    *(u32x4*)(rb + RB_RT + lane * 16) = __builtin_bit_cast(u32x4, rtF[0]); *(u32x4*)(rb + RB_RT + 1024 + lane * 16) = __builtin_bit_cast(u32x4, rtF[1]);
    *(u32x4*)(rb + RB_RAK + lane * 16) = rakW;
#pragma unroll
    for (int ct = 0; ct < 4; ++ct) {
        if (i == 0) *(f32x4*)(rb + RB_WL + (16 * ct + 4 * q) * 4) = wl15[ct];
        if (valid) { const int cbu = head * 64 + 16 * ct;
            *(u32x2v*)((char*)((bf16_t*)(p.ws + WS_OA) + cbu) + ((unsigned)row * RW + q4) * 2u) = c1P[ct];
            *(u32x2v*)((char*)((bf16_t*)(p.ws + WS_C2) + cbu) + ((unsigned)row * RW + q4) * 2u) = c2P[ct]; }
    }
    *(u32x4*)(rb + RB_P1 + lane * 16) = __builtin_bit_cast(u32x4, mk_frag(P1E[0], P1E[1]));
    *(u32x4*)(rb + RB_P1 + 1024 + lane * 16) = __builtin_bit_cast(u32x4, mk_frag(P1E[2], P1E[3]));
    { const f32x4 Qt = MFMA16(mk_frag(Mak, z4), Tfrag, z4);
      u32x4 w; w.x = 0u; w.y = 0u; w.z = pk2(Qt[0], Qt[1]); w.w = pk2(Qt[2], Qt[3]); *(u32x4*)(rb + RB_QP + lane * 16) = w; }
#pragma unroll
    for (int tt = 0; tt < 4; ++tt) {
        const u32x2v a = *(const LAS u32x2v*)(AT + (16 * tt + i) * 16 + 4 * q), b = *(const LAS u32x2v*)(KtT + (16 * tt + i) * 16 + 4 * q);
        u32x4 w; w.x = a.x; w.y = a.y; w.z = b.x; w.w = b.y; *(u32x4*)(ra + tt * 1024 + lane * 16) = w;
        *(u32x2v*)(rb + RB_VM + tt * 512 + lane * 8) = *(const LAS u32x2v*)(VT + (16 * tt + i) * 16 + 4 * q);
    }
    LDS_WAIT(); asm volatile("" ::: "memory");
}

struct ScanFr { bf16x8 P10, P11, RT0, RT1, QP, RAK, AK0, AK1, AK2, AK3; u32x2v vm; f32x4 WL0, WL1, WL2, WL3; };
__device__ __forceinline__ void scan_load(ScanFr& f, const P& p, int rec, int vs, int lane) {
    const unsigned char* ra = recA_ptr(p, rec); const unsigned char* rb = recB_ptr(p, rec);
    const unsigned l16 = (unsigned)lane * 16u, q16 = (unsigned)(lane >> 4) * 16u;
    f.P10 = ldu<bf16x8>(rb + RB_P1, l16); f.P11 = ldu<bf16x8>(rb + RB_P1 + 1024, l16);
    f.RT0 = ldu<bf16x8>(rb + RB_RT, l16); f.RT1 = ldu<bf16x8>(rb + RB_RT + 1024, l16);
    f.QP = ldu<bf16x8>(rb + RB_QP, l16); f.RAK = ldu<bf16x8>(rb + RB_RAK, l16);
    f.vm = ldu<u32x2v>(rb + RB_VM + vs * 512, (unsigned)lane * 8u);
    f.AK0 = ldu<bf16x8>(ra, l16); f.AK1 = ldu<bf16x8>(ra + 1024, l16); f.AK2 = ldu<bf16x8>(ra + 2048, l16); f.AK3 = ldu<bf16x8>(ra + 3072, l16);
    f.WL0 = ldu<f32x4>(rb + RB_WL, q16); f.WL1 = ldu<f32x4>(rb + RB_WL + 64, q16); f.WL2 = ldu<f32x4>(rb + RB_WL + 128, q16); f.WL3 = ldu<f32x4>(rb + RB_WL + 192, q16);
}
__device__ __forceinline__ void scan_step(const ScanFr& f, f32x4 (&St)[4], float* oraw, int c, int q, bool prompt) {
    const f32x4 z4 = (f32x4){0.f, 0.f, 0.f, 0.f};
    const bf16x8 SB0 = mk_frag(St[0], St[1]), SB1 = mk_frag(St[2], St[3]);
    u32x4 vw; vw.x = 0u; vw.y = 0u; vw.z = f.vm.x; vw.w = f.vm.y;
    f32x4 U = MFMA16(f.QP, __builtin_bit_cast(bf16x8, vw), z4);
    U = MFMA16(f.P10, SB0, U); U = MFMA16(f.P11, SB1, U);
    u32x4 uw; uw.x = pk2(U[0], U[1]); uw.y = pk2(U[2], U[3]); uw.z = f.vm.x; uw.w = f.vm.y;
    const bf16x8 UB = __builtin_bit_cast(bf16x8, uw);
    f32x4 O = MFMA16(f.RT0, SB0, z4); O = MFMA16(f.RT1, SB1, O); O = MFMA16(f.RAK, UB, O);
    St[0] = MFMA16(f.AK0, UB, St[0]) * f.WL0; St[1] = MFMA16(f.AK1, UB, St[1]) * f.WL1;
    St[2] = MFMA16(f.AK2, UB, St[2]) * f.WL2; St[3] = MFMA16(f.AK3, UB, St[3]) * f.WL3;
#pragma unroll
    for (int r = 0; r < 4; ++r) { const int tk = 4 * q + r; if (prompt || tk < TS) oraw[(size_t)(16 * c + tk) * RW] = O[r]; }
}
__device__ __forceinline__ void scan_chain_prompt(const P& p, int sq, int head, int vs, int lane, volatile LAS unsigned* prog) {
    constexpr int nch = TP / 16;
    const int rec0 = sq * nch * NH + head, vl = lane & 15, q = lane >> 4;
    f32x4 St[4];
    float* sout = p.out + O_WKVP + ((size_t)sq * NH + head) * HS * HS + (size_t)(16 * vs + vl) * HS + 4 * q;
    float* oraw = (float*)(p.ws + WS_ZRW) + (size_t)(sq * TP) * RW + head * HS + 16 * vs + vl;
    ScanFr f0, f1, f2;
    scan_load(f0, p, rec0, vs, lane); scan_load(f1, p, rec0 + NH, vs, lane); scan_load(f2, p, rec0 + 2 * NH, vs, lane);
#pragma unroll
    for (int t = 0; t < 4; ++t) St[t] = (f32x4){0.f, 0.f, 0.f, 0.f};
    const bool pw = vs == 0 && lane == 0;
    int c = 0;
    for (; c + 3 <= nch; c += 3) {
        if (pw) *prog = (unsigned)c;
        scan_step(f0, St, oraw, c, q, true);     scan_load(f0, p, rec0 + (c + 3 < nch ? c + 3 : nch - 1) * NH, vs, lane);
        scan_step(f1, St, oraw, c + 1, q, true); scan_load(f1, p, rec0 + (c + 4 < nch ? c + 4 : nch - 1) * NH, vs, lane);
        scan_step(f2, St, oraw, c + 2, q, true); scan_load(f2, p, rec0 + (c + 5 < nch ? c + 5 : nch - 1) * NH, vs, lane);
    }
    if (c < nch) { scan_step(f0, St, oraw, c, q, true); ++c; }
    if (c < nch) { scan_step(f1, St, oraw, c, q, true); }
#pragma unroll
    for (int t = 0; t < 4; ++t) *(f32x4*)(sout + 16 * t) = St[t];
}
__device__ __forceinline__ void scan_chain_sample(const P& p, int s, int head, int vs, int lane) {
    const int vl = lane & 15, q = lane >> 4;
    const size_t so = ((size_t)s * NH + head) * HS * HS + (size_t)(16 * vs + vl) * HS + 4 * q;
    ScanFr f0; scan_load(f0, p, NREC_P + s * NH + head, vs, lane);
    f32x4 St[4];
#pragma unroll
    for (int t = 0; t < 4; ++t) St[t] = *(const f32x4*)(p.in[2] + so + 16 * t);
    scan_step(f0, St, (float*)(p.ws + WS_ZRW) + (size_t)(MP + s * TS) * RW + head * HS + 16 * vs + vl, 0, q, false);
#pragma unroll
    for (int t = 0; t < 4; ++t) *(f32x4*)(p.out + O_WKVS + so + 16 * t) = St[t];
}

constexpr int SCAN_AHEAD = 10;
__device__ __forceinline__ void scan_prefetch(const P& p, volatile LAS unsigned* prog, int sq, int head, int k, int lane) {
    const int rec0 = sq * (TP / 16) * NH + head;
    const unsigned l16 = (unsigned)lane * 16u;
    for (int c = k; c < TP / 16; c += 4) {
        while ((int)*prog < c - SCAN_AHEAD) __builtin_amdgcn_s_sleep(8);
        const unsigned char* ra = recA_ptr(p, rec0 + c * NH); const unsigned char* rb = recB_ptr(p, rec0 + c * NH);
        u32x4 x[12];
#pragma unroll
        for (int j = 0; j < 4; ++j) x[j] = ldu<u32x4>(ra + j * 1024, l16);
#pragma unroll
        for (int j = 0; j < 8; ++j) x[4 + j] = ldu<u32x4>(rb + j * 1024, l16);
        const u32x4 y = ldu<u32x4>(rb + 8192, (unsigned)(lane & 15) * 16u);
#pragma unroll
        for (int j = 0; j < 12; ++j) asm volatile("" :: "v"(x[j].x));
        asm volatile("" :: "v"(y.x));
    }
}

__device__ __forceinline__ void mix_item(const P& p, int item, int wave, int lane) {
    const int g = item & 7, row0 = (item >> 3) * 128;
    const int dl = lane & 15, q = lane >> 4, col = g * 128 + wave * 16;
    const bf16_t* vn = (const bf16_t*)(p.ws + WS_VN) + (size_t)row0 * MLPW + col + dl;
    bf16x8 A[4];
#pragma unroll
    for (int sb = 0; sb < 4; ++sb)
#pragma unroll
        for (int j = 0; j < 8; ++j) A[sb][j] = (short)vn[(size_t)(32 * sb + 8 * q + j) * MLPW];
    const float* wsg = p.in[23] + ((size_t)g * 128 + dl) * 128 + 8 * q;
    const bf16_t* zu = (const bf16_t*)(p.ws + WS_ZUG) + (size_t)(row0 + dl) * ZUGW + ZU_U + col + 4 * q;
    bf16_t* ub = (bf16_t*)(p.ws + WS_UB) + (size_t)(row0 + dl) * MLPW + col + 4 * q;
#pragma unroll
    for (int tt = 0; tt < 8; ++tt) {
        const int t = 16 * tt + dl;
        f32x4 acc = (f32x4){0.f, 0.f, 0.f, 0.f};
#pragma unroll
        for (int sb = 0; sb <= tt / 2; ++sb) {
            const float* wr = wsg + (size_t)(16 * tt) * 128 + 32 * sb;
            f32x4 w0 = *(const f32x4*)wr, w1 = *(const f32x4*)(wr + 4);
            if (sb == tt / 2) {
#pragma unroll
                for (int e = 0; e < 4; ++e) { if (32 * sb + 8 * q + e > t) w0[e] = 0.f; if (32 * sb + 8 * q + 4 + e > t) w1[e] = 0.f; }
            }
            acc = MFMA16(A[sb], mk_frag(w0, w1), acc);
        }
        const float bias = p.in[24][g * 128 + t];
        const f32x4 u = ld_bf4(zu + (size_t)(16 * tt) * ZUGW);
        const f32x4 o = (acc + bias) * u;
        u32x2v w; w.x = pk2(o[0], o[1]); w.y = pk2(o[2], o[3]); *(u32x2v*)(ub + (size_t)(16 * tt) * MLPW) = w;
    }
}

__device__ __forceinline__ void post_rows(const P& p, int gw, int NGW, int lane) {
    const float* oraw = (const float*)(p.ws + WS_ZRW);
    for (int row = gw; row < M; row += NGW) {
        const size_t off = (size_t)row * RW + lane * 16;
        f32x4 o[4]; float s = 0.f;
#pragma unroll
        for (int j = 0; j < 4; ++j) { o[j] = *(const f32x4*)(oraw + off + 4 * j); s += (o[j][0] + o[j][1]) + (o[j][2] + o[j][3]); }
        s += __shfl_xor(s, 1); s += __shfl_xor(s, 2);
        const float mean = s * (1.f / HS); float qv = 0.f;
#pragma unroll
        for (int j = 0; j < 4; ++j) { o[j] = o[j] - mean; qv += (o[j][0] * o[j][0] + o[j][1] * o[j][1]) + (o[j][2] * o[j][2] + o[j][3] * o[j][3]); }
        qv += __shfl_xor(qv, 1); qv += __shfl_xor(qv, 2);
        const float rstd = rsqrtf(qv * (1.f / HS) + 64e-5f);
        bf16_t* oa = (bf16_t*)(p.ws + WS_OA) + off; const bf16_t* c2p = (const bf16_t*)(p.ws + WS_C2) + off;
#pragma unroll
        for (int h = 0; h < 2; ++h) {
            const u32x4 c1 = *(const u32x4*)(oa + 8 * h), c2 = *(const u32x4*)(c2p + 8 * h);
            const f32x4 a = o[2 * h] * rstd, b = o[2 * h + 1] * rstd;
            u32x4 w;
            w.x = pk2(a[0] * bflo(c1.x) + bflo(c2.x), a[1] * bfhi(c1.x) + bfhi(c2.x)); w.y = pk2(a[2] * bflo(c1.y) + bflo(c2.y), a[3] * bfhi(c1.y) + bfhi(c2.y));
            w.z = pk2(b[0] * bflo(c1.z) + bflo(c2.z), b[1] * bfhi(c1.z) + bfhi(c2.z)); w.w = pk2(b[2] * bflo(c1.w) + bflo(c2.w), b[3] * bfhi(c1.w) + bfhi(c2.w));
            *(u32x4*)(oa + 8 * h) = w;
        }
    }
}

constexpr int NWAVES = 8, NTHR = NWAVES * 64;
constexpr int RING_BYTES = 131072, LDSCTL_OFF = RING_BYTES, MISC_OFF = LDSCTL_OFF + 320, LDS_BYTES = 147456;

__device__ __forceinline__ void p0_mod_slab(const P& p, LAS float* red, int slab, int tid, int lane, int wave) {
    for (int i = tid; i < 144 * 48; i += NTHR) red[i] = 0.f;
    __syncthreads();
    const int n0 = slab * 48, fr = lane & 15, fq = lane >> 4;
    const float* W = p.in[6];
    f32x4 acc[9][3];
#pragma unroll
    for (int a = 0; a < 9; ++a)
#pragma unroll
        for (int b = 0; b < 3; ++b) acc[a][b] = (f32x4){0.f, 0.f, 0.f, 0.f};
    for (int kb = 0; kb < 8; ++kb) {
        const int k0 = wave * 256 + kb * 32 + fq * 8;
        float bw[3][8];
#pragma unroll
        for (int nt = 0; nt < 3; ++nt) {
            const float* wp = W + (size_t)k0 * (6 * D) + n0 + nt * 16 + fr;
#pragma unroll
            for (int j = 0; j < 8; ++j) bw[nt][j] = wp[(size_t)j * (6 * D)];
        }
        bf16x8 bfr[3];
#pragma unroll
        for (int nt = 0; nt < 3; ++nt) { u32x4 w; w.x = pk2(bw[nt][0], bw[nt][1]); w.y = pk2(bw[nt][2], bw[nt][3]); w.z = pk2(bw[nt][4], bw[nt][5]); w.w = pk2(bw[nt][6], bw[nt][7]);
            bfr[nt] = __builtin_bit_cast(bf16x8, w); }
#pragma unroll
        for (int mb = 0; mb < 9; mb += 3) {
            f32x4 c0[3], c1[3];
#pragma unroll
            for (int u = 0; u < 3; ++u) {
                int row = (mb + u) * 16 + fr; row = row < NSEQ ? row : NSEQ - 1;
                const float* c = (row < NPB ? p.in[4] + (size_t)row * D : p.in[5] + (size_t)(row - NPB) * D) + k0;
                c0[u] = *(const f32x4*)c; c1[u] = *(const f32x4*)(c + 4);
            }
#pragma unroll
            for (int u = 0; u < 3; ++u) {
                u32x4 aw;
                aw.x = pk2(c0[u][0] * sigmoidf_(c0[u][0]), c0[u][1] * sigmoidf_(c0[u][1])); aw.y = pk2(c0[u][2] * sigmoidf_(c0[u][2]), c0[u][3] * sigmoidf_(c0[u][3]));
                aw.z = pk2(c1[u][0] * sigmoidf_(c1[u][0]), c1[u][1] * sigmoidf_(c1[u][1])); aw.w = pk2(c1[u][2] * sigmoidf_(c1[u][2]), c1[u][3] * sigmoidf_(c1[u][3]));
                const bf16x8 afr = __builtin_bit_cast(bf16x8, aw);
#pragma unroll
                for (int nt = 0; nt < 3; ++nt) acc[mb + u][nt] = __builtin_amdgcn_mfma_f32_16x16x32_bf16(afr, bfr[nt], acc[mb + u][nt], 0, 0, 0);
            }
        }
    }
#pragma unroll
    for (int mt = 0; mt < 9; ++mt)
#pragma unroll
        for (int nt = 0; nt < 3; ++nt)
#pragma unroll
            for (int r = 0; r < 4; ++r) __hip_atomic_fetch_add(red + (mt * 16 + 4 * fq + r) * 48 + nt * 16 + fr, acc[mt][nt][r], __ATOMIC_RELAXED, __HIP_MEMORY_SCOPE_WORKGROUP);
    __syncthreads();
    float* mod = (float*)(p.ws + WS_MOD);
    for (int i = tid; i < NSEQ * 48; i += NTHR) { const int row = i / 48, c = i % 48; mod[(size_t)row * (6 * D) + n0 + c] = red[row * 48 + c] + p.in[7][n0 + c]; }
    __syncthreads();
}
__device__ __forceinline__ void p0_transpose_item(const float* W, int K, int N, bf16_t* WT, bool swz, LAS float* scr, int item, int lane) {
    const int nblk = N / 32, kb = item / nblk, nb = item % nblk, k0 = 64 * kb, n0 = 32 * nb;
    int r0 = n0;
    if (swz) { r0 = n0 < DFF ? 256 * (n0 >> 7) + (n0 & 127) : 256 * ((n0 - DFF) >> 7) + 128 + ((n0 - DFF) & 127); }
#pragma unroll 8
    for (int i = 0; i < 32; ++i) { const int kk = 2 * i + (lane >> 5); scr[kk * 33 + (lane & 31)] = W[(size_t)(k0 + kk) * N + n0 + (lane & 31)]; }
    LDS_WAIT(); asm volatile("" ::: "memory");
    const int c = lane & 7;
#pragma unroll
    for (int j = 0; j < 4; ++j) { const int n = (lane >> 3) + 8 * j; const LAS float* s = scr + (8 * c) * 33 + n;
        u32x4 o; o.x = pk2(s[0 * 33], s[1 * 33]); o.y = pk2(s[2 * 33], s[3 * 33]); o.z = pk2(s[4 * 33], s[5 * 33]); o.w = pk2(s[6 * 33], s[7 * 33]);
        *(u32x4*)(WT + (size_t)(r0 + n) * K + k0 + 8 * c) = o; }
    LDS_WAIT(); asm volatile("" ::: "memory");
}
__device__ __forceinline__ void p0_transposes(const P& p, LAS float* scr, int part, int gw, int NGW, int lane) {
    constexpr int I_IN = (D / 64) * (CIN / 32), I_BA = (RW / 64) * (D / 32), I_OUT = (D / 64) * (D / 32), I_FI = (D / 64) * (2 * DFF / 32), I_FO = (DFF / 64) * (D / 32);
    constexpr int I_L64 = (RW / 32), I_L128 = 2 * (RW / 32);
    unsigned char* ws = p.ws;
    if (part == 0) {
        for (int it = gw; it < I_IN + 2 * I_L64 + I_L128; it += NGW) {
            int r = it;
            if (r < I_IN) { p0_transpose_item(p.in[9], D, CIN, (bf16_t*)(ws + WS_WIN), false, scr, r, lane); continue; } r -= I_IN;
            if (r < I_L64) { p0_transpose_item(p.in[12], 64, RW, (bf16_t*)(ws + WS_LORA), false, scr, r, lane); continue; } r -= I_L64;
            if (r < I_L64) { p0_transpose_item(p.in[14], 64, RW, (bf16_t*)(ws + WS_LORA) + RW * 64, false, scr, r, lane); continue; } r -= I_L64;
            p0_transpose_item(p.in[15], 128, RW, (bf16_t*)(ws + WS_LORA) + 2 * RW * 64, false, scr, r, lane);
        }
    } else {
        for (int it = gw; it < 2 * I_BA + I_OUT + I_FI + I_FO; it += NGW) {
            int r = it;
            if (r < I_BA) { p0_transpose_item(p.in[25], RW, D, (bf16_t*)(ws + WS_WBA), false, scr, r, lane); continue; } r -= I_BA;
            if (r < I_BA) { p0_transpose_item(p.in[26], RW, D, (bf16_t*)(ws + WS_WBB), false, scr, r, lane); continue; } r -= I_BA;
            if (r < I_OUT) { p0_transpose_item(p.in[27], D, D, (bf16_t*)(ws + WS_WOUT), false, scr, r, lane); continue; } r -= I_OUT;
            if (r < I_FI) { p0_transpose_item(p.in[29], D, 2 * DFF, (bf16_t*)(ws + WS_WFI), true, scr, r, lane); continue; } r -= I_FI;
            p0_transpose_item(p.in[30], DFF, D, (bf16_t*)(ws + WS_WFO), false, scr, r, lane);
        }
    }
}
__device__ __forceinline__ void norm_row(const float* x, const float* g, const float* scale, const float* shift, bf16_t* h, int lane) {
    f32x4 v[8]; float s = 0.f;
#pragma unroll
    for (int j = 0; j < 8; ++j) { v[j] = *(const f32x4*)(x + 4 * lane + 256 * j); s += (v[j][0] * v[j][0] + v[j][1] * v[j][1]) + (v[j][2] * v[j][2] + v[j][3] * v[j][3]); }
    const float rstd = rsqrtf(wave_sum(s) * (1.f / D) + 1e-6f);
#pragma unroll
    for (int j = 0; j < 8; ++j) { const int k = 4 * lane + 256 * j;
        const f32x4 gg = *(const f32x4*)(g + k), sc = *(const f32x4*)(scale + k), sh = *(const f32x4*)(shift + k);
        const f32x4 o = v[j] * rstd * gg * (sc + 1.f) + sh;
        u32x2v w; w.x = pk2(o[0], o[1]); w.y = pk2(o[2], o[3]); *(u32x2v*)(h + k) = w; }
}
__device__ __forceinline__ void phase_norm(const P& p, int which, int gw, int NGW, int lane) {
    const float* g = which == 0 ? p.in[8] : p.in[28];
    for (int row = gw; row < M; row += NGW) {
        const float* x = which == 0 ? (row < MP ? p.in[0] + (size_t)row * D : p.in[1] + (size_t)(row - MP) * D) : p.out + (size_t)row * D;
        const float* mod = (const float*)(p.ws + WS_MOD) + (size_t)seq_of_row(row) * (6 * D);
        norm_row(x, g, mod + (which == 0 ? 1 : 4) * D, mod + (which == 0 ? 0 : 3) * D, (bf16_t*)(p.ws + WS_H) + (size_t)row * D, lane);
    }
}
__device__ __forceinline__ void phase_lnv(const P& p, int gw, int NGW, int lane) {
    for (int row = gw; row < M; row += NGW) {
        const bf16_t* zv = (const bf16_t*)(p.ws + WS_ZUG) + (size_t)row * ZUGW + ZU_V;
        float v[16]; float s = 0.f;
#pragma unroll
        for (int j = 0; j < 2; ++j) { const u32x4 w = *(const u32x4*)(zv + 8 * lane + 512 * j);
            v[8 * j + 0] = bflo(w.x); v[8 * j + 1] = bfhi(w.x); v[8 * j + 2] = bflo(w.y); v[8 * j + 3] = bfhi(w.y);
            v[8 * j + 4] = bflo(w.z); v[8 * j + 5] = bfhi(w.z); v[8 * j + 6] = bflo(w.w); v[8 * j + 7] = bfhi(w.w); }
#pragma unroll
        for (int i = 0; i < 16; ++i) s += v[i];
        const float mean = wave_sum(s) * (1.f / MLPW);
        float q = 0.f;
#pragma unroll
        for (int i = 0; i < 16; ++i) { v[i] -= mean; q += v[i] * v[i]; }
        const float rstd = rsqrtf(wave_sum(q) * (1.f / MLPW) + 1e-5f);
        bf16_t* vn = (bf16_t*)(p.ws + WS_VN) + (size_t)row * MLPW;
#pragma unroll
        for (int j = 0; j < 2; ++j) { const int c = 8 * lane + 512 * j; float o[8];
#pragma unroll
            for (int e = 0; e < 8; ++e) o[e] = v[8 * j + e] * rstd * p.in[21][c + e] + p.in[22][c + e];
            u32x4 w; w.x = pk2(o[0], o[1]); w.y = pk2(o[2], o[3]); w.z = pk2(o[4], o[5]); w.w = pk2(o[6], o[7]);
            *(u32x4*)(vn + c) = w;
            if (row >= MP) { float* vs = p.out + O_VS + (size_t)(row - MP) * MLPW + c;
                *(f32x4*)vs = (f32x4){o[0], o[1], o[2], o[3]}; *(f32x4*)(vs + 4) = (f32x4){o[4], o[5], o[6], o[7]}; }
        }
    }
}
__device__ __forceinline__ void phase_final(const P& p, int gw, int NGW, int lane) {
    for (int row = gw; row < M; row += NGW) {
        float* x = p.out + (size_t)row * D;
        f32x4 v[8]; float s = 0.f;
#pragma unroll
        for (int j = 0; j < 8; ++j) { v[j] = *(const f32x4*)(x + 4 * lane + 256 * j); s += (v[j][0] * v[j][0] + v[j][1] * v[j][1]) + (v[j][2] * v[j][2] + v[j][3] * v[j][3]); }
        const float rstd = rsqrtf(wave_sum(s) * (1.f / D) + 1e-6f);
#pragma unroll
        for (int j = 0; j < 8; ++j) { const int k = 4 * lane + 256 * j; *(f32x4*)(x + k) = v[j] * rstd * *(const f32x4*)(p.in[31] + k); }
    }
}
__device__ __forceinline__ void mix_naive_row(const P& p, int row, int tid, int nthr) {
    int t;
    if (row < MP) t = (row & (TP - 1)) & 127; else t = (row - MP) & (TS - 1);
    const int rowc0 = row - t;
    const bf16_t* vn = (const bf16_t*)(p.ws + WS_VN);
    const bf16_t* zu = (const bf16_t*)(p.ws + WS_ZUG) + (size_t)row * ZUGW + ZU_U;
    bf16_t* ub = (bf16_t*)(p.ws + WS_UB) + (size_t)row * MLPW;
    for (int c = tid; c < MLPW; c += nthr) {
        const int g = c >> 7; const float* wsg = p.in[23] + ((size_t)g * 128 + t) * 128;
        float acc = 0.f;
        for (int s = 0; s <= t; ++s) acc += wsg[s] * bf2f(vn[(size_t)(rowc0 + s) * MLPW + c]);
        acc += p.in[24][g * 128 + t];
        ub[c] = f2bf(bf2f(zu[c]) * acc);
    }
}

#define PHASE_IDS() int tid = threadIdx.x; asm volatile("" : "+v"(tid)); const int lane = tid & 63, wave = __builtin_amdgcn_readfirstlane(tid >> 6); \
    const int gw = bx * NWAVES + wave, NGW = G * NWAVES; (void)lane; (void)gw; (void)NGW
__global__ void __launch_bounds__(NTHR, 2) mega_fwd(P p) {
    extern __shared__ __attribute__((aligned(16))) unsigned char lds_raw[];
    LAS unsigned char* lds = (LAS unsigned char*)lds_raw;
    const int G = gridDim.x, bx = blockIdx.x;
    unsigned char* ws = p.ws;
    { PHASE_IDS();
      for (int u = tid; u < (LDS_BYTES - LDSCTL_OFF) / 4; u += NTHR) ((LAS unsigned*)(lds + LDSCTL_OFF))[u] = 0u; }
    __syncthreads();
    XcdBarrier bar = xcd_barrier_post((unsigned*)(ws + WS_CTL) + CW_BAR, (volatile LAS unsigned*)(lds + MISC_OFF) + 8);
#ifdef TSMASK
    unsigned long long* tsw = (unsigned long long*)(ws + WS_CTL + 524288); int nst = 0;
#define STAMP() do { if (bx == 0 && threadIdx.x == 0) tsw[nst] = __builtin_amdgcn_s_memrealtime(); ++nst; } while (0)
#else
#define STAMP() do { } while (0)
#endif
    STAMP();

    { PHASE_IDS();
      for (int slab = bx; slab < 256; slab += G) p0_mod_slab(p, (LAS float*)lds, slab, tid, lane, wave);
      p0_transposes(p, (LAS float*)(lds + wave * 16384), 0, gw, NGW, lane); }
    xcd_barrier(bar); STAMP();
    { PHASE_IDS(); phase_norm(p, 0, gw, NGW, lane); }
    xcd_barrier(bar); STAMP();
    {
        pg8::Gemm g{(const bf16_t*)(ws + WS_H), (const bf16_t*)(ws + WS_WIN), M, CIN, D}; pg8::StaticOrder S; S.init(M, CIN, G, bx);
        EpiZ E{(bf16_t*)(ws + WS_ZRW), (bf16_t*)(ws + WS_ZUG), p.out};
        pg8::gemm_phase<EpiZ, pg8::StaticOrder, PG8_ALIGN, PG8_SP2>(lds, g, S, E);
    }
    xcd_barrier(bar); STAMP();
    { PHASE_IDS();
      phase_lnv(p, gw, NGW, lane);
      for (int rec = gw; rec < NREC; rec += NGW) prep_record(p, lds + wave * 16384, rec, lane); }
    xcd_barrier(bar); STAMP();
    { PHASE_IDS();
        const int NPC = NPB * NH;
        volatile LAS unsigned* prog = (volatile LAS unsigned*)(lds + MISC_OFF) + 16;
        if (bx < NPC) { if (wave < 4) scan_chain_prompt(p, bx >> 4, bx & 15, wave, lane, prog); else scan_prefetch(p, prog, bx >> 4, bx & 15, wave - 4, lane); }
        else {
            const int wid = (bx - NPC) * NWAVES + wave, NW = (G - NPC) * NWAVES;
            for (int j = wid; j < NSB * NH * 4; j += NW) scan_chain_sample(p, j >> 6, (j >> 2) & 15, j & 3, lane);
            for (int item = bx - NPC; item < NPB * 16 * 8; item += G - NPC) mix_item(p, item, wave, lane);
            for (int row = MP + bx - NPC; row < M; row += G - NPC) mix_naive_row(p, row, tid, NTHR);
            p0_transposes(p, (LAS float*)(lds + wave * 16384), 1, wid, NW, lane);
        }
    }
    xcd_barrier(bar); STAMP();
    { PHASE_IDS(); post_rows(p, gw, NGW, lane); }
    xcd_barrier(bar); STAMP();
    {
        pg8::Gemm g{(const bf16_t*)(ws + WS_OA), (const bf16_t*)(ws + WS_WBA), 2 * M, 2 * D, RW}; BranchOrder S{G, bx};
        EpiMerge E{(const bf16_t*)(ws + WS_ZUG), (bf16_t*)(ws + WS_H)};
        pg8::gemm_phase<EpiMerge, BranchOrder, PG8_ALIGN, PG8_SP2>(lds, g, S, E);
    }
    xcd_barrier(bar); STAMP();
    {
        pg8::Gemm g{(const bf16_t*)(ws + WS_H), (const bf16_t*)(ws + WS_WOUT), M, D, D}; pg8::StaticOrder S; S.init(M, D, G, bx);
        EpiRes1 E{p.in[0], p.in[1], (const float*)(ws + WS_MOD), p.out};
        pg8::gemm_phase<EpiRes1, pg8::StaticOrder, PG8_ALIGN, PG8_SP2>(lds, g, S, E);
    }
    xcd_barrier(bar); STAMP();
    { PHASE_IDS(); phase_norm(p, 1, gw, NGW, lane); }
    xcd_barrier(bar); STAMP();
    {
        pg8::Gemm g{(const bf16_t*)(ws + WS_H), (const bf16_t*)(ws + WS_WFI), M, 2 * DFF, D}; pg8::StaticOrder S; S.init(M, 2 * DFF, G, bx);
        EpiSwiglu E{(bf16_t*)(ws + WS_ZUG)};
        pg8::gemm_phase<EpiSwiglu, pg8::StaticOrder, PG8_ALIGN, PG8_SP2>(lds, g, S, E);
    }
    xcd_barrier(bar); STAMP();
    {
        pg8::Gemm g{(const bf16_t*)(ws + WS_ZUG), (const bf16_t*)(ws + WS_WFO), M, D, DFF}; pg8::StaticOrder S; S.init(M, D, G, bx);
        EpiRes2 E{(const float*)(ws + WS_MOD), p.out};
        pg8::gemm_phase<EpiRes2, pg8::StaticOrder, PG8_ALIGN, PG8_SP2>(lds, g, S, E);
    }
    xcd_barrier(bar); STAMP();
    { PHASE_IDS(); phase_final(p, gw, NGW, lane); }
#ifdef TSMASK
    STAMP();
    if (bx == 0 && threadIdx.x == 0) {
        unsigned long long tot = 0;
        for (int k = 0; k < nst - 1; ++k) if ((TSMASK >> k) & 1) tot += tsw[k + 1] - tsw[k];
        p.out[0] += (float)tot * (1.0f / 20000.0f);
    }
#endif
}

extern "C" void kernel_launch(void* const* d_in, const int* in_sizes, int n_in, void* d_out, int out_size, void* d_ws, size_t ws_size, hipStream_t stream) {
    static int grid = 0;
    if (grid == 0) {
        if (n_in != 32 || (size_t)out_size != O_END || ws_size < WS_END) { fprintf(stderr, "kernel_launch: unexpected shapes n_in=%d out=%d ws=%zu (need %zu)\n", n_in, out_size, ws_size, (size_t)WS_END); grid = -1; return; }
        int dev = 0, cus = 0, per_cu = 0;
        if (hipGetDevice(&dev) != hipSuccess || hipDeviceGetAttribute(&cus, hipDeviceAttributeMultiprocessorCount, dev) != hipSuccess) { grid = -1; return; }
        if (hipFuncSetAttribute((const void*)mega_fwd, hipFuncAttributeMaxDynamicSharedMemorySize, LDS_BYTES) != hipSuccess) { fprintf(stderr, "kernel_launch: hipFuncSetAttribute failed\n"); grid = -1; return; }
        if (hipOccupancyMaxActiveBlocksPerMultiprocessor(&per_cu, (const void*)mega_fwd, NTHR, LDS_BYTES) != hipSuccess || per_cu < 1) { fprintf(stderr, "kernel_launch: occupancy query says %d blocks per CU\n", per_cu); }
        (void)hipGetLastError();
        grid = cus;
        if (grid < 128) { fprintf(stderr, "kernel_launch: this kernel's phase plan needs >= 128 CUs (got %d)\n", cus); grid = -1; return; }
    }
    if (grid < 0) return;
    if (hipMemsetAsync((char*)d_ws + WS_CTL, 0, CTL_ZERO_BYTES, stream) != hipSuccess) { fprintf(stderr, "kernel_launch: memset failed\n"); return; }
    P p{};
    for (int i = 0; i < 32; ++i) p.in[i] = (const float*)d_in[i];
    p.out = (float*)d_out; p.ws = (unsigned char*)d_ws;
    hipLaunchKernelGGL(mega_fwd, dim3(grid), dim3(NTHR), LDS_BYTES, stream, p);
    const hipError_t le = hipPeekAtLastError();
    if (le != hipSuccess) fprintf(stderr, "kernel_launch: launch failed: %s\n", hipGetErrorName(le));
}
```

```cpp
#include <hip/hip_runtime.h>
#include <cstdio>
#include <cstdint>

constexpr int D = 2048, NPB = 4, TP = 2048, NSB = 128, TS = 8;
constexpr int MP = NPB * TP, MS = NSB * TS, M = MP + MS;
constexpr int RW = 1024, NH = 16, HS = 64;
constexpr int CSH = 3328, CIN = 9472, DFF = 5632, MLPW = 1024;
constexpr int C_U = CSH, C_V = CSH + 1024, C_G0 = CSH + 2048, C_G1 = C_G0 + 2048;
constexpr int ZUGW = CIN - CSH, ZU_U = 0, ZU_V = 1024, ZU_G0 = 2048, ZU_G1 = 4096;
constexpr int NSEQ = NPB + NSB;
constexpr size_t O_YP = 0, O_YS = O_YP + (size_t)MP * D, O_WKVP = O_YS + (size_t)MS * D, O_SHP = O_WKVP + (size_t)NPB * NH * HS * HS,
                 O_WKVS = O_SHP + (size_t)NPB * CSH, O_SHS = O_WKVS + (size_t)NSB * NH * HS * HS, O_VS = O_SHS + (size_t)NSB * CSH,
                 O_END = O_VS + (size_t)MS * MLPW;
constexpr size_t WS_CTL = 0, CTL_ZERO_BYTES = 1u << 20;
constexpr size_t WS_WIN = CTL_ZERO_BYTES;
constexpr size_t WS_WBA = WS_WIN + (size_t)CIN * D * 2;
constexpr size_t WS_WBB = WS_WBA + (size_t)D * RW * 2;
constexpr size_t WS_WOUT = WS_WBB + (size_t)D * RW * 2;
constexpr size_t WS_WFI = WS_WOUT + (size_t)D * D * 2;
constexpr size_t WS_WFO = WS_WFI + (size_t)2 * DFF * D * 2;
constexpr size_t WS_MOD = WS_WFO + (size_t)D * DFF * 2;
constexpr size_t WS_H = WS_MOD + (size_t)NSEQ * 6 * D * 4;
constexpr size_t WS_ZRW = WS_H + (size_t)M * D * 2;
constexpr size_t WS_ZUG = WS_ZRW + (size_t)M * CSH * 2;
constexpr size_t WS_VN = WS_ZUG + (size_t)M * ZUGW * 2;
constexpr size_t WS_OA = WS_VN + (size_t)M * MLPW * 2;
constexpr size_t WS_UB = WS_OA + (size_t)M * RW * 2;
constexpr size_t WS_C2 = WS_UB + (size_t)M * MLPW * 2;
constexpr size_t WS_LORA = WS_C2 + (size_t)M * RW * 2;
constexpr size_t WS_SILU = WS_LORA + (size_t)RW * 256 * 2;
constexpr size_t WS_FRA_S = WS_SILU + (size_t)144 * D * 2;
constexpr size_t WS_FRB_S = WS_FRA_S + (size_t)NSB * NH * 4096;
constexpr size_t WS_END = WS_FRB_S + (size_t)NSB * NH * 8448;
constexpr int NREC_P = NPB * 128 * NH, NREC = NREC_P + NSB * NH;
constexpr int RECA = 4096, RECB = 8448;
static_assert(WS_C2 + (size_t)M * RW * 2 - WS_VN >= (size_t)256 * 262144, "stream-K slabs (256 x 256 KiB) fit VN | OA|UB | C2");
static_assert((size_t)NREC_P * RECA <= (size_t)M * D * 2 && (size_t)NREC_P * RECB <= (size_t)M * D * 4, "prompt fragment records fit the H buffer / the y region of d_out");
constexpr int CW_BAR = 4096, CW_FLAGS = 32768;

typedef float f32x2v __attribute__((ext_vector_type(2)));
typedef __bf16 bf16x2v __attribute__((ext_vector_type(2)));
typedef unsigned u32x2v __attribute__((ext_vector_type(2)));

struct P { const float* in[32]; float* out; unsigned char* ws; };

__device__ __forceinline__ unsigned pk2(float lo, float hi) { return __builtin_bit_cast(unsigned, __builtin_convertvector((f32x2v){lo, hi}, bf16x2v)); }
__device__ __forceinline__ unsigned short f2bf(float f) { return (unsigned short)(pk2(f, 0.f) & 0xffffu); }
__device__ __forceinline__ float bf2f(unsigned short h) { return __uint_as_float(((unsigned)h) << 16); }
__device__ __forceinline__ float bflo(unsigned w) { return __uint_as_float(w << 16); }
__device__ __forceinline__ float bfhi(unsigned w) { return __uint_as_float(w & 0xffff0000u); }
__device__ __forceinline__ float sigmoidf_(float x) { return 1.f / (1.f + __expf(-x)); }
__device__ __forceinline__ float gelu_tanh(float x) {
    const float u = 0.7978845608028654f * (x + 0.044715f * x * x * x); return x / (1.f + __expf(-2.f * u)); }
__device__ __forceinline__ float wave_sum(float v) {
#pragma unroll
    for (int o = 1; o < 64; o <<= 1) v += __shfl_xor(v, o);
    return v;
}
__device__ __forceinline__ int seq_of_row(int row) { return row < MP ? row / TP : NPB + (row - MP) / TS; }

namespace pg8 {
#define PG8_LAS __attribute__((address_space(3)))
typedef unsigned short bf16_t;
typedef short bf16x8 __attribute__((ext_vector_type(8)));
typedef float f32x4 __attribute__((ext_vector_type(4)));
typedef unsigned u32x4 __attribute__((ext_vector_type(4)));
constexpr int BM = 256, BK = 64, HALF = 128, HTB = HALF * BK * 2  , STAGE_BYTES = 8 * HTB, NXCD = 8, WGM = 8;

__host__ __device__ __forceinline__ int lds_byte(int r, int c) { const int st = (r >> 4) * 2 + (c >> 5), rr = r & 15, cc = c & 31, ob = rr * 64 + cc * 2; return st * 1024 + (ob ^ (((ob >> 9) & 1) << 5)); }
__host__ __device__ __forceinline__ void stage_rc(int b, int& R, int& C) { const int st = b / 1024, sb = b % 1024, swz = sb ^ (((sb >> 9) & 1) << 5); R = (st >> 1) * 16 + swz / 64; C = (st & 1) * 32 + (swz % 64) / 2; }
__host__ __device__ __forceinline__ int perm32(int rho) { const int n = rho >> 4, i = rho & 15; return 8 * (i >> 2) + 4 * n + (i & 3); }

struct Unit { int pm, pn, kb, nk, kind, peer; };
struct Gemm { const bf16_t* A; const bf16_t* Bt; int M, N, K; };

struct StaticOrder {
    int nM, nN, nwg, G, c;
    __host__ __device__ void init(int M, int N, int G_, int c_) { nM = M / BM; nN = N / BM; nwg = nM * nN; G = G_; c = c_; }
    __host__ __device__ bool next(int i, Unit& u) const {
        const long L = (long)i * G + c; if (L >= nwg) return false;
        int wgid = (int)L; { const int q = nwg / NXCD, r = nwg % NXCD, xcd = wgid % NXCD, off = wgid / NXCD; wgid = (xcd < r ? xcd * (q + 1) : r * (q + 1) + (xcd - r) * q) + off; }
        const int nig = WGM * nN, gid = wgid / nig, fm = gid * WGM, gsz = (nM - fm) < WGM ? (nM - fm) : WGM;
        u.pm = fm + ((wgid % nig) % gsz); u.pn = (wgid % nig) / gsz; return true;
    }
    __device__ __forceinline__ void a_ready(const Unit&) const {}
    __device__ __forceinline__ void done(const Unit&) const {}
};
template <class Epi, class Sched, bool ALIGN_EPI = false, bool SP2 = false>
__device__ __forceinline__ void gemm_phase(PG8_LAS unsigned char* lds, const Gemm g, const Sched& S, const Epi& E) {
    int tid_ = threadIdx.x; asm volatile("" : "+v"(tid_));
    const int tid = tid_, wid = __builtin_amdgcn_readfirstlane(tid >> 6), lane = tid & 63, wr = wid >> 2, wc = wid & 3, fr = lane & 15, fq = lane >> 4;
    const int K = g.K;
    unsigned voffA[2], voffB[2];
#pragma unroll
    for (int i = 0; i < 2; ++i) { int R, C; stage_rc(tid * 16 + i * 8192, R, C); const int Rb = Epi::PERM ? ((R & ~31) + perm32(R & 31)) : R;
        voffA[i] = (unsigned)(R * K + C) * 2u; voffB[i] = (unsigned)(Rb * K + C) * 2u; }
    const size_t kstep = (size_t)(BK * 2);
    const size_t hstep = (size_t)HALF * K * 2;
    const size_t tstep = 2 * hstep;
    const unsigned ldsw = (unsigned)wid * 1024u;
    const int aoff = lds_byte(wr * 64 + fr, fq * 8), boff = lds_byte(wc * 32 + fr, fq * 8);
#define PG8_SA(b, h) (((b) * 2 + (h)) * HTB)
#define PG8_SB(b, h) ((4 + (b) * 2 + (h)) * HTB)
#define PG8_STAGE(bufoff, gbase, voff) do { _Pragma("unroll") for (int _i = 0; _i < 2; ++_i) \
        __builtin_amdgcn_global_load_lds((const unsigned*)((const char*)(gbase) + (voff)[_i]), (PG8_LAS unsigned*)(lds + (bufoff) + ldsw + _i * 8192), 16, 0, 0); } while (0)
#define PG8_LDA(dst, b, h) do { _Pragma("unroll") for (int m = 0; m < 4; ++m) _Pragma("unroll") for (int k = 0; k < 2; ++k) dst[m][k] = *(const PG8_LAS bf16x8*)(lds + PG8_SA(b, h) + aoff + m * 2048 + k * 1024); } while (0)
#define PG8_LDB(dst, b, h) do { _Pragma("unroll") for (int n = 0; n < 2; ++n) _Pragma("unroll") for (int k = 0; k < 2; ++k) dst[n][k] = *(const PG8_LAS bf16x8*)(lds + PG8_SB(b, h) + boff + n * 2048 + k * 1024); } while (0)
#define PG8_MMA(ai, bj, At, Bt) do { __builtin_amdgcn_s_setprio(1); _Pragma("unroll") for (int m = 0; m < 4; ++m) _Pragma("unroll") for (int n = 0; n < 2; ++n) _Pragma("unroll") for (int k = 0; k < 2; ++k) \
        acc[ai][bj][m][n] = __builtin_amdgcn_mfma_f32_16x16x32_bf16(Bt[n][k], At[m][k], acc[ai][bj][m][n], 0, 0, 0); __builtin_amdgcn_s_setprio(0); } while (0)
#define PG8_WAIT_V(n) asm volatile("s_waitcnt vmcnt(" #n ")" ::: "memory")
#define PG8_WAIT_L(n) asm volatile("s_waitcnt lgkmcnt(" #n ")" ::: "memory")
#define PG8_BAR __builtin_amdgcn_s_barrier()
#define PG8_SCHED __builtin_amdgcn_sched_barrier(0)
    Unit cur, nxt; int ui = 0;
    if (!S.next(0, cur)) return;
    f32x4 acc[2][2][4][2];
#pragma unroll
    for (int a = 0; a < 2; ++a)
#pragma unroll
        for (int b = 0; b < 2; ++b)
#pragma unroll
            for (int m = 0; m < 4; ++m)
#pragma unroll
                for (int n = 0; n < 2; ++n) acc[a][b][m][n] = (f32x4){0.f, 0.f, 0.f, 0.f};
    bf16x8 At[4][2], B0[2][2], B1[2][2];
    const char* cA = (const char*)g.A + (size_t)cur.pm * tstep + (size_t)cur.kb * kstep; const char* cB = (const char*)g.Bt + (size_t)cur.pn * tstep + (size_t)cur.kb * kstep;
    S.a_ready(cur);
    if constexpr (SP2) {
        PG8_STAGE(PG8_SB(0, 0), cB, voffB); PG8_STAGE(PG8_SB(0, 1), cB + hstep, voffB); PG8_STAGE(PG8_SA(0, 0), cA, voffA); PG8_STAGE(PG8_SA(0, 1), cA + hstep, voffA);
        if (wr == 1) PG8_BAR;
        PG8_WAIT_V(2); PG8_BAR;
        PG8_STAGE(PG8_SB(1, 0), cB + kstep, voffB); PG8_STAGE(PG8_SA(1, 0), cA + kstep, voffA); PG8_STAGE(PG8_SB(1, 1), cB + hstep + kstep, voffB);
        PG8_WAIT_V(6); PG8_BAR;
    } else {
        PG8_STAGE(PG8_SB(0, 0), cB, voffB); PG8_STAGE(PG8_SA(0, 0), cA, voffA); PG8_STAGE(PG8_SB(0, 1), cB + hstep, voffB); PG8_STAGE(PG8_SA(0, 1), cA + hstep, voffA);
        if (wr == 1) PG8_BAR;
        PG8_WAIT_V(4); PG8_BAR;
        PG8_STAGE(PG8_SB(1, 0), cB + kstep, voffB); PG8_STAGE(PG8_SA(1, 0), cA + kstep, voffA); PG8_STAGE(PG8_SB(1, 1), cB + hstep + kstep, voffB);
        PG8_WAIT_V(6); PG8_BAR;
    }
    for (;;) {
        const bool has_next = S.next(ui + 1, nxt);
        const char* nA = has_next ? (const char*)g.A + (size_t)nxt.pm * tstep + (size_t)nxt.kb * kstep : cA; const char* nB = has_next ? (const char*)g.Bt + (size_t)nxt.pn * tstep + (size_t)nxt.kb * kstep : cB;
        const int nt = cur.nk;
        for (int t = 0; t < nt; t += 2) {
            const bool last = (t == nt - 2);
            if constexpr (Epi::HOOK_TILE > 0) { if (cur.kb + t == Epi::HOOK_TILE && t > 0) E.mid(acc, cur, wr, wc, fr, fq); }
            const char* a1 = cA + (size_t)(t + 1) * kstep;
            const char* a2 = last ? nA : cA + (size_t)(t + 2) * kstep; const char* b2 = last ? nB : cB + (size_t)(t + 2) * kstep;
            const char* a3 = a2 + kstep; const char* b3 = b2 + kstep;
            if (last && has_next) S.a_ready(nxt);
            if constexpr (SP2) {
            PG8_LDB(B0, 0, 0); PG8_LDB(B1, 0, 1); PG8_SCHED; PG8_LDA(At, 0, 0); PG8_STAGE(PG8_SA(1, 1), a1 + hstep, voffA);
            PG8_WAIT_V(8); PG8_WAIT_L(0); PG8_BAR; PG8_MMA(0, 0, At, B0); PG8_MMA(0, 1, At, B1); PG8_BAR; PG8_SCHED;
            PG8_LDA(At, 0, 1); PG8_STAGE(PG8_SB(0, 0), b2, voffB); PG8_STAGE(PG8_SB(0, 1), b2 + hstep, voffB); PG8_STAGE(PG8_SA(0, 0), a2, voffA);
            PG8_WAIT_V(8); PG8_WAIT_L(0); PG8_BAR; PG8_MMA(1, 0, At, B0); PG8_MMA(1, 1, At, B1); PG8_BAR; PG8_SCHED;
            PG8_LDB(B0, 1, 0); PG8_LDB(B1, 1, 1); PG8_SCHED; PG8_LDA(At, 1, 0); PG8_STAGE(PG8_SA(0, 1), a2 + hstep, voffA);
            PG8_WAIT_V(8); PG8_WAIT_L(0); PG8_BAR; PG8_MMA(0, 0, At, B0); PG8_MMA(0, 1, At, B1); PG8_BAR; PG8_SCHED;
            PG8_LDA(At, 1, 1); PG8_STAGE(PG8_SB(1, 0), b3, voffB); PG8_STAGE(PG8_SB(1, 1), b3 + hstep, voffB); PG8_STAGE(PG8_SA(1, 0), a3, voffA);
            PG8_WAIT_V(8); PG8_WAIT_L(0); PG8_BAR; PG8_MMA(1, 0, At, B0); PG8_MMA(1, 1, At, B1); PG8_BAR; PG8_SCHED;
            } else {
            PG8_LDB(B0, 0, 0); PG8_SCHED; PG8_LDA(At, 0, 0); PG8_STAGE(PG8_SA(1, 1), a1 + hstep, voffA);
            PG8_WAIT_L(8); PG8_BAR; PG8_WAIT_L(0); PG8_MMA(0, 0, At, B0); PG8_BAR; PG8_SCHED;
            PG8_LDB(B1, 0, 1); PG8_STAGE(PG8_SB(0, 0), b2, voffB);
            PG8_BAR; PG8_WAIT_L(0); PG8_MMA(0, 1, At, B1); PG8_BAR;
            PG8_LDA(At, 0, 1); PG8_STAGE(PG8_SA(0, 0), a2, voffA);
            PG8_BAR; PG8_WAIT_L(0); PG8_MMA(1, 0, At, B0); PG8_BAR; PG8_SCHED;
            PG8_STAGE(PG8_SB(0, 1), b2 + hstep, voffB);
            PG8_WAIT_V(6); PG8_BAR; PG8_MMA(1, 1, At, B1); PG8_BAR;
            PG8_LDB(B0, 1, 0); PG8_SCHED; PG8_LDA(At, 1, 0); PG8_STAGE(PG8_SA(0, 1), a2 + hstep, voffA);
            PG8_WAIT_L(8); PG8_BAR; PG8_WAIT_L(0); PG8_MMA(0, 0, At, B0); PG8_BAR; PG8_SCHED;
            PG8_LDB(B1, 1, 1); PG8_STAGE(PG8_SB(1, 0), b3, voffB);
            PG8_BAR; PG8_WAIT_L(0); PG8_MMA(0, 1, At, B1); PG8_BAR;
            PG8_LDA(At, 1, 1); PG8_STAGE(PG8_SA(1, 0), a3, voffA);
            PG8_BAR; PG8_WAIT_L(0); PG8_MMA(1, 0, At, B0); PG8_BAR; PG8_SCHED;
            PG8_STAGE(PG8_SB(1, 1), b3 + hstep, voffB);
            PG8_WAIT_V(6); PG8_BAR; PG8_MMA(1, 1, At, B1); PG8_BAR;
            }
        }
        if constexpr (ALIGN_EPI) { if (wr == 0) PG8_BAR; }
        if constexpr (Epi::HOOK_TILE > 0) { if (cur.kb + cur.nk <= Epi::HOOK_TILE) E.mid(acc, cur, wr, wc, fr, fq); }
        if (cur.kind == 3) {
            const int ti4 = (wid * 64 + fq * 16 + fr) * 4;
            float* sl = S.slab + (size_t)(cur.peer * S.nsl + S.s) * 65536 + ti4;
#pragma unroll
            for (int a = 0; a < 2; ++a)
#pragma unroll
                for (int b = 0; b < 2; ++b)
#pragma unroll
                    for (int m = 0; m < 4; ++m)
#pragma unroll
                        for (int n = 0; n < 2; ++n) *(f32x4*)(sl + (((a * 2 + b) * 4 + m) * 2 + n) * 2048) = acc[a][b][m][n];
            PG8_WAIT_V(0); PG8_BAR;
            if (wid == 0 && (fq | fr) == 0) {
                __builtin_amdgcn_fence(__ATOMIC_RELEASE, "agent"); PG8_WAIT_V(0);
                __hip_atomic_fetch_add(S.cnt + cur.peer, 1u, __ATOMIC_RELAXED, __HIP_MEMORY_SCOPE_AGENT);
                unsigned sp = 0; while (__hip_atomic_load(S.cnt + cur.peer, __ATOMIC_RELAXED, __HIP_MEMORY_SCOPE_AGENT) < (unsigned)S.nsl && ++sp < (1u << 22)) __builtin_amdgcn_s_sleep(2);
                __builtin_amdgcn_fence(__ATOMIC_ACQUIRE, "agent"); PG8_WAIT_V(0);
            }
            PG8_BAR; asm volatile("" ::: "memory");
            for (int blk = S.s; blk < 8; blk += S.nsl) {
                const int a = blk >> 2, m0 = blk & 3;
                f32x4 r[4];
#pragma unroll
                for (int v = 0; v < 4; ++v) r[v] = (f32x4){0.f, 0.f, 0.f, 0.f};
                for (int s2 = 0; s2 < S.nsl; ++s2) {
                    const float* ss = S.slab + (size_t)(cur.peer * S.nsl + s2) * 65536 + ti4;
#pragma unroll
                    for (int v = 0; v < 4; ++v) r[v] += *(const f32x4*)(ss + (size_t)((((a * 2 + (v >> 1)) * 4 + m0) * 2 + (v & 1)) * 2048));
                }
                E.rg(r[0], r[1], r[2], r[3], cur, a, m0, wr, wc, fr, fq);
            }
        } else {
            E(acc, cur, wr, wc, fr, fq);
        }
        if (!has_next) break;
#pragma unroll
        for (int a = 0; a < 2; ++a)
#pragma unroll
            for (int b = 0; b < 2; ++b)
#pragma unroll
                for (int m = 0; m < 4; ++m)
#pragma unroll
                    for (int n = 0; n < 2; ++n) acc[a][b][m][n] = (f32x4){0.f, 0.f, 0.f, 0.f};
        cur = nxt; cA = nA; cB = nB; ++ui;
        if constexpr (ALIGN_EPI) { if (wr == 1) PG8_BAR; }
    }
    PG8_WAIT_V(0);
    if constexpr (!ALIGN_EPI) { if (wr == 0) PG8_BAR; }
    PG8_BAR;
    if constexpr (Epi::AFTER_DRAIN) { E.fused(acc, cur, wr, wc, fr, fq, lds, wid, lane); S.done(cur); }
#undef PG8_SA
#undef PG8_SB
#undef PG8_STAGE
#undef PG8_LDA
#undef PG8_LDB
#undef PG8_MMA
#undef PG8_WAIT_V
#undef PG8_WAIT_L
#undef PG8_BAR
#undef PG8_SCHED
}
}
#define PG8_SP2 true
#define PG8_ALIGN true

using pg8::f32x4; using pg8::Unit; using pg8::BM; using pg8::HALF; typedef pg8::u32x4 u32x4;
typedef unsigned short bf16_t;

#define EPI_WALK() __device__ __forceinline__ void operator()(const f32x4 (&acc)[2][2][4][2], const Unit& u, int wr, int wc, int fr, int fq) const { \
        _Pragma("unroll") for (int ai = 0; ai < 2; ++ai) _Pragma("unroll") for (int m = 0; m < 4; ++m) { \
            rg(acc[ai][0][m][0], acc[ai][0][m][1], acc[ai][1][m][0], acc[ai][1][m][1], u, ai, m, wr, wc, fr, fq); asm volatile("" ::: "memory"); } }

struct EpiZ {
    static constexpr int HOOK_TILE = 0;
    static constexpr bool PERM = true, AFTER_DRAIN = false;
    bf16_t* zrw; bf16_t* zug; float* out;
    __device__ __forceinline__ void rg(f32x4 v00, f32x4 v01, f32x4 v10, f32x4 v11, const Unit& u, int ai, int m, int wr, int wc, int fr, int fq) const {
        const int colt = u.pn * BM;
        const int mode = colt < CSH ? 0 : (colt < C_G0 ? 1 : 2);
        const int row = u.pm * BM + wr * 64 + fr + ai * HALF + m * 16, col0 = colt + wc * 32 + 8 * fq;
        bf16_t* rowp = mode == 0 ? zrw + (size_t)row * CSH + col0 : zug + (size_t)row * ZUGW + (col0 - CSH);
        if (mode == 0) {
            bool last; float* sh;
            if (row < MP) { last = (row & (TP - 1)) == TP - 1; sh = out + O_SHP + (size_t)(row / TP) * CSH + col0; }
            else { const int rs = row - MP; last = (rs & (TS - 1)) == TS - 1; sh = out + O_SHS + (size_t)(rs / TS) * CSH + col0; }
            if (last) { *(f32x4*)sh = v00; *(f32x4*)(sh + 4) = v01; *(f32x4*)(sh + HALF) = v10; *(f32x4*)(sh + HALF + 4) = v11; }
        } else if (mode == 1) {
#pragma unroll
            for (int e = 0; e < 4; ++e) { v00[e] = gelu_tanh(v00[e]); v01[e] = gelu_tanh(v01[e]); v10[e] = gelu_tanh(v10[e]); v11[e] = gelu_tanh(v11[e]); }
        } else {
#pragma unroll
            for (int e = 0; e < 4; ++e) { v00[e] = sigmoidf_(v00[e]); v01[e] = sigmoidf_(v01[e]); v10[e] = sigmoidf_(v10[e]); v11[e] = sigmoidf_(v11[e]); }
        }
        u32x4 w; w.x = pk2(v00[0], v00[1]); w.y = pk2(v00[2], v00[3]); w.z = pk2(v01[0], v01[1]); w.w = pk2(v01[2], v01[3]);
        *(u32x4*)rowp = w;
        w.x = pk2(v10[0], v10[1]); w.y = pk2(v10[2], v10[3]); w.z = pk2(v11[0], v11[1]); w.w = pk2(v11[2], v11[3]);
        *(u32x4*)(rowp + HALF) = w;
    }
    EPI_WALK()
};
struct EpiMerge {
    static constexpr int HOOK_TILE = 16;
    static constexpr bool PERM = true, AFTER_DRAIN = false;
    const bf16_t* z; bf16_t* mg;
    __device__ __forceinline__ void mid(f32x4 (&acc)[2][2][4][2], const Unit& u, int wr, int wc, int fr, int fq) const {
        asm volatile("" : "+v"(fr));
        const int row0 = u.pm * BM + wr * 64 + fr, col0 = u.pn * BM + wc * 32 + 8 * fq;
#pragma unroll
        for (int ai = 0; ai < 2; ++ai)
#pragma unroll
            for (int m = 0; m < 4; ++m) {
                const bf16_t* zr = z + (size_t)(row0 + ai * HALF + m * 16) * ZUGW + col0;
#pragma unroll
                for (int bj = 0; bj < 2; ++bj) {
                    const u32x4 g0 = *(const u32x4*)(zr + ZU_G0 + bj * HALF), g1 = *(const u32x4*)(zr + ZU_G1 + bj * HALF);
                    f32x4& v0 = acc[ai][bj][m][0]; f32x4& v1 = acc[ai][bj][m][1];
                    v0[0] *= bflo(g0.x) / fmaxf(bflo(g1.x), 1e-30f); v0[1] *= bfhi(g0.x) / fmaxf(bfhi(g1.x), 1e-30f);
                    v0[2] *= bflo(g0.y) / fmaxf(bflo(g1.y), 1e-30f); v0[3] *= bfhi(g0.y) / fmaxf(bfhi(g1.y), 1e-30f);
                    v1[0] *= bflo(g0.z) / fmaxf(bflo(g1.z), 1e-30f); v1[1] *= bfhi(g0.z) / fmaxf(bfhi(g1.z), 1e-30f);
                    v1[2] *= bflo(g0.w) / fmaxf(bflo(g1.w), 1e-30f); v1[3] *= bfhi(g0.w) / fmaxf(bfhi(g1.w), 1e-30f);
                }
                asm volatile("" ::: "memory");
            }
    }
    __device__ __forceinline__ void rg(f32x4 v00, f32x4 v01, f32x4 v10, f32x4 v11, const Unit& u, int ai, int m, int wr, int wc, int fr, int fq) const {
        const int row = u.pm * BM + wr * 64 + fr + ai * HALF + m * 16, col0 = u.pn * BM + wc * 32 + 8 * fq;
        const bf16_t* zr = z + (size_t)row * ZUGW + ZU_G1 + col0;
        const u32x4 ga = *(const u32x4*)zr, gb = *(const u32x4*)(zr + HALF);
        u32x4 w;
        w.x = pk2(bflo(ga.x) * v00[0], bfhi(ga.x) * v00[1]); w.y = pk2(bflo(ga.y) * v00[2], bfhi(ga.y) * v00[3]);
        w.z = pk2(bflo(ga.z) * v01[0], bfhi(ga.z) * v01[1]); w.w = pk2(bflo(ga.w) * v01[2], bfhi(ga.w) * v01[3]);
        *(u32x4*)(mg + (size_t)row * D + col0) = w;
        w.x = pk2(bflo(gb.x) * v10[0], bfhi(gb.x) * v10[1]); w.y = pk2(bflo(gb.y) * v10[2], bfhi(gb.y) * v10[3]);
        w.z = pk2(bflo(gb.z) * v11[0], bfhi(gb.z) * v11[1]); w.w = pk2(bflo(gb.w) * v11[2], bfhi(gb.w) * v11[3]);
        *(u32x4*)(mg + (size_t)row * D + col0 + HALF) = w;
    }
    EPI_WALK()
};
struct EpiRes1 {
    static constexpr int HOOK_TILE = 0;
    static constexpr bool PERM = false, AFTER_DRAIN = false;
    const float* xp; const float* xs; const float* mod; float* out;
    __device__ __forceinline__ void rg(f32x4 v00, f32x4 v01, f32x4 v10, f32x4 v11, const Unit& u, int ai, int m, int wr, int wc, int fr, int fq) const {
        const int row = u.pm * BM + wr * 64 + fr + ai * HALF + m * 16, col0 = u.pn * BM + wc * 32 + 4 * fq;
        const float* xr = (row < MP ? xp + (size_t)row * D : xs + (size_t)(row - MP) * D) + col0;
        const float* gm = mod + (size_t)seq_of_row(row) * (6 * D) + 2 * D + col0;
        float* o = out + (size_t)row * D + col0;
        *(f32x4*)o = *(const f32x4*)xr + *(const f32x4*)gm * v00;
        *(f32x4*)(o + 16) = *(const f32x4*)(xr + 16) + *(const f32x4*)(gm + 16) * v01;
        *(f32x4*)(o + HALF) = *(const f32x4*)(xr + HALF) + *(const f32x4*)(gm + HALF) * v10;
        *(f32x4*)(o + HALF + 16) = *(const f32x4*)(xr + HALF + 16) + *(const f32x4*)(gm + HALF + 16) * v11;
    }
    EPI_WALK()
};
struct EpiSwiglu {
    static constexpr int HOOK_TILE = 0;
    static constexpr bool PERM = true, AFTER_DRAIN = false;
    bf16_t* act;
    __device__ __forceinline__ void rg(f32x4 v00, f32x4 v01, f32x4 v10, f32x4 v11, const Unit& u, int ai, int m, int wr, int wc, int fr, int fq) const {
        const int row = u.pm * BM + wr * 64 + fr + ai * HALF + m * 16, col0 = u.pn * HALF + wc * 32 + 8 * fq;
        float r[8];
#pragma unroll
        for (int e = 0; e < 4; ++e) { r[e] = v00[e] * sigmoidf_(v00[e]) * v10[e]; r[4 + e] = v01[e] * sigmoidf_(v01[e]) * v11[e]; }
        u32x4 w; w.x = pk2(r[0], r[1]); w.y = pk2(r[2], r[3]); w.z = pk2(r[4], r[5]); w.w = pk2(r[6], r[7]);
        *(u32x4*)(act + (size_t)row * DFF + col0) = w;
    }
    EPI_WALK()
};
struct EpiRes2 {
    static constexpr int HOOK_TILE = 0;
    static constexpr bool PERM = false, AFTER_DRAIN = false;
    const float* mod; float* out;
    __device__ __forceinline__ void rg(f32x4 v00, f32x4 v01, f32x4 v10, f32x4 v11, const Unit& u, int ai, int m, int wr, int wc, int fr, int fq) const {
        const int row = u.pm * BM + wr * 64 + fr + ai * HALF + m * 16, col0 = u.pn * BM + wc * 32 + 4 * fq;
        const float* gf = mod + (size_t)seq_of_row(row) * (6 * D) + 5 * D + col0;
        float* o = out + (size_t)row * D + col0;
        *(f32x4*)o = *(const f32x4*)o + *(const f32x4*)gf * v00;
        *(f32x4*)(o + 16) = *(const f32x4*)(o + 16) + *(const f32x4*)(gf + 16) * v01;
        *(f32x4*)(o + HALF) = *(const f32x4*)(o + HALF) + *(const f32x4*)(gf + HALF) * v10;
        *(f32x4*)(o + HALF + 16) = *(const f32x4*)(o + HALF + 16) + *(const f32x4*)(gf + HALF + 16) * v11;
    }
    EPI_WALK()
};
struct SliceOrder {
    int nM, nN, nwg, KT, R1, c, nleft, nsl, l, s;
    unsigned* cnt; float* slab;
    __device__ void init(int M_, int N_, int K_, int c_, unsigned* cnt_, float* slab_) {
        nM = M_ / BM; nN = N_ / BM; nwg = nM * nN; KT = K_ / 64; c = c_; cnt = cnt_; slab = slab_;
        R1 = nwg / 256; nleft = nwg - R1 * 256; nsl = nleft ? 256 / nleft : 1; if (nsl > 8) nsl = 8;
        l = nleft ? c % nleft : 0; s = nleft ? c / nleft : nsl;
    }
    __device__ int kbnd(int i) const { return i >= nsl ? KT : (((KT * i) / nsl + 1) & ~1); }
    __device__ void pmpn(int L, Unit& u) const {
        int wgid = L; { const int q = nwg / pg8::NXCD, r = nwg % pg8::NXCD, xcd = wgid % pg8::NXCD, off = wgid / pg8::NXCD; wgid = (xcd < r ? xcd * (q + 1) : r * (q + 1) + (xcd - r) * q) + off; }
        const int nig = pg8::WGM * nN, gid = wgid / nig, fm = gid * pg8::WGM, gsz = (nM - fm) < pg8::WGM ? (nM - fm) : pg8::WGM;
        u.pm = fm + ((wgid % nig) % gsz); u.pn = (wgid % nig) / gsz;
    }
    __device__ bool next(int i, Unit& u) const {
        if (i < R1) { pmpn(i * 256 + c, u); u.kb = 0; u.nk = KT; u.kind = 0; u.peer = 0; return true; }
        if (i == R1 && nleft && s < nsl) { pmpn(R1 * 256 + l, u); u.kb = kbnd(s); u.nk = kbnd(s + 1) - u.kb; u.kind = 3; u.peer = l; return true; }
        return false;
    }
    __device__ __forceinline__ void a_ready(const Unit&) const {}
    __device__ __forceinline__ void done(const Unit&) const {}
};

#define GAS __attribute__((address_space(1)))
#define LAS __attribute__((address_space(3)))
typedef GAS unsigned gu32;
#define RLX_AGENT __ATOMIC_RELAXED, __HIP_MEMORY_SCOPE_AGENT
#define LDS_WAIT() asm volatile("s_waitcnt lgkmcnt(0)" ::: "memory")
#define VM_WAIT() asm volatile("s_waitcnt vmcnt(0)" ::: "memory")
#define XB_TMO      128
#define XB_XCNT(j)  (256  + 64 * (j))
#define XB_XSUB(j)  (1280 + 64 * (j))
#define XB_XGEN(j)  (2304 + 64 * (j))
#define XB_TOP      3328
#define XB_TOPGEN   3392
#define XCD_BAR_WORDS 3456
#define XB_SPIN_CAP (1u << 18)

__device__ __forceinline__ unsigned xb_ld(unsigned* p)              { return __hip_atomic_load(p, __ATOMIC_RELAXED, __HIP_MEMORY_SCOPE_AGENT); }
__device__ __forceinline__ unsigned xb_add(unsigned* p, unsigned v) { return __hip_atomic_fetch_add(p, v, __ATOMIC_RELAXED, __HIP_MEMORY_SCOPE_AGENT); }
__device__ __forceinline__ unsigned xb_xcc_id() { return (unsigned)__builtin_amdgcn_s_getreg((3 << 11) | 20) & 0xFu; }
#define XB_SPIN(cond, bar) do { unsigned _sp = 0; while (cond) { __builtin_amdgcn_s_sleep(1); \
    if ((++_sp & 255u) == 0u) { if (xb_ld(&(bar)[XB_TMO])) break; if (_sp > XB_SPIN_CAP) { atomicAdd(&(bar)[XB_TMO], 1u); break; } } } } while (0)

struct XcdBarrier {
    unsigned* bar; unsigned x;
    volatile LAS unsigned* st;
};

__device__ __forceinline__ XcdBarrier xcd_barrier_post(unsigned* bar, volatile LAS unsigned* st) {
    XcdBarrier b; b.bar = bar; b.x = xb_xcc_id(); b.st = st;
    if (threadIdx.x == 0) (void)xb_add(&bar[XB_XCNT(b.x)], 1u);
    return b;
}
__device__ __forceinline__ void xcd_barrier_complete(unsigned* bar, unsigned x, unsigned& nloc, unsigned& nx) {
    const unsigned G = gridDim.x * gridDim.y * gridDim.z;
    unsigned sum, cnt, mine, sp = 0u;
    for (;;) {
        sum = 0u; cnt = 0u; mine = 0u;
#pragma unroll
        for (unsigned j = 0; j < 16; ++j) { const unsigned c = xb_ld(&bar[XB_XCNT(j)]); sum += c; cnt += (c > 0u) ? 1u : 0u; mine = (j == x) ? c : mine; }
        if (sum == G) break;
        __builtin_amdgcn_s_sleep(1);
        if ((++sp & 255u) == 0u) { if (xb_ld(&bar[XB_TMO])) break; if (sp > XB_SPIN_CAP) { atomicAdd(&bar[XB_TMO], 1u); break; } }
    }
    nloc = mine > 0u ? mine : 1u; nx = cnt > 0u ? cnt : 1u;
}

__device__ __forceinline__ void xcd_barrier(const XcdBarrier& b) {
    asm volatile("s_waitcnt vmcnt(0)" ::: "memory");
    __syncthreads();
    if (threadIdx.x == 0) {
        unsigned* bar = b.bar;
        __builtin_amdgcn_s_waitcnt(0);
        unsigned nloc = b.st[0], nx = b.st[1];
        if (nloc == 0u) { xcd_barrier_complete(bar, b.x, nloc, nx); b.st[0] = nloc; b.st[1] = nx; }
        const unsigned old = xb_add(&bar[XB_XSUB(b.x)], 1u);
        const unsigned gen = old / nloc;
        if (old + 1u == (gen + 1u) * nloc) {
            __builtin_amdgcn_fence(__ATOMIC_RELEASE, "agent");
            asm volatile("s_waitcnt vmcnt(0)" ::: "memory");
            const unsigned og = xb_add(&bar[XB_TOP], 1u);
            const unsigned tg = og / nx;
            if (og + 1u == (tg + 1u) * nx) xb_add(&bar[XB_TOPGEN], 1u);
            else XB_SPIN(xb_ld(&bar[XB_TOPGEN]) == tg, bar);
            __builtin_amdgcn_fence(__ATOMIC_ACQUIRE, "agent");
            xb_add(&bar[XB_XGEN(b.x)], 1u);
            asm volatile("s_waitcnt vmcnt(0)" ::: "memory");
        } else {
            XB_SPIN(xb_ld(&bar[XB_XGEN(b.x)]) == gen, bar);
            __builtin_amdgcn_fence(__ATOMIC_ACQUIRE, "agent");
            asm volatile("s_waitcnt vmcnt(0)" ::: "memory");
        }
    }
    __syncthreads();
}

typedef pg8::bf16x8 bf16x8;
#define MFMA16(a, b, c) __builtin_amdgcn_mfma_f32_16x16x32_bf16((a), (b), (c), 0, 0, 0)
constexpr int RB_P1 = 0, RB_RT = 2048, RB_QP = 4096, RB_RAK = 5120, RB_VM = 6144, RB_WL = 8192;

__device__ __forceinline__ f32x4 ld_bf4(const bf16_t* p) { const u32x2v w = *(const u32x2v*)p; return (f32x4){bflo(w.x), bfhi(w.x), bflo(w.y), bfhi(w.y)}; }
__device__ __forceinline__ bf16x8 mk_frag(const f32x4 a, const f32x4 b) { u32x4 w; w.x = pk2(a[0], a[1]); w.y = pk2(a[2], a[3]); w.z = pk2(b[0], b[1]); w.w = pk2(b[2], b[3]); return __builtin_bit_cast(bf16x8, w); }
__device__ __forceinline__ unsigned char* recA_ptr(const P& p, int rec) { return rec < NREC_P ? p.ws + WS_H + (size_t)rec * RECA : p.ws + WS_FRA_S + (size_t)(rec - NREC_P) * RECA; }
__device__ __forceinline__ unsigned char* recB_ptr(const P& p, int rec) { return rec < NREC_P ? (unsigned char*)p.out + (size_t)rec * RECB : p.ws + WS_FRB_S + (size_t)(rec - NREC_P) * RECB; }
__device__ __forceinline__ f32x4 sig4(f32x4 x) { return (f32x4){sigmoidf_(x[0]), sigmoidf_(x[1]), sigmoidf_(x[2]), sigmoidf_(x[3])}; }
__device__ __forceinline__ f32x4 exp4(f32x4 x) { return (f32x4){__expf(x[0]), __expf(x[1]), __expf(x[2]), __expf(x[3])}; }

template <class T> __device__ __forceinline__ T ldu(const void* ubase, unsigned voff) { return *(const T*)((const char*)ubase + voff); }
__device__ __forceinline__ f32x4 bf4(const u32x2v w) { return (f32x4){bflo(w.x), bfhi(w.x), bflo(w.y), bfhi(w.y)}; }
struct ShiftCtx { const bf16_t* zrw; const float* ss; const float* mu; unsigned zoc, zop; float fv, fpz, fps; };
__device__ __forceinline__ f32x4 shift4(const ShiftCtx& k, int cu, unsigned lp) {
    const u32x2v cw = ldu<u32x2v>(k.zrw + cu, k.zoc + lp * 2u), pw = ldu<u32x2v>(k.zrw + cu, k.zop + lp * 2u);
    const f32x4 sv = ldu<f32x4>(k.ss + cu, lp * 4u), m = ldu<f32x4>(k.mu + cu, lp * 4u);
    const f32x4 cur = bf4(cw) * k.fv;
    const f32x4 pv = bf4(pw) * k.fpz + sv * k.fps;
    return cur + (pv - cur) * m;
}

__device__ __forceinline__ void prep_record(const P& p, LAS unsigned char* wl, int rec, int lane_in) {
    int lane = lane_in; asm volatile("" : "+v"(lane));
    const int head = rec & 15, chunkid = rec >> 4;
    const bool prompt = chunkid < NPB * 128;
    const int sq = prompt ? (chunkid >> 7) : NPB + (chunkid - NPB * 128);
    const int c = prompt ? (chunkid & 127) : 0;
    const int row0 = prompt ? sq * TP + c * 16 : MP + (sq - NPB) * TS;
    const int nvalid = prompt ? 16 : TS;
    const int i = lane & 15, q = lane >> 4;
    const bool valid = i < nvalid, first = (c == 0);
    const bool pz = valid && (i > 0 || !first), ps = valid && (i == 0) && first && !prompt;
    const int row = row0 + (valid ? i : 0);
    ShiftCtx K;
    K.zrw = (const bf16_t*)(p.ws + WS_ZRW); K.ss = p.in[3] + (size_t)(prompt ? 0 : sq - NPB) * CSH; K.mu = p.in[10];
    K.zoc = (unsigned)row * (unsigned)(CSH * 2); K.zop = pz ? K.zoc - (unsigned)(CSH * 2) : K.zoc; K.fv = valid ? 1.f : 0.f; K.fpz = pz ? 1.f : 0.f; K.fps = ps ? 1.f : 0.f;
    const unsigned q4 = (unsigned)q * 4u, q8 = (unsigned)q * 8u;
    const unsigned wlo64 = (unsigned)(i * 64 + q * 8) * 2u, wlo128 = (unsigned)(i * 128 + q * 8) * 2u;
    const bf16_t* WDUT = (const bf16_t*)(p.ws + WS_LORA); const bf16_t* WAUT = WDUT + RW * 64; const bf16_t* WGUT = WAUT + RW * 64;
    const f32x4 z4 = (f32x4){0.f, 0.f, 0.f, 0.f};

    f32x4 accw[4], acca[4];
#pragma unroll
    for (int ct = 0; ct < 4; ++ct) { accw[ct] = z4; acca[ct] = z4; }
#pragma unroll
    for (int s = 0; s < 2; ++s) {
        const int cw = 3072 + 32 * s, ca = 3136 + 32 * s;
        f32x4 x0 = shift4(K, cw, q8), x1 = shift4(K, cw + 4, q8);
#pragma unroll
        for (int e = 0; e < 4; ++e) { x0[e] = 2.f * sigmoidf_(2.f * x0[e]) - 1.f; x1[e] = 2.f * sigmoidf_(2.f * x1[e]) - 1.f; }
        const bf16x8 td = mk_frag(x0, x1);
        const bf16x8 ad = mk_frag(shift4(K, ca, q8), shift4(K, ca + 4, q8));
#pragma unroll
        for (int ct = 0; ct < 4; ++ct) {
            const int wo = (head * 64 + 16 * ct) * 64 + 32 * s;
            accw[ct] = MFMA16(ldu<bf16x8>(WDUT + wo, wlo64), td, accw[ct]);
            acca[ct] = MFMA16(ldu<bf16x8>(WAUT + wo, wlo64), ad, acca[ct]);
        }
    }
    f32x4 lw[4], av[4], ks[4];
    float ssq = 0.f;
#pragma unroll
    for (int ct = 0; ct < 4; ++ct) {
        const int cbu = head * 64 + 16 * ct;
        lw[ct] = sig4(ldu<f32x4>(p.in[11] + cbu, q4 * 4u) + accw[ct]) * (-0.6065306597126334f);
        lw[ct] = lw[ct] * K.fv;
        av[ct] = sig4(ldu<f32x4>(p.in[13] + cbu, q4 * 4u) + acca[ct]);
        ks[ct] = shift4(K, RW + cbu, q4);
        const f32x4 kk0 = ks[ct] * ldu<f32x4>(p.in[16] + cbu, q4 * 4u);
        ssq += (kk0[0] * kk0[0] + kk0[1] * kk0[1]) + (kk0[2] * kk0[2] + kk0[3] * kk0[3]);
    }
    ssq += __shfl_xor(ssq, 16); ssq += __shfl_xor(ssq, 32);
    const float kinv = 1.f / fmaxf(sqrtf(ssq), 1e-12f);
    f32x4 lwc[4];
#pragma unroll
    for (int ct = 0; ct < 4; ++ct) lwc[ct] = lw[ct];
#pragma unroll
    for (int d = 1; d < 16; d <<= 1)
#pragma unroll
        for (int ct = 0; ct < 4; ++ct)
#pragma unroll
            for (int e = 0; e < 4; ++e) { const float t = __shfl_up(lwc[ct][e], d, 16); if (i >= d) lwc[ct][e] += t; }
    unsigned char* rb = recB_ptr(p, rec); unsigned char* ra = recA_ptr(p, rec);
    LAS unsigned short* KT = (LAS unsigned short*)wl; LAS unsigned short* AT = KT + 1024; LAS unsigned short* KtT = KT + 2048; LAS unsigned short* VT = KT + 3072;
    LAS float* MT = (LAS float*)(wl + 8192);
    u32x2v kapP[4], alpP[4], ktP[4], rtP[4];
    f32x4 wl15[4];
    float bsum = 0.f;
#pragma unroll
    for (int ct = 0; ct < 4; ++ct) {
        const int cbu = head * 64 + 16 * ct;
        const f32x4 Wt = exp4(lwc[ct]), Wtm1 = exp4(lwc[ct] - lw[ct]), Winv = exp4(-lwc[ct]);
        const f32x4 kkn = ks[ct] * ldu<f32x4>(p.in[16] + cbu, q4 * 4u) * kinv;
        const f32x4 kmod = ks[ct] * ((av[ct] - 1.f) * ldu<f32x4>(p.in[17] + cbu, q4 * 4u) + 1.f);
        const f32x4 kap = kkn * Wtm1, alp = kkn * av[ct] * Winv, kt = kmod * Winv;
        const f32x4 rs = shift4(K, cbu, q4);
        const f32x4 rt = rs * Wt;
        const f32x4 rk = rs * kmod * ldu<f32x4>(p.in[18] + cbu, q4 * 4u);
        bsum += (rk[0] + rk[1]) + (rk[2] + rk[3]);
#pragma unroll
        for (int e = 0; e < 4; ++e) wl15[ct][e] = __shfl(Wt[e], 15, 16);
        kapP[ct].x = pk2(kap[0], kap[1]); kapP[ct].y = pk2(kap[2], kap[3]); alpP[ct].x = pk2(alp[0], alp[1]); alpP[ct].y = pk2(alp[2], alp[3]);
        ktP[ct].x = pk2(kt[0], kt[1]); ktP[ct].y = pk2(kt[2], kt[3]); rtP[ct].x = pk2(rt[0], rt[1]); rtP[ct].y = pk2(rt[2], rt[3]);
#pragma unroll
        for (int e = 0; e < 4; ++e) { const int ch = 16 * ct + 4 * q + e; const int sh = (e & 1) * 16;
            KT[ch * 16 + i] = (unsigned short)(((e < 2 ? kapP[ct].x : kapP[ct].y) >> sh) & 0xffffu);
            AT[ch * 16 + i] = (unsigned short)(((e < 2 ? alpP[ct].x : alpP[ct].y) >> sh) & 0xffffu);
            KtT[ch * 16 + i] = (unsigned short)(((e < 2 ? ktP[ct].x : ktP[ct].y) >> sh) & 0xffffu); }
    }
    bsum += __shfl_xor(bsum, 16); bsum += __shfl_xor(bsum, 32);
    u32x2v c1P[4], c2P[4];
    {
        f32x4 accg[4];
#pragma unroll
        for (int ct = 0; ct < 4; ++ct) accg[ct] = z4;
#pragma unroll
        for (int s = 0; s < 4; ++s) {
            const int cg = 3200 + 32 * s;
            const bf16x8 gd = mk_frag(sig4(shift4(K, cg, q8)), sig4(shift4(K, cg + 4, q8)));
#pragma unroll
            for (int ct = 0; ct < 4; ++ct) accg[ct] = MFMA16(ldu<bf16x8>(WGUT + (head * 64 + 16 * ct) * 128 + 32 * s, wlo128), gd, accg[ct]);
        }
#pragma unroll
        for (int ct = 0; ct < 4; ++ct) {
            const int cbu = head * 64 + 16 * ct;
            const f32x4 c1 = ldu<f32x4>(p.in[19] + cbu, q4 * 4u) * accg[ct];
            const f32x4 vsf = shift4(K, 2 * RW + cbu, q4);
            const f32x4 c2 = (ldu<f32x4>(p.in[20] + cbu, q4 * 4u) + vsf * bsum) * accg[ct];
            c1P[ct].x = pk2(c1[0], c1[1]); c1P[ct].y = pk2(c1[2], c1[3]); c2P[ct].x = pk2(c2[0], c2[1]); c2P[ct].y = pk2(c2[2], c2[3]);
#pragma unroll
            for (int e = 0; e < 4; ++e) VT[(16 * ct + 4 * q + e) * 16 + i] = f2bf(vsf[e]);
        }
    }
    bf16x8 kapF[2], alpF[2], ktF[2], rtF[2];
#pragma unroll
    for (int s = 0; s < 2; ++s) {
        kapF[s] = __builtin_bit_cast(bf16x8, (u32x4){kapP[2 * s].x, kapP[2 * s].y, kapP[2 * s + 1].x, kapP[2 * s + 1].y});
        alpF[s] = __builtin_bit_cast(bf16x8, (u32x4){alpP[2 * s].x, alpP[2 * s].y, alpP[2 * s + 1].x, alpP[2 * s + 1].y});
        ktF[s] = __builtin_bit_cast(bf16x8, (u32x4){ktP[2 * s].x, ktP[2 * s].y, ktP[2 * s + 1].x, ktP[2 * s + 1].y});
        rtF[s] = __builtin_bit_cast(bf16x8, (u32x4){rtP[2 * s].x, rtP[2 * s].y, rtP[2 * s + 1].x, rtP[2 * s + 1].y});
    }
    f32x4 Maa = z4, Mak = z4, RAt = z4, RKt = z4;
#pragma unroll
    for (int s = 0; s < 2; ++s) {
        Maa = MFMA16(kapF[s], alpF[s], Maa); Mak = MFMA16(kapF[s], ktF[s], Mak);
        RAt = MFMA16(alpF[s], rtF[s], RAt); RKt = MFMA16(ktF[s], rtF[s], RKt);
    }
#pragma unroll
    for (int r = 0; r < 4; ++r) { const int rw_ = 4 * q + r;
        if (!(rw_ > i)) { Maa[r] = 0.f; Mak[r] = 0.f; }
        if (!(i >= rw_)) { RAt[r] = 0.f; RKt[r] = 0.f; } }
    *(LAS f32x4*)(MT + i * 16 + 4 * q) = Maa;
    u32x4 rakW; rakW.x = pk2(RAt[0], RAt[1]); rakW.y = pk2(RAt[2], RAt[3]); rakW.z = pk2(RKt[0], RKt[1]); rakW.w = pk2(RKt[2], RKt[3]);
    LDS_WAIT(); asm volatile("" ::: "memory");
    float t[16];
#pragma unroll
    for (int cc = 15; cc >= 0; --cc) {
        float acc = (i == cc) ? 1.f : 0.f;
        f32x4 mrow[4];
#pragma unroll
        for (int b = 0; b < 4; ++b) mrow[b] = *(const LAS f32x4*)(MT + cc * 16 + 4 * b);
#pragma unroll
        for (int j = cc + 1; j < 16; ++j) acc -= t[j] * mrow[j >> 2][j & 3];
        t[cc] = acc;
    }
    f32x4 tsel;
#pragma unroll
    for (int e = 0; e < 4; ++e) tsel[e] = -(q == 0 ? t[e] : (q == 1 ? t[4 + e] : (q == 2 ? t[8 + e] : t[12 + e])));
    const bf16x8 Tfrag = mk_frag(tsel, z4);
    f32x4 P1E[4];
#pragma unroll
    for (int ct = 0; ct < 4; ++ct) { const u32x2v w = *(const LAS u32x2v*)(KT + (16 * ct + i) * 16 + 4 * q);
        u32x4 aw; aw.x = w.x; aw.y = w.y; aw.z = 0u; aw.w = 0u; P1E[ct] = MFMA16(__builtin_bit_cast(bf16x8, aw), Tfrag, z4); }
    *(u32x4*)(rb + RB_RT + lane * 16) = __builtin_bit_cast(u32x4, rtF[0]); *(u32x4*)(rb + RB_RT + 1024 + lane * 16) = __builtin_bit_cast(u32x4, rtF[1]);
    *(u32x4*)(rb + RB_RAK + lane * 16) = rakW;
#pragma unroll
    for (int ct = 0; ct < 4; ++ct) {
        if (i == 0) *(f32x4*)(rb + RB_WL + (16 * ct + 4 * q) * 4) = wl15[ct];
        if (valid) { const int cbu = head * 64 + 16 * ct;
            *(u32x2v*)((char*)((bf16_t*)(p.ws + WS_OA) + cbu) + ((unsigned)row * (2 * RW) + q4) * 2u) = c1P[ct];
            *(u32x2v*)((char*)((bf16_t*)(p.ws + WS_C2) + cbu) + ((unsigned)row * RW + q4) * 2u) = c2P[ct]; }
    }
    *(u32x4*)(rb + RB_P1 + lane * 16) = __builtin_bit_cast(u32x4, mk_frag(P1E[0], P1E[1]));
    *(u32x4*)(rb + RB_P1 + 1024 + lane * 16) = __builtin_bit_cast(u32x4, mk_frag(P1E[2], P1E[3]));
    { const f32x4 Qt = MFMA16(mk_frag(Mak, z4), Tfrag, z4);
      u32x4 w; w.x = 0u; w.y = 0u; w.z = pk2(Qt[0], Qt[1]); w.w = pk2(Qt[2], Qt[3]); *(u32x4*)(rb + RB_QP + lane * 16) = w; }
#pragma unroll
    for (int tt = 0; tt < 4; ++tt) {
        const u32x2v a = *(const LAS u32x2v*)(AT + (16 * tt + i) * 16 + 4 * q), b = *(const LAS u32x2v*)(KtT + (16 * tt + i) * 16 + 4 * q);
        u32x4 w; w.x = a.x; w.y = a.y; w.z = b.x; w.w = b.y; *(u32x4*)(ra + tt * 1024 + lane * 16) = w;
        *(u32x2v*)(rb + RB_VM + tt * 512 + lane * 8) = *(const LAS u32x2v*)(VT + (16 * tt + i) * 16 + 4 * q);
    }
    LDS_WAIT(); asm volatile("" ::: "memory");
}

struct ScanFr { bf16x8 P10, P11, RT0, RT1, QP, RAK, AK0, AK1, AK2, AK3; u32x2v vm; f32x4 WL0, WL1, WL2, WL3; };
__device__ __forceinline__ void scan_load(ScanFr& f, const P& p, int rec, int vs, int lane) {
    const unsigned char* ra = recA_ptr(p, rec); const unsigned char* rb = recB_ptr(p, rec);
    const unsigned l16 = (unsigned)lane * 16u, q16 = (unsigned)(lane >> 4) * 16u;
    f.P10 = ldu<bf16x8>(rb + RB_P1, l16); f.P11 = ldu<bf16x8>(rb + RB_P1 + 1024, l16);
    f.RT0 = ldu<bf16x8>(rb + RB_RT, l16); f.RT1 = ldu<bf16x8>(rb + RB_RT + 1024, l16);
    f.QP = ldu<bf16x8>(rb + RB_QP, l16); f.RAK = ldu<bf16x8>(rb + RB_RAK, l16);
    f.vm = ldu<u32x2v>(rb + RB_VM + vs * 512, (unsigned)lane * 8u);
    f.AK0 = ldu<bf16x8>(ra, l16); f.AK1 = ldu<bf16x8>(ra + 1024, l16); f.AK2 = ldu<bf16x8>(ra + 2048, l16); f.AK3 = ldu<bf16x8>(ra + 3072, l16);
    f.WL0 = ldu<f32x4>(rb + RB_WL, q16); f.WL1 = ldu<f32x4>(rb + RB_WL + 64, q16); f.WL2 = ldu<f32x4>(rb + RB_WL + 128, q16); f.WL3 = ldu<f32x4>(rb + RB_WL + 192, q16);
}
template <int NS>
__device__ __forceinline__ void scan_step(const ScanFr& f, const u32x2v (&vm)[NS], f32x4 (&St)[NS][4], float* oraw, int c, int q, bool prompt) {
    const f32x4 z4 = (f32x4){0.f, 0.f, 0.f, 0.f};
#pragma unroll
    for (int i = 0; i < NS; ++i) {
        const bf16x8 SB0 = mk_frag(St[i][0], St[i][1]), SB1 = mk_frag(St[i][2], St[i][3]);
        u32x4 vw; vw.x = 0u; vw.y = 0u; vw.z = vm[i].x; vw.w = vm[i].y;
        f32x4 U = MFMA16(f.QP, __builtin_bit_cast(bf16x8, vw), z4);
        U = MFMA16(f.P10, SB0, U); U = MFMA16(f.P11, SB1, U);
        u32x4 uw; uw.x = pk2(U[0], U[1]); uw.y = pk2(U[2], U[3]); uw.z = vm[i].x; uw.w = vm[i].y;
        const bf16x8 UB = __builtin_bit_cast(bf16x8, uw);
        f32x4 O = MFMA16(f.RT0, SB0, z4); O = MFMA16(f.RT1, SB1, O); O = MFMA16(f.RAK, UB, O);
        St[i][0] = MFMA16(f.AK0, UB, St[i][0]) * f.WL0; St[i][1] = MFMA16(f.AK1, UB, St[i][1]) * f.WL1;
        St[i][2] = MFMA16(f.AK2, UB, St[i][2]) * f.WL2; St[i][3] = MFMA16(f.AK3, UB, St[i][3]) * f.WL3;
#pragma unroll
        for (int r = 0; r < 4; ++r) { const int tk = 4 * q + r; if (prompt || tk < TS) oraw[(size_t)(16 * c + tk) * RW + 16 * i] = O[r]; }
    }
}
__device__ __forceinline__ void scan_chain_prompt(const P& p, int sq, int head, int vp, int lane, volatile LAS unsigned* prog) {
    constexpr int nch = TP / 16;
    const int rec0 = sq * nch * NH + head, vl = lane & 15, q = lane >> 4;
    f32x4 St[2][4];
    float* sout = p.out + O_WKVP + ((size_t)sq * NH + head) * HS * HS + (size_t)(32 * vp + vl) * HS + 4 * q;
    float* oraw = (float*)(p.ws + WS_ZRW) + (size_t)(sq * TP) * RW + head * HS + 32 * vp + vl;
    ScanFr f0, f1; u32x2v v0[2], v1[2];
#define SCAN_LD(f, v, cc) do { const int rec_ = rec0 + (cc) * NH; scan_load(f, p, rec_, 2 * vp, lane); v[0] = f.vm; v[1] = ldu<u32x2v>(recB_ptr(p, rec_) + RB_VM + (2 * vp + 1) * 512, (unsigned)lane * 8u); } while (0)
    SCAN_LD(f0, v0, 0); SCAN_LD(f1, v1, 1);
#pragma unroll
    for (int i = 0; i < 2; ++i)
#pragma unroll
        for (int t = 0; t < 4; ++t) St[i][t] = (f32x4){0.f, 0.f, 0.f, 0.f};
    const bool pw = vp == 0 && lane == 0;
    for (int c = 0; c < nch; c += 2) {
        if (pw) *prog = (unsigned)c;
        scan_step<2>(f0, v0, St, oraw, c, q, true);     SCAN_LD(f0, v0, c + 2 < nch ? c + 2 : nch - 1);
        scan_step<2>(f1, v1, St, oraw, c + 1, q, true); SCAN_LD(f1, v1, c + 3 < nch ? c + 3 : nch - 1);
    }
#undef SCAN_LD
#pragma unroll
    for (int i = 0; i < 2; ++i)
#pragma unroll
        for (int t = 0; t < 4; ++t) *(f32x4*)(sout + (size_t)(16 * i) * HS + 16 * t) = St[i][t];
}
__device__ __forceinline__ void scan_chain_sample(const P& p, int s, int head, int vs, int lane) {
    const int vl = lane & 15, q = lane >> 4;
    const size_t so = ((size_t)s * NH + head) * HS * HS + (size_t)(16 * vs + vl) * HS + 4 * q;
    ScanFr f0; scan_load(f0, p, NREC_P + s * NH + head, vs, lane);
    f32x4 St[1][4]; u32x2v vm[1]; vm[0] = f0.vm;
#pragma unroll
    for (int t = 0; t < 4; ++t) St[0][t] = *(const f32x4*)(p.in[2] + so + 16 * t);
    scan_step<1>(f0, vm, St, (float*)(p.ws + WS_ZRW) + (size_t)(MP + s * TS) * RW + head * HS + 16 * vs + vl, 0, q, false);
#pragma unroll
    for (int t = 0; t < 4; ++t) *(f32x4*)(p.out + O_WKVS + so + 16 * t) = St[0][t];
}

constexpr int SCAN_AHEAD = 10;
__device__ __forceinline__ void scan_prefetch(const P& p, volatile LAS unsigned* prog, int sq, int head, int k, int lane) {
    const int rec0 = sq * (TP / 16) * NH + head;
    const unsigned l16 = (unsigned)lane * 16u;
    for (int c = k; c < TP / 16; c += 4) {
        while ((int)*prog < c - SCAN_AHEAD) __builtin_amdgcn_s_sleep(8);
        const unsigned char* ra = recA_ptr(p, rec0 + c * NH); const unsigned char* rb = recB_ptr(p, rec0 + c * NH);
        u32x4 x[12];
#pragma unroll
        for (int j = 0; j < 4; ++j) x[j] = ldu<u32x4>(ra + j * 1024, l16);
#pragma unroll
        for (int j = 0; j < 8; ++j) x[4 + j] = ldu<u32x4>(rb + j * 1024, l16);
        const u32x4 y = ldu<u32x4>(rb + 8192, (unsigned)(lane & 15) * 16u);
#pragma unroll
        for (int j = 0; j < 12; ++j) asm volatile("" :: "v"(x[j].x));
        asm volatile("" :: "v"(y.x));
    }
}

__device__ __forceinline__ void mix_item(const P& p, int item, int wave, int lane) {
    const int g = item & 7, row0 = (item >> 3) * 128;
    const int dl = lane & 15, q = lane >> 4, col = g * 128 + wave * 16;
    const bf16_t* vn = (const bf16_t*)(p.ws + WS_VN) + (size_t)row0 * MLPW + col + dl;
    bf16x8 A[4];
#pragma unroll
    for (int sb = 0; sb < 4; ++sb)
#pragma unroll
        for (int j = 0; j < 8; ++j) A[sb][j] = (short)vn[(size_t)(32 * sb + 8 * q + j) * MLPW];
    const float* wsg = p.in[23] + ((size_t)g * 128 + dl) * 128 + 8 * q;
    const bf16_t* zu = (const bf16_t*)(p.ws + WS_ZUG) + (size_t)(row0 + dl) * ZUGW + ZU_U + col + 4 * q;
    bf16_t* ub = (bf16_t*)(p.ws + WS_OA) + (size_t)(row0 + dl) * (2 * RW) + RW + col + 4 * q;
#pragma unroll
    for (int tt = 0; tt < 8; ++tt) {
        const int t = 16 * tt + dl;
        f32x4 acc = (f32x4){0.f, 0.f, 0.f, 0.f};
#pragma unroll
        for (int sb = 0; sb <= tt / 2; ++sb) {
            const float* wr = wsg + (size_t)(16 * tt) * 128 + 32 * sb;
            f32x4 w0 = *(const f32x4*)wr, w1 = *(const f32x4*)(wr + 4);
            if (sb == tt / 2) {
#pragma unroll
                for (int e = 0; e < 4; ++e) { if (32 * sb + 8 * q + e > t) w0[e] = 0.f; if (32 * sb + 8 * q + 4 + e > t) w1[e] = 0.f; }
            }
            acc = MFMA16(A[sb], mk_frag(w0, w1), acc);
        }
        const float bias = p.in[24][g * 128 + t];
        const f32x4 u = ld_bf4(zu + (size_t)(16 * tt) * ZUGW);
        const f32x4 o = (acc + bias) * u;
        u32x2v w; w.x = pk2(o[0], o[1]); w.y = pk2(o[2], o[3]); *(u32x2v*)(ub + (size_t)(16 * tt) * (2 * RW)) = w;
    }
}

__device__ __forceinline__ void post_rows(const P& p, int gw, int NGW, int lane) {
    const float* oraw = (const float*)(p.ws + WS_ZRW);
    for (int row = gw; row < M; row += NGW) {
        const size_t off = (size_t)row * RW + lane * 16;
        f32x4 o[4]; float s = 0.f;
#pragma unroll
        for (int j = 0; j < 4; ++j) { o[j] = *(const f32x4*)(oraw + off + 4 * j); s += (o[j][0] + o[j][1]) + (o[j][2] + o[j][3]); }
        s += __shfl_xor(s, 1); s += __shfl_xor(s, 2);
        const float mean = s * (1.f / HS); float qv = 0.f;
#pragma unroll
        for (int j = 0; j < 4; ++j) { o[j] = o[j] - mean; qv += (o[j][0] * o[j][0] + o[j][1] * o[j][1]) + (o[j][2] * o[j][2] + o[j][3] * o[j][3]); }
        qv += __shfl_xor(qv, 1); qv += __shfl_xor(qv, 2);
        const float rstd = rsqrtf(qv * (1.f / HS) + 64e-5f);
        bf16_t* oa = (bf16_t*)(p.ws + WS_OA) + (size_t)row * (2 * RW) + lane * 16; const bf16_t* c2p = (const bf16_t*)(p.ws + WS_C2) + off;
#pragma unroll
        for (int h = 0; h < 2; ++h) {
            const u32x4 c1 = *(const u32x4*)(oa + 8 * h), c2 = *(const u32x4*)(c2p + 8 * h);
            const f32x4 a = o[2 * h] * rstd, b = o[2 * h + 1] * rstd;
            u32x4 w;
            w.x = pk2(a[0] * bflo(c1.x) + bflo(c2.x), a[1] * bfhi(c1.x) + bfhi(c2.x)); w.y = pk2(a[2] * bflo(c1.y) + bflo(c2.y), a[3] * bfhi(c1.y) + bfhi(c2.y));
            w.z = pk2(b[0] * bflo(c1.z) + bflo(c2.z), b[1] * bfhi(c1.z) + bfhi(c2.z)); w.w = pk2(b[2] * bflo(c1.w) + bflo(c2.w), b[3] * bfhi(c1.w) + bfhi(c2.w));
            *(u32x4*)(oa + 8 * h) = w;
        }
    }
}

constexpr int NWAVES = 8, NTHR = NWAVES * 64;
constexpr int RING_BYTES = 131072, LDSCTL_OFF = RING_BYTES, MISC_OFF = LDSCTL_OFF + 320, LDS_BYTES = 147456;

__device__ __forceinline__ void p0_mod_slab(const P& p, LAS unsigned char* lds, int slab, int tid, int lane, int wave) {
    LAS float* red = (LAS float*)(lds + 8 * 12288);
    LAS float* Bl = (LAS float*)(lds + wave * 12288);
    for (int i = tid; i < 144 * 48; i += NTHR) red[i] = 0.f;
    __syncthreads();
    const int n0 = slab * 48, fr = lane & 15, fq = lane >> 4;
    const float* W = p.in[6] + n0;
    f32x4 acc[9][3];
#pragma unroll
    for (int a = 0; a < 9; ++a)
#pragma unroll
        for (int b = 0; b < 3; ++b) acc[a][b] = (f32x4){0.f, 0.f, 0.f, 0.f};
    for (int sc = 0; sc < 4; ++sc) {
        const int kb0 = ((wave + slab) & 7) * 256 + ((sc + (slab >> 3)) & 3) * 64;
        f32x4 v[12];
        int ln = lane; asm volatile("" : "+v"(ln));
        const float* Wk = W + (size_t)kb0 * (6 * D);
        { int r = ln / 12, c4 = ln - r * 12;
#pragma unroll
          for (int t = 0; t < 12; ++t) { v[t] = ldu<f32x4>(Wk, (unsigned)(r * (6 * D) + 4 * c4) * 4u); c4 += 4; r += 5; if (c4 >= 12) { c4 -= 12; r += 1; } } }
        { int r = ln / 12, c4 = ln - r * 12;
#pragma unroll
          for (int t = 0; t < 12; ++t) { *(LAS f32x4*)(Bl + r * 48 + 4 * c4) = v[t]; c4 += 4; r += 5; if (c4 >= 12) { c4 -= 12; r += 1; } } }
        LDS_WAIT(); asm volatile("" ::: "memory");
#pragma unroll
        for (int kb2 = 0; kb2 < 2; ++kb2) {
            const int k0 = kb0 + kb2 * 32 + fq * 8;
            bf16x8 bfr[3];
#pragma unroll
            for (int nt = 0; nt < 3; ++nt) { const LAS float* bp = Bl + (kb2 * 32 + fq * 8) * 48 + nt * 16 + fr;
                u32x4 w; w.x = pk2(bp[0], bp[48]); w.y = pk2(bp[96], bp[144]); w.z = pk2(bp[192], bp[240]); w.w = pk2(bp[288], bp[336]);
                bfr[nt] = __builtin_bit_cast(bf16x8, w); }
            const bf16_t* sil = (const bf16_t*)(p.ws + WS_SILU) + (size_t)fr * D + k0;
            bf16x8 afr[9];
#pragma unroll
            for (int mt = 0; mt < 9; ++mt) afr[mt] = *(const bf16x8*)(sil + (size_t)(mt * 16) * D);
#pragma unroll
            for (int mt = 0; mt < 9; ++mt)
#pragma unroll
                for (int nt = 0; nt < 3; ++nt) acc[mt][nt] = __builtin_amdgcn_mfma_f32_16x16x32_bf16(afr[mt], bfr[nt], acc[mt][nt], 0, 0, 0);
        }
        LDS_WAIT(); asm volatile("" ::: "memory");
    }
    for (int w = 0; w < NWAVES; ++w) {
        if (wave == w) {
#pragma unroll
            for (int mt = 0; mt < 9; ++mt)
#pragma unroll
                for (int nt = 0; nt < 3; ++nt)
#pragma unroll
                    for (int r = 0; r < 4; ++r) { LAS float* q = red + (mt * 16 + 4 * fq + r) * 48 + nt * 16 + fr; *q = *q + acc[mt][nt][r]; }
        }
        __syncthreads();
    }
    float* mod = (float*)(p.ws + WS_MOD);
    for (int i = tid; i < NSEQ * 48; i += NTHR) { const int row = i / 48, c = i % 48; mod[(size_t)row * (6 * D) + n0 + c] = red[row * 48 + c] + p.in[7][n0 + c]; }
    __syncthreads();
}
__device__ __forceinline__ void p0_silu(const P& p, int gt, int NT) {
    bf16_t* sil = (bf16_t*)(p.ws + WS_SILU);
    for (int i = gt; i < 144 * D / 4; i += NT) {
        const int row = i / (D / 4), k = (i - row * (D / 4)) * 4;
        f32x4 v = (f32x4){0.f, 0.f, 0.f, 0.f};
        if (row < NSEQ) { v = *(const f32x4*)((row < NPB ? p.in[4] + (size_t)row * D : p.in[5] + (size_t)(row - NPB) * D) + k);
#pragma unroll
            for (int e = 0; e < 4; ++e) v[e] = v[e] * sigmoidf_(v[e]); }
        u32x2v w; w.x = pk2(v[0], v[1]); w.y = pk2(v[2], v[3]); *(u32x2v*)(sil + (size_t)row * D + k) = w;
    }
}
__device__ __forceinline__ void p0_transpose_item(const float* W, int K, int N, bf16_t* WT, bool swz, LAS float* scr, int item, int lane, int ldw = 0, int kofs = 0) {
    if (ldw == 0) ldw = K;
    const int nblk = N / 32, kb = item / nblk, nb = item % nblk, k0 = 64 * kb, n0 = 32 * nb;
    int r0 = n0;
    if (swz) { r0 = n0 < DFF ? 256 * (n0 >> 7) + (n0 & 127) : 256 * ((n0 - DFF) >> 7) + 128 + ((n0 - DFF) & 127); }
    float tv[32];
#pragma unroll
    for (int i = 0; i < 32; ++i) tv[i] = W[(size_t)(k0 + 2 * i + (lane >> 5)) * N + n0 + (lane & 31)];
#pragma unroll
    for (int i = 0; i < 32; ++i) scr[(2 * i + (lane >> 5)) * 33 + (lane & 31)] = tv[i];
    LDS_WAIT(); asm volatile("" ::: "memory");
    const int c = lane & 7;
#pragma unroll
    for (int j = 0; j < 4; ++j) { const int n = (lane >> 3) + 8 * j; const LAS float* s = scr + (8 * c) * 33 + n;
        u32x4 o; o.x = pk2(s[0 * 33], s[1 * 33]); o.y = pk2(s[2 * 33], s[3 * 33]); o.z = pk2(s[4 * 33], s[5 * 33]); o.w = pk2(s[6 * 33], s[7 * 33]);
        *(u32x4*)(WT + (size_t)(r0 + n) * ldw + kofs + k0 + 8 * c) = o; }
    LDS_WAIT(); asm volatile("" ::: "memory");
}
__device__ __forceinline__ void p0_transposes(const P& p, LAS float* scr, int part, int gw, int NGW, int lane) {
    constexpr int I_IN = (D / 64) * (CIN / 32), I_BA = (RW / 64) * (D / 32), I_OUT = (D / 64) * (D / 32), I_FI = (D / 64) * (2 * DFF / 32), I_FO = (DFF / 64) * (D / 32);
    constexpr int I_L64 = (RW / 32), I_L128 = 2 * (RW / 32);
    unsigned char* ws = p.ws;
    if (part == 0) {
        for (int it = gw; it < I_IN + 2 * I_L64 + I_L128; it += NGW) {
            int r = it;
            if (r < I_IN) { p0_transpose_item(p.in[9], D, CIN, (bf16_t*)(ws + WS_WIN), false, scr, r, lane); continue; } r -= I_IN;
            if (r < I_L64) { p0_transpose_item(p.in[12], 64, RW, (bf16_t*)(ws + WS_LORA), false, scr, r, lane); continue; } r -= I_L64;
            if (r < I_L64) { p0_transpose_item(p.in[14], 64, RW, (bf16_t*)(ws + WS_LORA) + RW * 64, false, scr, r, lane); continue; } r -= I_L64;
            p0_transpose_item(p.in[15], 128, RW, (bf16_t*)(ws + WS_LORA) + 2 * RW * 64, false, scr, r, lane);
        }
    } else {
        for (int it = gw; it < 2 * I_BA + I_OUT + I_FI + I_FO; it += NGW) {
            int r = it;
            if (r < I_BA) { p0_transpose_item(p.in[25], RW, D, (bf16_t*)(ws + WS_WBA), false, scr, r, lane, 2 * RW, 0); continue; } r -= I_BA;
            if (r < I_BA) { p0_transpose_item(p.in[26], RW, D, (bf16_t*)(ws + WS_WBA), false, scr, r, lane, 2 * RW, RW); continue; } r -= I_BA;
            if (r < I_OUT) { p0_transpose_item(p.in[27], D, D, (bf16_t*)(ws + WS_WOUT), false, scr, r, lane); continue; } r -= I_OUT;
            if (r < I_FI) { p0_transpose_item(p.in[29], D, 2 * DFF, (bf16_t*)(ws + WS_WFI), true, scr, r, lane); continue; } r -= I_FI;
            p0_transpose_item(p.in[30], DFF, D, (bf16_t*)(ws + WS_WFO), false, scr, r, lane);
        }
    }
}
__device__ __forceinline__ void norm_row(const float* x, const float* g, const float* scale, const float* shift, bf16_t* h, int lane) {
    f32x4 v[8]; float s = 0.f;
#pragma unroll
    for (int j = 0; j < 8; ++j) { v[j] = *(const f32x4*)(x + 4 * lane + 256 * j); s += (v[j][0] * v[j][0] + v[j][1] * v[j][1]) + (v[j][2] * v[j][2] + v[j][3] * v[j][3]); }
    const float rstd = rsqrtf(wave_sum(s) * (1.f / D) + 1e-6f);
#pragma unroll
    for (int j = 0; j < 8; ++j) { const int k = 4 * lane + 256 * j;
        const f32x4 gg = *(const f32x4*)(g + k), sc = *(const f32x4*)(scale + k), sh = *(const f32x4*)(shift + k);
        const f32x4 o = v[j] * rstd * gg * (sc + 1.f) + sh;
        u32x2v w; w.x = pk2(o[0], o[1]); w.y = pk2(o[2], o[3]); *(u32x2v*)(h + k) = w; }
}
__device__ __forceinline__ void phase_norm(const P& p, int which, int gw, int NGW, int lane) {
    const float* g = which == 0 ? p.in[8] : p.in[28];
    for (int row = gw; row < M; row += NGW) {
        const float* x = which == 0 ? (row < MP ? p.in[0] + (size_t)row * D : p.in[1] + (size_t)(row - MP) * D) : p.out + (size_t)row * D;
        const float* mod = (const float*)(p.ws + WS_MOD) + (size_t)seq_of_row(row) * (6 * D);
        norm_row(x, g, mod + (which == 0 ? 1 : 4) * D, mod + (which == 0 ? 0 : 3) * D, (bf16_t*)(p.ws + WS_H) + (size_t)row * D, lane);
    }
}
__device__ __forceinline__ void phase_lnv(const P& p, int gw, int NGW, int lane) {
    for (int row = gw; row < M; row += NGW) {
        const bf16_t* zv = (const bf16_t*)(p.ws + WS_ZUG) + (size_t)row * ZUGW + ZU_V;
        float v[16]; float s = 0.f;
#pragma unroll
        for (int j = 0; j < 2; ++j) { const u32x4 w = *(const u32x4*)(zv + 8 * lane + 512 * j);
            v[8 * j + 0] = bflo(w.x); v[8 * j + 1] = bfhi(w.x); v[8 * j + 2] = bflo(w.y); v[8 * j + 3] = bfhi(w.y);
            v[8 * j + 4] = bflo(w.z); v[8 * j + 5] = bfhi(w.z); v[8 * j + 6] = bflo(w.w); v[8 * j + 7] = bfhi(w.w); }
#pragma unroll
        for (int i = 0; i < 16; ++i) s += v[i];
        const float mean = wave_sum(s) * (1.f / MLPW);
        float q = 0.f;
#pragma unroll
        for (int i = 0; i < 16; ++i) { v[i] -= mean; q += v[i] * v[i]; }
        const float rstd = rsqrtf(wave_sum(q) * (1.f / MLPW) + 1e-5f);
        bf16_t* vn = (bf16_t*)(p.ws + WS_VN) + (size_t)row * MLPW;
#pragma unroll
        for (int j = 0; j < 2; ++j) { const int c = 8 * lane + 512 * j; float o[8];
#pragma unroll
            for (int e = 0; e < 8; ++e) o[e] = v[8 * j + e] * rstd * p.in[21][c + e] + p.in[22][c + e];
            u32x4 w; w.x = pk2(o[0], o[1]); w.y = pk2(o[2], o[3]); w.z = pk2(o[4], o[5]); w.w = pk2(o[6], o[7]);
            *(u32x4*)(vn + c) = w;
            if (row >= MP) { float* vs = p.out + O_VS + (size_t)(row - MP) * MLPW + c;
                *(f32x4*)vs = (f32x4){o[0], o[1], o[2], o[3]}; *(f32x4*)(vs + 4) = (f32x4){o[4], o[5], o[6], o[7]}; }
        }
    }
}
__device__ __forceinline__ void phase_final(const P& p, int gw, int NGW, int lane) {
    for (int row = gw; row < M; row += NGW) {
        float* x = p.out + (size_t)row * D;
        f32x4 v[8]; float s = 0.f;
#pragma unroll
        for (int j = 0; j < 8; ++j) { v[j] = *(const f32x4*)(x + 4 * lane + 256 * j); s += (v[j][0] * v[j][0] + v[j][1] * v[j][1]) + (v[j][2] * v[j][2] + v[j][3] * v[j][3]); }
        const float rstd = rsqrtf(wave_sum(s) * (1.f / D) + 1e-6f);
#pragma unroll
        for (int j = 0; j < 8; ++j) { const int k = 4 * lane + 256 * j; *(f32x4*)(x + k) = v[j] * rstd * *(const f32x4*)(p.in[31] + k); }
    }
}
__device__ __forceinline__ void mix_naive_row(const P& p, int row, int tid, int nthr) {
    int t;
    if (row < MP) t = (row & (TP - 1)) & 127; else t = (row - MP) & (TS - 1);
    const int rowc0 = row - t;
    const bf16_t* vn = (const bf16_t*)(p.ws + WS_VN);
    const bf16_t* zu = (const bf16_t*)(p.ws + WS_ZUG) + (size_t)row * ZUGW + ZU_U;
    bf16_t* ub = (bf16_t*)(p.ws + WS_OA) + (size_t)row * (2 * RW) + RW;
    for (int c = tid; c < MLPW; c += nthr) {
        const int g = c >> 7; const float* wsg = p.in[23] + ((size_t)g * 128 + t) * 128;
        float acc = 0.f;
        for (int s = 0; s <= t; ++s) acc += wsg[s] * bf2f(vn[(size_t)(rowc0 + s) * MLPW + c]);
        acc += p.in[24][g * 128 + t];
        ub[c] = f2bf(bf2f(zu[c]) * acc);
    }
}

#define PHASE_IDS() int tid = threadIdx.x; asm volatile("" : "+v"(tid)); const int lane = tid & 63, wave = __builtin_amdgcn_readfirstlane(tid >> 6); \
    const int gw = bx * NWAVES + wave, NGW = G * NWAVES; (void)lane; (void)gw; (void)NGW
__global__ void __launch_bounds__(NTHR, 2) mega_fwd(P p) {
    extern __shared__ __attribute__((aligned(16))) unsigned char lds_raw[];
    LAS unsigned char* lds = (LAS unsigned char*)lds_raw;
    const int G = gridDim.x, bx = blockIdx.x;
    unsigned char* ws = p.ws;
#define FLAGS(k) ((unsigned*)(ws + WS_CTL) + CW_FLAGS + (k) * 256)
    { PHASE_IDS();
      for (int u = tid; u < (LDS_BYTES - LDSCTL_OFF) / 4; u += NTHR) ((LAS unsigned*)(lds + LDSCTL_OFF))[u] = 0u; }
    __syncthreads();
    XcdBarrier bar = xcd_barrier_post((unsigned*)(ws + WS_CTL) + CW_BAR, (volatile LAS unsigned*)(lds + MISC_OFF) + 8);
#ifdef TSMASK
    unsigned long long* tsw = (unsigned long long*)(ws + WS_CTL + 524288); int nst = 0;
#define STAMP() do { if (bx == 0 && threadIdx.x == 0) tsw[nst] = __builtin_amdgcn_s_memrealtime(); ++nst; } while (0)
#else
#define STAMP() do { } while (0)
#endif
    STAMP();

    { PHASE_IDS();
      p0_silu(p, bx * NTHR + tid, G * NTHR);
      p0_transposes(p, (LAS float*)(lds + wave * 16384), 0, gw, NGW, lane); }
    xcd_barrier(bar); STAMP();
    { PHASE_IDS();
      for (int slab = bx; slab < 256; slab += G) p0_mod_slab(p, lds, slab, tid, lane, wave); }
    xcd_barrier(bar); STAMP();
    { PHASE_IDS(); phase_norm(p, 0, gw, NGW, lane); }
    xcd_barrier(bar); STAMP();
    {
        pg8::Gemm g{(const bf16_t*)(ws + WS_H), (const bf16_t*)(ws + WS_WIN), M, CIN, D}; SliceOrder S; S.init(M, CIN, D, bx, FLAGS(0), (float*)(ws + WS_VN));
        EpiZ E{(bf16_t*)(ws + WS_ZRW), (bf16_t*)(ws + WS_ZUG), p.out};
        pg8::gemm_phase<EpiZ, SliceOrder, PG8_ALIGN, PG8_SP2>(lds, g, S, E);
    }
    xcd_barrier(bar); STAMP();
    { PHASE_IDS();
      phase_lnv(p, gw, NGW, lane);
      STAMP();
      for (int rec = gw; rec < NREC; rec += NGW) prep_record(p, lds + wave * 16384, rec, lane); }
    xcd_barrier(bar); STAMP();
    { PHASE_IDS();
        const int NPC = NPB * NH;
        volatile LAS unsigned* prog = (volatile LAS unsigned*)(lds + MISC_OFF) + 16;
        if (bx < NPC) { if (wave < 2) scan_chain_prompt(p, bx >> 4, bx & 15, wave, lane, prog); else if (wave >= 4) scan_prefetch(p, prog, bx >> 4, bx & 15, wave - 4, lane); STAMP(); }
        else {
            const int wid = (bx - NPC) * NWAVES + wave, NW = (G - NPC) * NWAVES;
            for (int j = wid; j < NSB * NH * 4; j += NW) scan_chain_sample(p, j >> 6, (j >> 2) & 15, j & 3, lane);
            for (int item = bx - NPC; item < NPB * 16 * 8; item += G - NPC) mix_item(p, item, wave, lane);
            for (int row = MP + bx - NPC; row < M; row += G - NPC) mix_naive_row(p, row, tid, NTHR);
            p0_transposes(p, (LAS float*)(lds + wave * 16384), 1, wid, NW, lane);
        }
    }
    xcd_barrier(bar); STAMP();
    { PHASE_IDS(); post_rows(p, gw, NGW, lane); }
    xcd_barrier(bar); STAMP();
    {
        pg8::Gemm g{(const bf16_t*)(ws + WS_OA), (const bf16_t*)(ws + WS_WBA), M, D, 2 * RW}; SliceOrder S; S.init(M, D, 2 * RW, bx, FLAGS(1), p.out);
        EpiMerge E{(const bf16_t*)(ws + WS_ZUG), (bf16_t*)(ws + WS_H)};
        pg8::gemm_phase<EpiMerge, SliceOrder, PG8_ALIGN, PG8_SP2>(lds, g, S, E);
    }
    xcd_barrier(bar); STAMP();
    {
        pg8::Gemm g{(const bf16_t*)(ws + WS_H), (const bf16_t*)(ws + WS_WOUT), M, D, D}; SliceOrder S; S.init(M, D, D, bx, FLAGS(2), (float*)(ws + WS_VN));
        EpiRes1 E{p.in[0], p.in[1], (const float*)(ws + WS_MOD), p.out};
        pg8::gemm_phase<EpiRes1, SliceOrder, PG8_ALIGN, PG8_SP2>(lds, g, S, E);
    }
    xcd_barrier(bar); STAMP();
    { PHASE_IDS(); phase_norm(p, 1, gw, NGW, lane); }
    xcd_barrier(bar); STAMP();
    {
        pg8::Gemm g{(const bf16_t*)(ws + WS_H), (const bf16_t*)(ws + WS_WFI), M, 2 * DFF, D}; SliceOrder S; S.init(M, 2 * DFF, D, bx, FLAGS(3), (float*)(ws + WS_VN));
        EpiSwiglu E{(bf16_t*)(ws + WS_ZUG)};
        pg8::gemm_phase<EpiSwiglu, SliceOrder, PG8_ALIGN, PG8_SP2>(lds, g, S, E);
    }
    xcd_barrier(bar); STAMP();
    {
        pg8::Gemm g{(const bf16_t*)(ws + WS_ZUG), (const bf16_t*)(ws + WS_WFO), M, D, DFF}; SliceOrder S; S.init(M, D, DFF, bx, FLAGS(4), (float*)(ws + WS_VN));
        EpiRes2 E{(const float*)(ws + WS_MOD), p.out};
        pg8::gemm_phase<EpiRes2, SliceOrder, PG8_ALIGN, PG8_SP2>(lds, g, S, E);
    }
    xcd_barrier(bar); STAMP();
    { PHASE_IDS(); phase_final(p, gw, NGW, lane); }
#ifdef TSMASK
    STAMP();
    if (bx == 0 && threadIdx.x == 0) {
        unsigned long long tot = 0;
        for (int k = 0; k < nst - 1; ++k) if ((TSMASK >> k) & 1) tot += tsw[k + 1] - tsw[k];
        p.out[0] += (float)tot * (1.0f / 20000.0f);
    }
#endif
}

extern "C" void kernel_launch(void* const* d_in, const int* in_sizes, int n_in, void* d_out, int out_size, void* d_ws, size_t ws_size, hipStream_t stream) {
    static int grid = 0;
    if (grid == 0) {
        if (n_in != 32 || (size_t)out_size != O_END || ws_size < WS_END) { fprintf(stderr, "kernel_launch: unexpected shapes n_in=%d out=%d ws=%zu (need %zu)\n", n_in, out_size, ws_size, (size_t)WS_END); grid = -1; return; }
        int dev = 0, cus = 0, per_cu = 0;
        if (hipGetDevice(&dev) != hipSuccess || hipDeviceGetAttribute(&cus, hipDeviceAttributeMultiprocessorCount, dev) != hipSuccess) { grid = -1; return; }
        if (hipFuncSetAttribute((const void*)mega_fwd, hipFuncAttributeMaxDynamicSharedMemorySize, LDS_BYTES) != hipSuccess) { fprintf(stderr, "kernel_launch: hipFuncSetAttribute failed\n"); grid = -1; return; }
        if (hipOccupancyMaxActiveBlocksPerMultiprocessor(&per_cu, (const void*)mega_fwd, NTHR, LDS_BYTES) != hipSuccess || per_cu < 1) { fprintf(stderr, "kernel_launch: occupancy query says %d blocks per CU\n", per_cu); }
        (void)hipGetLastError();
        grid = cus;
        if (grid != 256) { fprintf(stderr, "kernel_launch: built for 256 CUs (got %d)\n", cus); grid = -1; return; }
        if (grid < 128) { fprintf(stderr, "kernel_launch: this kernel's phase plan needs >= 128 CUs (got %d)\n", cus); grid = -1; return; }
    }
    if (grid < 0) return;
    if (hipMemsetAsync((char*)d_ws + WS_CTL, 0, CTL_ZERO_BYTES, stream) != hipSuccess) { fprintf(stderr, "kernel_launch: memset failed\n"); return; }
    P p{};
    for (int i = 0; i < 32; ++i) p.in[i] = (const float*)d_in[i];
    p.out = (float*)d_out; p.ws = (unsigned char*)d_ws;
    hipLaunchKernelGGL(mega_fwd, dim3(grid), dim3(NTHR), LDS_BYTES, stream, p);
    const hipError_t le = hipPeekAtLastError();
    if (le != hipSuccess) fprintf(stderr, "kernel_launch: launch failed: %s\n", hipGetErrorName(le));
}
```

```cpp
#include <hip/hip_runtime.h>
#include <cstdio>
#include <cstdint>

constexpr int D = 2048, NPB = 4, TP = 2048, NSB = 128, TS = 8;
constexpr int MP = NPB * TP, MS = NSB * TS, M = MP + MS;
constexpr int RW = 1024, NH = 16, HS = 64;
constexpr int CSH = 3328, CIN = 9472, DFF = 5632, MLPW = 1024;
constexpr int C_U = CSH, C_V = CSH + 1024, C_G0 = CSH + 2048, C_G1 = C_G0 + 2048;
constexpr int ZUGW = CIN - CSH, ZU_U = 0, ZU_V = 1024, ZU_G0 = 2048, ZU_G1 = 4096;
constexpr int NSEQ = NPB + NSB;
constexpr size_t O_YP = 0, O_YS = O_YP + (size_t)MP * D, O_WKVP = O_YS + (size_t)MS * D, O_SHP = O_WKVP + (size_t)NPB * NH * HS * HS,
                 O_WKVS = O_SHP + (size_t)NPB * CSH, O_SHS = O_WKVS + (size_t)NSB * NH * HS * HS, O_VS = O_SHS + (size_t)NSB * CSH,
                 O_END = O_VS + (size_t)MS * MLPW;
constexpr size_t WS_CTL = 0, CTL_ZERO_BYTES = 1u << 20;
constexpr size_t WS_WIN = CTL_ZERO_BYTES;
constexpr size_t WS_WBA = WS_WIN + (size_t)CIN * D * 2;
constexpr size_t WS_WBB = WS_WBA + (size_t)D * RW * 2;
constexpr size_t WS_WOUT = WS_WBB + (size_t)D * RW * 2;
constexpr size_t WS_WFI = WS_WOUT + (size_t)D * D * 2;
constexpr size_t WS_WFO = WS_WFI + (size_t)2 * DFF * D * 2;
constexpr size_t WS_MOD = WS_WFO + (size_t)D * DFF * 2;
constexpr size_t WS_H = WS_MOD + (size_t)NSEQ * 6 * D * 4;
constexpr size_t WS_ZRW = WS_H + (size_t)M * D * 2;
constexpr size_t WS_ZUG = WS_ZRW + (size_t)M * CSH * 2;
constexpr size_t WS_VN = WS_ZUG + (size_t)M * ZUGW * 2;
constexpr size_t WS_OA = WS_VN + (size_t)M * MLPW * 2;
constexpr size_t WS_UB = WS_OA + (size_t)M * RW * 2;
constexpr size_t WS_C2 = WS_UB + (size_t)M * MLPW * 2;
constexpr size_t WS_LORA = WS_C2 + (size_t)M * RW * 2;
constexpr size_t WS_SILU = WS_LORA + (size_t)RW * 256 * 2;
constexpr size_t WS_FRA_S = WS_SILU + (size_t)144 * D * 2;
constexpr size_t WS_FRB_S = WS_FRA_S + (size_t)NSB * NH * 4096;
constexpr size_t WS_END = WS_FRB_S + (size_t)NSB * NH * 8448;
constexpr int NREC_P = NPB * 128 * NH, NREC = NREC_P + NSB * NH;
constexpr int RECA = 4096, RECB = 8448;
static_assert(WS_C2 + (size_t)M * RW * 2 - WS_VN >= (size_t)256 * 262144, "stream-K slabs (256 x 256 KiB) fit VN | OA|UB | C2");
static_assert((size_t)NREC_P * RECA <= (size_t)M * D * 2 && (size_t)NREC_P * RECB <= (size_t)M * D * 4, "prompt fragment records fit the H buffer / the y region of d_out");
constexpr int CW_BAR = 4096, CW_FLAGS = 32768;

typedef float f32x2v __attribute__((ext_vector_type(2)));
typedef __bf16 bf16x2v __attribute__((ext_vector_type(2)));
typedef unsigned u32x2v __attribute__((ext_vector_type(2)));

struct P { const float* in[32]; float* out; unsigned char* ws; };

__device__ __forceinline__ unsigned pk2(float lo, float hi) { return __builtin_bit_cast(unsigned, __builtin_convertvector((f32x2v){lo, hi}, bf16x2v)); }
__device__ __forceinline__ unsigned short f2bf(float f) { return (unsigned short)(pk2(f, 0.f) & 0xffffu); }
__device__ __forceinline__ float bf2f(unsigned short h) { return __uint_as_float(((unsigned)h) << 16); }
__device__ __forceinline__ float bflo(unsigned w) { return __uint_as_float(w << 16); }
__device__ __forceinline__ float bfhi(unsigned w) { return __uint_as_float(w & 0xffff0000u); }
__device__ __forceinline__ float sigmoidf_(float x) { return 1.f / (1.f + __expf(-x)); }
__device__ __forceinline__ float gelu_tanh(float x) {
    const float u = 0.7978845608028654f * (x + 0.044715f * x * x * x); return x / (1.f + __expf(-2.f * u)); }
__device__ __forceinline__ float wave_sum(float v) {
#pragma unroll
    for (int o = 1; o < 64; o <<= 1) v += __shfl_xor(v, o);
    return v;
}
__device__ __forceinline__ int seq_of_row(int row) { return row < MP ? row / TP : NPB + (row - MP) / TS; }

namespace pg8 {
#define PG8_LAS __attribute__((address_space(3)))
typedef unsigned short bf16_t;
typedef short bf16x8 __attribute__((ext_vector_type(8)));
typedef float f32x4 __attribute__((ext_vector_type(4)));
typedef unsigned u32x4 __attribute__((ext_vector_type(4)));
constexpr int BM = 256, BK = 64, HALF = 128, HTB = HALF * BK * 2  , STAGE_BYTES = 8 * HTB, NXCD = 8, WGM = 8;

__host__ __device__ __forceinline__ int lds_byte(int r, int c) { const int st = (r >> 4) * 2 + (c >> 5), rr = r & 15, cc = c & 31, ob = rr * 64 + cc * 2; return st * 1024 + (ob ^ (((ob >> 9) & 1) << 5)); }
__host__ __device__ __forceinline__ void stage_rc(int b, int& R, int& C) { const int st = b / 1024, sb = b % 1024, swz = sb ^ (((sb >> 9) & 1) << 5); R = (st >> 1) * 16 + swz / 64; C = (st & 1) * 32 + (swz % 64) / 2; }
__host__ __device__ __forceinline__ int perm32(int rho) { const int n = rho >> 4, i = rho & 15; return 8 * (i >> 2) + 4 * n + (i & 3); }

struct Unit { int pm, pn, kb, nk, kind, peer; };
struct Gemm { const bf16_t* A; const bf16_t* Bt; int M, N, K; };

struct StaticOrder {
    int nM, nN, nwg, G, c;
    __host__ __device__ void init(int M, int N, int G_, int c_) { nM = M / BM; nN = N / BM; nwg = nM * nN; G = G_; c = c_; }
    __host__ __device__ bool next(int i, Unit& u) const {
        const long L = (long)i * G + c; if (L >= nwg) return false;
        int wgid = (int)L; { const int q = nwg / NXCD, r = nwg % NXCD, xcd = wgid % NXCD, off = wgid / NXCD; wgid = (xcd < r ? xcd * (q + 1) : r * (q + 1) + (xcd - r) * q) + off; }
        const int nig = WGM * nN, gid = wgid / nig, fm = gid * WGM, gsz = (nM - fm) < WGM ? (nM - fm) : WGM;
        u.pm = fm + ((wgid % nig) % gsz); u.pn = (wgid % nig) / gsz; return true;
    }
    __device__ __forceinline__ void a_ready(const Unit&) const {}
    __device__ __forceinline__ void done(const Unit&) const {}
};
template <class Epi, class Sched, bool ALIGN_EPI = false, bool SP2 = false>
__device__ __forceinline__ void gemm_phase(PG8_LAS unsigned char* lds, const Gemm g, const Sched& S, const Epi& E) {
    int tid_ = threadIdx.x; asm volatile("" : "+v"(tid_));
    const int tid = tid_, wid = __builtin_amdgcn_readfirstlane(tid >> 6), lane = tid & 63, wr = wid >> 2, wc = wid & 3, fr = lane & 15, fq = lane >> 4;
    const int K = g.K;
    unsigned voffA[2], voffB[2];
#pragma unroll
    for (int i = 0; i < 2; ++i) { int R, C; stage_rc(tid * 16 + i * 8192, R, C); const int Rb = Epi::PERM ? ((R & ~31) + perm32(R & 31)) : R;
        voffA[i] = (unsigned)(R * K + C) * 2u; voffB[i] = (unsigned)(Rb * K + C) * 2u; }
    const size_t kstep = (size_t)(BK * 2);
    const size_t hstep = (size_t)HALF * K * 2;
    const size_t tstep = 2 * hstep;
    const unsigned ldsw = (unsigned)wid * 1024u;
    const int aoff = lds_byte(wr * 64 + fr, fq * 8), boff = lds_byte(wc * 32 + fr, fq * 8);
#define PG8_SA(b, h) (((b) * 2 + (h)) * HTB)
#define PG8_SB(b, h) ((4 + (b) * 2 + (h)) * HTB)
#define PG8_STAGE(bufoff, gbase, voff) do { _Pragma("unroll") for (int _i = 0; _i < 2; ++_i) \
        __builtin_amdgcn_global_load_lds((const unsigned*)((const char*)(gbase) + (voff)[_i]), (PG8_LAS unsigned*)(lds + (bufoff) + ldsw + _i * 8192), 16, 0, 0); } while (0)
#define PG8_LDA(dst, b, h) do { _Pragma("unroll") for (int m = 0; m < 4; ++m) _Pragma("unroll") for (int k = 0; k < 2; ++k) dst[m][k] = *(const PG8_LAS bf16x8*)(lds + PG8_SA(b, h) + aoff + m * 2048 + k * 1024); } while (0)
#define PG8_LDB(dst, b, h) do { _Pragma("unroll") for (int n = 0; n < 2; ++n) _Pragma("unroll") for (int k = 0; k < 2; ++k) dst[n][k] = *(const PG8_LAS bf16x8*)(lds + PG8_SB(b, h) + boff + n * 2048 + k * 1024); } while (0)
#define PG8_MMA(ai, bj, At, Bt) do { __builtin_amdgcn_s_setprio(1); _Pragma("unroll") for (int m = 0; m < 4; ++m) _Pragma("unroll") for (int n = 0; n < 2; ++n) _Pragma("unroll") for (int k = 0; k < 2; ++k) \
        acc[ai][bj][m][n] = __builtin_amdgcn_mfma_f32_16x16x32_bf16(Bt[n][k], At[m][k], acc[ai][bj][m][n], 0, 0, 0); __builtin_amdgcn_s_setprio(0); } while (0)
#define PG8_WAIT_V(n) asm volatile("s_waitcnt vmcnt(" #n ")" ::: "memory")
#define PG8_WAIT_L(n) asm volatile("s_waitcnt lgkmcnt(" #n ")" ::: "memory")
#define PG8_BAR __builtin_amdgcn_s_barrier()
#define PG8_SCHED __builtin_amdgcn_sched_barrier(0)
    Unit cur, nxt; int ui = 0;
    if (!S.next(0, cur)) return;
    f32x4 acc[2][2][4][2];
#pragma unroll
    for (int a = 0; a < 2; ++a)
#pragma unroll
        for (int b = 0; b < 2; ++b)
#pragma unroll
            for (int m = 0; m < 4; ++m)
#pragma unroll
                for (int n = 0; n < 2; ++n) acc[a][b][m][n] = (f32x4){0.f, 0.f, 0.f, 0.f};
    bf16x8 At[4][2], B0[2][2], B1[2][2];
    const char* cA = (const char*)g.A + (size_t)cur.pm * tstep + (size_t)cur.kb * kstep; const char* cB = (const char*)g.Bt + (size_t)cur.pn * tstep + (size_t)cur.kb * kstep;
    S.a_ready(cur);
    if constexpr (SP2) {
        PG8_STAGE(PG8_SB(0, 0), cB, voffB); PG8_STAGE(PG8_SB(0, 1), cB + hstep, voffB); PG8_STAGE(PG8_SA(0, 0), cA, voffA); PG8_STAGE(PG8_SA(0, 1), cA + hstep, voffA);
        if (wr == 1) PG8_BAR;
        PG8_WAIT_V(2); PG8_BAR;
        PG8_STAGE(PG8_SB(1, 0), cB + kstep, voffB); PG8_STAGE(PG8_SA(1, 0), cA + kstep, voffA); PG8_STAGE(PG8_SB(1, 1), cB + hstep + kstep, voffB);
        PG8_WAIT_V(6); PG8_BAR;
    } else {
        PG8_STAGE(PG8_SB(0, 0), cB, voffB); PG8_STAGE(PG8_SA(0, 0), cA, voffA); PG8_STAGE(PG8_SB(0, 1), cB + hstep, voffB); PG8_STAGE(PG8_SA(0, 1), cA + hstep, voffA);
        if (wr == 1) PG8_BAR;
        PG8_WAIT_V(4); PG8_BAR;
        PG8_STAGE(PG8_SB(1, 0), cB + kstep, voffB); PG8_STAGE(PG8_SA(1, 0), cA + kstep, voffA); PG8_STAGE(PG8_SB(1, 1), cB + hstep + kstep, voffB);
        PG8_WAIT_V(6); PG8_BAR;
    }
    for (;;) {
        const bool has_next = S.next(ui + 1, nxt);
        const char* nA = has_next ? (const char*)g.A + (size_t)nxt.pm * tstep + (size_t)nxt.kb * kstep : cA; const char* nB = has_next ? (const char*)g.Bt + (size_t)nxt.pn * tstep + (size_t)nxt.kb * kstep : cB;
        const int nt = cur.nk;
        for (int t = 0; t < nt; t += 2) {
            const bool last = (t == nt - 2);
            if constexpr (Epi::HOOK_TILE > 0) { if (cur.kb + t == Epi::HOOK_TILE && t > 0) E.mid(acc, cur, wr, wc, fr, fq); }
            const char* a1 = cA + (size_t)(t + 1) * kstep;
            const char* a2 = last ? nA : cA + (size_t)(t + 2) * kstep; const char* b2 = last ? nB : cB + (size_t)(t + 2) * kstep;
            const char* a3 = a2 + kstep; const char* b3 = b2 + kstep;
            if (last && has_next) S.a_ready(nxt);
            if constexpr (SP2) {
            PG8_LDB(B0, 0, 0); PG8_LDB(B1, 0, 1); PG8_SCHED; PG8_LDA(At, 0, 0); PG8_STAGE(PG8_SA(1, 1), a1 + hstep, voffA);
            PG8_WAIT_V(8); PG8_WAIT_L(0); PG8_BAR; PG8_MMA(0, 0, At, B0); PG8_MMA(0, 1, At, B1); PG8_BAR; PG8_SCHED;
            PG8_LDA(At, 0, 1); PG8_STAGE(PG8_SB(0, 0), b2, voffB); PG8_STAGE(PG8_SB(0, 1), b2 + hstep, voffB); PG8_STAGE(PG8_SA(0, 0), a2, voffA);
            PG8_WAIT_V(8); PG8_WAIT_L(0); PG8_BAR; PG8_MMA(1, 0, At, B0); PG8_MMA(1, 1, At, B1); PG8_BAR; PG8_SCHED;
            PG8_LDB(B0, 1, 0); PG8_LDB(B1, 1, 1); PG8_SCHED; PG8_LDA(At, 1, 0); PG8_STAGE(PG8_SA(0, 1), a2 + hstep, voffA);
            PG8_WAIT_V(8); PG8_WAIT_L(0); PG8_BAR; PG8_MMA(0, 0, At, B0); PG8_MMA(0, 1, At, B1); PG8_BAR; PG8_SCHED;
            PG8_LDA(At, 1, 1); PG8_STAGE(PG8_SB(1, 0), b3, voffB); PG8_STAGE(PG8_SB(1, 1), b3 + hstep, voffB); PG8_STAGE(PG8_SA(1, 0), a3, voffA);
            PG8_WAIT_V(8); PG8_WAIT_L(0); PG8_BAR; PG8_MMA(1, 0, At, B0); PG8_MMA(1, 1, At, B1); PG8_BAR; PG8_SCHED;
            } else {
            PG8_LDB(B0, 0, 0); PG8_SCHED; PG8_LDA(At, 0, 0); PG8_STAGE(PG8_SA(1, 1), a1 + hstep, voffA);
            PG8_WAIT_L(8); PG8_BAR; PG8_WAIT_L(0); PG8_MMA(0, 0, At, B0); PG8_BAR; PG8_SCHED;
            PG8_LDB(B1, 0, 1); PG8_STAGE(PG8_SB(0, 0), b2, voffB);
            PG8_BAR; PG8_WAIT_L(0); PG8_MMA(0, 1, At, B1); PG8_BAR;
            PG8_LDA(At, 0, 1); PG8_STAGE(PG8_SA(0, 0), a2, voffA);
            PG8_BAR; PG8_WAIT_L(0); PG8_MMA(1, 0, At, B0); PG8_BAR; PG8_SCHED;
            PG8_STAGE(PG8_SB(0, 1), b2 + hstep, voffB);
            PG8_WAIT_V(6); PG8_BAR; PG8_MMA(1, 1, At, B1); PG8_BAR;
            PG8_LDB(B0, 1, 0); PG8_SCHED; PG8_LDA(At, 1, 0); PG8_STAGE(PG8_SA(0, 1), a2 + hstep, voffA);
            PG8_WAIT_L(8); PG8_BAR; PG8_WAIT_L(0); PG8_MMA(0, 0, At, B0); PG8_BAR; PG8_SCHED;
            PG8_LDB(B1, 1, 1); PG8_STAGE(PG8_SB(1, 0), b3, voffB);
            PG8_BAR; PG8_WAIT_L(0); PG8_MMA(0, 1, At, B1); PG8_BAR;
            PG8_LDA(At, 1, 1); PG8_STAGE(PG8_SA(1, 0), a3, voffA);
            PG8_BAR; PG8_WAIT_L(0); PG8_MMA(1, 0, At, B0); PG8_BAR; PG8_SCHED;
            PG8_STAGE(PG8_SB(1, 1), b3 + hstep, voffB);
            PG8_WAIT_V(6); PG8_BAR; PG8_MMA(1, 1, At, B1); PG8_BAR;
            }
        }
        if constexpr (ALIGN_EPI) { if (wr == 0) PG8_BAR; }
        if constexpr (Epi::HOOK_TILE > 0) { if (cur.kb + cur.nk <= Epi::HOOK_TILE) E.mid(acc, cur, wr, wc, fr, fq); }
        if (cur.kind == 3) {
            int fr_ = fr; asm volatile("" : "+v"(fr_));
            const int ti4 = (wid * 64 + fq * 16 + fr_) * 4;
            {
                float* slw = S.slab + (size_t)(cur.peer * S.nsl + S.s) * 65536;
                const __amdgpu_buffer_rsrc_t rs = __builtin_amdgcn_make_buffer_rsrc(slw, 0, 262144, 0x00020000);
#pragma unroll
                for (int a = 0; a < 2; ++a)
#pragma unroll
                    for (int b = 0; b < 2; ++b)
#pragma unroll
                        for (int m = 0; m < 4; ++m)
#pragma unroll
                            for (int n = 0; n < 2; ++n)
                                __builtin_amdgcn_raw_buffer_store_b128(__builtin_bit_cast(u32x4, acc[a][b][m][n]), rs, (ti4 + (((a * 2 + b) * 4 + m) * 2 + n) * 2048) * 4, 0, 16);
            }
            PG8_WAIT_V(0); PG8_BAR;
            if (wid == 0 && (fq | fr) == 0) {
                __hip_atomic_fetch_add(S.cnt + cur.peer, 1u, __ATOMIC_RELAXED, __HIP_MEMORY_SCOPE_AGENT);
                unsigned sp = 0; while (__hip_atomic_load(S.cnt + cur.peer, __ATOMIC_RELAXED, __HIP_MEMORY_SCOPE_AGENT) < (unsigned)S.nsl && ++sp < (1u << 22)) __builtin_amdgcn_s_sleep(2);
                __builtin_amdgcn_fence(__ATOMIC_ACQUIRE, "agent"); PG8_WAIT_V(0);
            }
            PG8_BAR; asm volatile("" ::: "memory");
            for (int blk = S.s; blk < 8; blk += S.nsl) {
                const int a = blk >> 2, m0 = blk & 3;
                f32x4 r[4];
#pragma unroll
                for (int v = 0; v < 4; ++v) r[v] = (f32x4){0.f, 0.f, 0.f, 0.f};
                for (int s2 = 0; s2 < S.nsl; ++s2) {
                    const float* ss = S.slab + (size_t)(cur.peer * S.nsl + s2) * 65536 + ti4;
#pragma unroll
                    for (int v = 0; v < 4; ++v) r[v] += *(const f32x4*)(ss + (size_t)((((a * 2 + (v >> 1)) * 4 + m0) * 2 + (v & 1)) * 2048));
                }
                E.rg(r[0], r[1], r[2], r[3], cur, a, m0, wr, wc, fr, fq);
            }
        } else {
            E(acc, cur, wr, wc, fr, fq);
        }
        if (!has_next) break;
#pragma unroll
        for (int a = 0; a < 2; ++a)
#pragma unroll
            for (int b = 0; b < 2; ++b)
#pragma unroll
                for (int m = 0; m < 4; ++m)
#pragma unroll
                    for (int n = 0; n < 2; ++n) acc[a][b][m][n] = (f32x4){0.f, 0.f, 0.f, 0.f};
        cur = nxt; cA = nA; cB = nB; ++ui;
        if constexpr (ALIGN_EPI) { if (wr == 1) PG8_BAR; }
    }
    PG8_WAIT_V(0);
    if constexpr (!ALIGN_EPI) { if (wr == 0) PG8_BAR; }
    PG8_BAR;
    if constexpr (Epi::AFTER_DRAIN) { E.fused(acc, cur, wr, wc, fr, fq, lds, wid, lane); S.done(cur); }
#undef PG8_SA
#undef PG8_SB
#undef PG8_STAGE
#undef PG8_LDA
#undef PG8_LDB
#undef PG8_MMA
#undef PG8_WAIT_V
#undef PG8_WAIT_L
#undef PG8_BAR
#undef PG8_SCHED
}
}
#define PG8_SP2 true
#define PG8_ALIGN true

using pg8::f32x4; using pg8::Unit; using pg8::BM; using pg8::HALF; typedef pg8::u32x4 u32x4;
typedef unsigned short bf16_t;

#define EPI_WALK() __device__ __forceinline__ void operator()(const f32x4 (&acc)[2][2][4][2], const Unit& u, int wr, int wc, int fr, int fq) const { \
        _Pragma("unroll") for (int ai = 0; ai < 2; ++ai) _Pragma("unroll") for (int m = 0; m < 4; ++m) { \
            rg(acc[ai][0][m][0], acc[ai][0][m][1], acc[ai][1][m][0], acc[ai][1][m][1], u, ai, m, wr, wc, fr, fq); asm volatile("" ::: "memory"); } }

struct EpiZ {
    static constexpr int HOOK_TILE = 0;
    static constexpr bool PERM = true, AFTER_DRAIN = false;
    bf16_t* zrw; bf16_t* zug; float* out;
    __device__ __forceinline__ void rg(f32x4 v00, f32x4 v01, f32x4 v10, f32x4 v11, const Unit& u, int ai, int m, int wr, int wc, int fr, int fq) const {
        const int colt = u.pn * BM;
        const int mode = colt < CSH ? 0 : (colt < C_G0 ? 1 : 2);
        const int row = u.pm * BM + wr * 64 + fr + ai * HALF + m * 16, col0 = colt + wc * 32 + 8 * fq;
        bf16_t* rowp = mode == 0 ? zrw + (size_t)row * CSH + col0 : zug + (size_t)row * ZUGW + (col0 - CSH);
        if (mode == 0) {
            bool last; float* sh;
            if (row < MP) { last = (row & (TP - 1)) == TP - 1; sh = out + O_SHP + (size_t)(row / TP) * CSH + col0; }
            else { const int rs = row - MP; last = (rs & (TS - 1)) == TS - 1; sh = out + O_SHS + (size_t)(rs / TS) * CSH + col0; }
            if (last) { *(f32x4*)sh = v00; *(f32x4*)(sh + 4) = v01; *(f32x4*)(sh + HALF) = v10; *(f32x4*)(sh + HALF + 4) = v11; }
        } else if (mode == 1) {
#pragma unroll
            for (int e = 0; e < 4; ++e) { v00[e] = gelu_tanh(v00[e]); v01[e] = gelu_tanh(v01[e]); v10[e] = gelu_tanh(v10[e]); v11[e] = gelu_tanh(v11[e]); }
        } else {
#pragma unroll
            for (int e = 0; e < 4; ++e) { v00[e] = sigmoidf_(v00[e]); v01[e] = sigmoidf_(v01[e]); v10[e] = sigmoidf_(v10[e]); v11[e] = sigmoidf_(v11[e]); }
        }
        u32x4 w; w.x = pk2(v00[0], v00[1]); w.y = pk2(v00[2], v00[3]); w.z = pk2(v01[0], v01[1]); w.w = pk2(v01[2], v01[3]);
        *(u32x4*)rowp = w;
        w.x = pk2(v10[0], v10[1]); w.y = pk2(v10[2], v10[3]); w.z = pk2(v11[0], v11[1]); w.w = pk2(v11[2], v11[3]);
        *(u32x4*)(rowp + HALF) = w;
    }
    EPI_WALK()
};
struct EpiMerge {
    static constexpr int HOOK_TILE = 16;
    static constexpr bool PERM = true, AFTER_DRAIN = false;
    const bf16_t* z; bf16_t* mg;
    __device__ __forceinline__ void mid(f32x4 (&acc)[2][2][4][2], const Unit& u, int wr, int wc, int fr, int fq) const {
        asm volatile("" : "+v"(fr));
        const int row0 = u.pm * BM + wr * 64 + fr, col0 = u.pn * BM + wc * 32 + 8 * fq;
#pragma unroll
        for (int ai = 0; ai < 2; ++ai)
#pragma unroll
            for (int m = 0; m < 4; ++m) {
                const bf16_t* zr = z + (size_t)(row0 + ai * HALF + m * 16) * ZUGW + col0;
#pragma unroll
                for (int bj = 0; bj < 2; ++bj) {
                    const u32x4 g0 = *(const u32x4*)(zr + ZU_G0 + bj * HALF), g1 = *(const u32x4*)(zr + ZU_G1 + bj * HALF);
                    f32x4& v0 = acc[ai][bj][m][0]; f32x4& v1 = acc[ai][bj][m][1];
                    v0[0] *= bflo(g0.x) / fmaxf(bflo(g1.x), 1e-30f); v0[1] *= bfhi(g0.x) / fmaxf(bfhi(g1.x), 1e-30f);
                    v0[2] *= bflo(g0.y) / fmaxf(bflo(g1.y), 1e-30f); v0[3] *= bfhi(g0.y) / fmaxf(bfhi(g1.y), 1e-30f);
                    v1[0] *= bflo(g0.z) / fmaxf(bflo(g1.z), 1e-30f); v1[1] *= bfhi(g0.z) / fmaxf(bfhi(g1.z), 1e-30f);
                    v1[2] *= bflo(g0.w) / fmaxf(bflo(g1.w), 1e-30f); v1[3] *= bfhi(g0.w) / fmaxf(bfhi(g1.w), 1e-30f);
                }
                asm volatile("" ::: "memory");
            }
    }
    __device__ __forceinline__ void rg(f32x4 v00, f32x4 v01, f32x4 v10, f32x4 v11, const Unit& u, int ai, int m, int wr, int wc, int fr, int fq) const {
        const int row = u.pm * BM + wr * 64 + fr + ai * HALF + m * 16, col0 = u.pn * BM + wc * 32 + 8 * fq;
        const bf16_t* zr = z + (size_t)row * ZUGW + ZU_G1 + col0;
        const u32x4 ga = *(const u32x4*)zr, gb = *(const u32x4*)(zr + HALF);
        u32x4 w;
        w.x = pk2(bflo(ga.x) * v00[0], bfhi(ga.x) * v00[1]); w.y = pk2(bflo(ga.y) * v00[2], bfhi(ga.y) * v00[3]);
        w.z = pk2(bflo(ga.z) * v01[0], bfhi(ga.z) * v01[1]); w.w = pk2(bflo(ga.w) * v01[2], bfhi(ga.w) * v01[3]);
        *(u32x4*)(mg + (size_t)row * D + col0) = w;
        w.x = pk2(bflo(gb.x) * v10[0], bfhi(gb.x) * v10[1]); w.y = pk2(bflo(gb.y) * v10[2], bfhi(gb.y) * v10[3]);
        w.z = pk2(bflo(gb.z) * v11[0], bfhi(gb.z) * v11[1]); w.w = pk2(bflo(gb.w) * v11[2], bfhi(gb.w) * v11[3]);
        *(u32x4*)(mg + (size_t)row * D + col0 + HALF) = w;
    }
    EPI_WALK()
};
struct EpiRes1 {
    static constexpr int HOOK_TILE = 0;
    static constexpr bool PERM = false, AFTER_DRAIN = false;
    const float* xp; const float* xs; const float* mod; float* out;
    __device__ __forceinline__ void rg(f32x4 v00, f32x4 v01, f32x4 v10, f32x4 v11, const Unit& u, int ai, int m, int wr, int wc, int fr, int fq) const {
        const int row = u.pm * BM + wr * 64 + fr + ai * HALF + m * 16, col0 = u.pn * BM + wc * 32 + 4 * fq;
        const float* xr = (row < MP ? xp + (size_t)row * D : xs + (size_t)(row - MP) * D) + col0;
        const float* gm = mod + (size_t)seq_of_row(row) * (6 * D) + 2 * D + col0;
        float* o = out + (size_t)row * D + col0;
        *(f32x4*)o = *(const f32x4*)xr + *(const f32x4*)gm * v00;
        *(f32x4*)(o + 16) = *(const f32x4*)(xr + 16) + *(const f32x4*)(gm + 16) * v01;
        *(f32x4*)(o + HALF) = *(const f32x4*)(xr + HALF) + *(const f32x4*)(gm + HALF) * v10;
        *(f32x4*)(o + HALF + 16) = *(const f32x4*)(xr + HALF + 16) + *(const f32x4*)(gm + HALF + 16) * v11;
    }
    EPI_WALK()
};
struct EpiSwiglu {
    static constexpr int HOOK_TILE = 0;
    static constexpr bool PERM = true, AFTER_DRAIN = false;
    bf16_t* act;
    __device__ __forceinline__ void rg(f32x4 v00, f32x4 v01, f32x4 v10, f32x4 v11, const Unit& u, int ai, int m, int wr, int wc, int fr, int fq) const {
        const int row = u.pm * BM + wr * 64 + fr + ai * HALF + m * 16, col0 = u.pn * HALF + wc * 32 + 8 * fq;
        float r[8];
#pragma unroll
        for (int e = 0; e < 4; ++e) { r[e] = v00[e] * sigmoidf_(v00[e]) * v10[e]; r[4 + e] = v01[e] * sigmoidf_(v01[e]) * v11[e]; }
        u32x4 w; w.x = pk2(r[0], r[1]); w.y = pk2(r[2], r[3]); w.z = pk2(r[4], r[5]); w.w = pk2(r[6], r[7]);
        *(u32x4*)(act + (size_t)row * DFF + col0) = w;
    }
    EPI_WALK()
};
struct EpiRes2 {
    static constexpr int HOOK_TILE = 0;
    static constexpr bool PERM = false, AFTER_DRAIN = false;
    const float* mod; float* out;
    __device__ __forceinline__ void rg(f32x4 v00, f32x4 v01, f32x4 v10, f32x4 v11, const Unit& u, int ai, int m, int wr, int wc, int fr, int fq) const {
        const int row = u.pm * BM + wr * 64 + fr + ai * HALF + m * 16, col0 = u.pn * BM + wc * 32 + 4 * fq;
        const float* gf = mod + (size_t)seq_of_row(row) * (6 * D) + 5 * D + col0;
        float* o = out + (size_t)row * D + col0;
        *(f32x4*)o = *(const f32x4*)o + *(const f32x4*)gf * v00;
        *(f32x4*)(o + 16) = *(const f32x4*)(o + 16) + *(const f32x4*)(gf + 16) * v01;
        *(f32x4*)(o + HALF) = *(const f32x4*)(o + HALF) + *(const f32x4*)(gf + HALF) * v10;
        *(f32x4*)(o + HALF + 16) = *(const f32x4*)(o + HALF + 16) + *(const f32x4*)(gf + HALF + 16) * v11;
    }
    EPI_WALK()
};
struct SliceOrder {
    int nM, nN, nwg, KT, R1, c, nleft, nsl, l, s;
    unsigned* cnt; float* slab;
    __device__ void init(int M_, int N_, int K_, int c_, unsigned* cnt_, float* slab_) {
        nM = M_ / BM; nN = N_ / BM; nwg = nM * nN; KT = K_ / 64; c = c_; cnt = cnt_; slab = slab_;
        R1 = nwg / 256; nleft = nwg - R1 * 256; nsl = nleft ? 256 / nleft : 1; if (nsl > 8) nsl = 8;
        l = nleft ? c % nleft : 0; s = nleft ? c / nleft : nsl;
    }
    __device__ int kbnd(int i) const { return i >= nsl ? KT : (((KT * i) / nsl + 1) & ~1); }
    __device__ void pmpn(int L, Unit& u) const {
        int wgid = L; { const int q = nwg / pg8::NXCD, r = nwg % pg8::NXCD, xcd = wgid % pg8::NXCD, off = wgid / pg8::NXCD; wgid = (xcd < r ? xcd * (q + 1) : r * (q + 1) + (xcd - r) * q) + off; }
        const int nig = pg8::WGM * nN, gid = wgid / nig, fm = gid * pg8::WGM, gsz = (nM - fm) < pg8::WGM ? (nM - fm) : pg8::WGM;
        u.pm = fm + ((wgid % nig) % gsz); u.pn = (wgid % nig) / gsz;
    }
    __device__ bool next(int i, Unit& u) const {
        if (i < R1) { pmpn(i * 256 + c, u); u.kb = 0; u.nk = KT; u.kind = 0; u.peer = 0; return true; }
        if (i == R1 && nleft && s < nsl) { pmpn(R1 * 256 + l, u); u.kb = kbnd(s); u.nk = kbnd(s + 1) - u.kb; u.kind = 3; u.peer = l; return true; }
        return false;
    }
    __device__ __forceinline__ void a_ready(const Unit&) const {}
    __device__ __forceinline__ void done(const Unit&) const {}
};

#define GAS __attribute__((address_space(1)))
#define LAS __attribute__((address_space(3)))
typedef GAS unsigned gu32;
#define RLX_AGENT __ATOMIC_RELAXED, __HIP_MEMORY_SCOPE_AGENT
#define LDS_WAIT() asm volatile("s_waitcnt lgkmcnt(0)" ::: "memory")
#define VM_WAIT() asm volatile("s_waitcnt vmcnt(0)" ::: "memory")
#define XB_TMO      128
#define XB_XCNT(j)  (256  + 64 * (j))
#define XB_XSUB(j)  (1280 + 64 * (j))
#define XB_XGEN(j)  (2304 + 64 * (j))
#define XB_TOP      3328
#define XB_TOPGEN   3392
#define XCD_BAR_WORDS 3456
#define XB_SPIN_CAP (1u << 18)

__device__ __forceinline__ unsigned xb_ld(unsigned* p)              { return __hip_atomic_load(p, __ATOMIC_RELAXED, __HIP_MEMORY_SCOPE_AGENT); }
__device__ __forceinline__ unsigned xb_add(unsigned* p, unsigned v) { return __hip_atomic_fetch_add(p, v, __ATOMIC_RELAXED, __HIP_MEMORY_SCOPE_AGENT); }
__device__ __forceinline__ unsigned xb_xcc_id() { return (unsigned)__builtin_amdgcn_s_getreg((3 << 11) | 20) & 0xFu; }
#define XB_SPIN(cond, bar) do { unsigned _sp = 0; while (cond) { __builtin_amdgcn_s_sleep(1); \
    if ((++_sp & 255u) == 0u) { if (xb_ld(&(bar)[XB_TMO])) break; if (_sp > XB_SPIN_CAP) { atomicAdd(&(bar)[XB_TMO], 1u); break; } } } } while (0)

struct XcdBarrier {
    unsigned* bar; unsigned x;
    volatile LAS unsigned* st;
};

__device__ __forceinline__ XcdBarrier xcd_barrier_post(unsigned* bar, volatile LAS unsigned* st) {
    XcdBarrier b; b.bar = bar; b.x = xb_xcc_id(); b.st = st;
    if (threadIdx.x == 0) (void)xb_add(&bar[XB_XCNT(b.x)], 1u);
    return b;
}
__device__ __forceinline__ void xcd_barrier_complete(unsigned* bar, unsigned x, unsigned& nloc, unsigned& nx) {
    const unsigned G = gridDim.x * gridDim.y * gridDim.z;
    unsigned sum, cnt, mine, sp = 0u;
    for (;;) {
        sum = 0u; cnt = 0u; mine = 0u;
#pragma unroll
        for (unsigned j = 0; j < 16; ++j) { const unsigned c = xb_ld(&bar[XB_XCNT(j)]); sum += c; cnt += (c > 0u) ? 1u : 0u; mine = (j == x) ? c : mine; }
        if (sum == G) break;
        __builtin_amdgcn_s_sleep(1);
        if ((++sp & 255u) == 0u) { if (xb_ld(&bar[XB_TMO])) break; if (sp > XB_SPIN_CAP) { atomicAdd(&bar[XB_TMO], 1u); break; } }
    }
    nloc = mine > 0u ? mine : 1u; nx = cnt > 0u ? cnt : 1u;
}

__device__ __forceinline__ void xcd_barrier(const XcdBarrier& b) {
    asm volatile("s_waitcnt vmcnt(0)" ::: "memory");
    __syncthreads();
    if (threadIdx.x == 0) {
        unsigned* bar = b.bar;
        __builtin_amdgcn_s_waitcnt(0);
        unsigned nloc = b.st[0], nx = b.st[1];
        if (nloc == 0u) { xcd_barrier_complete(bar, b.x, nloc, nx); b.st[0] = nloc; b.st[1] = nx; }
        const unsigned old = xb_add(&bar[XB_XSUB(b.x)], 1u);
        const unsigned gen = old / nloc;
        if (old + 1u == (gen + 1u) * nloc) {
            __builtin_amdgcn_fence(__ATOMIC_RELEASE, "agent");
            asm volatile("s_waitcnt vmcnt(0)" ::: "memory");
            const unsigned og = xb_add(&bar[XB_TOP], 1u);
            const unsigned tg = og / nx;
            if (og + 1u == (tg + 1u) * nx) xb_add(&bar[XB_TOPGEN], 1u);
            else XB_SPIN(xb_ld(&bar[XB_TOPGEN]) == tg, bar);
            __builtin_amdgcn_fence(__ATOMIC_ACQUIRE, "agent");
            xb_add(&bar[XB_XGEN(b.x)], 1u);
            asm volatile("s_waitcnt vmcnt(0)" ::: "memory");
        } else {
            XB_SPIN(xb_ld(&bar[XB_XGEN(b.x)]) == gen, bar);
            __builtin_amdgcn_fence(__ATOMIC_ACQUIRE, "agent");
            asm volatile("s_waitcnt vmcnt(0)" ::: "memory");
        }
    }
    __syncthreads();
}

typedef pg8::bf16x8 bf16x8;
#define MFMA16(a, b, c) __builtin_amdgcn_mfma_f32_16x16x32_bf16((a), (b), (c), 0, 0, 0)
constexpr int RB_P1 = 0, RB_RT = 2048, RB_QP = 4096, RB_RAK = 5120, RB_VM = 6144, RB_WL = 8192;

__device__ __forceinline__ f32x4 ld_bf4(const bf16_t* p) { const u32x2v w = *(const u32x2v*)p; return (f32x4){bflo(w.x), bfhi(w.x), bflo(w.y), bfhi(w.y)}; }
__device__ __forceinline__ bf16x8 mk_frag(const f32x4 a, const f32x4 b) { u32x4 w; w.x = pk2(a[0], a[1]); w.y = pk2(a[2], a[3]); w.z = pk2(b[0], b[1]); w.w = pk2(b[2], b[3]); return __builtin_bit_cast(bf16x8, w); }
__device__ __forceinline__ unsigned char* recA_ptr(const P& p, int rec) { return rec < NREC_P ? p.ws + WS_H + (size_t)rec * RECA : p.ws + WS_FRA_S + (size_t)(rec - NREC_P) * RECA; }
__device__ __forceinline__ unsigned char* recB_ptr(const P& p, int rec) { return rec < NREC_P ? (unsigned char*)p.out + (size_t)rec * RECB : p.ws + WS_FRB_S + (size_t)(rec - NREC_P) * RECB; }
__device__ __forceinline__ f32x4 sig4(f32x4 x) { return (f32x4){sigmoidf_(x[0]), sigmoidf_(x[1]), sigmoidf_(x[2]), sigmoidf_(x[3])}; }
__device__ __forceinline__ f32x4 exp4(f32x4 x) { return (f32x4){__expf(x[0]), __expf(x[1]), __expf(x[2]), __expf(x[3])}; }

template <class T> __device__ __forceinline__ T ldu(const void* ubase, unsigned voff) { return *(const T*)((const char*)ubase + voff); }
__device__ __forceinline__ f32x4 bf4(const u32x2v w) { return (f32x4){bflo(w.x), bfhi(w.x), bflo(w.y), bfhi(w.y)}; }
struct ShiftCtx { const bf16_t* zrw; const float* ss; const float* mu; unsigned zoc, zop; float fv, fpz, fps; };
__device__ __forceinline__ f32x4 shift4(const ShiftCtx& k, int cu, unsigned lp) {
    const u32x2v cw = ldu<u32x2v>(k.zrw + cu, k.zoc + lp * 2u), pw = ldu<u32x2v>(k.zrw + cu, k.zop + lp * 2u);
    const f32x4 sv = ldu<f32x4>(k.ss + cu, lp * 4u), m = ldu<f32x4>(k.mu + cu, lp * 4u);
    const f32x4 cur = bf4(cw) * k.fv;
    const f32x4 pv = bf4(pw) * k.fpz + sv * k.fps;
    return cur + (pv - cur) * m;
}

__device__ __forceinline__ void prep_record(const P& p, LAS unsigned char* wl, int rec, int lane_in) {
    int lane = lane_in; asm volatile("" : "+v"(lane));
    const int head = rec & 15, chunkid = rec >> 4;
    const bool prompt = chunkid < NPB * 128;
    const int sq = prompt ? (chunkid >> 7) : NPB + (chunkid - NPB * 128);
    const int c = prompt ? (chunkid & 127) : 0;
    const int row0 = prompt ? sq * TP + c * 16 : MP + (sq - NPB) * TS;
    const int nvalid = prompt ? 16 : TS;
    const int i = lane & 15, q = lane >> 4;
    const bool valid = i < nvalid, first = (c == 0);
    const bool pz = valid && (i > 0 || !first), ps = valid && (i == 0) && first && !prompt;
    const int row = row0 + (valid ? i : 0);
    ShiftCtx K;
    K.zrw = (const bf16_t*)(p.ws + WS_ZRW); K.ss = p.in[3] + (size_t)(prompt ? 0 : sq - NPB) * CSH; K.mu = p.in[10];
    K.zoc = (unsigned)row * (unsigned)(CSH * 2); K.zop = pz ? K.zoc - (unsigned)(CSH * 2) : K.zoc; K.fv = valid ? 1.f : 0.f; K.fpz = pz ? 1.f : 0.f; K.fps = ps ? 1.f : 0.f;
    const unsigned q4 = (unsigned)q * 4u, q8 = (unsigned)q * 8u;
    const unsigned wlo64 = (unsigned)(i * 64 + q * 8) * 2u, wlo128 = (unsigned)(i * 128 + q * 8) * 2u;
    const bf16_t* WDUT = (const bf16_t*)(p.ws + WS_LORA); const bf16_t* WAUT = WDUT + RW * 64; const bf16_t* WGUT = WAUT + RW * 64;
    const f32x4 z4 = (f32x4){0.f, 0.f, 0.f, 0.f};

    f32x4 accw[4], acca[4];
#pragma unroll
    for (int ct = 0; ct < 4; ++ct) { accw[ct] = z4; acca[ct] = z4; }
#pragma unroll
    for (int s = 0; s < 2; ++s) {
        const int cw = 3072 + 32 * s, ca = 3136 + 32 * s;
        f32x4 x0 = shift4(K, cw, q8), x1 = shift4(K, cw + 4, q8);
#pragma unroll
        for (int e = 0; e < 4; ++e) { x0[e] = 2.f * sigmoidf_(2.f * x0[e]) - 1.f; x1[e] = 2.f * sigmoidf_(2.f * x1[e]) - 1.f; }
        const bf16x8 td = mk_frag(x0, x1);
        const bf16x8 ad = mk_frag(shift4(K, ca, q8), shift4(K, ca + 4, q8));
#pragma unroll
        for (int ct = 0; ct < 4; ++ct) {
            const int wo = (head * 64 + 16 * ct) * 64 + 32 * s;
            accw[ct] = MFMA16(ldu<bf16x8>(WDUT + wo, wlo64), td, accw[ct]);
            acca[ct] = MFMA16(ldu<bf16x8>(WAUT + wo, wlo64), ad, acca[ct]);
        }
    }
    f32x4 lw[4], av[4], ks[4];
    float ssq = 0.f;
#pragma unroll
    for (int ct = 0; ct < 4; ++ct) {
        const int cbu = head * 64 + 16 * ct;
        lw[ct] = sig4(ldu<f32x4>(p.in[11] + cbu, q4 * 4u) + accw[ct]) * (-0.6065306597126334f);
        lw[ct] = lw[ct] * K.fv;
        av[ct] = sig4(ldu<f32x4>(p.in[13] + cbu, q4 * 4u) + acca[ct]);
        ks[ct] = shift4(K, RW + cbu, q4);
        const f32x4 kk0 = ks[ct] * ldu<f32x4>(p.in[16] + cbu, q4 * 4u);
        ssq += (kk0[0] * kk0[0] + kk0[1] * kk0[1]) + (kk0[2] * kk0[2] + kk0[3] * kk0[3]);
    }
    ssq += __shfl_xor(ssq, 16); ssq += __shfl_xor(ssq, 32);
    const float kinv = 1.f / fmaxf(sqrtf(ssq), 1e-12f);
    f32x4 lwc[4];
#pragma unroll
    for (int ct = 0; ct < 4; ++ct) lwc[ct] = lw[ct];
#pragma unroll
    for (int d = 1; d < 16; d <<= 1)
#pragma unroll
        for (int ct = 0; ct < 4; ++ct)
#pragma unroll
            for (int e = 0; e < 4; ++e) { const float t = __shfl_up(lwc[ct][e], d, 16); if (i >= d) lwc[ct][e] += t; }
    unsigned char* rb = recB_ptr(p, rec); unsigned char* ra = recA_ptr(p, rec);
    LAS unsigned short* KT = (LAS unsigned short*)wl; LAS unsigned short* AT = KT + 1024; LAS unsigned short* KtT = KT + 2048; LAS unsigned short* VT = KT + 3072;
    LAS float* MT = (LAS float*)(wl + 8192);
    u32x2v kapP[4], alpP[4], ktP[4], rtP[4];
    f32x4 wl15[4];
    float bsum = 0.f;
#pragma unroll
    for (int ct = 0; ct < 4; ++ct) {
        const int cbu = head * 64 + 16 * ct;
        const f32x4 Wt = exp4(lwc[ct]), Wtm1 = exp4(lwc[ct] - lw[ct]), Winv = exp4(-lwc[ct]);
        const f32x4 kkn = ks[ct] * ldu<f32x4>(p.in[16] + cbu, q4 * 4u) * kinv;
        const f32x4 kmod = ks[ct] * ((av[ct] - 1.f) * ldu<f32x4>(p.in[17] + cbu, q4 * 4u) + 1.f);
        const f32x4 kap = kkn * Wtm1, alp = kkn * av[ct] * Winv, kt = kmod * Winv;
        const f32x4 rs = shift4(K, cbu, q4);
        const f32x4 rt = rs * Wt;
        const f32x4 rk = rs * kmod * ldu<f32x4>(p.in[18] + cbu, q4 * 4u);
        bsum += (rk[0] + rk[1]) + (rk[2] + rk[3]);
#pragma unroll
        for (int e = 0; e < 4; ++e) wl15[ct][e] = __shfl(Wt[e], 15, 16);
        kapP[ct].x = pk2(kap[0], kap[1]); kapP[ct].y = pk2(kap[2], kap[3]); alpP[ct].x = pk2(alp[0], alp[1]); alpP[ct].y = pk2(alp[2], alp[3]);
        ktP[ct].x = pk2(kt[0], kt[1]); ktP[ct].y = pk2(kt[2], kt[3]); rtP[ct].x = pk2(rt[0], rt[1]); rtP[ct].y = pk2(rt[2], rt[3]);
#pragma unroll
        for (int e = 0; e < 4; ++e) { const int ch = 16 * ct + 4 * q + e; const int sh = (e & 1) * 16;
            KT[ch * 16 + i] = (unsigned short)(((e < 2 ? kapP[ct].x : kapP[ct].y) >> sh) & 0xffffu);
            AT[ch * 16 + i] = (unsigned short)(((e < 2 ? alpP[ct].x : alpP[ct].y) >> sh) & 0xffffu);
            KtT[ch * 16 + i] = (unsigned short)(((e < 2 ? ktP[ct].x : ktP[ct].y) >> sh) & 0xffffu); }
    }
    bsum += __shfl_xor(bsum, 16); bsum += __shfl_xor(bsum, 32);
    u32x2v c1P[4], c2P[4];
    {
        f32x4 accg[4];
#pragma unroll
        for (int ct = 0; ct < 4; ++ct) accg[ct] = z4;
#pragma unroll
        for (int s = 0; s < 4; ++s) {
            const int cg = 3200 + 32 * s;
            const bf16x8 gd = mk_frag(sig4(shift4(K, cg, q8)), sig4(shift4(K, cg + 4, q8)));
#pragma unroll
            for (int ct = 0; ct < 4; ++ct) accg[ct] = MFMA16(ldu<bf16x8>(WGUT + (head * 64 + 16 * ct) * 128 + 32 * s, wlo128), gd, accg[ct]);
        }
#pragma unroll
        for (int ct = 0; ct < 4; ++ct) {
            const int cbu = head * 64 + 16 * ct;
            const f32x4 c1 = ldu<f32x4>(p.in[19] + cbu, q4 * 4u) * accg[ct];
            const f32x4 vsf = shift4(K, 2 * RW + cbu, q4);
            const f32x4 c2 = (ldu<f32x4>(p.in[20] + cbu, q4 * 4u) + vsf * bsum) * accg[ct];
            c1P[ct].x = pk2(c1[0], c1[1]); c1P[ct].y = pk2(c1[2], c1[3]); c2P[ct].x = pk2(c2[0], c2[1]); c2P[ct].y = pk2(c2[2], c2[3]);
#pragma unroll
            for (int e = 0; e < 4; ++e) VT[(16 * ct + 4 * q + e) * 16 + i] = f2bf(vsf[e]);
        }
    }
    bf16x8 kapF[2], alpF[2], ktF[2], rtF[2];
#pragma unroll
    for (int s = 0; s < 2; ++s) {
        kapF[s] = __builtin_bit_cast(bf16x8, (u32x4){kapP[2 * s].x, kapP[2 * s].y, kapP[2 * s + 1].x, kapP[2 * s + 1].y});
        alpF[s] = __builtin_bit_cast(bf16x8, (u32x4){alpP[2 * s].x, alpP[2 * s].y, alpP[2 * s + 1].x, alpP[2 * s + 1].y});
        ktF[s] = __builtin_bit_cast(bf16x8, (u32x4){ktP[2 * s].x, ktP[2 * s].y, ktP[2 * s + 1].x, ktP[2 * s + 1].y});
        rtF[s] = __builtin_bit_cast(bf16x8, (u32x4){rtP[2 * s].x, rtP[2 * s].y, rtP[2 * s + 1].x, rtP[2 * s + 1].y});
    }
    f32x4 Maa = z4, Mak = z4, RAt = z4, RKt = z4;
#pragma unroll
    for (int s = 0; s < 2; ++s) {
        Maa = MFMA16(kapF[s], alpF[s], Maa); Mak = MFMA16(kapF[s], ktF[s], Mak);
        RAt = MFMA16(alpF[s], rtF[s], RAt); RKt = MFMA16(ktF[s], rtF[s], RKt);
    }
#pragma unroll
    for (int r = 0; r < 4; ++r) { const int rw_ = 4 * q + r;
        if (!(rw_ > i)) { Maa[r] = 0.f; Mak[r] = 0.f; }
        if (!(i >= rw_)) { RAt[r] = 0.f; RKt[r] = 0.f; } }
    *(LAS f32x4*)(MT + i * 16 + 4 * q) = Maa;
    u32x4 rakW; rakW.x = pk2(RAt[0], RAt[1]); rakW.y = pk2(RAt[2], RAt[3]); rakW.z = pk2(RKt[0], RKt[1]); rakW.w = pk2(RKt[2], RKt[3]);
    LDS_WAIT(); asm volatile("" ::: "memory");
    float t[16];
#pragma unroll
    for (int cc = 15; cc >= 0; --cc) {
        float acc = (i == cc) ? 1.f : 0.f;
        f32x4 mrow[4];
#pragma unroll
        for (int b = 0; b < 4; ++b) mrow[b] = *(const LAS f32x4*)(MT + cc * 16 + 4 * b);
#pragma unroll
        for (int j = cc + 1; j < 16; ++j) acc -= t[j] * mrow[j >> 2][j & 3];
        t[cc] = acc;
    }
    f32x4 tsel;
#pragma unroll
    for (int e = 0; e < 4; ++e) tsel[e] = -(q == 0 ? t[e] : (q == 1 ? t[4 + e] : (q == 2 ? t[8 + e] : t[12 + e])));
    const bf16x8 Tfrag = mk_frag(tsel, z4);
    f32x4 P1E[4];
#pragma unroll
    for (int ct = 0; ct < 4; ++ct) { const u32x2v w = *(const LAS u32x2v*)(KT + (16 * ct + i) * 16 + 4 * q);
        u32x4 aw; aw.x = w.x; aw.y = w.y; aw.z = 0u; aw.w = 0u; P1E[ct] = MFMA16(__builtin_bit_cast(bf16x8, aw), Tfrag, z4); }
    *(u32x4*)(rb + RB_RT + lane * 16) = __builtin_bit_cast(u32x4, rtF[0]); *(u32x4*)(rb + RB_RT + 1024 + lane * 16) = __builtin_bit_cast(u32x4, rtF[1]);
    *(u32x4*)(rb + RB_RAK + lane * 16) = rakW;
#pragma unroll
    for (int ct = 0; ct < 4; ++ct) {
        if (i == 0) *(f32x4*)(rb + RB_WL + (16 * ct + 4 * q) * 4) = wl15[ct];
        if (valid) { const int cbu = head * 64 + 16 * ct;
            *(u32x2v*)((char*)((bf16_t*)(p.ws + WS_OA) + cbu) + ((unsigned)row * (2 * RW) + q4) * 2u) = c1P[ct];
            *(u32x2v*)((char*)((bf16_t*)(p.ws + WS_C2) + cbu) + ((unsigned)row * RW + q4) * 2u) = c2P[ct]; }
    }
    *(u32x4*)(rb + RB_P1 + lane * 16) = __builtin_bit_cast(u32x4, mk_frag(P1E[0], P1E[1]));
    *(u32x4*)(rb + RB_P1 + 1024 + lane * 16) = __builtin_bit_cast(u32x4, mk_frag(P1E[2], P1E[3]));
    { const f32x4 Qt = MFMA16(mk_frag(Mak, z4), Tfrag, z4);
      u32x4 w; w.x = 0u; w.y = 0u; w.z = pk2(Qt[0], Qt[1]); w.w = pk2(Qt[2], Qt[3]); *(u32x4*)(rb + RB_QP + lane * 16) = w; }
#pragma unroll
    for (int tt = 0; tt < 4; ++tt) {
        const u32x2v a = *(const LAS u32x2v*)(AT + (16 * tt + i) * 16 + 4 * q), b = *(const LAS u32x2v*)(KtT + (16 * tt + i) * 16 + 4 * q);
        u32x4 w; w.x = a.x; w.y = a.y; w.z = b.x; w.w = b.y; *(u32x4*)(ra + tt * 1024 + lane * 16) = w;
        *(u32x2v*)(rb + RB_VM + tt * 512 + lane * 8) = *(const LAS u32x2v*)(VT + (16 * tt + i) * 16 + 4 * q);
    }
    LDS_WAIT(); asm volatile("" ::: "memory");
}

struct ScanFr { bf16x8 P10, P11, RT0, RT1, QP, RAK, AK0, AK1, AK2, AK3; u32x2v vm; f32x4 WL0, WL1, WL2, WL3; };
__device__ __forceinline__ void scan_load(ScanFr& f, const P& p, int rec, int vs, int lane) {
    const unsigned char* ra = recA_ptr(p, rec); const unsigned char* rb = recB_ptr(p, rec);
    const unsigned l16 = (unsigned)lane * 16u, q16 = (unsigned)(lane >> 4) * 16u;
    f.P10 = ldu<bf16x8>(rb + RB_P1, l16); f.P11 = ldu<bf16x8>(rb + RB_P1 + 1024, l16);
    f.RT0 = ldu<bf16x8>(rb + RB_RT, l16); f.RT1 = ldu<bf16x8>(rb + RB_RT + 1024, l16);
    f.QP = ldu<bf16x8>(rb + RB_QP, l16); f.RAK = ldu<bf16x8>(rb + RB_RAK, l16);
    f.vm = ldu<u32x2v>(rb + RB_VM + vs * 512, (unsigned)lane * 8u);
    f.AK0 = ldu<bf16x8>(ra, l16); f.AK1 = ldu<bf16x8>(ra + 1024, l16); f.AK2 = ldu<bf16x8>(ra + 2048, l16); f.AK3 = ldu<bf16x8>(ra + 3072, l16);
    f.WL0 = ldu<f32x4>(rb + RB_WL, q16); f.WL1 = ldu<f32x4>(rb + RB_WL + 64, q16); f.WL2 = ldu<f32x4>(rb + RB_WL + 128, q16); f.WL3 = ldu<f32x4>(rb + RB_WL + 192, q16);
}
template <int NS>
__device__ __forceinline__ void scan_step(const ScanFr& f, const u32x2v (&vm)[NS], f32x4 (&St)[NS][4], float* oraw, int c, int q, bool prompt) {
    const f32x4 z4 = (f32x4){0.f, 0.f, 0.f, 0.f};
#pragma unroll
    for (int i = 0; i < NS; ++i) {
        const bf16x8 SB0 = mk_frag(St[i][0], St[i][1]), SB1 = mk_frag(St[i][2], St[i][3]);
        u32x4 vw; vw.x = 0u; vw.y = 0u; vw.z = vm[i].x; vw.w = vm[i].y;
        f32x4 U = MFMA16(f.QP, __builtin_bit_cast(bf16x8, vw), z4);
        U = MFMA16(f.P10, SB0, U); U = MFMA16(f.P11, SB1, U);
        u32x4 uw; uw.x = pk2(U[0], U[1]); uw.y = pk2(U[2], U[3]); uw.z = vm[i].x; uw.w = vm[i].y;
        const bf16x8 UB = __builtin_bit_cast(bf16x8, uw);
        f32x4 O = MFMA16(f.RT0, SB0, z4); O = MFMA16(f.RT1, SB1, O); O = MFMA16(f.RAK, UB, O);
        St[i][0] = MFMA16(f.AK0, UB, St[i][0]) * f.WL0; St[i][1] = MFMA16(f.AK1, UB, St[i][1]) * f.WL1;
        St[i][2] = MFMA16(f.AK2, UB, St[i][2]) * f.WL2; St[i][3] = MFMA16(f.AK3, UB, St[i][3]) * f.WL3;
#pragma unroll
        for (int r = 0; r < 4; ++r) { const int tk = 4 * q + r; if (prompt || tk < TS) oraw[(size_t)(16 * c + tk) * RW + 16 * i] = O[r]; }
    }
}
__device__ __forceinline__ void scan_chain_prompt(const P& p, int sq, int head, int vp, int lane, volatile LAS unsigned* prog) {
    constexpr int nch = TP / 16;
    const int rec0 = sq * nch * NH + head, vl = lane & 15, q = lane >> 4;
    f32x4 St[2][4];
    float* sout = p.out + O_WKVP + ((size_t)sq * NH + head) * HS * HS + (size_t)(32 * vp + vl) * HS + 4 * q;
    float* oraw = (float*)(p.ws + WS_ZRW) + (size_t)(sq * TP) * RW + head * HS + 32 * vp + vl;
    ScanFr f0, f1; u32x2v v0[2], v1[2];
#define SCAN_LD(f, v, cc) do { const int rec_ = rec0 + (cc) * NH; scan_load(f, p, rec_, 2 * vp, lane); v[0] = f.vm; v[1] = ldu<u32x2v>(recB_ptr(p, rec_) + RB_VM + (2 * vp + 1) * 512, (unsigned)lane * 8u); } while (0)
    SCAN_LD(f0, v0, 0); SCAN_LD(f1, v1, 1);
#pragma unroll
    for (int i = 0; i < 2; ++i)
#pragma unroll
        for (int t = 0; t < 4; ++t) St[i][t] = (f32x4){0.f, 0.f, 0.f, 0.f};
    const bool pw = vp == 0 && lane == 0;
    for (int c = 0; c < nch; c += 2) {
        if (pw) *prog = (unsigned)c;
        scan_step<2>(f0, v0, St, oraw, c, q, true);     SCAN_LD(f0, v0, c + 2 < nch ? c + 2 : nch - 1);
        scan_step<2>(f1, v1, St, oraw, c + 1, q, true); SCAN_LD(f1, v1, c + 3 < nch ? c + 3 : nch - 1);
    }
#undef SCAN_LD
#pragma unroll
    for (int i = 0; i < 2; ++i)
#pragma unroll
        for (int t = 0; t < 4; ++t) *(f32x4*)(sout + (size_t)(16 * i) * HS + 16 * t) = St[i][t];
}
__device__ __forceinline__ void scan_chain_sample(const P& p, int s, int head, int vs, int lane) {
    const int vl = lane & 15, q = lane >> 4;
    const size_t so = ((size_t)s * NH + head) * HS * HS + (size_t)(16 * vs + vl) * HS + 4 * q;
    ScanFr f0; scan_load(f0, p, NREC_P + s * NH + head, vs, lane);
    f32x4 St[1][4]; u32x2v vm[1]; vm[0] = f0.vm;
#pragma unroll
    for (int t = 0; t < 4; ++t) St[0][t] = *(const f32x4*)(p.in[2] + so + 16 * t);
    scan_step<1>(f0, vm, St, (float*)(p.ws + WS_ZRW) + (size_t)(MP + s * TS) * RW + head * HS + 16 * vs + vl, 0, q, false);
#pragma unroll
    for (int t = 0; t < 4; ++t) *(f32x4*)(p.out + O_WKVS + so + 16 * t) = St[0][t];
}

constexpr int SCAN_AHEAD = 10;
__device__ __forceinline__ void scan_prefetch(const P& p, volatile LAS unsigned* prog, int sq, int head, int k, int lane) {
    const int rec0 = sq * (TP / 16) * NH + head;
    const unsigned l16 = (unsigned)lane * 16u;
    for (int c = k; c < TP / 16; c += 4) {
        while ((int)*prog < c - SCAN_AHEAD) __builtin_amdgcn_s_sleep(8);
        const unsigned char* ra = recA_ptr(p, rec0 + c * NH); const unsigned char* rb = recB_ptr(p, rec0 + c * NH);
        u32x4 x[12];
#pragma unroll
        for (int j = 0; j < 4; ++j) x[j] = ldu<u32x4>(ra + j * 1024, l16);
#pragma unroll
        for (int j = 0; j < 8; ++j) x[4 + j] = ldu<u32x4>(rb + j * 1024, l16);
        const u32x4 y = ldu<u32x4>(rb + 8192, (unsigned)(lane & 15) * 16u);
#pragma unroll
        for (int j = 0; j < 12; ++j) asm volatile("" :: "v"(x[j].x));
        asm volatile("" :: "v"(y.x));
    }
}

__device__ __forceinline__ void mix_item(const P& p, int item, int wave, int lane) {
    const int g = item & 7, row0 = (item >> 3) * 128;
    const int dl = lane & 15, q = lane >> 4, col = g * 128 + wave * 16;
    const bf16_t* vn = (const bf16_t*)(p.ws + WS_VN) + (size_t)row0 * MLPW + col + dl;
    bf16x8 A[4];
#pragma unroll
    for (int sb = 0; sb < 4; ++sb)
#pragma unroll
        for (int j = 0; j < 8; ++j) A[sb][j] = (short)vn[(size_t)(32 * sb + 8 * q + j) * MLPW];
    const float* wsg = p.in[23] + ((size_t)g * 128 + dl) * 128 + 8 * q;
    const bf16_t* zu = (const bf16_t*)(p.ws + WS_ZUG) + (size_t)(row0 + dl) * ZUGW + ZU_U + col + 4 * q;
    bf16_t* ub = (bf16_t*)(p.ws + WS_OA) + (size_t)(row0 + dl) * (2 * RW) + RW + col + 4 * q;
#pragma unroll
    for (int tt = 0; tt < 8; ++tt) {
        const int t = 16 * tt + dl;
        f32x4 acc = (f32x4){0.f, 0.f, 0.f, 0.f};
#pragma unroll
        for (int sb = 0; sb <= tt / 2; ++sb) {
            const float* wr = wsg + (size_t)(16 * tt) * 128 + 32 * sb;
            f32x4 w0 = *(const f32x4*)wr, w1 = *(const f32x4*)(wr + 4);
            if (sb == tt / 2) {
#pragma unroll
                for (int e = 0; e < 4; ++e) { if (32 * sb + 8 * q + e > t) w0[e] = 0.f; if (32 * sb + 8 * q + 4 + e > t) w1[e] = 0.f; }
            }
            acc = MFMA16(A[sb], mk_frag(w0, w1), acc);
        }
        const float bias = p.in[24][g * 128 + t];
        const f32x4 u = ld_bf4(zu + (size_t)(16 * tt) * ZUGW);
        const f32x4 o = (acc + bias) * u;
        u32x2v w; w.x = pk2(o[0], o[1]); w.y = pk2(o[2], o[3]); *(u32x2v*)(ub + (size_t)(16 * tt) * (2 * RW)) = w;
    }
}

__device__ __forceinline__ void post_rows(const P& p, int gw, int NGW, int lane) {
    const float* oraw = (const float*)(p.ws + WS_ZRW);
    for (int row = gw; row < M; row += NGW) {
        const size_t off = (size_t)row * RW + lane * 16;
        f32x4 o[4]; float s = 0.f;
#pragma unroll
        for (int j = 0; j < 4; ++j) { o[j] = *(const f32x4*)(oraw + off + 4 * j); s += (o[j][0] + o[j][1]) + (o[j][2] + o[j][3]); }
        s += __shfl_xor(s, 1); s += __shfl_xor(s, 2);
        const float mean = s * (1.f / HS); float qv = 0.f;
#pragma unroll
        for (int j = 0; j < 4; ++j) { o[j] = o[j] - mean; qv += (o[j][0] * o[j][0] + o[j][1] * o[j][1]) + (o[j][2] * o[j][2] + o[j][3] * o[j][3]); }
        qv += __shfl_xor(qv, 1); qv += __shfl_xor(qv, 2);
        const float rstd = rsqrtf(qv * (1.f / HS) + 64e-5f);
        bf16_t* oa = (bf16_t*)(p.ws + WS_OA) + (size_t)row * (2 * RW) + lane * 16; const bf16_t* c2p = (const bf16_t*)(p.ws + WS_C2) + off;
#pragma unroll
        for (int h = 0; h < 2; ++h) {
            const u32x4 c1 = *(const u32x4*)(oa + 8 * h), c2 = *(const u32x4*)(c2p + 8 * h);
            const f32x4 a = o[2 * h] * rstd, b = o[2 * h + 1] * rstd;
            u32x4 w;
            w.x = pk2(a[0] * bflo(c1.x) + bflo(c2.x), a[1] * bfhi(c1.x) + bfhi(c2.x)); w.y = pk2(a[2] * bflo(c1.y) + bflo(c2.y), a[3] * bfhi(c1.y) + bfhi(c2.y));
            w.z = pk2(b[0] * bflo(c1.z) + bflo(c2.z), b[1] * bfhi(c1.z) + bfhi(c2.z)); w.w = pk2(b[2] * bflo(c1.w) + bflo(c2.w), b[3] * bfhi(c1.w) + bfhi(c2.w));
            *(u32x4*)(oa + 8 * h) = w;
        }
    }
}

constexpr int NWAVES = 8, NTHR = NWAVES * 64;
constexpr int RING_BYTES = 131072, LDSCTL_OFF = RING_BYTES, MISC_OFF = LDSCTL_OFF + 320, LDS_BYTES = 147456;

__device__ __forceinline__ void p0_mod_slab(const P& p, LAS unsigned char* lds, int slab, int tid, int lane, int wave) {
    LAS float* red = (LAS float*)(lds + 8 * 12288);
    LAS float* Bl = (LAS float*)(lds + wave * 12288);
    for (int i = tid; i < 144 * 48; i += NTHR) red[i] = 0.f;
    __syncthreads();
    const int n0 = slab * 48, fr = lane & 15, fq = lane >> 4;
    const float* W = p.in[6] + n0;
    f32x4 acc[9][3];
#pragma unroll
    for (int a = 0; a < 9; ++a)
#pragma unroll
        for (int b = 0; b < 3; ++b) acc[a][b] = (f32x4){0.f, 0.f, 0.f, 0.f};
    for (int sc = 0; sc < 4; ++sc) {
        const int kb0 = ((wave + slab) & 7) * 256 + ((sc + (slab >> 3)) & 3) * 64;
        f32x4 v[12];
        int ln = lane; asm volatile("" : "+v"(ln));
        const float* Wk = W + (size_t)kb0 * (6 * D);
        { int r = ln / 12, c4 = ln - r * 12;
#pragma unroll
          for (int t = 0; t < 12; ++t) { v[t] = ldu<f32x4>(Wk, (unsigned)(r * (6 * D) + 4 * c4) * 4u); c4 += 4; r += 5; if (c4 >= 12) { c4 -= 12; r += 1; } } }
        { int r = ln / 12, c4 = ln - r * 12;
#pragma unroll
          for (int t = 0; t < 12; ++t) { *(LAS f32x4*)(Bl + r * 48 + 4 * c4) = v[t]; c4 += 4; r += 5; if (c4 >= 12) { c4 -= 12; r += 1; } } }
        LDS_WAIT(); asm volatile("" ::: "memory");
#pragma unroll
        for (int kb2 = 0; kb2 < 2; ++kb2) {
            const int k0 = kb0 + kb2 * 32 + fq * 8;
            bf16x8 bfr[3];
#pragma unroll
            for (int nt = 0; nt < 3; ++nt) { const LAS float* bp = Bl + (kb2 * 32 + fq * 8) * 48 + nt * 16 + fr;
                u32x4 w; w.x = pk2(bp[0], bp[48]); w.y = pk2(bp[96], bp[144]); w.z = pk2(bp[192], bp[240]); w.w = pk2(bp[288], bp[336]);
                bfr[nt] = __builtin_bit_cast(bf16x8, w); }
            const bf16_t* sil = (const bf16_t*)(p.ws + WS_SILU) + (size_t)fr * D + k0;
            bf16x8 afr[9];
#pragma unroll
            for (int mt = 0; mt < 9; ++mt) afr[mt] = *(const bf16x8*)(sil + (size_t)(mt * 16) * D);
#pragma unroll
            for (int mt = 0; mt < 9; ++mt)
#pragma unroll
                for (int nt = 0; nt < 3; ++nt) acc[mt][nt] = __builtin_amdgcn_mfma_f32_16x16x32_bf16(afr[mt], bfr[nt], acc[mt][nt], 0, 0, 0);
        }
        LDS_WAIT(); asm volatile("" ::: "memory");
    }
    for (int w = 0; w < NWAVES; ++w) {
        if (wave == w) {
#pragma unroll
            for (int mt = 0; mt < 9; ++mt)
#pragma unroll
                for (int nt = 0; nt < 3; ++nt)
#pragma unroll
                    for (int r = 0; r < 4; ++r) { LAS float* q = red + (mt * 16 + 4 * fq + r) * 48 + nt * 16 + fr; *q = *q + acc[mt][nt][r]; }
        }
        __syncthreads();
    }
    float* mod = (float*)(p.ws + WS_MOD);
    for (int i = tid; i < NSEQ * 48; i += NTHR) { const int row = i / 48, c = i % 48; mod[(size_t)row * (6 * D) + n0 + c] = red[row * 48 + c] + p.in[7][n0 + c]; }
    __syncthreads();
}
__device__ __forceinline__ void p0_silu(const P& p, int gt, int NT) {
    bf16_t* sil = (bf16_t*)(p.ws + WS_SILU);
    for (int i = gt; i < 144 * D / 4; i += NT) {
        const int row = i / (D / 4), k = (i - row * (D / 4)) * 4;
        f32x4 v = (f32x4){0.f, 0.f, 0.f, 0.f};
        if (row < NSEQ) { v = *(const f32x4*)((row < NPB ? p.in[4] + (size_t)row * D : p.in[5] + (size_t)(row - NPB) * D) + k);
#pragma unroll
            for (int e = 0; e < 4; ++e) v[e] = v[e] * sigmoidf_(v[e]); }
        u32x2v w; w.x = pk2(v[0], v[1]); w.y = pk2(v[2], v[3]); *(u32x2v*)(sil + (size_t)row * D + k) = w;
    }
}
__device__ __forceinline__ void p0_transpose_item(const float* W, int K, int N, bf16_t* WT, bool swz, LAS float* scr, int item, int lane, int ldw = 0, int kofs = 0) {
    if (ldw == 0) ldw = K;
    const int nblk = N / 32, kb = item / nblk, nb = item % nblk, k0 = 64 * kb, n0 = 32 * nb;
    int r0 = n0;
    if (swz) { r0 = n0 < DFF ? 256 * (n0 >> 7) + (n0 & 127) : 256 * ((n0 - DFF) >> 7) + 128 + ((n0 - DFF) & 127); }
    float tv[32];
#pragma unroll
    for (int i = 0; i < 32; ++i) tv[i] = W[(size_t)(k0 + 2 * i + (lane >> 5)) * N + n0 + (lane & 31)];
#pragma unroll
    for (int i = 0; i < 32; ++i) scr[(2 * i + (lane >> 5)) * 33 + (lane & 31)] = tv[i];
    LDS_WAIT(); asm volatile("" ::: "memory");
    const int c = lane & 7;
#pragma unroll
    for (int j = 0; j < 4; ++j) { const int n = (lane >> 3) + 8 * j; const LAS float* s = scr + (8 * c) * 33 + n;
        u32x4 o; o.x = pk2(s[0 * 33], s[1 * 33]); o.y = pk2(s[2 * 33], s[3 * 33]); o.z = pk2(s[4 * 33], s[5 * 33]); o.w = pk2(s[6 * 33], s[7 * 33]);
        *(u32x4*)(WT + (size_t)(r0 + n) * ldw + kofs + k0 + 8 * c) = o; }
    LDS_WAIT(); asm volatile("" ::: "memory");
}
__device__ __forceinline__ void p0_transposes(const P& p, LAS float* scr, int part, int gw, int NGW, int lane) {
    constexpr int I_IN = (D / 64) * (CIN / 32), I_BA = (RW / 64) * (D / 32), I_OUT = (D / 64) * (D / 32), I_FI = (D / 64) * (2 * DFF / 32), I_FO = (DFF / 64) * (D / 32);
    constexpr int I_L64 = (RW / 32), I_L128 = 2 * (RW / 32);
    unsigned char* ws = p.ws;
    if (part == 0) {
        for (int it = gw; it < I_IN + 2 * I_L64 + I_L128; it += NGW) {
            int r = it;
            if (r < I_IN) { p0_transpose_item(p.in[9], D, CIN, (bf16_t*)(ws + WS_WIN), false, scr, r, lane); continue; } r -= I_IN;
            if (r < I_L64) { p0_transpose_item(p.in[12], 64, RW, (bf16_t*)(ws + WS_LORA), false, scr, r, lane); continue; } r -= I_L64;
            if (r < I_L64) { p0_transpose_item(p.in[14], 64, RW, (bf16_t*)(ws + WS_LORA) + RW * 64, false, scr, r, lane); continue; } r -= I_L64;
            p0_transpose_item(p.in[15], 128, RW, (bf16_t*)(ws + WS_LORA) + 2 * RW * 64, false, scr, r, lane);
        }
    } else {
        for (int it = gw; it < 2 * I_BA + I_OUT + I_FI + I_FO; it += NGW) {
            int r = it;
            if (r < I_BA) { p0_transpose_item(p.in[25], RW, D, (bf16_t*)(ws + WS_WBA), false, scr, r, lane, 2 * RW, 0); continue; } r -= I_BA;
            if (r < I_BA) { p0_transpose_item(p.in[26], RW, D, (bf16_t*)(ws + WS_WBA), false, scr, r, lane, 2 * RW, RW); continue; } r -= I_BA;
            if (r < I_OUT) { p0_transpose_item(p.in[27], D, D, (bf16_t*)(ws + WS_WOUT), false, scr, r, lane); continue; } r -= I_OUT;
            if (r < I_FI) { p0_transpose_item(p.in[29], D, 2 * DFF, (bf16_t*)(ws + WS_WFI), true, scr, r, lane); continue; } r -= I_FI;
            p0_transpose_item(p.in[30], DFF, D, (bf16_t*)(ws + WS_WFO), false, scr, r, lane);
        }
    }
}
__device__ __forceinline__ void norm_row(const float* x, const float* g, const float* scale, const float* shift, bf16_t* h, int lane) {
    f32x4 v[8]; float s = 0.f;
#pragma unroll
    for (int j = 0; j < 8; ++j) { v[j] = *(const f32x4*)(x + 4 * lane + 256 * j); s += (v[j][0] * v[j][0] + v[j][1] * v[j][1]) + (v[j][2] * v[j][2] + v[j][3] * v[j][3]); }
    const float rstd = rsqrtf(wave_sum(s) * (1.f / D) + 1e-6f);
#pragma unroll
    for (int j = 0; j < 8; ++j) { const int k = 4 * lane + 256 * j;
        const f32x4 gg = *(const f32x4*)(g + k), sc = *(const f32x4*)(scale + k), sh = *(const f32x4*)(shift + k);
        const f32x4 o = v[j] * rstd * gg * (sc + 1.f) + sh;
        u32x2v w; w.x = pk2(o[0], o[1]); w.y = pk2(o[2], o[3]); *(u32x2v*)(h + k) = w; }
}
__device__ __forceinline__ void phase_norm(const P& p, int which, int gw, int NGW, int lane) {
    const float* g = which == 0 ? p.in[8] : p.in[28];
    for (int row = gw; row < M; row += NGW) {
        const float* x = which == 0 ? (row < MP ? p.in[0] + (size_t)row * D : p.in[1] + (size_t)(row - MP) * D) : p.out + (size_t)row * D;
        const float* mod = (const float*)(p.ws + WS_MOD) + (size_t)seq_of_row(row) * (6 * D);
        norm_row(x, g, mod + (which == 0 ? 1 : 4) * D, mod + (which == 0 ? 0 : 3) * D, (bf16_t*)(p.ws + WS_H) + (size_t)row * D, lane);
    }
}
__device__ __forceinline__ void phase_lnv(const P& p, int gw, int NGW, int lane) {
    for (int row = gw; row < M; row += NGW) {
        const bf16_t* zv = (const bf16_t*)(p.ws + WS_ZUG) + (size_t)row * ZUGW + ZU_V;
        float v[16]; float s = 0.f;
#pragma unroll
        for (int j = 0; j < 2; ++j) { const u32x4 w = *(const u32x4*)(zv + 8 * lane + 512 * j);
            v[8 * j + 0] = bflo(w.x); v[8 * j + 1] = bfhi(w.x); v[8 * j + 2] = bflo(w.y); v[8 * j + 3] = bfhi(w.y);
            v[8 * j + 4] = bflo(w.z); v[8 * j + 5] = bfhi(w.z); v[8 * j + 6] = bflo(w.w); v[8 * j + 7] = bfhi(w.w); }
#pragma unroll
        for (int i = 0; i < 16; ++i) s += v[i];
        const float mean = wave_sum(s) * (1.f / MLPW);
        float q = 0.f;
#pragma unroll
        for (int i = 0; i < 16; ++i) { v[i] -= mean; q += v[i] * v[i]; }
        const float rstd = rsqrtf(wave_sum(q) * (1.f / MLPW) + 1e-5f);
        bf16_t* vn = (bf16_t*)(p.ws + WS_VN) + (size_t)row * MLPW;
#pragma unroll
        for (int j = 0; j < 2; ++j) { const int c = 8 * lane + 512 * j; float o[8];
#pragma unroll
            for (int e = 0; e < 8; ++e) o[e] = v[8 * j + e] * rstd * p.in[21][c + e] + p.in[22][c + e];
            u32x4 w; w.x = pk2(o[0], o[1]); w.y = pk2(o[2], o[3]); w.z = pk2(o[4], o[5]); w.w = pk2(o[6], o[7]);
            *(u32x4*)(vn + c) = w;
            if (row >= MP) { float* vs = p.out + O_VS + (size_t)(row - MP) * MLPW + c;
                *(f32x4*)vs = (f32x4){o[0], o[1], o[2], o[3]}; *(f32x4*)(vs + 4) = (f32x4){o[4], o[5], o[6], o[7]}; }
        }
    }
}
__device__ __forceinline__ void phase_final(const P& p, int gw, int NGW, int lane) {
    for (int row = gw; row < M; row += NGW) {
        float* x = p.out + (size_t)row * D;
        f32x4 v[8]; float s = 0.f;
#pragma unroll
        for (int j = 0; j < 8; ++j) { v[j] = *(const f32x4*)(x + 4 * lane + 256 * j); s += (v[j][0] * v[j][0] + v[j][1] * v[j][1]) + (v[j][2] * v[j][2] + v[j][3] * v[j][3]); }
        const float rstd = rsqrtf(wave_sum(s) * (1.f / D) + 1e-6f);
#pragma unroll
        for (int j = 0; j < 8; ++j) { const int k = 4 * lane + 256 * j; *(f32x4*)(x + k) = v[j] * rstd * *(const f32x4*)(p.in[31] + k); }
    }
}
__device__ __forceinline__ void mix_naive_row(const P& p, int row, int tid, int nthr) {
    int t;
    if (row < MP) t = (row & (TP - 1)) & 127; else t = (row - MP) & (TS - 1);
    const int rowc0 = row - t;
    const bf16_t* vn = (const bf16_t*)(p.ws + WS_VN);
    const bf16_t* zu = (const bf16_t*)(p.ws + WS_ZUG) + (size_t)row * ZUGW + ZU_U;
    bf16_t* ub = (bf16_t*)(p.ws + WS_OA) + (size_t)row * (2 * RW) + RW;
    for (int c = tid; c < MLPW; c += nthr) {
        const int g = c >> 7; const float* wsg = p.in[23] + ((size_t)g * 128 + t) * 128;
        float acc = 0.f;
        for (int s = 0; s <= t; ++s) acc += wsg[s] * bf2f(vn[(size_t)(rowc0 + s) * MLPW + c]);
        acc += p.in[24][g * 128 + t];
        ub[c] = f2bf(bf2f(zu[c]) * acc);
    }
}

#define PHASE_IDS() int tid = threadIdx.x; asm volatile("" : "+v"(tid)); const int lane = tid & 63, wave = __builtin_amdgcn_readfirstlane(tid >> 6); \
    const int gw = bx * NWAVES + wave, NGW = G * NWAVES; (void)lane; (void)gw; (void)NGW
__global__ void __launch_bounds__(NTHR, 2) mega_fwd(P p) {
    extern __shared__ __attribute__((aligned(16))) unsigned char lds_raw[];
    LAS unsigned char* lds = (LAS unsigned char*)lds_raw;
    const int G = gridDim.x, bx = blockIdx.x;
    unsigned char* ws = p.ws;
#define FLAGS(k) ((unsigned*)(ws + WS_CTL) + CW_FLAGS + (k) * 256)
    { PHASE_IDS();
      for (int u = tid; u < (LDS_BYTES - LDSCTL_OFF) / 4; u += NTHR) ((LAS unsigned*)(lds + LDSCTL_OFF))[u] = 0u; }
    __syncthreads();
    XcdBarrier bar = xcd_barrier_post((unsigned*)(ws + WS_CTL) + CW_BAR, (volatile LAS unsigned*)(lds + MISC_OFF) + 8);
#ifdef TSMASK
    unsigned long long* tsw = (unsigned long long*)(ws + WS_CTL + 524288); int nst = 0;
#define STAMP() do { if (bx == 0 && threadIdx.x == 0) tsw[nst] = __builtin_amdgcn_s_memrealtime(); ++nst; } while (0)
#else
#define STAMP() do { } while (0)
#endif
    STAMP();

    { PHASE_IDS();
      p0_silu(p, bx * NTHR + tid, G * NTHR);
      p0_transposes(p, (LAS float*)(lds + wave * 16384), 0, gw, NGW, lane); }
    xcd_barrier(bar); STAMP();
    { PHASE_IDS();
      for (int slab = bx; slab < 256; slab += G) p0_mod_slab(p, lds, slab, tid, lane, wave); }
    xcd_barrier(bar); STAMP();
    { PHASE_IDS(); phase_norm(p, 0, gw, NGW, lane); }
    xcd_barrier(bar); STAMP();
    {
        pg8::Gemm g{(const bf16_t*)(ws + WS_H), (const bf16_t*)(ws + WS_WIN), M, CIN, D}; SliceOrder S; S.init(M, CIN, D, bx, FLAGS(0), (float*)(ws + WS_VN));
        EpiZ E{(bf16_t*)(ws + WS_ZRW), (bf16_t*)(ws + WS_ZUG), p.out};
        pg8::gemm_phase<EpiZ, SliceOrder, PG8_ALIGN, PG8_SP2>(lds, g, S, E);
    }
    xcd_barrier(bar); STAMP();
    { PHASE_IDS();
      phase_lnv(p, gw, NGW, lane);
      STAMP();
      for (int rec = gw; rec < NREC; rec += NGW) prep_record(p, lds + wave * 16384, rec, lane); }
    xcd_barrier(bar); STAMP();
    { PHASE_IDS();
        const int NPC = NPB * NH;
        volatile LAS unsigned* prog = (volatile LAS unsigned*)(lds + MISC_OFF) + 16;
        if (bx < NPC) { if (wave < 2) scan_chain_prompt(p, bx >> 4, bx & 15, wave, lane, prog); else if (wave >= 4) scan_prefetch(p, prog, bx >> 4, bx & 15, wave - 4, lane); STAMP(); }
        else {
            const int wid = (bx - NPC) * NWAVES + wave, NW = (G - NPC) * NWAVES;
            for (int j = wid; j < NSB * NH * 4; j += NW) scan_chain_sample(p, j >> 6, (j >> 2) & 15, j & 3, lane);
            for (int item = bx - NPC; item < NPB * 16 * 8; item += G - NPC) mix_item(p, item, wave, lane);
            for (int row = MP + bx - NPC; row < M; row += G - NPC) mix_naive_row(p, row, tid, NTHR);
            p0_transposes(p, (LAS float*)(lds + wave * 16384), 1, wid, NW, lane);
        }
    }
    xcd_barrier(bar); STAMP();
    { PHASE_IDS(); post_rows(p, gw, NGW, lane); }
    xcd_barrier(bar); STAMP();
    {
        pg8::Gemm g{(const bf16_t*)(ws + WS_OA), (const bf16_t*)(ws + WS_WBA), M, D, 2 * RW}; SliceOrder S; S.init(M, D, 2 * RW, bx, FLAGS(1), p.out);
        EpiMerge E{(const bf16_t*)(ws + WS_ZUG), (bf16_t*)(ws + WS_H)};
        pg8::gemm_phase<EpiMerge, SliceOrder, PG8_ALIGN, PG8_SP2>(lds, g, S, E);
    }
    xcd_barrier(bar); STAMP();
    {
        pg8::Gemm g{(const bf16_t*)(ws + WS_H), (const bf16_t*)(ws + WS_WOUT), M, D, D}; SliceOrder S; S.init(M, D, D, bx, FLAGS(2), (float*)(ws + WS_VN));
        EpiRes1 E{p.in[0], p.in[1], (const float*)(ws + WS_MOD), p.out};
        pg8::gemm_phase<EpiRes1, SliceOrder, PG8_ALIGN, PG8_SP2>(lds, g, S, E);
    }
    xcd_barrier(bar); STAMP();
    { PHASE_IDS(); phase_norm(p, 1, gw, NGW, lane); }
    xcd_barrier(bar); STAMP();
    {
        pg8::Gemm g{(const bf16_t*)(ws + WS_H), (const bf16_t*)(ws + WS_WFI), M, 2 * DFF, D}; SliceOrder S; S.init(M, 2 * DFF, D, bx, FLAGS(3), (float*)(ws + WS_VN));
        EpiSwiglu E{(bf16_t*)(ws + WS_ZUG)};
        pg8::gemm_phase<EpiSwiglu, SliceOrder, PG8_ALIGN, PG8_SP2>(lds, g, S, E);
    }
    xcd_barrier(bar); STAMP();
    {
        pg8::Gemm g{(const bf16_t*)(ws + WS_ZUG), (const bf16_t*)(ws + WS_WFO), M, D, DFF}; SliceOrder S; S.init(M, D, DFF, bx, FLAGS(4), (float*)(ws + WS_VN));
        EpiRes2 E{(const float*)(ws + WS_MOD), p.out};
        pg8::gemm_phase<EpiRes2, SliceOrder, PG8_ALIGN, PG8_SP2>(lds, g, S, E);
    }
    xcd_barrier(bar); STAMP();
    { PHASE_IDS(); phase_final(p, gw, NGW, lane); }
#ifdef TSMASK
    STAMP();
    if (bx == 0 && threadIdx.x == 0) {
        unsigned long long tot = 0;
        for (int k = 0; k < nst - 1; ++k) if ((TSMASK >> k) & 1) tot += tsw[k + 1] - tsw[k];
        p.out[0] += (float)tot * (1.0f / 20000.0f);
    }
#endif
}

extern "C" void kernel_launch(void* const* d_in, const int* in_sizes, int n_in, void* d_out, int out_size, void* d_ws, size_t ws_size, hipStream_t stream) {
    static int grid = 0;
    if (grid == 0) {
        if (n_in != 32 || (size_t)out_size != O_END || ws_size < WS_END) { fprintf(stderr, "kernel_launch: unexpected shapes n_in=%d out=%d ws=%zu (need %zu)\n", n_in, out_size, ws_size, (size_t)WS_END); grid = -1; return; }
        int dev = 0, cus = 0, per_cu = 0;
        if (hipGetDevice(&dev) != hipSuccess || hipDeviceGetAttribute(&cus, hipDeviceAttributeMultiprocessorCount, dev) != hipSuccess) { grid = -1; return; }
        if (hipFuncSetAttribute((const void*)mega_fwd, hipFuncAttributeMaxDynamicSharedMemorySize, LDS_BYTES) != hipSuccess) { fprintf(stderr, "kernel_launch: hipFuncSetAttribute failed\n"); grid = -1; return; }
        if (hipOccupancyMaxActiveBlocksPerMultiprocessor(&per_cu, (const void*)mega_fwd, NTHR, LDS_BYTES) != hipSuccess || per_cu < 1) { fprintf(stderr, "kernel_launch: occupancy query says %d blocks per CU\n", per_cu); }
        (void)hipGetLastError();
        grid = cus;
        if (grid != 256) { fprintf(stderr, "kernel_launch: built for 256 CUs (got %d)\n", cus); grid = -1; return; }
        if (grid < 128) { fprintf(stderr, "kernel_launch: this kernel's phase plan needs >= 128 CUs (got %d)\n", cus); grid = -1; return; }
    }
    if (grid < 0) return;
    if (hipMemsetAsync((char*)d_ws + WS_CTL, 0, CTL_ZERO_BYTES, stream) != hipSuccess) { fprintf(stderr, "kernel_launch: memset failed\n"); return; }
    P p{};
    for (int i = 0; i < 32; ++i) p.in[i] = (const float*)d_in[i];
    p.out = (float*)d_out; p.ws = (unsigned char*)d_ws;
    hipLaunchKernelGGL(mega_fwd, dim3(grid), dim3(NTHR), LDS_BYTES, stream, p);
    const hipError_t le = hipPeekAtLastError();
    if (le != hipSuccess) fprintf(stderr, "kernel_launch: launch failed: %s\n", hipGetErrorName(le));
}
```

```cpp
#include <hip/hip_runtime.h>
#include <cstdio>
#include <cstdint>

constexpr int D = 2048, NPB = 4, TP = 2048, NSB = 128, TS = 8;
constexpr int MP = NPB * TP, MS = NSB * TS, M = MP + MS;
constexpr int RW = 1024, NH = 16, HS = 64;
constexpr int CSH = 3328, CIN = 9472, DFF = 5632, MLPW = 1024;
constexpr int C_U = CSH, C_V = CSH + 1024, C_G0 = CSH + 2048, C_G1 = C_G0 + 2048;
constexpr int ZUGW = CIN - CSH, ZU_U = 0, ZU_V = 1024, ZU_G0 = 2048, ZU_G1 = 4096;
constexpr int NSEQ = NPB + NSB;
constexpr size_t O_YP = 0, O_YS = O_YP + (size_t)MP * D, O_WKVP = O_YS + (size_t)MS * D, O_SHP = O_WKVP + (size_t)NPB * NH * HS * HS,
                 O_WKVS = O_SHP + (size_t)NPB * CSH, O_SHS = O_WKVS + (size_t)NSB * NH * HS * HS, O_VS = O_SHS + (size_t)NSB * CSH,
                 O_END = O_VS + (size_t)MS * MLPW;
constexpr size_t WS_CTL = 0, CTL_ZERO_BYTES = 1u << 20;
constexpr size_t WS_WIN = CTL_ZERO_BYTES;
constexpr size_t WS_WBA = WS_WIN + (size_t)CIN * D * 2;
constexpr size_t WS_WBB = WS_WBA + (size_t)D * RW * 2;
constexpr size_t WS_WOUT = WS_WBB + (size_t)D * RW * 2;
constexpr size_t WS_WFI = WS_WOUT + (size_t)D * D * 2;
constexpr size_t WS_WFO = WS_WFI + (size_t)2 * DFF * D * 2;
constexpr size_t WS_MOD = WS_WFO + (size_t)D * DFF * 2;
constexpr size_t WS_H = WS_MOD + (size_t)NSEQ * 6 * D * 4;
constexpr size_t WS_ZRW = WS_H + (size_t)M * D * 2;
constexpr size_t WS_ZUG = WS_ZRW + (size_t)M * CSH * 2;
constexpr size_t WS_VN = WS_ZUG + (size_t)M * ZUGW * 2;
constexpr size_t WS_OA = WS_VN + (size_t)M * MLPW * 2;
constexpr size_t WS_UB = WS_OA + (size_t)M * RW * 2;
constexpr size_t WS_C2 = WS_UB + (size_t)M * MLPW * 2;
constexpr size_t WS_LORA = WS_C2 + (size_t)M * RW * 2;
constexpr size_t WS_SILU = WS_LORA + (size_t)RW * 256 * 2;
constexpr size_t WS_FRA_S = WS_SILU + (size_t)144 * D * 2;
constexpr size_t WS_FRB_S = WS_FRA_S + (size_t)NSB * NH * 4096;
constexpr size_t WS_END = WS_FRB_S + (size_t)NSB * NH * 8448;
constexpr int NREC_P = NPB * 128 * NH, NREC = NREC_P + NSB * NH;
constexpr int RECA = 4096, RECB = 8448;
static_assert(WS_C2 + (size_t)M * RW * 2 - WS_VN >= (size_t)256 * 262144, "stream-K slabs (256 x 256 KiB) fit VN | OA|UB | C2");
static_assert((size_t)NREC_P * RECA <= (size_t)M * D * 2 && (size_t)NREC_P * RECB <= (size_t)M * D * 4, "prompt fragment records fit the H buffer / the y region of d_out");
constexpr int CW_BAR = 4096, CW_PREPQ = 16384, CW_FLAGS = 32768;

typedef float f32x2v __attribute__((ext_vector_type(2)));
typedef __bf16 bf16x2v __attribute__((ext_vector_type(2)));
typedef unsigned u32x2v __attribute__((ext_vector_type(2)));

struct P { const float* in[32]; float* out; unsigned char* ws; };

__device__ __forceinline__ unsigned pk2(float lo, float hi) { return __builtin_bit_cast(unsigned, __builtin_convertvector((f32x2v){lo, hi}, bf16x2v)); }
__device__ __forceinline__ unsigned short f2bf(float f) { return (unsigned short)(pk2(f, 0.f) & 0xffffu); }
__device__ __forceinline__ float bf2f(unsigned short h) { return __uint_as_float(((unsigned)h) << 16); }
__device__ __forceinline__ float bflo(unsigned w) { return __uint_as_float(w << 16); }
__device__ __forceinline__ float bfhi(unsigned w) { return __uint_as_float(w & 0xffff0000u); }
__device__ __forceinline__ float sigmoidf_(float x) { return __builtin_amdgcn_rcpf(1.f + __expf(-x)); }
__device__ __forceinline__ float gelu_tanh(float x) {
    const float u = 0.7978845608028654f * (x + 0.044715f * x * x * x); return x * __builtin_amdgcn_rcpf(1.f + __expf(-2.f * u)); }
__device__ __forceinline__ float wave_sum(float v) {
#pragma unroll
    for (int o = 1; o < 64; o <<= 1) v += __shfl_xor(v, o);
    return v;
}
__device__ __forceinline__ int seq_of_row(int row) { return row < MP ? row / TP : NPB + (row - MP) / TS; }

namespace pg8 {
#define PG8_LAS __attribute__((address_space(3)))
typedef unsigned short bf16_t;
typedef short bf16x8 __attribute__((ext_vector_type(8)));
typedef float f32x4 __attribute__((ext_vector_type(4)));
typedef unsigned u32x4 __attribute__((ext_vector_type(4)));
constexpr int BM = 256, BK = 64, HALF = 128, HTB = HALF * BK * 2  , STAGE_BYTES = 8 * HTB, NXCD = 8, WGM = 8;

__host__ __device__ __forceinline__ int lds_byte(int r, int c) { const int st = (r >> 4) * 2 + (c >> 5), rr = r & 15, cc = c & 31, ob = rr * 64 + cc * 2; return st * 1024 + (ob ^ (((ob >> 9) & 1) << 5)); }
__host__ __device__ __forceinline__ void stage_rc(int b, int& R, int& C) { const int st = b / 1024, sb = b % 1024, swz = sb ^ (((sb >> 9) & 1) << 5); R = (st >> 1) * 16 + swz / 64; C = (st & 1) * 32 + (swz % 64) / 2; }
__host__ __device__ __forceinline__ int perm32(int rho) { const int n = rho >> 4, i = rho & 15; return 8 * (i >> 2) + 4 * n + (i & 3); }

struct Unit { int pm, pn, kb, nk, kind, peer; };
struct Gemm { const bf16_t* A; const bf16_t* Bt; int M, N, K; };

struct StaticOrder {
    int nM, nN, nwg, G, c;
    __host__ __device__ void init(int M, int N, int G_, int c_) { nM = M / BM; nN = N / BM; nwg = nM * nN; G = G_; c = c_; }
    __host__ __device__ bool next(int i, Unit& u) const {
        const long L = (long)i * G + c; if (L >= nwg) return false;
        int wgid = (int)L; { const int q = nwg / NXCD, r = nwg % NXCD, xcd = wgid % NXCD, off = wgid / NXCD; wgid = (xcd < r ? xcd * (q + 1) : r * (q + 1) + (xcd - r) * q) + off; }
        const int nig = WGM * nN, gid = wgid / nig, fm = gid * WGM, gsz = (nM - fm) < WGM ? (nM - fm) : WGM;
        u.pm = fm + ((wgid % nig) % gsz); u.pn = (wgid % nig) / gsz; return true;
    }
    __device__ __forceinline__ void a_ready(const Unit&) const {}
    __device__ __forceinline__ void done(const Unit&) const {}
};
template <class Epi, class Sched, bool ALIGN_EPI = false, bool SP2 = false>
__device__ __forceinline__ void gemm_phase(PG8_LAS unsigned char* lds, const Gemm g, const Sched& S, const Epi& E) {
    int tid_ = threadIdx.x; asm volatile("" : "+v"(tid_));
    const int tid = tid_, wid = __builtin_amdgcn_readfirstlane(tid >> 6), lane = tid & 63, wr = wid >> 2, wc = wid & 3, fr = lane & 15, fq = lane >> 4;
    const int K = g.K;
    unsigned voffA[2], voffB[2];
#pragma unroll
    for (int i = 0; i < 2; ++i) { int R, C; stage_rc(tid * 16 + i * 8192, R, C); const int Rb = Epi::PERM ? ((R & ~31) + perm32(R & 31)) : R;
        voffA[i] = (unsigned)(R * K + C) * 2u; voffB[i] = (unsigned)(Rb * K + C) * 2u; }
    const size_t kstep = (size_t)(BK * 2);
    const size_t hstep = (size_t)HALF * K * 2;
    const size_t tstep = 2 * hstep;
    const unsigned ldsw = (unsigned)wid * 1024u;
    const int aoff = lds_byte(wr * 64 + fr, fq * 8), boff = lds_byte(wc * 32 + fr, fq * 8);
#define PG8_SA(b, h) (((b) * 2 + (h)) * HTB)
#define PG8_SB(b, h) ((4 + (b) * 2 + (h)) * HTB)
#define PG8_STAGE(bufoff, gbase, voff) do { _Pragma("unroll") for (int _i = 0; _i < 2; ++_i) \
        __builtin_amdgcn_global_load_lds((const unsigned*)((const char*)(gbase) + (voff)[_i]), (PG8_LAS unsigned*)(lds + (bufoff) + ldsw + _i * 8192), 16, 0, 0); } while (0)
#define PG8_LDA(dst, b, h) do { _Pragma("unroll") for (int m = 0; m < 4; ++m) _Pragma("unroll") for (int k = 0; k < 2; ++k) dst[m][k] = *(const PG8_LAS bf16x8*)(lds + PG8_SA(b, h) + aoff + m * 2048 + k * 1024); } while (0)
#define PG8_LDB(dst, b, h) do { _Pragma("unroll") for (int n = 0; n < 2; ++n) _Pragma("unroll") for (int k = 0; k < 2; ++k) dst[n][k] = *(const PG8_LAS bf16x8*)(lds + PG8_SB(b, h) + boff + n * 2048 + k * 1024); } while (0)
#define PG8_MMA(ai, bj, At, Bt) do { __builtin_amdgcn_s_setprio(1); _Pragma("unroll") for (int m = 0; m < 4; ++m) _Pragma("unroll") for (int n = 0; n < 2; ++n) _Pragma("unroll") for (int k = 0; k < 2; ++k) \
        acc[ai][bj][m][n] = __builtin_amdgcn_mfma_f32_16x16x32_bf16(Bt[n][k], At[m][k], acc[ai][bj][m][n], 0, 0, 0); __builtin_amdgcn_s_setprio(0); } while (0)
#define PG8_WAIT_V(n) asm volatile("s_waitcnt vmcnt(" #n ")" ::: "memory")
#define PG8_WAIT_L(n) asm volatile("s_waitcnt lgkmcnt(" #n ")" ::: "memory")
#define PG8_BAR __builtin_amdgcn_s_barrier()
#define PG8_SCHED __builtin_amdgcn_sched_barrier(0)
    Unit cur, nxt; int ui = 0;
    if (!S.next(0, cur)) return;
    f32x4 acc[2][2][4][2];
#pragma unroll
    for (int a = 0; a < 2; ++a)
#pragma unroll
        for (int b = 0; b < 2; ++b)
#pragma unroll
            for (int m = 0; m < 4; ++m)
#pragma unroll
                for (int n = 0; n < 2; ++n) acc[a][b][m][n] = (f32x4){0.f, 0.f, 0.f, 0.f};
    bf16x8 At[4][2], B0[2][2], B1[2][2];
    const char* cA = (const char*)g.A + (size_t)cur.pm * tstep + (size_t)cur.kb * kstep; const char* cB = (const char*)g.Bt + (size_t)cur.pn * tstep + (size_t)cur.kb * kstep;
    S.a_ready(cur);
    if constexpr (SP2) {
        PG8_STAGE(PG8_SB(0, 0), cB, voffB); PG8_STAGE(PG8_SB(0, 1), cB + hstep, voffB); PG8_STAGE(PG8_SA(0, 0), cA, voffA); PG8_STAGE(PG8_SA(0, 1), cA + hstep, voffA);
        if (wr == 1) PG8_BAR;
        PG8_WAIT_V(2); PG8_BAR;
        PG8_STAGE(PG8_SB(1, 0), cB + kstep, voffB); PG8_STAGE(PG8_SA(1, 0), cA + kstep, voffA); PG8_STAGE(PG8_SB(1, 1), cB + hstep + kstep, voffB);
        PG8_WAIT_V(6); PG8_BAR;
    } else {
        PG8_STAGE(PG8_SB(0, 0), cB, voffB); PG8_STAGE(PG8_SA(0, 0), cA, voffA); PG8_STAGE(PG8_SB(0, 1), cB + hstep, voffB); PG8_STAGE(PG8_SA(0, 1), cA + hstep, voffA);
        if (wr == 1) PG8_BAR;
        PG8_WAIT_V(4); PG8_BAR;
        PG8_STAGE(PG8_SB(1, 0), cB + kstep, voffB); PG8_STAGE(PG8_SA(1, 0), cA + kstep, voffA); PG8_STAGE(PG8_SB(1, 1), cB + hstep + kstep, voffB);
        PG8_WAIT_V(6); PG8_BAR;
    }
    for (;;) {
        const bool has_next = S.next(ui + 1, nxt);
        const char* nA = has_next ? (const char*)g.A + (size_t)nxt.pm * tstep + (size_t)nxt.kb * kstep : cA; const char* nB = has_next ? (const char*)g.Bt + (size_t)nxt.pn * tstep + (size_t)nxt.kb * kstep : cB;
        const int nt = cur.nk;
        for (int t = 0; t < nt; t += 2) {
            const bool last = (t == nt - 2);
            if constexpr (Epi::HOOK_TILE > 0) { if (cur.kb + t == Epi::HOOK_TILE && t > 0) E.mid(acc, cur, wr, wc, fr, fq); }
            const char* a1 = cA + (size_t)(t + 1) * kstep;
            const char* a2 = last ? nA : cA + (size_t)(t + 2) * kstep; const char* b2 = last ? nB : cB + (size_t)(t + 2) * kstep;
            const char* a3 = a2 + kstep; const char* b3 = b2 + kstep;
            if (last && has_next) S.a_ready(nxt);
            if constexpr (SP2) {
            PG8_LDB(B0, 0, 0); PG8_LDB(B1, 0, 1); PG8_SCHED; PG8_LDA(At, 0, 0); PG8_STAGE(PG8_SA(1, 1), a1 + hstep, voffA);
            PG8_WAIT_V(8); PG8_WAIT_L(0); PG8_BAR; PG8_MMA(0, 0, At, B0); PG8_MMA(0, 1, At, B1); PG8_BAR; PG8_SCHED;
            PG8_LDA(At, 0, 1); PG8_STAGE(PG8_SB(0, 0), b2, voffB); PG8_STAGE(PG8_SB(0, 1), b2 + hstep, voffB); PG8_STAGE(PG8_SA(0, 0), a2, voffA);
            PG8_WAIT_V(8); PG8_WAIT_L(0); PG8_BAR; PG8_MMA(1, 0, At, B0); PG8_MMA(1, 1, At, B1); PG8_BAR; PG8_SCHED;
            PG8_LDB(B0, 1, 0); PG8_LDB(B1, 1, 1); PG8_SCHED; PG8_LDA(At, 1, 0); PG8_STAGE(PG8_SA(0, 1), a2 + hstep, voffA);
            PG8_WAIT_V(8); PG8_WAIT_L(0); PG8_BAR; PG8_MMA(0, 0, At, B0); PG8_MMA(0, 1, At, B1); PG8_BAR; PG8_SCHED;
            PG8_LDA(At, 1, 1); PG8_STAGE(PG8_SB(1, 0), b3, voffB); PG8_STAGE(PG8_SB(1, 1), b3 + hstep, voffB); PG8_STAGE(PG8_SA(1, 0), a3, voffA);
            PG8_WAIT_V(8); PG8_WAIT_L(0); PG8_BAR; PG8_MMA(1, 0, At, B0); PG8_MMA(1, 1, At, B1); PG8_BAR; PG8_SCHED;
            } else {
            PG8_LDB(B0, 0, 0); PG8_SCHED; PG8_LDA(At, 0, 0); PG8_STAGE(PG8_SA(1, 1), a1 + hstep, voffA);
            PG8_WAIT_L(8); PG8_BAR; PG8_WAIT_L(0); PG8_MMA(0, 0, At, B0); PG8_BAR; PG8_SCHED;
            PG8_LDB(B1, 0, 1); PG8_STAGE(PG8_SB(0, 0), b2, voffB);
            PG8_BAR; PG8_WAIT_L(0); PG8_MMA(0, 1, At, B1); PG8_BAR;
            PG8_LDA(At, 0, 1); PG8_STAGE(PG8_SA(0, 0), a2, voffA);
            PG8_BAR; PG8_WAIT_L(0); PG8_MMA(1, 0, At, B0); PG8_BAR; PG8_SCHED;
            PG8_STAGE(PG8_SB(0, 1), b2 + hstep, voffB);
            PG8_WAIT_V(6); PG8_BAR; PG8_MMA(1, 1, At, B1); PG8_BAR;
            PG8_LDB(B0, 1, 0); PG8_SCHED; PG8_LDA(At, 1, 0); PG8_STAGE(PG8_SA(0, 1), a2 + hstep, voffA);
            PG8_WAIT_L(8); PG8_BAR; PG8_WAIT_L(0); PG8_MMA(0, 0, At, B0); PG8_BAR; PG8_SCHED;
            PG8_LDB(B1, 1, 1); PG8_STAGE(PG8_SB(1, 0), b3, voffB);
            PG8_BAR; PG8_WAIT_L(0); PG8_MMA(0, 1, At, B1); PG8_BAR;
            PG8_LDA(At, 1, 1); PG8_STAGE(PG8_SA(1, 0), a3, voffA);
            PG8_BAR; PG8_WAIT_L(0); PG8_MMA(1, 0, At, B0); PG8_BAR; PG8_SCHED;
            PG8_STAGE(PG8_SB(1, 1), b3 + hstep, voffB);
            PG8_WAIT_V(6); PG8_BAR; PG8_MMA(1, 1, At, B1); PG8_BAR;
            }
        }
        if constexpr (ALIGN_EPI) { if (wr == 0) PG8_BAR; }
        if constexpr (Epi::HOOK_TILE > 0) { if (cur.kb + cur.nk <= Epi::HOOK_TILE) E.mid(acc, cur, wr, wc, fr, fq); }
        if (cur.kind == 3) {
            int fr_ = fr; asm volatile("" : "+v"(fr_));
            const int ti4 = (wid * 64 + fq * 16 + fr_) * 4;
            {
                float* slw = S.slab + (size_t)(cur.peer * S.nsl + S.s) * 65536;
                const __amdgpu_buffer_rsrc_t rs = __builtin_amdgcn_make_buffer_rsrc(slw, 0, 262144, 0x00020000);
#pragma unroll
                for (int a = 0; a < 2; ++a)
#pragma unroll
                    for (int b = 0; b < 2; ++b)
#pragma unroll
                        for (int m = 0; m < 4; ++m)
#pragma unroll
                            for (int n = 0; n < 2; ++n)
                                __builtin_amdgcn_raw_buffer_store_b128(__builtin_bit_cast(u32x4, acc[a][b][m][n]), rs, (ti4 + (((a * 2 + b) * 4 + m) * 2 + n) * 2048) * 4, 0, 16);
            }
            PG8_WAIT_V(0); PG8_BAR;
            if (wid == 0 && (fq | fr) == 0) {
                __hip_atomic_fetch_add(S.cnt + cur.peer, 1u, __ATOMIC_RELAXED, __HIP_MEMORY_SCOPE_AGENT);
                unsigned sp = 0; while (__hip_atomic_load(S.cnt + cur.peer, __ATOMIC_RELAXED, __HIP_MEMORY_SCOPE_AGENT) < (unsigned)S.nsl && ++sp < (1u << 22)) __builtin_amdgcn_s_sleep(2);
                __builtin_amdgcn_fence(__ATOMIC_ACQUIRE, "agent"); PG8_WAIT_V(0);
            }
            PG8_BAR; asm volatile("" ::: "memory");
            for (int blk = S.s; blk < 8; blk += S.nsl) {
                const int a = blk >> 2, m0 = blk & 3;
                f32x4 r[4];
#pragma unroll
                for (int v = 0; v < 4; ++v) r[v] = (f32x4){0.f, 0.f, 0.f, 0.f};
                for (int s2 = 0; s2 < S.nsl; ++s2) {
                    const float* ss = S.slab + (size_t)(cur.peer * S.nsl + s2) * 65536 + ti4;
#pragma unroll
                    for (int v = 0; v < 4; ++v) r[v] += *(const f32x4*)(ss + (size_t)((((a * 2 + (v >> 1)) * 4 + m0) * 2 + (v & 1)) * 2048));
                }
                E.rg(r[0], r[1], r[2], r[3], cur, a, m0, wr, wc, fr, fq);
            }
        } else {
            E(acc, cur, wr, wc, fr, fq);
        }
        if (!has_next) break;
#pragma unroll
        for (int a = 0; a < 2; ++a)
#pragma unroll
            for (int b = 0; b < 2; ++b)
#pragma unroll
                for (int m = 0; m < 4; ++m)
#pragma unroll
                    for (int n = 0; n < 2; ++n) acc[a][b][m][n] = (f32x4){0.f, 0.f, 0.f, 0.f};
        cur = nxt; cA = nA; cB = nB; ++ui;
        if constexpr (ALIGN_EPI) { if (wr == 1) PG8_BAR; }
    }
    PG8_WAIT_V(0);
    if constexpr (!ALIGN_EPI) { if (wr == 0) PG8_BAR; }
    PG8_BAR;
    if constexpr (Epi::AFTER_DRAIN) { E.fused(acc, cur, wr, wc, fr, fq, lds, wid, lane); S.done(cur); }
#undef PG8_SA
#undef PG8_SB
#undef PG8_STAGE
#undef PG8_LDA
#undef PG8_LDB
#undef PG8_MMA
#undef PG8_WAIT_V
#undef PG8_WAIT_L
#undef PG8_BAR
#undef PG8_SCHED
}
}
#define PG8_SP2 true
#define PG8_ALIGN true

using pg8::f32x4; using pg8::Unit; using pg8::BM; using pg8::HALF; typedef pg8::u32x4 u32x4;
typedef unsigned short bf16_t;

#define EPI_WALK() __device__ __forceinline__ void operator()(const f32x4 (&acc)[2][2][4][2], const Unit& u, int wr, int wc, int fr, int fq) const { \
        _Pragma("unroll") for (int ai = 0; ai < 2; ++ai) _Pragma("unroll") for (int m = 0; m < 4; ++m) { \
            rg(acc[ai][0][m][0], acc[ai][0][m][1], acc[ai][1][m][0], acc[ai][1][m][1], u, ai, m, wr, wc, fr, fq); asm volatile("" ::: "memory"); } }

struct EpiZ {
    static constexpr int HOOK_TILE = 0;
    static constexpr bool PERM = true, AFTER_DRAIN = false;
    bf16_t* zrw; bf16_t* zug; float* out;
    __device__ __forceinline__ void rg(f32x4 v00, f32x4 v01, f32x4 v10, f32x4 v11, const Unit& u, int ai, int m, int wr, int wc, int fr, int fq) const {
        const int colt = u.pn * BM;
        const int mode = colt < CSH ? 0 : (colt < C_G0 ? 1 : 2);
        const int row = u.pm * BM + wr * 64 + fr + ai * HALF + m * 16, col0 = colt + wc * 32 + 8 * fq;
        bf16_t* rowp = mode == 0 ? zrw + (size_t)row * CSH + col0 : zug + (size_t)row * ZUGW + (col0 - CSH);
        if (mode == 0) {
            bool last; float* sh;
            if (row < MP) { last = (row & (TP - 1)) == TP - 1; sh = out + O_SHP + (size_t)(row / TP) * CSH + col0; }
            else { const int rs = row - MP; last = (rs & (TS - 1)) == TS - 1; sh = out + O_SHS + (size_t)(rs / TS) * CSH + col0; }
            if (last) { *(f32x4*)sh = v00; *(f32x4*)(sh + 4) = v01; *(f32x4*)(sh + HALF) = v10; *(f32x4*)(sh + HALF + 4) = v11; }
        } else if (mode == 1) {
#pragma unroll
            for (int e = 0; e < 4; ++e) { v00[e] = gelu_tanh(v00[e]); v01[e] = gelu_tanh(v01[e]); v10[e] = gelu_tanh(v10[e]); v11[e] = gelu_tanh(v11[e]); }
        } else {
#pragma unroll
            for (int e = 0; e < 4; ++e) { v00[e] = sigmoidf_(v00[e]); v01[e] = sigmoidf_(v01[e]); v10[e] = sigmoidf_(v10[e]); v11[e] = sigmoidf_(v11[e]); }
        }
        u32x4 w; w.x = pk2(v00[0], v00[1]); w.y = pk2(v00[2], v00[3]); w.z = pk2(v01[0], v01[1]); w.w = pk2(v01[2], v01[3]);
        *(u32x4*)rowp = w;
        w.x = pk2(v10[0], v10[1]); w.y = pk2(v10[2], v10[3]); w.z = pk2(v11[0], v11[1]); w.w = pk2(v11[2], v11[3]);
        *(u32x4*)(rowp + HALF) = w;
    }
    EPI_WALK()
};
struct EpiMerge {
    static constexpr int HOOK_TILE = 16;
    static constexpr bool PERM = true, AFTER_DRAIN = false;
    const bf16_t* z; bf16_t* mg;
    __device__ __forceinline__ void mid(f32x4 (&acc)[2][2][4][2], const Unit& u, int wr, int wc, int fr, int fq) const {
        asm volatile("" : "+v"(fr));
        const int row0 = u.pm * BM + wr * 64 + fr, col0 = u.pn * BM + wc * 32 + 8 * fq;
#pragma unroll
        for (int ai = 0; ai < 2; ++ai)
#pragma unroll
            for (int m = 0; m < 4; ++m) {
                const bf16_t* zr = z + (size_t)(row0 + ai * HALF + m * 16) * ZUGW + col0;
#pragma unroll
                for (int bj = 0; bj < 2; ++bj) {
                    const u32x4 g0 = *(const u32x4*)(zr + ZU_G0 + bj * HALF), g1 = *(const u32x4*)(zr + ZU_G1 + bj * HALF);
                    f32x4& v0 = acc[ai][bj][m][0]; f32x4& v1 = acc[ai][bj][m][1];
                    v0[0] *= bflo(g0.x) * __builtin_amdgcn_rcpf(fmaxf(bflo(g1.x), 1e-30f)); v0[1] *= bfhi(g0.x) * __builtin_amdgcn_rcpf(fmaxf(bfhi(g1.x), 1e-30f));
                    v0[2] *= bflo(g0.y) * __builtin_amdgcn_rcpf(fmaxf(bflo(g1.y), 1e-30f)); v0[3] *= bfhi(g0.y) * __builtin_amdgcn_rcpf(fmaxf(bfhi(g1.y), 1e-30f));
                    v1[0] *= bflo(g0.z) * __builtin_amdgcn_rcpf(fmaxf(bflo(g1.z), 1e-30f)); v1[1] *= bfhi(g0.z) * __builtin_amdgcn_rcpf(fmaxf(bfhi(g1.z), 1e-30f));
                    v1[2] *= bflo(g0.w) * __builtin_amdgcn_rcpf(fmaxf(bflo(g1.w), 1e-30f)); v1[3] *= bfhi(g0.w) * __builtin_amdgcn_rcpf(fmaxf(bfhi(g1.w), 1e-30f));
                }
                asm volatile("" ::: "memory");
            }
    }
    __device__ __forceinline__ void rg(f32x4 v00, f32x4 v01, f32x4 v10, f32x4 v11, const Unit& u, int ai, int m, int wr, int wc, int fr, int fq) const {
        const int row = u.pm * BM + wr * 64 + fr + ai * HALF + m * 16, col0 = u.pn * BM + wc * 32 + 8 * fq;
        const bf16_t* zr = z + (size_t)row * ZUGW + ZU_G1 + col0;
        const u32x4 ga = *(const u32x4*)zr, gb = *(const u32x4*)(zr + HALF);
        u32x4 w;
        w.x = pk2(bflo(ga.x) * v00[0], bfhi(ga.x) * v00[1]); w.y = pk2(bflo(ga.y) * v00[2], bfhi(ga.y) * v00[3]);
        w.z = pk2(bflo(ga.z) * v01[0], bfhi(ga.z) * v01[1]); w.w = pk2(bflo(ga.w) * v01[2], bfhi(ga.w) * v01[3]);
        *(u32x4*)(mg + (size_t)row * D + col0) = w;
        w.x = pk2(bflo(gb.x) * v10[0], bfhi(gb.x) * v10[1]); w.y = pk2(bflo(gb.y) * v10[2], bfhi(gb.y) * v10[3]);
        w.z = pk2(bflo(gb.z) * v11[0], bfhi(gb.z) * v11[1]); w.w = pk2(bflo(gb.w) * v11[2], bfhi(gb.w) * v11[3]);
        *(u32x4*)(mg + (size_t)row * D + col0 + HALF) = w;
    }
    EPI_WALK()
};
struct EpiRes1 {
    static constexpr int HOOK_TILE = 0;
    static constexpr bool PERM = false, AFTER_DRAIN = false;
    const float* xp; const float* xs; const float* mod; float* out;
    __device__ __forceinline__ void rg(f32x4 v00, f32x4 v01, f32x4 v10, f32x4 v11, const Unit& u, int ai, int m, int wr, int wc, int fr, int fq) const {
        const int row = u.pm * BM + wr * 64 + fr + ai * HALF + m * 16, col0 = u.pn * BM + wc * 32 + 4 * fq;
        const float* xr = (row < MP ? xp + (size_t)row * D : xs + (size_t)(row - MP) * D) + col0;
        const float* gm = mod + (size_t)seq_of_row(row) * (6 * D) + 2 * D + col0;
        float* o = out + (size_t)row * D + col0;
        *(f32x4*)o = *(const f32x4*)xr + *(const f32x4*)gm * v00;
        *(f32x4*)(o + 16) = *(const f32x4*)(xr + 16) + *(const f32x4*)(gm + 16) * v01;
        *(f32x4*)(o + HALF) = *(const f32x4*)(xr + HALF) + *(const f32x4*)(gm + HALF) * v10;
        *(f32x4*)(o + HALF + 16) = *(const f32x4*)(xr + HALF + 16) + *(const f32x4*)(gm + HALF + 16) * v11;
    }
    EPI_WALK()
};
struct EpiSwiglu {
    static constexpr int HOOK_TILE = 0;
    static constexpr bool PERM = true, AFTER_DRAIN = false;
    bf16_t* act;
    __device__ __forceinline__ void rg(f32x4 v00, f32x4 v01, f32x4 v10, f32x4 v11, const Unit& u, int ai, int m, int wr, int wc, int fr, int fq) const {
        const int row = u.pm * BM + wr * 64 + fr + ai * HALF + m * 16, col0 = u.pn * HALF + wc * 32 + 8 * fq;
        float r[8];
#pragma unroll
        for (int e = 0; e < 4; ++e) { r[e] = v00[e] * sigmoidf_(v00[e]) * v10[e]; r[4 + e] = v01[e] * sigmoidf_(v01[e]) * v11[e]; }
        u32x4 w; w.x = pk2(r[0], r[1]); w.y = pk2(r[2], r[3]); w.z = pk2(r[4], r[5]); w.w = pk2(r[6], r[7]);
        *(u32x4*)(act + (size_t)row * DFF + col0) = w;
    }
    EPI_WALK()
};
struct EpiRes2 {
    static constexpr int HOOK_TILE = 0;
    static constexpr bool PERM = false, AFTER_DRAIN = false;
    const float* mod; float* out;
    __device__ __forceinline__ void rg(f32x4 v00, f32x4 v01, f32x4 v10, f32x4 v11, const Unit& u, int ai, int m, int wr, int wc, int fr, int fq) const {
        const int row = u.pm * BM + wr * 64 + fr + ai * HALF + m * 16, col0 = u.pn * BM + wc * 32 + 4 * fq;
        const float* gf = mod + (size_t)seq_of_row(row) * (6 * D) + 5 * D + col0;
        float* o = out + (size_t)row * D + col0;
        *(f32x4*)o = *(const f32x4*)o + *(const f32x4*)gf * v00;
        *(f32x4*)(o + 16) = *(const f32x4*)(o + 16) + *(const f32x4*)(gf + 16) * v01;
        *(f32x4*)(o + HALF) = *(const f32x4*)(o + HALF) + *(const f32x4*)(gf + HALF) * v10;
        *(f32x4*)(o + HALF + 16) = *(const f32x4*)(o + HALF + 16) + *(const f32x4*)(gf + HALF + 16) * v11;
    }
    EPI_WALK()
};
struct SliceOrder {
    int nM, nN, nwg, KT, R1, c, nleft, nsl, l, s;
    unsigned* cnt; float* slab;
    __device__ void init(int M_, int N_, int K_, int c_, unsigned* cnt_, float* slab_) {
        nM = M_ / BM; nN = N_ / BM; nwg = nM * nN; KT = K_ / 64; c = c_; cnt = cnt_; slab = slab_;
        R1 = nwg / 256; nleft = nwg - R1 * 256; nsl = nleft ? 256 / nleft : 1; if (nsl > 8) nsl = 8;
        l = nleft ? c % nleft : 0; s = nleft ? c / nleft : nsl;
    }
    __device__ int kbnd(int i) const { return i >= nsl ? KT : (((KT * i) / nsl + 1) & ~1); }
    __device__ void pmpn(int L, Unit& u) const {
        int wgid = L; { const int q = nwg / pg8::NXCD, r = nwg % pg8::NXCD, xcd = wgid % pg8::NXCD, off = wgid / pg8::NXCD; wgid = (xcd < r ? xcd * (q + 1) : r * (q + 1) + (xcd - r) * q) + off; }
        const int nig = pg8::WGM * nN, gid = wgid / nig, fm = gid * pg8::WGM, gsz = (nM - fm) < pg8::WGM ? (nM - fm) : pg8::WGM;
        u.pm = fm + ((wgid % nig) % gsz); u.pn = (wgid % nig) / gsz;
    }
    __device__ bool next(int i, Unit& u) const {
        if (i < R1) { pmpn(i * 256 + c, u); u.kb = 0; u.nk = KT; u.kind = 0; u.peer = 0; return true; }
        if (i == R1 && nleft && s < nsl) { pmpn(R1 * 256 + l, u); u.kb = kbnd(s); u.nk = kbnd(s + 1) - u.kb; u.kind = 3; u.peer = l; return true; }
        return false;
    }
    __device__ __forceinline__ void a_ready(const Unit&) const {}
    __device__ __forceinline__ void done(const Unit&) const {}
};

#define GAS __attribute__((address_space(1)))
#define LAS __attribute__((address_space(3)))
typedef GAS unsigned gu32;
#define RLX_AGENT __ATOMIC_RELAXED, __HIP_MEMORY_SCOPE_AGENT
#define LDS_WAIT() asm volatile("s_waitcnt lgkmcnt(0)" ::: "memory")
#define VM_WAIT() asm volatile("s_waitcnt vmcnt(0)" ::: "memory")
#define XB_TMO      128
#define XB_XCNT(j)  (256  + 64 * (j))
#define XB_XSUB(j)  (1280 + 64 * (j))
#define XB_XGEN(j)  (2304 + 64 * (j))
#define XB_TOP      3328
#define XB_TOPGEN   3392
#define XCD_BAR_WORDS 3456
#define XB_SPIN_CAP (1u << 18)

__device__ __forceinline__ unsigned xb_ld(unsigned* p)              { return __hip_atomic_load(p, __ATOMIC_RELAXED, __HIP_MEMORY_SCOPE_AGENT); }
__device__ __forceinline__ unsigned xb_add(unsigned* p, unsigned v) { return __hip_atomic_fetch_add(p, v, __ATOMIC_RELAXED, __HIP_MEMORY_SCOPE_AGENT); }
__device__ __forceinline__ unsigned xb_xcc_id() { return (unsigned)__builtin_amdgcn_s_getreg((3 << 11) | 20) & 0xFu; }
#define XB_SPIN(cond, bar) do { unsigned _sp = 0; while (cond) { __builtin_amdgcn_s_sleep(1); \
    if ((++_sp & 255u) == 0u) { if (xb_ld(&(bar)[XB_TMO])) break; if (_sp > XB_SPIN_CAP) { atomicAdd(&(bar)[XB_TMO], 1u); break; } } } } while (0)

struct XcdBarrier {
    unsigned* bar; unsigned x;
    volatile LAS unsigned* st;
};

__device__ __forceinline__ XcdBarrier xcd_barrier_post(unsigned* bar, volatile LAS unsigned* st) {
    XcdBarrier b; b.bar = bar; b.x = xb_xcc_id(); b.st = st;
    if (threadIdx.x == 0) (void)xb_add(&bar[XB_XCNT(b.x)], 1u);
    return b;
}
__device__ __forceinline__ void xcd_barrier_complete(unsigned* bar, unsigned x, unsigned& nloc, unsigned& nx) {
    const unsigned G = gridDim.x * gridDim.y * gridDim.z;
    unsigned sum, cnt, mine, sp = 0u;
    for (;;) {
        sum = 0u; cnt = 0u; mine = 0u;
#pragma unroll
        for (unsigned j = 0; j < 16; ++j) { const unsigned c = xb_ld(&bar[XB_XCNT(j)]); sum += c; cnt += (c > 0u) ? 1u : 0u; mine = (j == x) ? c : mine; }
        if (sum == G) break;
        __builtin_amdgcn_s_sleep(1);
        if ((++sp & 255u) == 0u) { if (xb_ld(&bar[XB_TMO])) break; if (sp > XB_SPIN_CAP) { atomicAdd(&bar[XB_TMO], 1u); break; } }
    }
    nloc = mine > 0u ? mine : 1u; nx = cnt > 0u ? cnt : 1u;
}

__device__ __forceinline__ void xcd_barrier(const XcdBarrier& b) {
    asm volatile("s_waitcnt vmcnt(0)" ::: "memory");
    __syncthreads();
    if (threadIdx.x == 0) {
        unsigned* bar = b.bar;
        __builtin_amdgcn_s_waitcnt(0);
        unsigned nloc = b.st[0], nx = b.st[1];
        if (nloc == 0u) { xcd_barrier_complete(bar, b.x, nloc, nx); b.st[0] = nloc; b.st[1] = nx; }
        const unsigned old = xb_add(&bar[XB_XSUB(b.x)], 1u);
        const unsigned gen = old / nloc;
        if (old + 1u == (gen + 1u) * nloc) {
            __builtin_amdgcn_fence(__ATOMIC_RELEASE, "agent");
            asm volatile("s_waitcnt vmcnt(0)" ::: "memory");
            const unsigned og = xb_add(&bar[XB_TOP], 1u);
            const unsigned tg = og / nx;
            if (og + 1u == (tg + 1u) * nx) xb_add(&bar[XB_TOPGEN], 1u);
            else XB_SPIN(xb_ld(&bar[XB_TOPGEN]) == tg, bar);
            __builtin_amdgcn_fence(__ATOMIC_ACQUIRE, "agent");
            xb_add(&bar[XB_XGEN(b.x)], 1u);
            asm volatile("s_waitcnt vmcnt(0)" ::: "memory");
        } else {
            XB_SPIN(xb_ld(&bar[XB_XGEN(b.x)]) == gen, bar);
            __builtin_amdgcn_fence(__ATOMIC_ACQUIRE, "agent");
            asm volatile("s_waitcnt vmcnt(0)" ::: "memory");
        }
    }
    __syncthreads();
}

typedef pg8::bf16x8 bf16x8;
#define MFMA16(a, b, c) __builtin_amdgcn_mfma_f32_16x16x32_bf16((a), (b), (c), 0, 0, 0)
constexpr int RB_P1 = 0, RB_RT = 2048, RB_QP = 4096, RB_RAK = 5120, RB_VM = 6144, RB_WL = 8192;

__device__ __forceinline__ f32x4 ld_bf4(const bf16_t* p) { const u32x2v w = *(const u32x2v*)p; return (f32x4){bflo(w.x), bfhi(w.x), bflo(w.y), bfhi(w.y)}; }
__device__ __forceinline__ bf16x8 mk_frag(const f32x4 a, const f32x4 b) { u32x4 w; w.x = pk2(a[0], a[1]); w.y = pk2(a[2], a[3]); w.z = pk2(b[0], b[1]); w.w = pk2(b[2], b[3]); return __builtin_bit_cast(bf16x8, w); }
__device__ __forceinline__ unsigned char* recA_ptr(const P& p, int rec) { return rec < NREC_P ? p.ws + WS_H + (size_t)rec * RECA : p.ws + WS_FRA_S + (size_t)(rec - NREC_P) * RECA; }
__device__ __forceinline__ unsigned char* recB_ptr(const P& p, int rec) { return rec < NREC_P ? (unsigned char*)p.out + (size_t)rec * RECB : p.ws + WS_FRB_S + (size_t)(rec - NREC_P) * RECB; }
__device__ __forceinline__ f32x4 sig4(f32x4 x) { return (f32x4){sigmoidf_(x[0]), sigmoidf_(x[1]), sigmoidf_(x[2]), sigmoidf_(x[3])}; }
__device__ __forceinline__ f32x4 exp4(f32x4 x) { return (f32x4){__expf(x[0]), __expf(x[1]), __expf(x[2]), __expf(x[3])}; }

template <class T> __device__ __forceinline__ T ldu(const void* ubase, unsigned voff) { return *(const T*)((const char*)ubase + voff); }
__device__ __forceinline__ f32x4 bf4(const u32x2v w) { return (f32x4){bflo(w.x), bfhi(w.x), bflo(w.y), bfhi(w.y)}; }
struct ShiftCtx { const bf16_t* zrw; const float* ss; const float* mu; unsigned zoc, zop; float fv, fpz, fps; };
__device__ __forceinline__ f32x4 shift4(const ShiftCtx& k, int cu, unsigned lp) {
    const u32x2v cw = ldu<u32x2v>(k.zrw + cu, k.zoc + lp * 2u), pw = ldu<u32x2v>(k.zrw + cu, k.zop + lp * 2u);
    const f32x4 sv = ldu<f32x4>(k.ss + cu, lp * 4u), m = ldu<f32x4>(k.mu + cu, lp * 4u);
    const f32x4 cur = bf4(cw) * k.fv;
    const f32x4 pv = bf4(pw) * k.fpz + sv * k.fps;
    return cur + (pv - cur) * m;
}

__device__ __forceinline__ void prep_record(const P& p, LAS unsigned char* wl, int rec, int lane_in) {
    int lane = lane_in; asm volatile("" : "+v"(lane));
    const int head = rec & 15, chunkid = rec >> 4;
    const bool prompt = chunkid < NPB * 128;
    const int sq = prompt ? (chunkid >> 7) : NPB + (chunkid - NPB * 128);
    const int c = prompt ? (chunkid & 127) : 0;
    const int row0 = prompt ? sq * TP + c * 16 : MP + (sq - NPB) * TS;
    const int nvalid = prompt ? 16 : TS;
    const int i = lane & 15, q = lane >> 4;
    const bool valid = i < nvalid, first = (c == 0);
    const bool pz = valid && (i > 0 || !first), ps = valid && (i == 0) && first && !prompt;
    const int row = row0 + (valid ? i : 0);
    ShiftCtx K;
    K.zrw = (const bf16_t*)(p.ws + WS_ZRW); K.ss = p.in[3] + (size_t)(prompt ? 0 : sq - NPB) * CSH; K.mu = p.in[10];
    K.zoc = (unsigned)row * (unsigned)(CSH * 2); K.zop = pz ? K.zoc - (unsigned)(CSH * 2) : K.zoc; K.fv = valid ? 1.f : 0.f; K.fpz = pz ? 1.f : 0.f; K.fps = ps ? 1.f : 0.f;
    const unsigned q4 = (unsigned)q * 4u, q8 = (unsigned)q * 8u;
    const unsigned wlo64 = (unsigned)(i * 64 + q * 8) * 2u, wlo128 = (unsigned)(i * 128 + q * 8) * 2u;
    const bf16_t* WDUT = (const bf16_t*)(p.ws + WS_LORA); const bf16_t* WAUT = WDUT + RW * 64; const bf16_t* WGUT = WAUT + RW * 64;
    const f32x4 z4 = (f32x4){0.f, 0.f, 0.f, 0.f};

    f32x4 accw[4], acca[4];
#pragma unroll
    for (int ct = 0; ct < 4; ++ct) { accw[ct] = z4; acca[ct] = z4; }
#pragma unroll
    for (int s = 0; s < 2; ++s) {
        const int cw = 3072 + 32 * s, ca = 3136 + 32 * s;
        f32x4 x0 = shift4(K, cw, q8), x1 = shift4(K, cw + 4, q8);
#pragma unroll
        for (int e = 0; e < 4; ++e) { x0[e] = 2.f * sigmoidf_(2.f * x0[e]) - 1.f; x1[e] = 2.f * sigmoidf_(2.f * x1[e]) - 1.f; }
        const bf16x8 td = mk_frag(x0, x1);
        const bf16x8 ad = mk_frag(shift4(K, ca, q8), shift4(K, ca + 4, q8));
#pragma unroll
        for (int ct = 0; ct < 4; ++ct) {
            const int wo = (head * 64 + 16 * ct) * 64 + 32 * s;
            accw[ct] = MFMA16(ldu<bf16x8>(WDUT + wo, wlo64), td, accw[ct]);
            acca[ct] = MFMA16(ldu<bf16x8>(WAUT + wo, wlo64), ad, acca[ct]);
        }
    }
    f32x4 lw[4], av[4], ks[4];
    float ssq = 0.f;
#pragma unroll
    for (int ct = 0; ct < 4; ++ct) {
        const int cbu = head * 64 + 16 * ct;
        lw[ct] = sig4(ldu<f32x4>(p.in[11] + cbu, q4 * 4u) + accw[ct]) * (-0.6065306597126334f);
        lw[ct] = lw[ct] * K.fv;
        av[ct] = sig4(ldu<f32x4>(p.in[13] + cbu, q4 * 4u) + acca[ct]);
        ks[ct] = shift4(K, RW + cbu, q4);
        const f32x4 kk0 = ks[ct] * ldu<f32x4>(p.in[16] + cbu, q4 * 4u);
        ssq += (kk0[0] * kk0[0] + kk0[1] * kk0[1]) + (kk0[2] * kk0[2] + kk0[3] * kk0[3]);
    }
    ssq += __shfl_xor(ssq, 16); ssq += __shfl_xor(ssq, 32);
    const float kinv = __builtin_amdgcn_rcpf(fmaxf(sqrtf(ssq), 1e-12f));
    f32x4 lwc[4];
#pragma unroll
    for (int ct = 0; ct < 4; ++ct) lwc[ct] = lw[ct];
#pragma unroll
    for (int d = 1; d < 16; d <<= 1)
#pragma unroll
        for (int ct = 0; ct < 4; ++ct)
#pragma unroll
            for (int e = 0; e < 4; ++e) { const float t = __shfl_up(lwc[ct][e], d, 16); if (i >= d) lwc[ct][e] += t; }
    unsigned char* rb = recB_ptr(p, rec); unsigned char* ra = recA_ptr(p, rec);
    LAS unsigned short* KT = (LAS unsigned short*)wl; LAS unsigned short* AT = KT + 1024; LAS unsigned short* KtT = KT + 2048; LAS unsigned short* VT = KT + 3072;
    LAS float* MT = (LAS float*)(wl + 8192);
    u32x2v kapP[4], alpP[4], ktP[4], rtP[4];
    f32x4 wl15[4];
    float bsum = 0.f;
#pragma unroll
    for (int ct = 0; ct < 4; ++ct) {
        const int cbu = head * 64 + 16 * ct;
        const f32x4 Wt = exp4(lwc[ct]), Wtm1 = exp4(lwc[ct] - lw[ct]), Winv = exp4(-lwc[ct]);
        const f32x4 kkn = ks[ct] * ldu<f32x4>(p.in[16] + cbu, q4 * 4u) * kinv;
        const f32x4 kmod = ks[ct] * ((av[ct] - 1.f) * ldu<f32x4>(p.in[17] + cbu, q4 * 4u) + 1.f);
        const f32x4 kap = kkn * Wtm1, alp = kkn * av[ct] * Winv, kt = kmod * Winv;
        const f32x4 rs = shift4(K, cbu, q4);
        const f32x4 rt = rs * Wt;
        const f32x4 rk = rs * kmod * ldu<f32x4>(p.in[18] + cbu, q4 * 4u);
        bsum += (rk[0] + rk[1]) + (rk[2] + rk[3]);
#pragma unroll
        for (int e = 0; e < 4; ++e) wl15[ct][e] = __shfl(Wt[e], 15, 16);
        kapP[ct].x = pk2(kap[0], kap[1]); kapP[ct].y = pk2(kap[2], kap[3]); alpP[ct].x = pk2(alp[0], alp[1]); alpP[ct].y = pk2(alp[2], alp[3]);
        ktP[ct].x = pk2(kt[0], kt[1]); ktP[ct].y = pk2(kt[2], kt[3]); rtP[ct].x = pk2(rt[0], rt[1]); rtP[ct].y = pk2(rt[2], rt[3]);
#pragma unroll
        for (int e = 0; e < 4; ++e) { const int ch = 16 * ct + 4 * q + e; const int sh = (e & 1) * 16;
            KT[ch * 16 + i] = (unsigned short)(((e < 2 ? kapP[ct].x : kapP[ct].y) >> sh) & 0xffffu);
            AT[ch * 16 + i] = (unsigned short)(((e < 2 ? alpP[ct].x : alpP[ct].y) >> sh) & 0xffffu);
            KtT[ch * 16 + i] = (unsigned short)(((e < 2 ? ktP[ct].x : ktP[ct].y) >> sh) & 0xffffu); }
    }
    bsum += __shfl_xor(bsum, 16); bsum += __shfl_xor(bsum, 32);
    u32x2v c1P[4], c2P[4];
    {
        f32x4 accg[4];
#pragma unroll
        for (int ct = 0; ct < 4; ++ct) accg[ct] = z4;
#pragma unroll
        for (int s = 0; s < 4; ++s) {
            const int cg = 3200 + 32 * s;
            const bf16x8 gd = mk_frag(sig4(shift4(K, cg, q8)), sig4(shift4(K, cg + 4, q8)));
#pragma unroll
            for (int ct = 0; ct < 4; ++ct) accg[ct] = MFMA16(ldu<bf16x8>(WGUT + (head * 64 + 16 * ct) * 128 + 32 * s, wlo128), gd, accg[ct]);
        }
#pragma unroll
        for (int ct = 0; ct < 4; ++ct) {
            const int cbu = head * 64 + 16 * ct;
            const f32x4 c1 = ldu<f32x4>(p.in[19] + cbu, q4 * 4u) * accg[ct];
            const f32x4 vsf = shift4(K, 2 * RW + cbu, q4);
            const f32x4 c2 = (ldu<f32x4>(p.in[20] + cbu, q4 * 4u) + vsf * bsum) * accg[ct];
            c1P[ct].x = pk2(c1[0], c1[1]); c1P[ct].y = pk2(c1[2], c1[3]); c2P[ct].x = pk2(c2[0], c2[1]); c2P[ct].y = pk2(c2[2], c2[3]);
#pragma unroll
            for (int e = 0; e < 4; ++e) VT[(16 * ct + 4 * q + e) * 16 + i] = f2bf(vsf[e]);
        }
    }
    bf16x8 kapF[2], alpF[2], ktF[2], rtF[2];
#pragma unroll
    for (int s = 0; s < 2; ++s) {
        kapF[s] = __builtin_bit_cast(bf16x8, (u32x4){kapP[2 * s].x, kapP[2 * s].y, kapP[2 * s + 1].x, kapP[2 * s + 1].y});
        alpF[s] = __builtin_bit_cast(bf16x8, (u32x4){alpP[2 * s].x, alpP[2 * s].y, alpP[2 * s + 1].x, alpP[2 * s + 1].y});
        ktF[s] = __builtin_bit_cast(bf16x8, (u32x4){ktP[2 * s].x, ktP[2 * s].y, ktP[2 * s + 1].x, ktP[2 * s + 1].y});
        rtF[s] = __builtin_bit_cast(bf16x8, (u32x4){rtP[2 * s].x, rtP[2 * s].y, rtP[2 * s + 1].x, rtP[2 * s + 1].y});
    }
    f32x4 Maa = z4, Mak = z4, RAt = z4, RKt = z4;
#pragma unroll
    for (int s = 0; s < 2; ++s) {
        Maa = MFMA16(kapF[s], alpF[s], Maa); Mak = MFMA16(kapF[s], ktF[s], Mak);
        RAt = MFMA16(alpF[s], rtF[s], RAt); RKt = MFMA16(ktF[s], rtF[s], RKt);
    }
#pragma unroll
    for (int r = 0; r < 4; ++r) { const int rw_ = 4 * q + r;
        if (!(rw_ > i)) { Maa[r] = 0.f; Mak[r] = 0.f; }
        if (!(i >= rw_)) { RAt[r] = 0.f; RKt[r] = 0.f; } }
    *(LAS f32x4*)(MT + i * 16 + 4 * q) = Maa;
    u32x4 rakW; rakW.x = pk2(RAt[0], RAt[1]); rakW.y = pk2(RAt[2], RAt[3]); rakW.z = pk2(RKt[0], RKt[1]); rakW.w = pk2(RKt[2], RKt[3]);
    LDS_WAIT(); asm volatile("" ::: "memory");
    float t[16];
#pragma unroll
    for (int cc = 15; cc >= 0; --cc) {
        float acc = (i == cc) ? 1.f : 0.f;
        f32x4 mrow[4];
#pragma unroll
        for (int b = 0; b < 4; ++b) mrow[b] = *(const LAS f32x4*)(MT + cc * 16 + 4 * b);
#pragma unroll
        for (int j = cc + 1; j < 16; ++j) acc -= t[j] * mrow[j >> 2][j & 3];
        t[cc] = acc;
    }
    f32x4 tsel;
#pragma unroll
    for (int e = 0; e < 4; ++e) tsel[e] = -(q == 0 ? t[e] : (q == 1 ? t[4 + e] : (q == 2 ? t[8 + e] : t[12 + e])));
    const bf16x8 Tfrag = mk_frag(tsel, z4);
    f32x4 P1E[4];
#pragma unroll
    for (int ct = 0; ct < 4; ++ct) { const u32x2v w = *(const LAS u32x2v*)(KT + (16 * ct + i) * 16 + 4 * q);
        u32x4 aw; aw.x = w.x; aw.y = w.y; aw.z = 0u; aw.w = 0u; P1E[ct] = MFMA16(__builtin_bit_cast(bf16x8, aw), Tfrag, z4); }
    *(u32x4*)(rb + RB_RT + lane * 16) = __builtin_bit_cast(u32x4, rtF[0]); *(u32x4*)(rb + RB_RT + 1024 + lane * 16) = __builtin_bit_cast(u32x4, rtF[1]);
    *(u32x4*)(rb + RB_RAK + lane * 16) = rakW;
#pragma unroll
    for (int ct = 0; ct < 4; ++ct) {
        if (i == 0) *(f32x4*)(rb + RB_WL + (16 * ct + 4 * q) * 4) = wl15[ct];
        if (valid) { const int cbu = head * 64 + 16 * ct;
            *(u32x2v*)((char*)((bf16_t*)(p.ws + WS_OA) + cbu) + ((unsigned)row * (2 * RW) + q4) * 2u) = c1P[ct];
            *(u32x2v*)((char*)((bf16_t*)(p.ws + WS_C2) + cbu) + ((unsigned)row * RW + q4) * 2u) = c2P[ct]; }
    }
    *(u32x4*)(rb + RB_P1 + lane * 16) = __builtin_bit_cast(u32x4, mk_frag(P1E[0], P1E[1]));
    *(u32x4*)(rb + RB_P1 + 1024 + lane * 16) = __builtin_bit_cast(u32x4, mk_frag(P1E[2], P1E[3]));
    { const f32x4 Qt = MFMA16(mk_frag(Mak, z4), Tfrag, z4);
      u32x4 w; w.x = 0u; w.y = 0u; w.z = pk2(Qt[0], Qt[1]); w.w = pk2(Qt[2], Qt[3]); *(u32x4*)(rb + RB_QP + lane * 16) = w; }
#pragma unroll
    for (int tt = 0; tt < 4; ++tt) {
        const u32x2v a = *(const LAS u32x2v*)(AT + (16 * tt + i) * 16 + 4 * q), b = *(const LAS u32x2v*)(KtT + (16 * tt + i) * 16 + 4 * q);
        u32x4 w; w.x = a.x; w.y = a.y; w.z = b.x; w.w = b.y; *(u32x4*)(ra + tt * 1024 + lane * 16) = w;
        *(u32x2v*)(rb + RB_VM + tt * 512 + lane * 8) = *(const LAS u32x2v*)(VT + (16 * tt + i) * 16 + 4 * q);
    }
    LDS_WAIT(); asm volatile("" ::: "memory");
}

struct ScanFr { bf16x8 P10, P11, RT0, RT1, QP, RAK, AK0, AK1, AK2, AK3; u32x2v vm; f32x4 WL0, WL1, WL2, WL3; };
__device__ __forceinline__ void scan_load(ScanFr& f, const P& p, int rec, int vs, int lane) {
    const unsigned char* ra = recA_ptr(p, rec); const unsigned char* rb = recB_ptr(p, rec);
    const unsigned l16 = (unsigned)lane * 16u, q16 = (unsigned)(lane >> 4) * 16u;
    f.P10 = ldu<bf16x8>(rb + RB_P1, l16); f.P11 = ldu<bf16x8>(rb + RB_P1 + 1024, l16);
    f.RT0 = ldu<bf16x8>(rb + RB_RT, l16); f.RT1 = ldu<bf16x8>(rb + RB_RT + 1024, l16);
    f.QP = ldu<bf16x8>(rb + RB_QP, l16); f.RAK = ldu<bf16x8>(rb + RB_RAK, l16);
    f.vm = ldu<u32x2v>(rb + RB_VM + vs * 512, (unsigned)lane * 8u);
    f.AK0 = ldu<bf16x8>(ra, l16); f.AK1 = ldu<bf16x8>(ra + 1024, l16); f.AK2 = ldu<bf16x8>(ra + 2048, l16); f.AK3 = ldu<bf16x8>(ra + 3072, l16);
    f.WL0 = ldu<f32x4>(rb + RB_WL, q16); f.WL1 = ldu<f32x4>(rb + RB_WL + 64, q16); f.WL2 = ldu<f32x4>(rb + RB_WL + 128, q16); f.WL3 = ldu<f32x4>(rb + RB_WL + 192, q16);
}
template <int NS>
__device__ __forceinline__ void scan_step(const ScanFr& f, const u32x2v (&vm)[NS], f32x4 (&St)[NS][4], float* oraw, int c, int q, bool prompt) {
    const f32x4 z4 = (f32x4){0.f, 0.f, 0.f, 0.f};
#pragma unroll
    for (int i = 0; i < NS; ++i) {
        const bf16x8 SB0 = mk_frag(St[i][0], St[i][1]), SB1 = mk_frag(St[i][2], St[i][3]);
        u32x4 vw; vw.x = 0u; vw.y = 0u; vw.z = vm[i].x; vw.w = vm[i].y;
        f32x4 U = MFMA16(f.QP, __builtin_bit_cast(bf16x8, vw), z4);
        U = MFMA16(f.P10, SB0, U); U = MFMA16(f.P11, SB1, U);
        u32x4 uw; uw.x = pk2(U[0], U[1]); uw.y = pk2(U[2], U[3]); uw.z = vm[i].x; uw.w = vm[i].y;
        const bf16x8 UB = __builtin_bit_cast(bf16x8, uw);
        f32x4 O = MFMA16(f.RT0, SB0, z4); O = MFMA16(f.RT1, SB1, O); O = MFMA16(f.RAK, UB, O);
        St[i][0] = MFMA16(f.AK0, UB, St[i][0]) * f.WL0; St[i][1] = MFMA16(f.AK1, UB, St[i][1]) * f.WL1;
        St[i][2] = MFMA16(f.AK2, UB, St[i][2]) * f.WL2; St[i][3] = MFMA16(f.AK3, UB, St[i][3]) * f.WL3;
#pragma unroll
        for (int r = 0; r < 4; ++r) { const int tk = 4 * q + r; if (prompt || tk < TS) oraw[(size_t)(16 * c + tk) * RW + 16 * i] = O[r]; }
    }
}
__device__ __forceinline__ void scan_chain_prompt(const P& p, int sq, int head, int vp, int lane, volatile LAS unsigned* prog) {
    constexpr int nch = TP / 16;
    const int rec0 = sq * nch * NH + head, vl = lane & 15, q = lane >> 4;
    f32x4 St[2][4];
    float* sout = p.out + O_WKVP + ((size_t)sq * NH + head) * HS * HS + (size_t)(32 * vp + vl) * HS + 4 * q;
    float* oraw = (float*)(p.ws + WS_ZRW) + (size_t)(sq * TP) * RW + head * HS + 32 * vp + vl;
    ScanFr f0, f1; u32x2v v0[2], v1[2];
#define SCAN_LD(f, v, cc) do { const int rec_ = rec0 + (cc) * NH; scan_load(f, p, rec_, 2 * vp, lane); v[0] = f.vm; v[1] = ldu<u32x2v>(recB_ptr(p, rec_) + RB_VM + (2 * vp + 1) * 512, (unsigned)lane * 8u); } while (0)
    SCAN_LD(f0, v0, 0); SCAN_LD(f1, v1, 1);
#pragma unroll
    for (int i = 0; i < 2; ++i)
#pragma unroll
        for (int t = 0; t < 4; ++t) St[i][t] = (f32x4){0.f, 0.f, 0.f, 0.f};
    const bool pw = vp == 0 && lane == 0;
    for (int c = 0; c < nch; c += 2) {
        if (pw) *prog = (unsigned)c;
        scan_step<2>(f0, v0, St, oraw, c, q, true);     SCAN_LD(f0, v0, c + 2 < nch ? c + 2 : nch - 1);
        scan_step<2>(f1, v1, St, oraw, c + 1, q, true); SCAN_LD(f1, v1, c + 3 < nch ? c + 3 : nch - 1);
    }
#undef SCAN_LD
#pragma unroll
    for (int i = 0; i < 2; ++i)
#pragma unroll
        for (int t = 0; t < 4; ++t) *(f32x4*)(sout + (size_t)(16 * i) * HS + 16 * t) = St[i][t];
}
__device__ __forceinline__ void scan_chain_sample(const P& p, int s, int head, int vs, int lane) {
    const int vl = lane & 15, q = lane >> 4;
    const size_t so = ((size_t)s * NH + head) * HS * HS + (size_t)(16 * vs + vl) * HS + 4 * q;
    ScanFr f0; scan_load(f0, p, NREC_P + s * NH + head, vs, lane);
    f32x4 St[1][4]; u32x2v vm[1]; vm[0] = f0.vm;
#pragma unroll
    for (int t = 0; t < 4; ++t) St[0][t] = *(const f32x4*)(p.in[2] + so + 16 * t);
    scan_step<1>(f0, vm, St, (float*)(p.ws + WS_ZRW) + (size_t)(MP + s * TS) * RW + head * HS + 16 * vs + vl, 0, q, false);
#pragma unroll
    for (int t = 0; t < 4; ++t) *(f32x4*)(p.out + O_WKVS + so + 16 * t) = St[0][t];
}

constexpr int SCAN_AHEAD = 10;
__device__ __forceinline__ void scan_prefetch(const P& p, volatile LAS unsigned* prog, int sq, int head, int k, int lane) {
    const int rec0 = sq * (TP / 16) * NH + head;
    const unsigned l16 = (unsigned)lane * 16u;
    for (int c = k; c < TP / 16; c += 2) {
        while ((int)*prog < c - SCAN_AHEAD) __builtin_amdgcn_s_sleep(8);
        const unsigned char* ra = recA_ptr(p, rec0 + c * NH); const unsigned char* rb = recB_ptr(p, rec0 + c * NH);
        u32x4 x[12];
#pragma unroll
        for (int j = 0; j < 4; ++j) x[j] = ldu<u32x4>(ra + j * 1024, l16);
#pragma unroll
        for (int j = 0; j < 8; ++j) x[4 + j] = ldu<u32x4>(rb + j * 1024, l16);
        const u32x4 y = ldu<u32x4>(rb + 8192, (unsigned)(lane & 15) * 16u);
#pragma unroll
        for (int j = 0; j < 12; ++j) asm volatile("" :: "v"(x[j].x));
        asm volatile("" :: "v"(y.x));
    }
}

__device__ __forceinline__ void mix_item(const P& p, int item, int wave, int lane) {
    const int g = item & 7, row0 = (item >> 3) * 128;
    const int dl = lane & 15, q = lane >> 4, col = g * 128 + wave * 16;
    const bf16_t* vn = (const bf16_t*)(p.ws + WS_VN) + (size_t)row0 * MLPW + col + dl;
    bf16x8 A[4];
#pragma unroll
    for (int sb = 0; sb < 4; ++sb)
#pragma unroll
        for (int j = 0; j < 8; ++j) A[sb][j] = (short)vn[(size_t)(32 * sb + 8 * q + j) * MLPW];
    const float* wsg = p.in[23] + ((size_t)g * 128 + dl) * 128 + 8 * q;
    const bf16_t* zu = (const bf16_t*)(p.ws + WS_ZUG) + (size_t)(row0 + dl) * ZUGW + ZU_U + col + 4 * q;
    bf16_t* ub = (bf16_t*)(p.ws + WS_OA) + (size_t)(row0 + dl) * (2 * RW) + RW + col + 4 * q;
#pragma unroll
    for (int tt = 0; tt < 8; ++tt) {
        const int t = 16 * tt + dl;
        f32x4 acc = (f32x4){0.f, 0.f, 0.f, 0.f};
#pragma unroll
        for (int sb = 0; sb <= tt / 2; ++sb) {
            const float* wr = wsg + (size_t)(16 * tt) * 128 + 32 * sb;
            f32x4 w0 = *(const f32x4*)wr, w1 = *(const f32x4*)(wr + 4);
            if (sb == tt / 2) {
#pragma unroll
                for (int e = 0; e < 4; ++e) { if (32 * sb + 8 * q + e > t) w0[e] = 0.f; if (32 * sb + 8 * q + 4 + e > t) w1[e] = 0.f; }
            }
            acc = MFMA16(A[sb], mk_frag(w0, w1), acc);
        }
        const float bias = p.in[24][g * 128 + t];
        const f32x4 u = ld_bf4(zu + (size_t)(16 * tt) * ZUGW);
        const f32x4 o = (acc + bias) * u;
        u32x2v w; w.x = pk2(o[0], o[1]); w.y = pk2(o[2], o[3]); *(u32x2v*)(ub + (size_t)(16 * tt) * (2 * RW)) = w;
    }
}

__device__ __forceinline__ void post_rows(const P& p, int gw, int NGW, int lane) {
    const float* oraw = (const float*)(p.ws + WS_ZRW);
    for (int row = gw; row < M; row += NGW) {
        const size_t off = (size_t)row * RW + lane * 16;
        f32x4 o[4]; float s = 0.f;
#pragma unroll
        for (int j = 0; j < 4; ++j) { o[j] = *(const f32x4*)(oraw + off + 4 * j); s += (o[j][0] + o[j][1]) + (o[j][2] + o[j][3]); }
        s += __shfl_xor(s, 1); s += __shfl_xor(s, 2);
        const float mean = s * (1.f / HS); float qv = 0.f;
#pragma unroll
        for (int j = 0; j < 4; ++j) { o[j] = o[j] - mean; qv += (o[j][0] * o[j][0] + o[j][1] * o[j][1]) + (o[j][2] * o[j][2] + o[j][3] * o[j][3]); }
        qv += __shfl_xor(qv, 1); qv += __shfl_xor(qv, 2);
        const float rstd = rsqrtf(qv * (1.f / HS) + 64e-5f);
        bf16_t* oa = (bf16_t*)(p.ws + WS_OA) + (size_t)row * (2 * RW) + lane * 16; const bf16_t* c2p = (const bf16_t*)(p.ws + WS_C2) + off;
#pragma unroll
        for (int h = 0; h < 2; ++h) {
            const u32x4 c1 = *(const u32x4*)(oa + 8 * h), c2 = *(const u32x4*)(c2p + 8 * h);
            const f32x4 a = o[2 * h] * rstd, b = o[2 * h + 1] * rstd;
            u32x4 w;
            w.x = pk2(a[0] * bflo(c1.x) + bflo(c2.x), a[1] * bfhi(c1.x) + bfhi(c2.x)); w.y = pk2(a[2] * bflo(c1.y) + bflo(c2.y), a[3] * bfhi(c1.y) + bfhi(c2.y));
            w.z = pk2(b[0] * bflo(c1.z) + bflo(c2.z), b[1] * bfhi(c1.z) + bfhi(c2.z)); w.w = pk2(b[2] * bflo(c1.w) + bflo(c2.w), b[3] * bfhi(c1.w) + bfhi(c2.w));
            *(u32x4*)(oa + 8 * h) = w;
        }
    }
}

constexpr int NWAVES = 8, NTHR = NWAVES * 64;
constexpr int RING_BYTES = 131072, LDSCTL_OFF = RING_BYTES, MISC_OFF = LDSCTL_OFF + 320, LDS_BYTES = 147456;

__device__ __forceinline__ void p0_mod_slab(const P& p, LAS unsigned char* lds, int slab, int tid, int lane, int wave) {
    LAS float* red = (LAS float*)(lds + 8 * 12288);
    LAS float* Bl = (LAS float*)(lds + wave * 12288);
    for (int i = tid; i < 144 * 48; i += NTHR) red[i] = 0.f;
    __syncthreads();
    const int n0 = slab * 48, fr = lane & 15, fq = lane >> 4;
    const float* W = p.in[6] + n0;
    f32x4 acc[9][3];
#pragma unroll
    for (int a = 0; a < 9; ++a)
#pragma unroll
        for (int b = 0; b < 3; ++b) acc[a][b] = (f32x4){0.f, 0.f, 0.f, 0.f};
    for (int sc = 0; sc < 4; ++sc) {
        const int kb0 = ((wave + slab) & 7) * 256 + ((sc + (slab >> 3)) & 3) * 64;
        f32x4 v[12];
        int ln = lane; asm volatile("" : "+v"(ln));
        const float* Wk = W + (size_t)kb0 * (6 * D);
        { int r = ln / 12, c4 = ln - r * 12;
#pragma unroll
          for (int t = 0; t < 12; ++t) { v[t] = ldu<f32x4>(Wk, (unsigned)(r * (6 * D) + 4 * c4) * 4u); c4 += 4; r += 5; if (c4 >= 12) { c4 -= 12; r += 1; } } }
        { int r = ln / 12, c4 = ln - r * 12;
#pragma unroll
          for (int t = 0; t < 12; ++t) { *(LAS f32x4*)(Bl + r * 48 + 4 * c4) = v[t]; c4 += 4; r += 5; if (c4 >= 12) { c4 -= 12; r += 1; } } }
        LDS_WAIT(); asm volatile("" ::: "memory");
#pragma unroll
        for (int kb2 = 0; kb2 < 2; ++kb2) {
            const int k0 = kb0 + kb2 * 32 + fq * 8;
            bf16x8 bfr[3];
#pragma unroll
            for (int nt = 0; nt < 3; ++nt) { const LAS float* bp = Bl + (kb2 * 32 + fq * 8) * 48 + nt * 16 + fr;
                u32x4 w; w.x = pk2(bp[0], bp[48]); w.y = pk2(bp[96], bp[144]); w.z = pk2(bp[192], bp[240]); w.w = pk2(bp[288], bp[336]);
                bfr[nt] = __builtin_bit_cast(bf16x8, w); }
            const bf16_t* sil = (const bf16_t*)(p.ws + WS_SILU) + (size_t)fr * D + k0;
            bf16x8 afr[9];
#pragma unroll
            for (int mt = 0; mt < 9; ++mt) afr[mt] = *(const bf16x8*)(sil + (size_t)(mt * 16) * D);
#pragma unroll
            for (int mt = 0; mt < 9; ++mt)
#pragma unroll
                for (int nt = 0; nt < 3; ++nt) acc[mt][nt] = __builtin_amdgcn_mfma_f32_16x16x32_bf16(afr[mt], bfr[nt], acc[mt][nt], 0, 0, 0);
        }
        LDS_WAIT(); asm volatile("" ::: "memory");
    }
    for (int w = 0; w < NWAVES; ++w) {
        if (wave == w) {
#pragma unroll
            for (int mt = 0; mt < 9; ++mt)
#pragma unroll
                for (int nt = 0; nt < 3; ++nt)
#pragma unroll
                    for (int r = 0; r < 4; ++r) { LAS float* q = red + (mt * 16 + 4 * fq + r) * 48 + nt * 16 + fr; *q = *q + acc[mt][nt][r]; }
        }
        __syncthreads();
    }
    float* mod = (float*)(p.ws + WS_MOD);
    for (int i = tid; i < NSEQ * 48; i += NTHR) { const int row = i / 48, c = i % 48; mod[(size_t)row * (6 * D) + n0 + c] = red[row * 48 + c] + p.in[7][n0 + c]; }
    __syncthreads();
}
__device__ __forceinline__ void p0_silu(const P& p, int gt, int NT) {
    bf16_t* sil = (bf16_t*)(p.ws + WS_SILU);
    for (int i = gt; i < 144 * D / 4; i += NT) {
        const int row = i / (D / 4), k = (i - row * (D / 4)) * 4;
        f32x4 v = (f32x4){0.f, 0.f, 0.f, 0.f};
        if (row < NSEQ) { v = *(const f32x4*)((row < NPB ? p.in[4] + (size_t)row * D : p.in[5] + (size_t)(row - NPB) * D) + k);
#pragma unroll
            for (int e = 0; e < 4; ++e) v[e] = v[e] * sigmoidf_(v[e]); }
        u32x2v w; w.x = pk2(v[0], v[1]); w.y = pk2(v[2], v[3]); *(u32x2v*)(sil + (size_t)row * D + k) = w;
    }
}
struct TJob { const float* W; bf16_t* WT; int K, N, ldw, kofs, item; bool swz; };
__device__ __forceinline__ void tr_load(const TJob& j, float (&tv)[32], int lane) {
    const int nblk = j.N / 32, kb = j.item / nblk, nb = j.item - kb * nblk;
    const float* w = j.W + (size_t)(64 * kb) * j.N + 32 * nb;
    const unsigned lo = (unsigned)((lane >> 5) * j.N + (lane & 31)) * 4u, rs2 = (unsigned)j.N * 8u;
#pragma unroll
    for (int i = 0; i < 32; ++i) tv[i] = ldu<float>(w, lo + (unsigned)i * rs2);
}
__device__ __forceinline__ void tr_store(const TJob& j, const float (&tv)[32], LAS float* scr, int lane) {
    const int nblk = j.N / 32, kb = j.item / nblk, nb = j.item - kb * nblk, k0 = 64 * kb, n0 = 32 * nb;
    int r0 = n0;
    if (j.swz) { r0 = n0 < DFF ? 256 * (n0 >> 7) + (n0 & 127) : 256 * ((n0 - DFF) >> 7) + 128 + ((n0 - DFF) & 127); }
#pragma unroll
    for (int i = 0; i < 32; ++i) scr[(2 * i + (lane >> 5)) * 33 + (lane & 31)] = tv[i];
    LDS_WAIT(); asm volatile("" ::: "memory");
    const int c = lane & 7;
#pragma unroll
    for (int jj = 0; jj < 4; ++jj) { const int n = (lane >> 3) + 8 * jj; const LAS float* s = scr + (8 * c) * 33 + n;
        u32x4 o; o.x = pk2(s[0 * 33], s[1 * 33]); o.y = pk2(s[2 * 33], s[3 * 33]); o.z = pk2(s[4 * 33], s[5 * 33]); o.w = pk2(s[6 * 33], s[7 * 33]);
        *(u32x4*)(j.WT + (size_t)(r0 + n) * j.ldw + j.kofs + k0 + 8 * c) = o; }
    LDS_WAIT(); asm volatile("" ::: "memory");
}
__device__ __forceinline__ bool tr_job(const P& p, int part, int it, TJob& j) {
    constexpr int I_IN = (D / 64) * (CIN / 32), I_BA = (RW / 64) * (D / 32), I_OUT = (D / 64) * (D / 32), I_FI = (D / 64) * (2 * DFF / 32), I_FO = (DFF / 64) * (D / 32);
    constexpr int I_L64 = (RW / 32), I_L128 = 2 * (RW / 32);
    unsigned char* ws = p.ws; int r = it;
    j.swz = false; j.kofs = 0;
    if (part == 0) {
        if (r < I_IN) { j.W = p.in[9]; j.WT = (bf16_t*)(ws + WS_WIN); j.K = D; j.N = CIN; j.ldw = D; j.item = r; return true; } r -= I_IN;
        if (r < I_L64) { j.W = p.in[12]; j.WT = (bf16_t*)(ws + WS_LORA); j.K = 64; j.N = RW; j.ldw = 64; j.item = r; return true; } r -= I_L64;
        if (r < I_L64) { j.W = p.in[14]; j.WT = (bf16_t*)(ws + WS_LORA) + RW * 64; j.K = 64; j.N = RW; j.ldw = 64; j.item = r; return true; } r -= I_L64;
        if (r < I_L128) { j.W = p.in[15]; j.WT = (bf16_t*)(ws + WS_LORA) + 2 * RW * 64; j.K = 128; j.N = RW; j.ldw = 128; j.item = r; return true; }
        return false;
    } else if (part == 1) {
        if (r < I_BA) { j.W = p.in[25]; j.WT = (bf16_t*)(ws + WS_WBA); j.K = RW; j.N = D; j.ldw = 2 * RW; j.item = r; return true; } r -= I_BA;
        if (r < I_BA) { j.W = p.in[26]; j.WT = (bf16_t*)(ws + WS_WBA); j.K = RW; j.N = D; j.ldw = 2 * RW; j.kofs = RW; j.item = r; return true; } r -= I_BA;
        if (r < I_OUT) { j.W = p.in[27]; j.WT = (bf16_t*)(ws + WS_WOUT); j.K = D; j.N = D; j.ldw = D; j.item = r; return true; } r -= I_OUT;
        if (r < I_FI) { j.W = p.in[29]; j.WT = (bf16_t*)(ws + WS_WFI); j.K = D; j.N = 2 * DFF; j.ldw = D; j.swz = true; j.item = r; return true; } r -= I_FI;
        if (r < I_FO) { j.W = p.in[30]; j.WT = (bf16_t*)(ws + WS_WFO); j.K = DFF; j.N = D; j.ldw = DFF; j.item = r; return true; }
        return false;
    } else {
        if (r < I_FO) { j.W = p.in[30]; j.WT = (bf16_t*)(ws + WS_WFO); j.K = DFF; j.N = D; j.ldw = DFF; j.item = r; return true; }
        return false;
    }
}
__device__ __forceinline__ void p0_transposes(const P& p, LAS float* scr, int part, int gw, int NGW, int lane) {
    TJob ja, jb; float ta[32], tb[32];
    int it = gw;
    if (!tr_job(p, part, it, ja)) return;
    tr_load(ja, ta, lane);
    for (;;) {
        const bool hb = tr_job(p, part, it + NGW, jb);
        if (hb) tr_load(jb, tb, lane);
        tr_store(ja, ta, scr, lane);
        if (!hb) break;
        const bool ha = tr_job(p, part, it + 2 * NGW, ja);
        if (ha) tr_load(ja, ta, lane);
        tr_store(jb, tb, scr, lane);
        if (!ha) break;
        it += 2 * NGW;
    }
}
__device__ __forceinline__ void norm_row(const float* x, const float* g, const float* scale, const float* shift, bf16_t* h, int lane) {
    f32x4 v[8]; float s = 0.f;
#pragma unroll
    for (int j = 0; j < 8; ++j) { v[j] = *(const f32x4*)(x + 4 * lane + 256 * j); s += (v[j][0] * v[j][0] + v[j][1] * v[j][1]) + (v[j][2] * v[j][2] + v[j][3] * v[j][3]); }
    const float rstd = rsqrtf(wave_sum(s) * (1.f / D) + 1e-6f);
#pragma unroll
    for (int j = 0; j < 8; ++j) { const int k = 4 * lane + 256 * j;
        const f32x4 gg = *(const f32x4*)(g + k), sc = *(const f32x4*)(scale + k), sh = *(const f32x4*)(shift + k);
        const f32x4 o = v[j] * rstd * gg * (sc + 1.f) + sh;
        u32x2v w; w.x = pk2(o[0], o[1]); w.y = pk2(o[2], o[3]); *(u32x2v*)(h + k) = w; }
}
__device__ __forceinline__ void phase_norm(const P& p, int which, int gw, int NGW, int lane) {
    const float* g = which == 0 ? p.in[8] : p.in[28];
    for (int row = gw; row < M; row += NGW) {
        const float* x = which == 0 ? (row < MP ? p.in[0] + (size_t)row * D : p.in[1] + (size_t)(row - MP) * D) : p.out + (size_t)row * D;
        const float* mod = (const float*)(p.ws + WS_MOD) + (size_t)seq_of_row(row) * (6 * D);
        norm_row(x, g, mod + (which == 0 ? 1 : 4) * D, mod + (which == 0 ? 0 : 3) * D, (bf16_t*)(p.ws + WS_H) + (size_t)row * D, lane);
    }
}
__device__ __forceinline__ void phase_lnv(const P& p, int gw, int NGW, int lane) {
    for (int row = gw; row < M; row += NGW) {
        const bf16_t* zv = (const bf16_t*)(p.ws + WS_ZUG) + (size_t)row * ZUGW + ZU_V;
        float v[16]; float s = 0.f;
#pragma unroll
        for (int j = 0; j < 2; ++j) { const u32x4 w = *(const u32x4*)(zv + 8 * lane + 512 * j);
            v[8 * j + 0] = bflo(w.x); v[8 * j + 1] = bfhi(w.x); v[8 * j + 2] = bflo(w.y); v[8 * j + 3] = bfhi(w.y);
            v[8 * j + 4] = bflo(w.z); v[8 * j + 5] = bfhi(w.z); v[8 * j + 6] = bflo(w.w); v[8 * j + 7] = bfhi(w.w); }
#pragma unroll
        for (int i = 0; i < 16; ++i) s += v[i];
        const float mean = wave_sum(s) * (1.f / MLPW);
        float q = 0.f;
#pragma unroll
        for (int i = 0; i < 16; ++i) { v[i] -= mean; q += v[i] * v[i]; }
        const float rstd = rsqrtf(wave_sum(q) * (1.f / MLPW) + 1e-5f);
        bf16_t* vn = (bf16_t*)(p.ws + WS_VN) + (size_t)row * MLPW;
#pragma unroll
        for (int j = 0; j < 2; ++j) { const int c = 8 * lane + 512 * j; float o[8];
#pragma unroll
            for (int e = 0; e < 8; ++e) o[e] = v[8 * j + e] * rstd * p.in[21][c + e] + p.in[22][c + e];
            u32x4 w; w.x = pk2(o[0], o[1]); w.y = pk2(o[2], o[3]); w.z = pk2(o[4], o[5]); w.w = pk2(o[6], o[7]);
            *(u32x4*)(vn + c) = w;
            if (row >= MP) { float* vs = p.out + O_VS + (size_t)(row - MP) * MLPW + c;
                *(f32x4*)vs = (f32x4){o[0], o[1], o[2], o[3]}; *(f32x4*)(vs + 4) = (f32x4){o[4], o[5], o[6], o[7]}; }
        }
    }
}
__device__ __forceinline__ void phase_final(const P& p, int gw, int NGW, int lane) {
    for (int row = gw; row < M; row += NGW) {
        float* x = p.out + (size_t)row * D;
        f32x4 v[8]; float s = 0.f;
#pragma unroll
        for (int j = 0; j < 8; ++j) { v[j] = *(const f32x4*)(x + 4 * lane + 256 * j); s += (v[j][0] * v[j][0] + v[j][1] * v[j][1]) + (v[j][2] * v[j][2] + v[j][3] * v[j][3]); }
        const float rstd = rsqrtf(wave_sum(s) * (1.f / D) + 1e-6f);
#pragma unroll
        for (int j = 0; j < 8; ++j) { const int k = 4 * lane + 256 * j; *(f32x4*)(x + k) = v[j] * rstd * *(const f32x4*)(p.in[31] + k); }
    }
}
__device__ __forceinline__ void mix_naive_row(const P& p, int row, int tid, int nthr) {
    int t;
    if (row < MP) t = (row & (TP - 1)) & 127; else t = (row - MP) & (TS - 1);
    const int rowc0 = row - t;
    const bf16_t* vn = (const bf16_t*)(p.ws + WS_VN);
    const bf16_t* zu = (const bf16_t*)(p.ws + WS_ZUG) + (size_t)row * ZUGW + ZU_U;
    bf16_t* ub = (bf16_t*)(p.ws + WS_OA) + (size_t)row * (2 * RW) + RW;
    for (int c = tid; c < MLPW; c += nthr) {
        const int g = c >> 7; const float* wsg = p.in[23] + ((size_t)g * 128 + t) * 128;
        float acc = 0.f;
        for (int s = 0; s <= t; ++s) acc += wsg[s] * bf2f(vn[(size_t)(rowc0 + s) * MLPW + c]);
        acc += p.in[24][g * 128 + t];
        ub[c] = f2bf(bf2f(zu[c]) * acc);
    }
}

#define PHASE_IDS() int tid = threadIdx.x; asm volatile("" : "+v"(tid)); const int lane = tid & 63, wave = __builtin_amdgcn_readfirstlane(tid >> 6); \
    const int gw = bx * NWAVES + wave, NGW = G * NWAVES; (void)lane; (void)gw; (void)NGW
__global__ void __launch_bounds__(NTHR, 2) mega_fwd(P p) {
    extern __shared__ __attribute__((aligned(16))) unsigned char lds_raw[];
    LAS unsigned char* lds = (LAS unsigned char*)lds_raw;
    const int G = gridDim.x, bx = blockIdx.x;
    unsigned char* ws = p.ws;
#define FLAGS(k) ((unsigned*)(ws + WS_CTL) + CW_FLAGS + (k) * 256)
    { PHASE_IDS();
      for (int u = tid; u < (LDS_BYTES - LDSCTL_OFF) / 4; u += NTHR) ((LAS unsigned*)(lds + LDSCTL_OFF))[u] = 0u; }
    __syncthreads();
    XcdBarrier bar = xcd_barrier_post((unsigned*)(ws + WS_CTL) + CW_BAR, (volatile LAS unsigned*)(lds + MISC_OFF) + 8);
#ifdef TSMASK
    unsigned long long* tsw = (unsigned long long*)(ws + WS_CTL + 524288); int nst = 0;
#define STAMP() do { if (bx == 0 && threadIdx.x == 0) tsw[nst] = __builtin_amdgcn_s_memrealtime(); ++nst; } while (0)
#else
#define STAMP() do { } while (0)
#endif
    STAMP();

    { PHASE_IDS();
      p0_silu(p, bx * NTHR + tid, G * NTHR);
      p0_transposes(p, (LAS float*)(lds + wave * 16384), 0, gw, NGW, lane); }
    xcd_barrier(bar); STAMP();
    { PHASE_IDS();
      for (int slab = bx; slab < 256; slab += G) p0_mod_slab(p, lds, slab, tid, lane, wave); }
    xcd_barrier(bar); STAMP();
    { PHASE_IDS(); phase_norm(p, 0, gw, NGW, lane); }
    xcd_barrier(bar); STAMP();
    {
        pg8::Gemm g{(const bf16_t*)(ws + WS_H), (const bf16_t*)(ws + WS_WIN), M, CIN, D}; SliceOrder S; S.init(M, CIN, D, bx, FLAGS(0), (float*)(ws + WS_VN));
        EpiZ E{(bf16_t*)(ws + WS_ZRW), (bf16_t*)(ws + WS_ZUG), p.out};
        pg8::gemm_phase<EpiZ, SliceOrder, PG8_ALIGN, PG8_SP2>(lds, g, S, E);
    }
    xcd_barrier(bar); STAMP();
    { PHASE_IDS();
      phase_lnv(p, gw, NGW, lane);
      STAMP();
      for (int rec = gw; rec < NREC; rec += NGW) prep_record(p, lds + wave * 16384, rec, lane); }
    xcd_barrier(bar); STAMP();
    { PHASE_IDS();
        const int NPC = NPB * NH;
        volatile LAS unsigned* prog = (volatile LAS unsigned*)(lds + MISC_OFF) + 16;
        if (bx < NPC) {
            if (wave < 2) scan_chain_prompt(p, bx >> 4, bx & 15, wave, lane, prog);
            else if (wave == 4 || wave == 5) scan_prefetch(p, prog, bx >> 4, bx & 15, wave - 4, lane);
            STAMP();
        }
        else {
            const int wid = (bx - NPC) * NWAVES + wave, NW = (G - NPC) * NWAVES;
            for (int j = wid; j < NSB * NH * 4; j += NW) scan_chain_sample(p, j >> 6, (j >> 2) & 15, j & 3, lane);
            for (int item = bx - NPC; item < NPB * 16 * 8; item += G - NPC) mix_item(p, item, wave, lane);
            for (int row = MP + bx - NPC; row < M; row += G - NPC) mix_naive_row(p, row, tid, NTHR);
            p0_transposes(p, (LAS float*)(lds + wave * 16384), 1, wid, NW, lane);
        }
    }
    xcd_barrier(bar); STAMP();
    { PHASE_IDS(); post_rows(p, gw, NGW, lane); }
    xcd_barrier(bar); STAMP();
    {
        pg8::Gemm g{(const bf16_t*)(ws + WS_OA), (const bf16_t*)(ws + WS_WBA), M, D, 2 * RW}; SliceOrder S; S.init(M, D, 2 * RW, bx, FLAGS(1), p.out);
        EpiMerge E{(const bf16_t*)(ws + WS_ZUG), (bf16_t*)(ws + WS_H)};
        pg8::gemm_phase<EpiMerge, SliceOrder, PG8_ALIGN, PG8_SP2>(lds, g, S, E);
    }
    xcd_barrier(bar); STAMP();
    {
        pg8::Gemm g{(const bf16_t*)(ws + WS_H), (const bf16_t*)(ws + WS_WOUT), M, D, D}; SliceOrder S; S.init(M, D, D, bx, FLAGS(2), (float*)(ws + WS_VN));
        EpiRes1 E{p.in[0], p.in[1], (const float*)(ws + WS_MOD), p.out};
        pg8::gemm_phase<EpiRes1, SliceOrder, PG8_ALIGN, PG8_SP2>(lds, g, S, E);
    }
    xcd_barrier(bar); STAMP();
    { PHASE_IDS(); phase_norm(p, 1, gw, NGW, lane); }
    xcd_barrier(bar); STAMP();
    {
        pg8::Gemm g{(const bf16_t*)(ws + WS_H), (const bf16_t*)(ws + WS_WFI), M, 2 * DFF, D}; SliceOrder S; S.init(M, 2 * DFF, D, bx, FLAGS(3), (float*)(ws + WS_VN));
        EpiSwiglu E{(bf16_t*)(ws + WS_ZUG)};
        pg8::gemm_phase<EpiSwiglu, SliceOrder, PG8_ALIGN, PG8_SP2>(lds, g, S, E);
    }
    xcd_barrier(bar); STAMP();
    {
        pg8::Gemm g{(const bf16_t*)(ws + WS_ZUG), (const bf16_t*)(ws + WS_WFO), M, D, DFF}; SliceOrder S; S.init(M, D, DFF, bx, FLAGS(4), (float*)(ws + WS_VN));
        EpiRes2 E{(const float*)(ws + WS_MOD), p.out};
        pg8::gemm_phase<EpiRes2, SliceOrder, PG8_ALIGN, PG8_SP2>(lds, g, S, E);
    }
    xcd_barrier(bar); STAMP();
    { PHASE_IDS(); phase_final(p, gw, NGW, lane); }
#ifdef TSMASK
    STAMP();
    if (bx == 0 && threadIdx.x == 0) {
        unsigned long long tot = 0;
        for (int k = 0; k < nst - 1; ++k) if ((TSMASK >> k) & 1) tot += tsw[k + 1] - tsw[k];
        p.out[0] += (float)tot * (1.0f / 20000.0f);
    }
#endif
}

extern "C" void kernel_launch(void* const* d_in, const int* in_sizes, int n_in, void* d_out, int out_size, void* d_ws, size_t ws_size, hipStream_t stream) {
    static int grid = 0;
    if (grid == 0) {
        if (n_in != 32 || (size_t)out_size != O_END || ws_size < WS_END) { fprintf(stderr, "kernel_launch: unexpected shapes n_in=%d out=%d ws=%zu (need %zu)\n", n_in, out_size, ws_size, (size_t)WS_END); grid = -1; return; }
        int dev = 0, cus = 0, per_cu = 0;
        if (hipGetDevice(&dev) != hipSuccess || hipDeviceGetAttribute(&cus, hipDeviceAttributeMultiprocessorCount, dev) != hipSuccess) { grid = -1; return; }
        if (hipFuncSetAttribute((const void*)mega_fwd, hipFuncAttributeMaxDynamicSharedMemorySize, LDS_BYTES) != hipSuccess) { fprintf(stderr, "kernel_launch: hipFuncSetAttribute failed\n"); grid = -1; return; }
        if (hipOccupancyMaxActiveBlocksPerMultiprocessor(&per_cu, (const void*)mega_fwd, NTHR, LDS_BYTES) != hipSuccess || per_cu < 1) { fprintf(stderr, "kernel_launch: occupancy query says %d blocks per CU\n", per_cu); }
        (void)hipGetLastError();
        grid = cus;
        if (grid != 256) { fprintf(stderr, "kernel_launch: built for 256 CUs (got %d)\n", cus); grid = -1; return; }
        if (grid < 128) { fprintf(stderr, "kernel_launch: this kernel's phase plan needs >= 128 CUs (got %d)\n", cus); grid = -1; return; }
    }
    if (grid < 0) return;
    if (hipMemsetAsync((char*)d_ws + WS_CTL, 0, CTL_ZERO_BYTES, stream) != hipSuccess) { fprintf(stderr, "kernel_launch: memset failed\n"); return; }
    P p{};
    for (int i = 0; i < 32; ++i) p.in[i] = (const float*)d_in[i];
    p.out = (float*)d_out; p.ws = (unsigned char*)d_ws;
    hipLaunchKernelGGL(mega_fwd, dim3(grid), dim3(NTHR), LDS_BYTES, stream, p);
    const hipError_t le = hipPeekAtLastError();
    if (le != hipSuccess) fprintf(stderr, "kernel_launch: launch failed: %s\n", hipGetErrorName(le));
}
```

```cpp
#include <hip/hip_runtime.h>
#include <cstdio>
#include <cstdint>

constexpr int D = 2048, NPB = 4, TP = 2048, NSB = 128, TS = 8;
constexpr int MP = NPB * TP, MS = NSB * TS, M = MP + MS;
constexpr int RW = 1024, NH = 16, HS = 64;
constexpr int CSH = 3328, CIN = 9472, DFF = 5632, MLPW = 1024;
constexpr int C_U = CSH, C_V = CSH + 1024, C_G0 = CSH + 2048, C_G1 = C_G0 + 2048;
constexpr int ZUGW = CIN - CSH, ZU_U = 0, ZU_V = 1024, ZU_G0 = 2048, ZU_G1 = 4096;
constexpr int NSEQ = NPB + NSB;
constexpr size_t O_YP = 0, O_YS = O_YP + (size_t)MP * D, O_WKVP = O_YS + (size_t)MS * D, O_SHP = O_WKVP + (size_t)NPB * NH * HS * HS,
                 O_WKVS = O_SHP + (size_t)NPB * CSH, O_SHS = O_WKVS + (size_t)NSB * NH * HS * HS, O_VS = O_SHS + (size_t)NSB * CSH,
                 O_END = O_VS + (size_t)MS * MLPW;
constexpr size_t WS_CTL = 0, CTL_ZERO_BYTES = 1u << 20;
constexpr size_t WS_WIN = CTL_ZERO_BYTES;
constexpr size_t WS_WBA = WS_WIN + (size_t)CIN * D * 2;
constexpr size_t WS_WBB = WS_WBA + (size_t)D * RW * 2;
constexpr size_t WS_WOUT = WS_WBB + (size_t)D * RW * 2;
constexpr size_t WS_WFI = WS_WOUT + (size_t)D * D * 2;
constexpr size_t WS_WFO = WS_WFI + (size_t)2 * DFF * D * 2;
constexpr size_t WS_MOD = WS_WFO + (size_t)D * DFF * 2;
constexpr size_t WS_H = WS_MOD + (size_t)NSEQ * 6 * D * 4;
constexpr size_t WS_ZRW = WS_H + (size_t)M * D * 2;
constexpr size_t WS_ZUG = WS_ZRW + (size_t)M * CSH * 2;
constexpr size_t WS_VN = WS_ZUG + (size_t)M * ZUGW * 2;
constexpr size_t WS_OA = WS_VN + (size_t)M * MLPW * 2;
constexpr size_t WS_UB = WS_OA + (size_t)M * RW * 2;
constexpr size_t WS_C2 = WS_UB + (size_t)M * MLPW * 2;
constexpr size_t WS_LORA = WS_C2 + (size_t)M * RW * 2;
constexpr size_t WS_SILU = WS_LORA + (size_t)RW * 256 * 2;
constexpr size_t WS_FRA_S = WS_SILU + (size_t)144 * D * 2;
constexpr size_t WS_FRB_S = WS_FRA_S + (size_t)NSB * NH * 4096;
constexpr size_t WS_END = WS_FRB_S + (size_t)NSB * NH * 8448;
constexpr int NREC_P = NPB * 128 * NH, NREC = NREC_P + NSB * NH;
constexpr int RECA = 4096, RECB = 8448;
static_assert(WS_C2 + (size_t)M * RW * 2 - WS_VN >= (size_t)256 * 262144, "stream-K slabs (256 x 256 KiB) fit VN | OA|UB | C2");
static_assert((size_t)NREC_P * RECA <= (size_t)M * D * 2 && (size_t)NREC_P * RECB <= (size_t)M * D * 4, "prompt fragment records fit the H buffer / the y region of d_out");
constexpr int CW_BAR = 4096, CW_PREPQ = 16384, CW_FLAGS = 32768;

typedef float f32x2v __attribute__((ext_vector_type(2)));
typedef __bf16 bf16x2v __attribute__((ext_vector_type(2)));
typedef unsigned u32x2v __attribute__((ext_vector_type(2)));

struct P { const float* in[32]; float* out; unsigned char* ws; };

__device__ __forceinline__ unsigned pk2(float lo, float hi) { return __builtin_bit_cast(unsigned, __builtin_convertvector((f32x2v){lo, hi}, bf16x2v)); }
__device__ __forceinline__ unsigned short f2bf(float f) { return (unsigned short)(pk2(f, 0.f) & 0xffffu); }
__device__ __forceinline__ float bf2f(unsigned short h) { return __uint_as_float(((unsigned)h) << 16); }
__device__ __forceinline__ float bflo(unsigned w) { return __uint_as_float(w << 16); }
__device__ __forceinline__ float bfhi(unsigned w) { return __uint_as_float(w & 0xffff0000u); }
__device__ __forceinline__ float sigmoidf_(float x) { return __builtin_amdgcn_rcpf(1.f + __expf(-x)); }
__device__ __forceinline__ float gelu_tanh(float x) {
    const float u = 0.7978845608028654f * (x + 0.044715f * x * x * x); return x * __builtin_amdgcn_rcpf(1.f + __expf(-2.f * u)); }
__device__ __forceinline__ float wave_sum(float v) {
#pragma unroll
    for (int o = 1; o < 64; o <<= 1) v += __shfl_xor(v, o);
    return v;
}
__device__ __forceinline__ int seq_of_row(int row) { return row < MP ? row / TP : NPB + (row - MP) / TS; }

namespace pg8 {
#define PG8_LAS __attribute__((address_space(3)))
typedef unsigned short bf16_t;
typedef short bf16x8 __attribute__((ext_vector_type(8)));
typedef float f32x4 __attribute__((ext_vector_type(4)));
typedef unsigned u32x4 __attribute__((ext_vector_type(4)));
constexpr int BM = 256, BK = 64, HALF = 128, HTB = HALF * BK * 2  , STAGE_BYTES = 8 * HTB, NXCD = 8, WGM = 8;

__host__ __device__ __forceinline__ int lds_byte(int r, int c) { const int st = (r >> 4) * 2 + (c >> 5), rr = r & 15, cc = c & 31, ob = rr * 64 + cc * 2; return st * 1024 + (ob ^ (((ob >> 9) & 1) << 5)); }
__host__ __device__ __forceinline__ void stage_rc(int b, int& R, int& C) { const int st = b / 1024, sb = b % 1024, swz = sb ^ (((sb >> 9) & 1) << 5); R = (st >> 1) * 16 + swz / 64; C = (st & 1) * 32 + (swz % 64) / 2; }
__host__ __device__ __forceinline__ int perm32(int rho) { const int n = rho >> 4, i = rho & 15; return 8 * (i >> 2) + 4 * n + (i & 3); }

struct Unit { int pm, pn, kb, nk, kind, peer; };
struct Gemm { const bf16_t* A; const bf16_t* Bt; int M, N, K; };

struct StaticOrder {
    int nM, nN, nwg, G, c;
    __host__ __device__ void init(int M, int N, int G_, int c_) { nM = M / BM; nN = N / BM; nwg = nM * nN; G = G_; c = c_; }
    __host__ __device__ bool next(int i, Unit& u) const {
        const long L = (long)i * G + c; if (L >= nwg) return false;
        int wgid = (int)L; { const int q = nwg / NXCD, r = nwg % NXCD, xcd = wgid % NXCD, off = wgid / NXCD; wgid = (xcd < r ? xcd * (q + 1) : r * (q + 1) + (xcd - r) * q) + off; }
        const int nig = WGM * nN, gid = wgid / nig, fm = gid * WGM, gsz = (nM - fm) < WGM ? (nM - fm) : WGM;
        u.pm = fm + ((wgid % nig) % gsz); u.pn = (wgid % nig) / gsz; return true;
    }
    __device__ __forceinline__ void a_ready(const Unit&) const {}
    __device__ __forceinline__ void done(const Unit&) const {}
};
template <class Epi, class Sched, bool ALIGN_EPI = false, bool SP2 = false>
__device__ __forceinline__ void gemm_phase(PG8_LAS unsigned char* lds, const Gemm g, const Sched& S, const Epi& E) {
    int tid_ = threadIdx.x; asm volatile("" : "+v"(tid_));
    const int tid = tid_, wid = __builtin_amdgcn_readfirstlane(tid >> 6), lane = tid & 63, wr = wid >> 2, wc = wid & 3, fr = lane & 15, fq = lane >> 4;
    const int K = g.K;
    unsigned voffA[2], voffB[2];
#pragma unroll
    for (int i = 0; i < 2; ++i) { int R, C; stage_rc(tid * 16 + i * 8192, R, C); const int Rb = Epi::PERM ? ((R & ~31) + perm32(R & 31)) : R;
        voffA[i] = (unsigned)(R * K + C) * 2u; voffB[i] = (unsigned)(Rb * K + C) * 2u; }
    const size_t kstep = (size_t)(BK * 2);
    const size_t hstep = (size_t)HALF * K * 2;
    const size_t tstep = 2 * hstep;
    const unsigned ldsw = (unsigned)wid * 1024u;
    const int aoff = lds_byte(wr * 64 + fr, fq * 8), boff = lds_byte(wc * 32 + fr, fq * 8);
#define PG8_SA(b, h) (((b) * 2 + (h)) * HTB)
#define PG8_SB(b, h) ((4 + (b) * 2 + (h)) * HTB)
#define PG8_STAGE(bufoff, gbase, voff) do { _Pragma("unroll") for (int _i = 0; _i < 2; ++_i) \
        __builtin_amdgcn_global_load_lds((const unsigned*)((const char*)(gbase) + (voff)[_i]), (PG8_LAS unsigned*)(lds + (bufoff) + ldsw + _i * 8192), 16, 0, 0); } while (0)
#define PG8_LDA(dst, b, h) do { _Pragma("unroll") for (int m = 0; m < 4; ++m) _Pragma("unroll") for (int k = 0; k < 2; ++k) dst[m][k] = *(const PG8_LAS bf16x8*)(lds + PG8_SA(b, h) + aoff + m * 2048 + k * 1024); } while (0)
#define PG8_LDB(dst, b, h) do { _Pragma("unroll") for (int n = 0; n < 2; ++n) _Pragma("unroll") for (int k = 0; k < 2; ++k) dst[n][k] = *(const PG8_LAS bf16x8*)(lds + PG8_SB(b, h) + boff + n * 2048 + k * 1024); } while (0)
#define PG8_MMA(ai, bj, At, Bt) do { __builtin_amdgcn_s_setprio(1); _Pragma("unroll") for (int m = 0; m < 4; ++m) _Pragma("unroll") for (int n = 0; n < 2; ++n) _Pragma("unroll") for (int k = 0; k < 2; ++k) \
        acc[ai][bj][m][n] = __builtin_amdgcn_mfma_f32_16x16x32_bf16(Bt[n][k], At[m][k], acc[ai][bj][m][n], 0, 0, 0); __builtin_amdgcn_s_setprio(0); } while (0)
#define PG8_WAIT_V(n) asm volatile("s_waitcnt vmcnt(" #n ")" ::: "memory")
#define PG8_WAIT_L(n) asm volatile("s_waitcnt lgkmcnt(" #n ")" ::: "memory")
#define PG8_BAR __builtin_amdgcn_s_barrier()
#define PG8_SCHED __builtin_amdgcn_sched_barrier(0)
    Unit cur, nxt; int ui = 0;
    if (!S.next(0, cur)) return;
    f32x4 acc[2][2][4][2];
#pragma unroll
    for (int a = 0; a < 2; ++a)
#pragma unroll
        for (int b = 0; b < 2; ++b)
#pragma unroll
            for (int m = 0; m < 4; ++m)
#pragma unroll
                for (int n = 0; n < 2; ++n) acc[a][b][m][n] = (f32x4){0.f, 0.f, 0.f, 0.f};
    bf16x8 At[4][2], B0[2][2], B1[2][2];
    const char* cA = (const char*)g.A + (size_t)cur.pm * tstep + (size_t)cur.kb * kstep; const char* cB = (const char*)g.Bt + (size_t)cur.pn * tstep + (size_t)cur.kb * kstep;
    S.a_ready(cur);
    if constexpr (SP2) {
        PG8_STAGE(PG8_SB(0, 0), cB, voffB); PG8_STAGE(PG8_SB(0, 1), cB + hstep, voffB); PG8_STAGE(PG8_SA(0, 0), cA, voffA); PG8_STAGE(PG8_SA(0, 1), cA + hstep, voffA);
        if (wr == 1) PG8_BAR;
        PG8_WAIT_V(2); PG8_BAR;
        PG8_STAGE(PG8_SB(1, 0), cB + kstep, voffB); PG8_STAGE(PG8_SA(1, 0), cA + kstep, voffA); PG8_STAGE(PG8_SB(1, 1), cB + hstep + kstep, voffB);
        PG8_WAIT_V(6); PG8_BAR;
    } else {
        PG8_STAGE(PG8_SB(0, 0), cB, voffB); PG8_STAGE(PG8_SA(0, 0), cA, voffA); PG8_STAGE(PG8_SB(0, 1), cB + hstep, voffB); PG8_STAGE(PG8_SA(0, 1), cA + hstep, voffA);
        if (wr == 1) PG8_BAR;
        PG8_WAIT_V(4); PG8_BAR;
        PG8_STAGE(PG8_SB(1, 0), cB + kstep, voffB); PG8_STAGE(PG8_SA(1, 0), cA + kstep, voffA); PG8_STAGE(PG8_SB(1, 1), cB + hstep + kstep, voffB);
        PG8_WAIT_V(6); PG8_BAR;
    }
    for (;;) {
        const bool has_next = S.next(ui + 1, nxt);
        const char* nA = has_next ? (const char*)g.A + (size_t)nxt.pm * tstep + (size_t)nxt.kb * kstep : cA; const char* nB = has_next ? (const char*)g.Bt + (size_t)nxt.pn * tstep + (size_t)nxt.kb * kstep : cB;
        const int nt = cur.nk;
        for (int t = 0; t < nt; t += 2) {
            const bool last = (t == nt - 2);
            if constexpr (Epi::HOOK_TILE > 0) { if (cur.kb + t == Epi::HOOK_TILE && t > 0) E.mid(acc, cur, wr, wc, fr, fq); }
            const char* a1 = cA + (size_t)(t + 1) * kstep;
            const char* a2 = last ? nA : cA + (size_t)(t + 2) * kstep; const char* b2 = last ? nB : cB + (size_t)(t + 2) * kstep;
            const char* a3 = a2 + kstep; const char* b3 = b2 + kstep;
            if (last && has_next) S.a_ready(nxt);
            if constexpr (SP2) {
            PG8_LDB(B0, 0, 0); PG8_LDB(B1, 0, 1); PG8_SCHED; PG8_LDA(At, 0, 0); PG8_STAGE(PG8_SA(1, 1), a1 + hstep, voffA);
            PG8_WAIT_V(8); PG8_WAIT_L(0); PG8_BAR; PG8_MMA(0, 0, At, B0); PG8_MMA(0, 1, At, B1); PG8_BAR; PG8_SCHED;
            PG8_LDA(At, 0, 1); PG8_STAGE(PG8_SB(0, 0), b2, voffB); PG8_STAGE(PG8_SB(0, 1), b2 + hstep, voffB); PG8_STAGE(PG8_SA(0, 0), a2, voffA);
            PG8_WAIT_V(8); PG8_WAIT_L(0); PG8_BAR; PG8_MMA(1, 0, At, B0); PG8_MMA(1, 1, At, B1); PG8_BAR; PG8_SCHED;
            PG8_LDB(B0, 1, 0); PG8_LDB(B1, 1, 1); PG8_SCHED; PG8_LDA(At, 1, 0); PG8_STAGE(PG8_SA(0, 1), a2 + hstep, voffA);
            PG8_WAIT_V(8); PG8_WAIT_L(0); PG8_BAR; PG8_MMA(0, 0, At, B0); PG8_MMA(0, 1, At, B1); PG8_BAR; PG8_SCHED;
            PG8_LDA(At, 1, 1); PG8_STAGE(PG8_SB(1, 0), b3, voffB); PG8_STAGE(PG8_SB(1, 1), b3 + hstep, voffB); PG8_STAGE(PG8_SA(1, 0), a3, voffA);
            PG8_WAIT_V(8); PG8_WAIT_L(0); PG8_BAR; PG8_MMA(1, 0, At, B0); PG8_MMA(1, 1, At, B1); PG8_BAR; PG8_SCHED;
            } else {
            PG8_LDB(B0, 0, 0); PG8_SCHED; PG8_LDA(At, 0, 0); PG8_STAGE(PG8_SA(1, 1), a1 + hstep, voffA);
            PG8_WAIT_L(8); PG8_BAR; PG8_WAIT_L(0); PG8_MMA(0, 0, At, B0); PG8_BAR; PG8_SCHED;
            PG8_LDB(B1, 0, 1); PG8_STAGE(PG8_SB(0, 0), b2, voffB);
            PG8_BAR; PG8_WAIT_L(0); PG8_MMA(0, 1, At, B1); PG8_BAR;
            PG8_LDA(At, 0, 1); PG8_STAGE(PG8_SA(0, 0), a2, voffA);
            PG8_BAR; PG8_WAIT_L(0); PG8_MMA(1, 0, At, B0); PG8_BAR; PG8_SCHED;
            PG8_STAGE(PG8_SB(0, 1), b2 + hstep, voffB);
            PG8_WAIT_V(6); PG8_BAR; PG8_MMA(1, 1, At, B1); PG8_BAR;
            PG8_LDB(B0, 1, 0); PG8_SCHED; PG8_LDA(At, 1, 0); PG8_STAGE(PG8_SA(0, 1), a2 + hstep, voffA);
            PG8_WAIT_L(8); PG8_BAR; PG8_WAIT_L(0); PG8_MMA(0, 0, At, B0); PG8_BAR; PG8_SCHED;
            PG8_LDB(B1, 1, 1); PG8_STAGE(PG8_SB(1, 0), b3, voffB);
            PG8_BAR; PG8_WAIT_L(0); PG8_MMA(0, 1, At, B1); PG8_BAR;
            PG8_LDA(At, 1, 1); PG8_STAGE(PG8_SA(1, 0), a3, voffA);
            PG8_BAR; PG8_WAIT_L(0); PG8_MMA(1, 0, At, B0); PG8_BAR; PG8_SCHED;
            PG8_STAGE(PG8_SB(1, 1), b3 + hstep, voffB);
            PG8_WAIT_V(6); PG8_BAR; PG8_MMA(1, 1, At, B1); PG8_BAR;
            }
        }
        if constexpr (ALIGN_EPI) { if (wr == 0) PG8_BAR; }
        if constexpr (Epi::HOOK_TILE > 0) { if (cur.kb + cur.nk <= Epi::HOOK_TILE) E.mid(acc, cur, wr, wc, fr, fq); }
        if (cur.kind == 3) {
            int fr_ = fr; asm volatile("" : "+v"(fr_));
            const int ti4 = (wid * 64 + fq * 16 + fr_) * 4;
            {
                float* slw = S.slab + (size_t)(cur.peer * S.nsl + S.s) * 65536;
                const __amdgpu_buffer_rsrc_t rs = __builtin_amdgcn_make_buffer_rsrc(slw, 0, 262144, 0x00020000);
#pragma unroll
                for (int a = 0; a < 2; ++a)
#pragma unroll
                    for (int b = 0; b < 2; ++b)
#pragma unroll
                        for (int m = 0; m < 4; ++m)
#pragma unroll
                            for (int n = 0; n < 2; ++n)
                                __builtin_amdgcn_raw_buffer_store_b128(__builtin_bit_cast(u32x4, acc[a][b][m][n]), rs, (ti4 + (((a * 2 + b) * 4 + m) * 2 + n) * 2048) * 4, 0, 16);
            }
            PG8_WAIT_V(0); PG8_BAR;
            if (wid == 0 && (fq | fr) == 0) {
                __hip_atomic_fetch_add(S.cnt + cur.peer, 1u, __ATOMIC_RELAXED, __HIP_MEMORY_SCOPE_AGENT);
                unsigned sp = 0; while (__hip_atomic_load(S.cnt + cur.peer, __ATOMIC_RELAXED, __HIP_MEMORY_SCOPE_AGENT) < (unsigned)S.nsl && ++sp < (1u << 22)) __builtin_amdgcn_s_sleep(2);
                __builtin_amdgcn_fence(__ATOMIC_ACQUIRE, "agent"); PG8_WAIT_V(0);
            }
            PG8_BAR; asm volatile("" ::: "memory");
            for (int blk = S.s; blk < 8; blk += S.nsl) {
                const int a = blk >> 2, m0 = blk & 3;
                f32x4 r[4];
#pragma unroll
                for (int v = 0; v < 4; ++v) r[v] = (f32x4){0.f, 0.f, 0.f, 0.f};
                for (int s2 = 0; s2 < S.nsl; ++s2) {
                    const float* ss = S.slab + (size_t)(cur.peer * S.nsl + s2) * 65536 + ti4;
#pragma unroll
                    for (int v = 0; v < 4; ++v) r[v] += *(const f32x4*)(ss + (size_t)((((a * 2 + (v >> 1)) * 4 + m0) * 2 + (v & 1)) * 2048));
                }
                E.rg(r[0], r[1], r[2], r[3], cur, a, m0, wr, wc, fr, fq);
            }
        } else {
            E(acc, cur, wr, wc, fr, fq);
        }
        if (!has_next) break;
#pragma unroll
        for (int a = 0; a < 2; ++a)
#pragma unroll
            for (int b = 0; b < 2; ++b)
#pragma unroll
                for (int m = 0; m < 4; ++m)
#pragma unroll
                    for (int n = 0; n < 2; ++n) acc[a][b][m][n] = (f32x4){0.f, 0.f, 0.f, 0.f};
        cur = nxt; cA = nA; cB = nB; ++ui;
        if constexpr (ALIGN_EPI) { if (wr == 1) PG8_BAR; }
    }
    PG8_WAIT_V(0);
    if constexpr (!ALIGN_EPI) { if (wr == 0) PG8_BAR; }
    PG8_BAR;
    if constexpr (Epi::AFTER_DRAIN) { E.fused(acc, cur, wr, wc, fr, fq, lds, wid, lane); S.done(cur); }
#undef PG8_SA
#undef PG8_SB
#undef PG8_STAGE
#undef PG8_LDA
#undef PG8_LDB
#undef PG8_MMA
#undef PG8_WAIT_V
#undef PG8_WAIT_L
#undef PG8_BAR
#undef PG8_SCHED
}
}
#define PG8_SP2 true
#define PG8_ALIGN true

using pg8::f32x4; using pg8::Unit; using pg8::BM; using pg8::HALF; typedef pg8::u32x4 u32x4;
typedef unsigned short bf16_t;

#define EPI_WALK() __device__ __forceinline__ void operator()(const f32x4 (&acc)[2][2][4][2], const Unit& u, int wr, int wc, int fr, int fq) const { \
        _Pragma("unroll") for (int ai = 0; ai < 2; ++ai) _Pragma("unroll") for (int m = 0; m < 4; ++m) { \
            rg(acc[ai][0][m][0], acc[ai][0][m][1], acc[ai][1][m][0], acc[ai][1][m][1], u, ai, m, wr, wc, fr, fq); asm volatile("" ::: "memory"); } }

struct EpiZ {
    static constexpr int HOOK_TILE = 0;
    static constexpr bool PERM = true, AFTER_DRAIN = false;
    bf16_t* zrw; bf16_t* zug; float* out;
    __device__ __forceinline__ void rg(f32x4 v00, f32x4 v01, f32x4 v10, f32x4 v11, const Unit& u, int ai, int m, int wr, int wc, int fr, int fq) const {
        const int colt = u.pn * BM;
        const int mode = colt < CSH ? 0 : (colt < C_G0 ? 1 : 2);
        const int row = u.pm * BM + wr * 64 + fr + ai * HALF + m * 16, col0 = colt + wc * 32 + 8 * fq;
        bf16_t* rowp = mode == 0 ? zrw + (size_t)row * CSH + col0 : zug + (size_t)row * ZUGW + (col0 - CSH);
        if (mode == 0) {
            bool last; float* sh;
            if (row < MP) { last = (row & (TP - 1)) == TP - 1; sh = out + O_SHP + (size_t)(row / TP) * CSH + col0; }
            else { const int rs = row - MP; last = (rs & (TS - 1)) == TS - 1; sh = out + O_SHS + (size_t)(rs / TS) * CSH + col0; }
            if (last) { *(f32x4*)sh = v00; *(f32x4*)(sh + 4) = v01; *(f32x4*)(sh + HALF) = v10; *(f32x4*)(sh + HALF + 4) = v11; }
        } else if (mode == 1) {
#pragma unroll
            for (int e = 0; e < 4; ++e) { v00[e] = gelu_tanh(v00[e]); v01[e] = gelu_tanh(v01[e]); v10[e] = gelu_tanh(v10[e]); v11[e] = gelu_tanh(v11[e]); }
        } else {
#pragma unroll
            for (int e = 0; e < 4; ++e) { v00[e] = sigmoidf_(v00[e]); v01[e] = sigmoidf_(v01[e]); v10[e] = sigmoidf_(v10[e]); v11[e] = sigmoidf_(v11[e]); }
        }
        u32x4 w; w.x = pk2(v00[0], v00[1]); w.y = pk2(v00[2], v00[3]); w.z = pk2(v01[0], v01[1]); w.w = pk2(v01[2], v01[3]);
        *(u32x4*)rowp = w;
        w.x = pk2(v10[0], v10[1]); w.y = pk2(v10[2], v10[3]); w.z = pk2(v11[0], v11[1]); w.w = pk2(v11[2], v11[3]);
        *(u32x4*)(rowp + HALF) = w;
    }
    EPI_WALK()
};
struct EpiMerge {
    static constexpr int HOOK_TILE = 16;
    static constexpr bool PERM = true, AFTER_DRAIN = false;
    const bf16_t* z; bf16_t* mg;
    __device__ __forceinline__ void mid(f32x4 (&acc)[2][2][4][2], const Unit& u, int wr, int wc, int fr, int fq) const {
        asm volatile("" : "+v"(fr));
        const int row0 = u.pm * BM + wr * 64 + fr, col0 = u.pn * BM + wc * 32 + 8 * fq;
#pragma unroll
        for (int ai = 0; ai < 2; ++ai)
#pragma unroll
            for (int m = 0; m < 4; ++m) {
                const bf16_t* zr = z + (size_t)(row0 + ai * HALF + m * 16) * ZUGW + col0;
#pragma unroll
                for (int bj = 0; bj < 2; ++bj) {
                    const u32x4 g0 = *(const u32x4*)(zr + ZU_G0 + bj * HALF), g1 = *(const u32x4*)(zr + ZU_G1 + bj * HALF);
                    f32x4& v0 = acc[ai][bj][m][0]; f32x4& v1 = acc[ai][bj][m][1];
                    v0[0] *= bflo(g0.x) * __builtin_amdgcn_rcpf(fmaxf(bflo(g1.x), 1e-30f)); v0[1] *= bfhi(g0.x) * __builtin_amdgcn_rcpf(fmaxf(bfhi(g1.x), 1e-30f));
                    v0[2] *= bflo(g0.y) * __builtin_amdgcn_rcpf(fmaxf(bflo(g1.y), 1e-30f)); v0[3] *= bfhi(g0.y) * __builtin_amdgcn_rcpf(fmaxf(bfhi(g1.y), 1e-30f));
                    v1[0] *= bflo(g0.z) * __builtin_amdgcn_rcpf(fmaxf(bflo(g1.z), 1e-30f)); v1[1] *= bfhi(g0.z) * __builtin_amdgcn_rcpf(fmaxf(bfhi(g1.z), 1e-30f));
                    v1[2] *= bflo(g0.w) * __builtin_amdgcn_rcpf(fmaxf(bflo(g1.w), 1e-30f)); v1[3] *= bfhi(g0.w) * __builtin_amdgcn_rcpf(fmaxf(bfhi(g1.w), 1e-30f));
                }
                asm volatile("" ::: "memory");
            }
    }
    __device__ __forceinline__ void rg(f32x4 v00, f32x4 v01, f32x4 v10, f32x4 v11, const Unit& u, int ai, int m, int wr, int wc, int fr, int fq) const {
        const int row = u.pm * BM + wr * 64 + fr + ai * HALF + m * 16, col0 = u.pn * BM + wc * 32 + 8 * fq;
        const bf16_t* zr = z + (size_t)row * ZUGW + ZU_G1 + col0;
        const u32x4 ga = *(const u32x4*)zr, gb = *(const u32x4*)(zr + HALF);
        u32x4 w;
        w.x = pk2(bflo(ga.x) * v00[0], bfhi(ga.x) * v00[1]); w.y = pk2(bflo(ga.y) * v00[2], bfhi(ga.y) * v00[3]);
        w.z = pk2(bflo(ga.z) * v01[0], bfhi(ga.z) * v01[1]); w.w = pk2(bflo(ga.w) * v01[2], bfhi(ga.w) * v01[3]);
        *(u32x4*)(mg + (size_t)row * D + col0) = w;
        w.x = pk2(bflo(gb.x) * v10[0], bfhi(gb.x) * v10[1]); w.y = pk2(bflo(gb.y) * v10[2], bfhi(gb.y) * v10[3]);
        w.z = pk2(bflo(gb.z) * v11[0], bfhi(gb.z) * v11[1]); w.w = pk2(bflo(gb.w) * v11[2], bfhi(gb.w) * v11[3]);
        *(u32x4*)(mg + (size_t)row * D + col0 + HALF) = w;
    }
    EPI_WALK()
};
struct EpiRes1 {
    static constexpr int HOOK_TILE = 0;
    static constexpr bool PERM = false, AFTER_DRAIN = false;
    const float* xp; const float* xs; const float* mod; float* out;
    __device__ __forceinline__ void rg(f32x4 v00, f32x4 v01, f32x4 v10, f32x4 v11, const Unit& u, int ai, int m, int wr, int wc, int fr, int fq) const {
        const int row = u.pm * BM + wr * 64 + fr + ai * HALF + m * 16, col0 = u.pn * BM + wc * 32 + 4 * fq;
        const float* xr = (row < MP ? xp + (size_t)row * D : xs + (size_t)(row - MP) * D) + col0;
        const float* gm = mod + (size_t)seq_of_row(row) * (6 * D) + 2 * D + col0;
        float* o = out + (size_t)row * D + col0;
        *(f32x4*)o = *(const f32x4*)xr + *(const f32x4*)gm * v00;
        *(f32x4*)(o + 16) = *(const f32x4*)(xr + 16) + *(const f32x4*)(gm + 16) * v01;
        *(f32x4*)(o + HALF) = *(const f32x4*)(xr + HALF) + *(const f32x4*)(gm + HALF) * v10;
        *(f32x4*)(o + HALF + 16) = *(const f32x4*)(xr + HALF + 16) + *(const f32x4*)(gm + HALF + 16) * v11;
    }
    EPI_WALK()
};
struct EpiSwiglu {
    static constexpr int HOOK_TILE = 0;
    static constexpr bool PERM = true, AFTER_DRAIN = false;
    bf16_t* act;
    __device__ __forceinline__ void rg(f32x4 v00, f32x4 v01, f32x4 v10, f32x4 v11, const Unit& u, int ai, int m, int wr, int wc, int fr, int fq) const {
        const int row = u.pm * BM + wr * 64 + fr + ai * HALF + m * 16, col0 = u.pn * HALF + wc * 32 + 8 * fq;
        float r[8];
#pragma unroll
        for (int e = 0; e < 4; ++e) { r[e] = v00[e] * sigmoidf_(v00[e]) * v10[e]; r[4 + e] = v01[e] * sigmoidf_(v01[e]) * v11[e]; }
        u32x4 w; w.x = pk2(r[0], r[1]); w.y = pk2(r[2], r[3]); w.z = pk2(r[4], r[5]); w.w = pk2(r[6], r[7]);
        *(u32x4*)(act + (size_t)row * DFF + col0) = w;
    }
    EPI_WALK()
};
struct EpiRes2 {
    static constexpr int HOOK_TILE = 0;
    static constexpr bool PERM = false, AFTER_DRAIN = false;
    const float* mod; float* out;
    __device__ __forceinline__ void rg(f32x4 v00, f32x4 v01, f32x4 v10, f32x4 v11, const Unit& u, int ai, int m, int wr, int wc, int fr, int fq) const {
        const int row = u.pm * BM + wr * 64 + fr + ai * HALF + m * 16, col0 = u.pn * BM + wc * 32 + 4 * fq;
        const float* gf = mod + (size_t)seq_of_row(row) * (6 * D) + 5 * D + col0;
        float* o = out + (size_t)row * D + col0;
        *(f32x4*)o = *(const f32x4*)o + *(const f32x4*)gf * v00;
        *(f32x4*)(o + 16) = *(const f32x4*)(o + 16) + *(const f32x4*)(gf + 16) * v01;
        *(f32x4*)(o + HALF) = *(const f32x4*)(o + HALF) + *(const f32x4*)(gf + HALF) * v10;
        *(f32x4*)(o + HALF + 16) = *(const f32x4*)(o + HALF + 16) + *(const f32x4*)(gf + HALF + 16) * v11;
    }
    EPI_WALK()
};
struct SliceOrder {
    int nM, nN, nwg, KT, R1, c, nleft, nsl, l, s;
    unsigned* cnt; float* slab;
    __device__ void init(int M_, int N_, int K_, int c_, unsigned* cnt_, float* slab_) {
        nM = M_ / BM; nN = N_ / BM; nwg = nM * nN; KT = K_ / 64; c = c_; cnt = cnt_; slab = slab_;
        R1 = nwg / 256; nleft = nwg - R1 * 256; nsl = nleft ? 256 / nleft : 1; if (nsl > 8) nsl = 8;
        l = nleft ? c % nleft : 0; s = nleft ? c / nleft : nsl;
    }
    __device__ int kbnd(int i) const { return i >= nsl ? KT : (((KT * i) / nsl + 1) & ~1); }
    __device__ void pmpn(int L, Unit& u) const {
        int wgid = L; { const int q = nwg / pg8::NXCD, r = nwg % pg8::NXCD, xcd = wgid % pg8::NXCD, off = wgid / pg8::NXCD; wgid = (xcd < r ? xcd * (q + 1) : r * (q + 1) + (xcd - r) * q) + off; }
        const int nig = pg8::WGM * nN, gid = wgid / nig, fm = gid * pg8::WGM, gsz = (nM - fm) < pg8::WGM ? (nM - fm) : pg8::WGM;
        u.pm = fm + ((wgid % nig) % gsz); u.pn = (wgid % nig) / gsz;
    }
    __device__ bool next(int i, Unit& u) const {
        if (i < R1) { pmpn(i * 256 + c, u); u.kb = 0; u.nk = KT; u.kind = 0; u.peer = 0; return true; }
        if (i == R1 && nleft && s < nsl) { pmpn(R1 * 256 + l, u); u.kb = kbnd(s); u.nk = kbnd(s + 1) - u.kb; u.kind = 3; u.peer = l; return true; }
        return false;
    }
    __device__ __forceinline__ void a_ready(const Unit&) const {}
    __device__ __forceinline__ void done(const Unit&) const {}
};

#define GAS __attribute__((address_space(1)))
#define LAS __attribute__((address_space(3)))
typedef GAS unsigned gu32;
#define RLX_AGENT __ATOMIC_RELAXED, __HIP_MEMORY_SCOPE_AGENT
#define LDS_WAIT() asm volatile("s_waitcnt lgkmcnt(0)" ::: "memory")
#define VM_WAIT() asm volatile("s_waitcnt vmcnt(0)" ::: "memory")
#define XB_TMO      128
#define XB_XCNT(j)  (256  + 64 * (j))
#define XB_XSUB(j)  (1280 + 64 * (j))
#define XB_XGEN(j)  (2304 + 64 * (j))
#define XB_TOP      3328
#define XB_TOPGEN   3392
#define XCD_BAR_WORDS 3456
#define XB_SPIN_CAP (1u << 18)

__device__ __forceinline__ unsigned xb_ld(unsigned* p)              { return __hip_atomic_load(p, __ATOMIC_RELAXED, __HIP_MEMORY_SCOPE_AGENT); }
__device__ __forceinline__ unsigned xb_add(unsigned* p, unsigned v) { return __hip_atomic_fetch_add(p, v, __ATOMIC_RELAXED, __HIP_MEMORY_SCOPE_AGENT); }
__device__ __forceinline__ unsigned xb_xcc_id() { return (unsigned)__builtin_amdgcn_s_getreg((3 << 11) | 20) & 0xFu; }
#define XB_SPIN(cond, bar) do { unsigned _sp = 0; while (cond) { __builtin_amdgcn_s_sleep(1); \
    if ((++_sp & 255u) == 0u) { if (xb_ld(&(bar)[XB_TMO])) break; if (_sp > XB_SPIN_CAP) { atomicAdd(&(bar)[XB_TMO], 1u); break; } } } } while (0)

struct XcdBarrier {
    unsigned* bar; unsigned x;
    volatile LAS unsigned* st;
};

__device__ __forceinline__ XcdBarrier xcd_barrier_post(unsigned* bar, volatile LAS unsigned* st) {
    XcdBarrier b; b.bar = bar; b.x = xb_xcc_id(); b.st = st;
    if (threadIdx.x == 0) (void)xb_add(&bar[XB_XCNT(b.x)], 1u);
    return b;
}
__device__ __forceinline__ void xcd_barrier_complete(unsigned* bar, unsigned x, unsigned& nloc, unsigned& nx) {
    const unsigned G = gridDim.x * gridDim.y * gridDim.z;
    unsigned sum, cnt, mine, sp = 0u;
    for (;;) {
        sum = 0u; cnt = 0u; mine = 0u;
#pragma unroll
        for (unsigned j = 0; j < 16; ++j) { const unsigned c = xb_ld(&bar[XB_XCNT(j)]); sum += c; cnt += (c > 0u) ? 1u : 0u; mine = (j == x) ? c : mine; }
        if (sum == G) break;
        __builtin_amdgcn_s_sleep(1);
        if ((++sp & 255u) == 0u) { if (xb_ld(&bar[XB_TMO])) break; if (sp > XB_SPIN_CAP) { atomicAdd(&bar[XB_TMO], 1u); break; } }
    }
    nloc = mine > 0u ? mine : 1u; nx = cnt > 0u ? cnt : 1u;
}

__device__ __forceinline__ void xcd_barrier(const XcdBarrier& b) {
    asm volatile("s_waitcnt vmcnt(0)" ::: "memory");
    __syncthreads();
    if (threadIdx.x == 0) {
        unsigned* bar = b.bar;
        __builtin_amdgcn_s_waitcnt(0);
        unsigned nloc = b.st[0], nx = b.st[1];
        if (nloc == 0u) { xcd_barrier_complete(bar, b.x, nloc, nx); b.st[0] = nloc; b.st[1] = nx; }
        const unsigned old = xb_add(&bar[XB_XSUB(b.x)], 1u);
        const unsigned gen = old / nloc;
        if (old + 1u == (gen + 1u) * nloc) {
            __builtin_amdgcn_fence(__ATOMIC_RELEASE, "agent");
            asm volatile("s_waitcnt vmcnt(0)" ::: "memory");
            const unsigned og = xb_add(&bar[XB_TOP], 1u);
            const unsigned tg = og / nx;
            if (og + 1u == (tg + 1u) * nx) xb_add(&bar[XB_TOPGEN], 1u);
            else XB_SPIN(xb_ld(&bar[XB_TOPGEN]) == tg, bar);
            __builtin_amdgcn_fence(__ATOMIC_ACQUIRE, "agent");
            xb_add(&bar[XB_XGEN(b.x)], 1u);
            asm volatile("s_waitcnt vmcnt(0)" ::: "memory");
        } else {
            XB_SPIN(xb_ld(&bar[XB_XGEN(b.x)]) == gen, bar);
            __builtin_amdgcn_fence(__ATOMIC_ACQUIRE, "agent");
            asm volatile("s_waitcnt vmcnt(0)" ::: "memory");
        }
    }
    __syncthreads();
}

typedef pg8::bf16x8 bf16x8;
#define MFMA16(a, b, c) __builtin_amdgcn_mfma_f32_16x16x32_bf16((a), (b), (c), 0, 0, 0)
constexpr int RB_P1 = 0, RB_RT = 2048, RB_QP = 4096, RB_RAK = 5120, RB_VM = 6144, RB_WL = 8192;

__device__ __forceinline__ f32x4 ld_bf4(const bf16_t* p) { const u32x2v w = *(const u32x2v*)p; return (f32x4){bflo(w.x), bfhi(w.x), bflo(w.y), bfhi(w.y)}; }
__device__ __forceinline__ bf16x8 mk_frag(const f32x4 a, const f32x4 b) { u32x4 w; w.x = pk2(a[0], a[1]); w.y = pk2(a[2], a[3]); w.z = pk2(b[0], b[1]); w.w = pk2(b[2], b[3]); return __builtin_bit_cast(bf16x8, w); }
__device__ __forceinline__ unsigned char* recA_ptr(const P& p, int rec) { return rec < NREC_P ? p.ws + WS_H + (size_t)rec * RECA : p.ws + WS_FRA_S + (size_t)(rec - NREC_P) * RECA; }
__device__ __forceinline__ unsigned char* recB_ptr(const P& p, int rec) { return rec < NREC_P ? (unsigned char*)p.out + (size_t)rec * RECB : p.ws + WS_FRB_S + (size_t)(rec - NREC_P) * RECB; }
__device__ __forceinline__ f32x4 sig4(f32x4 x) { return (f32x4){sigmoidf_(x[0]), sigmoidf_(x[1]), sigmoidf_(x[2]), sigmoidf_(x[3])}; }
__device__ __forceinline__ f32x4 exp4(f32x4 x) { return (f32x4){__expf(x[0]), __expf(x[1]), __expf(x[2]), __expf(x[3])}; }

template <class T> __device__ __forceinline__ T ldu(const void* ubase, unsigned voff) { return *(const T*)((const char*)ubase + voff); }
__device__ __forceinline__ f32x4 bf4(const u32x2v w) { return (f32x4){bflo(w.x), bfhi(w.x), bflo(w.y), bfhi(w.y)}; }
struct ShiftCtx { const bf16_t* zrw; const float* ss; const float* mu; unsigned zoc, zop; float fv, fpz, fps; };
__device__ __forceinline__ f32x4 shift4(const ShiftCtx& k, int cu, unsigned lp) {
    const u32x2v cw = ldu<u32x2v>(k.zrw + cu, k.zoc + lp * 2u), pw = ldu<u32x2v>(k.zrw + cu, k.zop + lp * 2u);
    const f32x4 sv = ldu<f32x4>(k.ss + cu, lp * 4u), m = ldu<f32x4>(k.mu + cu, lp * 4u);
    const f32x4 cur = bf4(cw) * k.fv;
    const f32x4 pv = bf4(pw) * k.fpz + sv * k.fps;
    return cur + (pv - cur) * m;
}

__device__ __forceinline__ void prep_record(const P& p, LAS unsigned char* wl, int rec, int lane_in) {
    int lane = lane_in; asm volatile("" : "+v"(lane));
    const int head = rec & 15, chunkid = rec >> 4;
    const bool prompt = chunkid < NPB * 128;
    const int sq = prompt ? (chunkid >> 7) : NPB + (chunkid - NPB * 128);
    const int c = prompt ? (chunkid & 127) : 0;
    const int row0 = prompt ? sq * TP + c * 16 : MP + (sq - NPB) * TS;
    const int nvalid = prompt ? 16 : TS;
    const int i = lane & 15, q = lane >> 4;
    const bool valid = i < nvalid, first = (c == 0);
    const bool pz = valid && (i > 0 || !first), ps = valid && (i == 0) && first && !prompt;
    const int row = row0 + (valid ? i : 0);
    ShiftCtx K;
    K.zrw = (const bf16_t*)(p.ws + WS_ZRW); K.ss = p.in[3] + (size_t)(prompt ? 0 : sq - NPB) * CSH; K.mu = p.in[10];
    K.zoc = (unsigned)row * (unsigned)(CSH * 2); K.zop = pz ? K.zoc - (unsigned)(CSH * 2) : K.zoc; K.fv = valid ? 1.f : 0.f; K.fpz = pz ? 1.f : 0.f; K.fps = ps ? 1.f : 0.f;
    const unsigned q4 = (unsigned)q * 4u, q8 = (unsigned)q * 8u;
    const unsigned wlo64 = (unsigned)(i * 64 + q * 8) * 2u, wlo128 = (unsigned)(i * 128 + q * 8) * 2u;
    const bf16_t* WDUT = (const bf16_t*)(p.ws + WS_LORA); const bf16_t* WAUT = WDUT + RW * 64; const bf16_t* WGUT = WAUT + RW * 64;
    const f32x4 z4 = (f32x4){0.f, 0.f, 0.f, 0.f};

    f32x4 accw[4], acca[4];
#pragma unroll
    for (int ct = 0; ct < 4; ++ct) { accw[ct] = z4; acca[ct] = z4; }
#pragma unroll
    for (int s = 0; s < 2; ++s) {
        const int cw = 3072 + 32 * s, ca = 3136 + 32 * s;
        f32x4 x0 = shift4(K, cw, q8), x1 = shift4(K, cw + 4, q8);
#pragma unroll
        for (int e = 0; e < 4; ++e) { x0[e] = 2.f * sigmoidf_(2.f * x0[e]) - 1.f; x1[e] = 2.f * sigmoidf_(2.f * x1[e]) - 1.f; }
        const bf16x8 td = mk_frag(x0, x1);
        const bf16x8 ad = mk_frag(shift4(K, ca, q8), shift4(K, ca + 4, q8));
#pragma unroll
        for (int ct = 0; ct < 4; ++ct) {
            const int wo = (head * 64 + 16 * ct) * 64 + 32 * s;
            accw[ct] = MFMA16(ldu<bf16x8>(WDUT + wo, wlo64), td, accw[ct]);
            acca[ct] = MFMA16(ldu<bf16x8>(WAUT + wo, wlo64), ad, acca[ct]);
        }
    }
    f32x4 lw[4], av[4], ks[4];
    float ssq = 0.f;
#pragma unroll
    for (int ct = 0; ct < 4; ++ct) {
        const int cbu = head * 64 + 16 * ct;
        lw[ct] = sig4(ldu<f32x4>(p.in[11] + cbu, q4 * 4u) + accw[ct]) * (-0.6065306597126334f);
        lw[ct] = lw[ct] * K.fv;
        av[ct] = sig4(ldu<f32x4>(p.in[13] + cbu, q4 * 4u) + acca[ct]);
        ks[ct] = shift4(K, RW + cbu, q4);
        const f32x4 kk0 = ks[ct] * ldu<f32x4>(p.in[16] + cbu, q4 * 4u);
        ssq += (kk0[0] * kk0[0] + kk0[1] * kk0[1]) + (kk0[2] * kk0[2] + kk0[3] * kk0[3]);
    }
    ssq += __shfl_xor(ssq, 16); ssq += __shfl_xor(ssq, 32);
    const float kinv = __builtin_amdgcn_rcpf(fmaxf(sqrtf(ssq), 1e-12f));
    f32x4 lwc[4];
#pragma unroll
    for (int ct = 0; ct < 4; ++ct) lwc[ct] = lw[ct];
#pragma unroll
    for (int d = 1; d < 16; d <<= 1)
#pragma unroll
        for (int ct = 0; ct < 4; ++ct)
#pragma unroll
            for (int e = 0; e < 4; ++e) { const float t = __shfl_up(lwc[ct][e], d, 16); if (i >= d) lwc[ct][e] += t; }
    unsigned char* rb = recB_ptr(p, rec); unsigned char* ra = recA_ptr(p, rec);
    LAS unsigned short* KT = (LAS unsigned short*)wl; LAS unsigned short* AT = KT + 1024; LAS unsigned short* KtT = KT + 2048; LAS unsigned short* VT = KT + 3072;
    LAS float* MT = (LAS float*)(wl + 8192);
    u32x2v kapP[4], alpP[4], ktP[4], rtP[4];
    f32x4 wl15[4];
    float bsum = 0.f;
#pragma unroll
    for (int ct = 0; ct < 4; ++ct) {
        const int cbu = head * 64 + 16 * ct;
        const f32x4 Wt = exp4(lwc[ct]), Wtm1 = exp4(lwc[ct] - lw[ct]), Winv = exp4(-lwc[ct]);
        const f32x4 kkn = ks[ct] * ldu<f32x4>(p.in[16] + cbu, q4 * 4u) * kinv;
        const f32x4 kmod = ks[ct] * ((av[ct] - 1.f) * ldu<f32x4>(p.in[17] + cbu, q4 * 4u) + 1.f);
        const f32x4 kap = kkn * Wtm1, alp = kkn * av[ct] * Winv, kt = kmod * Winv;
        const f32x4 rs = shift4(K, cbu, q4);
        const f32x4 rt = rs * Wt;
        const f32x4 rk = rs * kmod * ldu<f32x4>(p.in[18] + cbu, q4 * 4u);
        bsum += (rk[0] + rk[1]) + (rk[2] + rk[3]);
#pragma unroll
        for (int e = 0; e < 4; ++e) wl15[ct][e] = __shfl(Wt[e], 15, 16);
        kapP[ct].x = pk2(kap[0], kap[1]); kapP[ct].y = pk2(kap[2], kap[3]); alpP[ct].x = pk2(alp[0], alp[1]); alpP[ct].y = pk2(alp[2], alp[3]);
        ktP[ct].x = pk2(kt[0], kt[1]); ktP[ct].y = pk2(kt[2], kt[3]); rtP[ct].x = pk2(rt[0], rt[1]); rtP[ct].y = pk2(rt[2], rt[3]);
#pragma unroll
        for (int e = 0; e < 4; ++e) { const int ch = 16 * ct + 4 * q + e; const int sh = (e & 1) * 16;
            KT[ch * 16 + i] = (unsigned short)(((e < 2 ? kapP[ct].x : kapP[ct].y) >> sh) & 0xffffu);
            AT[ch * 16 + i] = (unsigned short)(((e < 2 ? alpP[ct].x : alpP[ct].y) >> sh) & 0xffffu);
            KtT[ch * 16 + i] = (unsigned short)(((e < 2 ? ktP[ct].x : ktP[ct].y) >> sh) & 0xffffu); }
    }
    bsum += __shfl_xor(bsum, 16); bsum += __shfl_xor(bsum, 32);
    u32x2v c1P[4], c2P[4];
    {
        f32x4 accg[4];
#pragma unroll
        for (int ct = 0; ct < 4; ++ct) accg[ct] = z4;
#pragma unroll
        for (int s = 0; s < 4; ++s) {
            const int cg = 3200 + 32 * s;
            const bf16x8 gd = mk_frag(sig4(shift4(K, cg, q8)), sig4(shift4(K, cg + 4, q8)));
#pragma unroll
            for (int ct = 0; ct < 4; ++ct) accg[ct] = MFMA16(ldu<bf16x8>(WGUT + (head * 64 + 16 * ct) * 128 + 32 * s, wlo128), gd, accg[ct]);
        }
#pragma unroll
        for (int ct = 0; ct < 4; ++ct) {
            const int cbu = head * 64 + 16 * ct;
            const f32x4 c1 = ldu<f32x4>(p.in[19] + cbu, q4 * 4u) * accg[ct];
            const f32x4 vsf = shift4(K, 2 * RW + cbu, q4);
            const f32x4 c2 = (ldu<f32x4>(p.in[20] + cbu, q4 * 4u) + vsf * bsum) * accg[ct];
            c1P[ct].x = pk2(c1[0], c1[1]); c1P[ct].y = pk2(c1[2], c1[3]); c2P[ct].x = pk2(c2[0], c2[1]); c2P[ct].y = pk2(c2[2], c2[3]);
#pragma unroll
            for (int e = 0; e < 4; ++e) VT[(16 * ct + 4 * q + e) * 16 + i] = f2bf(vsf[e]);
        }
    }
    bf16x8 kapF[2], alpF[2], ktF[2], rtF[2];
#pragma unroll
    for (int s = 0; s < 2; ++s) {
        kapF[s] = __builtin_bit_cast(bf16x8, (u32x4){kapP[2 * s].x, kapP[2 * s].y, kapP[2 * s + 1].x, kapP[2 * s + 1].y});
        alpF[s] = __builtin_bit_cast(bf16x8, (u32x4){alpP[2 * s].x, alpP[2 * s].y, alpP[2 * s + 1].x, alpP[2 * s + 1].y});
        ktF[s] = __builtin_bit_cast(bf16x8, (u32x4){ktP[2 * s].x, ktP[2 * s].y, ktP[2 * s + 1].x, ktP[2 * s + 1].y});
        rtF[s] = __builtin_bit_cast(bf16x8, (u32x4){rtP[2 * s].x, rtP[2 * s].y, rtP[2 * s + 1].x, rtP[2 * s + 1].y});
    }
    f32x4 Maa = z4, Mak = z4, RAt = z4, RKt = z4;
#pragma unroll
    for (int s = 0; s < 2; ++s) {
        Maa = MFMA16(kapF[s], alpF[s], Maa); Mak = MFMA16(kapF[s], ktF[s], Mak);
        RAt = MFMA16(alpF[s], rtF[s], RAt); RKt = MFMA16(ktF[s], rtF[s], RKt);
    }
#pragma unroll
    for (int r = 0; r < 4; ++r) { const int rw_ = 4 * q + r;
        if (!(rw_ > i)) { Maa[r] = 0.f; Mak[r] = 0.f; }
        if (!(i >= rw_)) { RAt[r] = 0.f; RKt[r] = 0.f; } }
    *(LAS f32x4*)(MT + i * 16 + 4 * q) = Maa;
    u32x4 rakW; rakW.x = pk2(RAt[0], RAt[1]); rakW.y = pk2(RAt[2], RAt[3]); rakW.z = pk2(RKt[0], RKt[1]); rakW.w = pk2(RKt[2], RKt[3]);
    LDS_WAIT(); asm volatile("" ::: "memory");
    float t[16];
#pragma unroll
    for (int cc = 15; cc >= 0; --cc) {
        float acc = (i == cc) ? 1.f : 0.f;
        f32x4 mrow[4];
#pragma unroll
        for (int b = 0; b < 4; ++b) mrow[b] = *(const LAS f32x4*)(MT + cc * 16 + 4 * b);
#pragma unroll
        for (int j = cc + 1; j < 16; ++j) acc -= t[j] * mrow[j >> 2][j & 3];
        t[cc] = acc;
    }
    f32x4 tsel;
#pragma unroll
    for (int e = 0; e < 4; ++e) tsel[e] = -(q == 0 ? t[e] : (q == 1 ? t[4 + e] : (q == 2 ? t[8 + e] : t[12 + e])));
    const bf16x8 Tfrag = mk_frag(tsel, z4);
    f32x4 P1E[4];
#pragma unroll
    for (int ct = 0; ct < 4; ++ct) { const u32x2v w = *(const LAS u32x2v*)(KT + (16 * ct + i) * 16 + 4 * q);
        u32x4 aw; aw.x = w.x; aw.y = w.y; aw.z = 0u; aw.w = 0u; P1E[ct] = MFMA16(__builtin_bit_cast(bf16x8, aw), Tfrag, z4); }
    *(u32x4*)(rb + RB_RT + lane * 16) = __builtin_bit_cast(u32x4, rtF[0]); *(u32x4*)(rb + RB_RT + 1024 + lane * 16) = __builtin_bit_cast(u32x4, rtF[1]);
    *(u32x4*)(rb + RB_RAK + lane * 16) = rakW;
#pragma unroll
    for (int ct = 0; ct < 4; ++ct) {
        if (i == 0) *(f32x4*)(rb + RB_WL + (16 * ct + 4 * q) * 4) = wl15[ct];
        if (valid) { const int cbu = head * 64 + 16 * ct;
            *(u32x2v*)((char*)((bf16_t*)(p.ws + WS_OA) + cbu) + ((unsigned)row * (2 * RW) + q4) * 2u) = c1P[ct];
            *(u32x2v*)((char*)((bf16_t*)(p.ws + WS_C2) + cbu) + ((unsigned)row * RW + q4) * 2u) = c2P[ct]; }
    }
    *(u32x4*)(rb + RB_P1 + lane * 16) = __builtin_bit_cast(u32x4, mk_frag(P1E[0], P1E[1]));
    *(u32x4*)(rb + RB_P1 + 1024 + lane * 16) = __builtin_bit_cast(u32x4, mk_frag(P1E[2], P1E[3]));
    { const f32x4 Qt = MFMA16(mk_frag(Mak, z4), Tfrag, z4);
      u32x4 w; w.x = 0u; w.y = 0u; w.z = pk2(Qt[0], Qt[1]); w.w = pk2(Qt[2], Qt[3]); *(u32x4*)(rb + RB_QP + lane * 16) = w; }
#pragma unroll
    for (int tt = 0; tt < 4; ++tt) {
        const u32x2v a = *(const LAS u32x2v*)(AT + (16 * tt + i) * 16 + 4 * q), b = *(const LAS u32x2v*)(KtT + (16 * tt + i) * 16 + 4 * q);
        u32x4 w; w.x = a.x; w.y = a.y; w.z = b.x; w.w = b.y; *(u32x4*)(ra + tt * 1024 + lane * 16) = w;
        *(u32x2v*)(rb + RB_VM + tt * 512 + lane * 8) = *(const LAS u32x2v*)(VT + (16 * tt + i) * 16 + 4 * q);
    }
    LDS_WAIT(); asm volatile("" ::: "memory");
}

struct ScanFr { bf16x8 P10, P11, RT0, RT1, QP, RAK, AK0, AK1, AK2, AK3; u32x2v vm; f32x4 WL0, WL1, WL2, WL3; };
__device__ __forceinline__ void scan_load(ScanFr& f, const P& p, int rec, int vs, int lane) {
    const unsigned char* ra = recA_ptr(p, rec); const unsigned char* rb = recB_ptr(p, rec);
    const unsigned l16 = (unsigned)lane * 16u, q16 = (unsigned)(lane >> 4) * 16u;
    f.P10 = ldu<bf16x8>(rb + RB_P1, l16); f.P11 = ldu<bf16x8>(rb + RB_P1 + 1024, l16);
    f.RT0 = ldu<bf16x8>(rb + RB_RT, l16); f.RT1 = ldu<bf16x8>(rb + RB_RT + 1024, l16);
    f.QP = ldu<bf16x8>(rb + RB_QP, l16); f.RAK = ldu<bf16x8>(rb + RB_RAK, l16);
    f.vm = ldu<u32x2v>(rb + RB_VM + vs * 512, (unsigned)lane * 8u);
    f.AK0 = ldu<bf16x8>(ra, l16); f.AK1 = ldu<bf16x8>(ra + 1024, l16); f.AK2 = ldu<bf16x8>(ra + 2048, l16); f.AK3 = ldu<bf16x8>(ra + 3072, l16);
    f.WL0 = ldu<f32x4>(rb + RB_WL, q16); f.WL1 = ldu<f32x4>(rb + RB_WL + 64, q16); f.WL2 = ldu<f32x4>(rb + RB_WL + 128, q16); f.WL3 = ldu<f32x4>(rb + RB_WL + 192, q16);
}
template <int NS>
__device__ __forceinline__ void scan_step(const ScanFr& f, const u32x2v (&vm)[NS], f32x4 (&St)[NS][4], float* oraw, int c, int q, bool prompt) {
    const f32x4 z4 = (f32x4){0.f, 0.f, 0.f, 0.f};
#pragma unroll
    for (int i = 0; i < NS; ++i) {
        const bf16x8 SB0 = mk_frag(St[i][0], St[i][1]), SB1 = mk_frag(St[i][2], St[i][3]);
        u32x4 vw; vw.x = 0u; vw.y = 0u; vw.z = vm[i].x; vw.w = vm[i].y;
        f32x4 U = MFMA16(f.QP, __builtin_bit_cast(bf16x8, vw), z4);
        U = MFMA16(f.P10, SB0, U); U = MFMA16(f.P11, SB1, U);
        u32x4 uw; uw.x = pk2(U[0], U[1]); uw.y = pk2(U[2], U[3]); uw.z = vm[i].x; uw.w = vm[i].y;
        const bf16x8 UB = __builtin_bit_cast(bf16x8, uw);
        f32x4 O = MFMA16(f.RT0, SB0, z4); O = MFMA16(f.RT1, SB1, O); O = MFMA16(f.RAK, UB, O);
        St[i][0] = MFMA16(f.AK0, UB, St[i][0]) * f.WL0; St[i][1] = MFMA16(f.AK1, UB, St[i][1]) * f.WL1;
        St[i][2] = MFMA16(f.AK2, UB, St[i][2]) * f.WL2; St[i][3] = MFMA16(f.AK3, UB, St[i][3]) * f.WL3;
#pragma unroll
        for (int r = 0; r < 4; ++r) { const int tk = 4 * q + r; if (prompt || tk < TS) oraw[(size_t)(16 * c + tk) * RW + 16 * i] = O[r]; }
    }
}
__device__ __forceinline__ void scan_chain_prompt(const P& p, int sq, int head, int vp, int lane, volatile LAS unsigned* prog) {
    constexpr int nch = TP / 16;
    const int rec0 = sq * nch * NH + head, vl = lane & 15, q = lane >> 4;
    f32x4 St[2][4];
    float* sout = p.out + O_WKVP + ((size_t)sq * NH + head) * HS * HS + (size_t)(32 * vp + vl) * HS + 4 * q;
    float* oraw = (float*)(p.ws + WS_ZRW) + (size_t)(sq * TP) * RW + head * HS + 32 * vp + vl;
    ScanFr f0, f1; u32x2v v0[2], v1[2];
#define SCAN_LD(f, v, cc) do { const int rec_ = rec0 + (cc) * NH; scan_load(f, p, rec_, 2 * vp, lane); v[0] = f.vm; v[1] = ldu<u32x2v>(recB_ptr(p, rec_) + RB_VM + (2 * vp + 1) * 512, (unsigned)lane * 8u); } while (0)
    SCAN_LD(f0, v0, 0); SCAN_LD(f1, v1, 1);
#pragma unroll
    for (int i = 0; i < 2; ++i)
#pragma unroll
        for (int t = 0; t < 4; ++t) St[i][t] = (f32x4){0.f, 0.f, 0.f, 0.f};
    const bool pw = vp == 0 && lane == 0;
    for (int c = 0; c < nch; c += 2) {
        if (pw) *prog = (unsigned)c;
        scan_step<2>(f0, v0, St, oraw, c, q, true);     SCAN_LD(f0, v0, c + 2 < nch ? c + 2 : nch - 1);
        scan_step<2>(f1, v1, St, oraw, c + 1, q, true); SCAN_LD(f1, v1, c + 3 < nch ? c + 3 : nch - 1);
    }
#undef SCAN_LD
#pragma unroll
    for (int i = 0; i < 2; ++i)
#pragma unroll
        for (int t = 0; t < 4; ++t) *(f32x4*)(sout + (size_t)(16 * i) * HS + 16 * t) = St[i][t];
}
struct SampleTask { ScanFr f; f32x4 St[4]; };
__device__ __forceinline__ void sample_load(SampleTask& t, const P& p, int j, int lane) {
    const int s = j >> 6, head = (j >> 2) & 15, vs = j & 3, vl = lane & 15, q = lane >> 4;
    scan_load(t.f, p, NREC_P + s * NH + head, vs, lane);
    const float* sin = p.in[2] + ((size_t)s * NH + head) * HS * HS + (size_t)(16 * vs + vl) * HS + 4 * q;
#pragma unroll
    for (int tt = 0; tt < 4; ++tt) t.St[tt] = *(const f32x4*)(sin + 16 * tt);
}
__device__ __forceinline__ void sample_run(SampleTask& t, const P& p, int j, int lane) {
    const int s = j >> 6, head = (j >> 2) & 15, vs = j & 3, vl = lane & 15, q = lane >> 4;
    f32x4 St[1][4]; u32x2v vm[1]; vm[0] = t.f.vm;
#pragma unroll
    for (int tt = 0; tt < 4; ++tt) St[0][tt] = t.St[tt];
    scan_step<1>(t.f, vm, St, (float*)(p.ws + WS_ZRW) + (size_t)(MP + s * TS) * RW + head * HS + 16 * vs + vl, 0, q, false);
    float* sout = p.out + O_WKVS + ((size_t)s * NH + head) * HS * HS + (size_t)(16 * vs + vl) * HS + 4 * q;
#pragma unroll
    for (int tt = 0; tt < 4; ++tt) *(f32x4*)(sout + 16 * tt) = St[0][tt];
}
__device__ __forceinline__ void scan_samples(const P& p, int j0, int stride, int lane) {
    constexpr int NT = NSB * NH * 4;
    if (j0 >= NT) return;
    SampleTask a, b;
    sample_load(a, p, j0, lane);
    for (int j = j0;;) {
        const int jb = j + stride; const bool hb = jb < NT;
        if (hb) sample_load(b, p, jb, lane);
        sample_run(a, p, j, lane);
        if (!hb) break;
        const int ja = jb + stride; const bool ha = ja < NT;
        if (ha) sample_load(a, p, ja, lane);
        sample_run(b, p, jb, lane);
        if (!ha) break;
        j = ja;
    }
}

constexpr int SCAN_AHEAD = 10;
__device__ __forceinline__ void scan_prefetch(const P& p, volatile LAS unsigned* prog, int sq, int head, int k, int lane) {
    const int rec0 = sq * (TP / 16) * NH + head;
    const unsigned l16 = (unsigned)lane * 16u;
    for (int c = k; c < TP / 16; c += 2) {
        while ((int)*prog < c - SCAN_AHEAD) __builtin_amdgcn_s_sleep(8);
        const unsigned char* ra = recA_ptr(p, rec0 + c * NH); const unsigned char* rb = recB_ptr(p, rec0 + c * NH);
        u32x4 x[12];
#pragma unroll
        for (int j = 0; j < 4; ++j) x[j] = ldu<u32x4>(ra + j * 1024, l16);
#pragma unroll
        for (int j = 0; j < 8; ++j) x[4 + j] = ldu<u32x4>(rb + j * 1024, l16);
        const u32x4 y = ldu<u32x4>(rb + 8192, (unsigned)(lane & 15) * 16u);
#pragma unroll
        for (int j = 0; j < 12; ++j) asm volatile("" :: "v"(x[j].x));
        asm volatile("" :: "v"(y.x));
    }
}

__device__ __forceinline__ void mix_item(const P& p, int item, int wave, int lane) {
    const int g = item & 7, row0 = (item >> 3) * 128;
    const int dl = lane & 15, q = lane >> 4, col = g * 128 + wave * 16;
    const bf16_t* vn = (const bf16_t*)(p.ws + WS_VN) + (size_t)row0 * MLPW + col + dl;
    bf16x8 A[4];
#pragma unroll
    for (int sb = 0; sb < 4; ++sb)
#pragma unroll
        for (int j = 0; j < 8; ++j) A[sb][j] = (short)vn[(size_t)(32 * sb + 8 * q + j) * MLPW];
    const float* wsg = p.in[23] + ((size_t)g * 128 + dl) * 128 + 8 * q;
    const bf16_t* zu = (const bf16_t*)(p.ws + WS_ZUG) + (size_t)(row0 + dl) * ZUGW + ZU_U + col + 4 * q;
    bf16_t* ub = (bf16_t*)(p.ws + WS_OA) + (size_t)(row0 + dl) * (2 * RW) + RW + col + 4 * q;
    u32x2v res[8];
#pragma unroll
    for (int tt = 0; tt < 8; ++tt) {
        const int t = 16 * tt + dl;
        f32x4 acc = (f32x4){0.f, 0.f, 0.f, 0.f};
#pragma unroll
        for (int sb = 0; sb <= tt / 2; ++sb) {
            const float* wr = wsg + (size_t)(16 * tt) * 128 + 32 * sb;
            f32x4 w0 = *(const f32x4*)wr, w1 = *(const f32x4*)(wr + 4);
            if (sb == tt / 2) {
#pragma unroll
                for (int e = 0; e < 4; ++e) { if (32 * sb + 8 * q + e > t) w0[e] = 0.f; if (32 * sb + 8 * q + 4 + e > t) w1[e] = 0.f; }
            }
            acc = MFMA16(A[sb], mk_frag(w0, w1), acc);
        }
        const float bias = p.in[24][g * 128 + t];
        const f32x4 u = ld_bf4(zu + (size_t)(16 * tt) * ZUGW);
        const f32x4 o = (acc + bias) * u;
        res[tt].x = pk2(o[0], o[1]); res[tt].y = pk2(o[2], o[3]);
    }
#pragma unroll
    for (int tt = 0; tt < 8; ++tt) *(u32x2v*)(ub + (size_t)(16 * tt) * (2 * RW)) = res[tt];
}

__device__ __forceinline__ void post_rows(const P& p, int gw, int NGW, int lane) {
    const float* oraw = (const float*)(p.ws + WS_ZRW);
    for (int row = gw; row < M; row += NGW) {
        const size_t off = (size_t)row * RW + lane * 16;
        f32x4 o[4]; float s = 0.f;
#pragma unroll
        for (int j = 0; j < 4; ++j) { o[j] = *(const f32x4*)(oraw + off + 4 * j); s += (o[j][0] + o[j][1]) + (o[j][2] + o[j][3]); }
        s += __shfl_xor(s, 1); s += __shfl_xor(s, 2);
        const float mean = s * (1.f / HS); float qv = 0.f;
#pragma unroll
        for (int j = 0; j < 4; ++j) { o[j] = o[j] - mean; qv += (o[j][0] * o[j][0] + o[j][1] * o[j][1]) + (o[j][2] * o[j][2] + o[j][3] * o[j][3]); }
        qv += __shfl_xor(qv, 1); qv += __shfl_xor(qv, 2);
        const float rstd = rsqrtf(qv * (1.f / HS) + 64e-5f);
        bf16_t* oa = (bf16_t*)(p.ws + WS_OA) + (size_t)row * (2 * RW) + lane * 16; const bf16_t* c2p = (const bf16_t*)(p.ws + WS_C2) + off;
#pragma unroll
        for (int h = 0; h < 2; ++h) {
            const u32x4 c1 = *(const u32x4*)(oa + 8 * h), c2 = *(const u32x4*)(c2p + 8 * h);
            const f32x4 a = o[2 * h] * rstd, b = o[2 * h + 1] * rstd;
            u32x4 w;
            w.x = pk2(a[0] * bflo(c1.x) + bflo(c2.x), a[1] * bfhi(c1.x) + bfhi(c2.x)); w.y = pk2(a[2] * bflo(c1.y) + bflo(c2.y), a[3] * bfhi(c1.y) + bfhi(c2.y));
            w.z = pk2(b[0] * bflo(c1.z) + bflo(c2.z), b[1] * bfhi(c1.z) + bfhi(c2.z)); w.w = pk2(b[2] * bflo(c1.w) + bflo(c2.w), b[3] * bfhi(c1.w) + bfhi(c2.w));
            *(u32x4*)(oa + 8 * h) = w;
        }
    }
}

constexpr int NWAVES = 8, NTHR = NWAVES * 64;
constexpr int RING_BYTES = 131072, LDSCTL_OFF = RING_BYTES, MISC_OFF = LDSCTL_OFF + 320, LDS_BYTES = 147456;

__device__ __forceinline__ void p0_mod_slab(const P& p, LAS unsigned char* lds, int slab, int tid, int lane, int wave) {
    LAS float* red = (LAS float*)(lds + 8 * 12288);
    LAS float* Bl = (LAS float*)(lds + wave * 12288);
    for (int i = tid; i < 144 * 48; i += NTHR) red[i] = 0.f;
    __syncthreads();
    const int n0 = slab * 48, fr = lane & 15, fq = lane >> 4;
    const float* W = p.in[6] + n0;
    f32x4 acc[9][3];
#pragma unroll
    for (int a = 0; a < 9; ++a)
#pragma unroll
        for (int b = 0; b < 3; ++b) acc[a][b] = (f32x4){0.f, 0.f, 0.f, 0.f};
    for (int sc = 0; sc < 4; ++sc) {
        const int kb0 = ((wave + slab) & 7) * 256 + ((sc + (slab >> 3)) & 3) * 64;
        f32x4 v[12];
        int ln = lane; asm volatile("" : "+v"(ln));
        const float* Wk = W + (size_t)kb0 * (6 * D);
        { int r = ln / 12, c4 = ln - r * 12;
#pragma unroll
          for (int t = 0; t < 12; ++t) { v[t] = ldu<f32x4>(Wk, (unsigned)(r * (6 * D) + 4 * c4) * 4u); c4 += 4; r += 5; if (c4 >= 12) { c4 -= 12; r += 1; } } }
        { int r = ln / 12, c4 = ln - r * 12;
#pragma unroll
          for (int t = 0; t < 12; ++t) { *(LAS f32x4*)(Bl + r * 48 + 4 * c4) = v[t]; c4 += 4; r += 5; if (c4 >= 12) { c4 -= 12; r += 1; } } }
        LDS_WAIT(); asm volatile("" ::: "memory");
#pragma unroll
        for (int kb2 = 0; kb2 < 2; ++kb2) {
            const int k0 = kb0 + kb2 * 32 + fq * 8;
            bf16x8 bfr[3];
#pragma unroll
            for (int nt = 0; nt < 3; ++nt) { const LAS float* bp = Bl + (kb2 * 32 + fq * 8) * 48 + nt * 16 + fr;
                u32x4 w; w.x = pk2(bp[0], bp[48]); w.y = pk2(bp[96], bp[144]); w.z = pk2(bp[192], bp[240]); w.w = pk2(bp[288], bp[336]);
                bfr[nt] = __builtin_bit_cast(bf16x8, w); }
            const bf16_t* sil = (const bf16_t*)(p.ws + WS_SILU) + (size_t)fr * D + k0;
            bf16x8 afr[9];
#pragma unroll
            for (int mt = 0; mt < 9; ++mt) afr[mt] = *(const bf16x8*)(sil + (size_t)(mt * 16) * D);
#pragma unroll
            for (int mt = 0; mt < 9; ++mt)
#pragma unroll
                for (int nt = 0; nt < 3; ++nt) acc[mt][nt] = __builtin_amdgcn_mfma_f32_16x16x32_bf16(afr[mt], bfr[nt], acc[mt][nt], 0, 0, 0);
        }
        LDS_WAIT(); asm volatile("" ::: "memory");
    }
    for (int w = 0; w < NWAVES; ++w) {
        if (wave == w) {
#pragma unroll
            for (int mt = 0; mt < 9; ++mt)
#pragma unroll
                for (int nt = 0; nt < 3; ++nt)
#pragma unroll
                    for (int r = 0; r < 4; ++r) { LAS float* q = red + (mt * 16 + 4 * fq + r) * 48 + nt * 16 + fr; *q = *q + acc[mt][nt][r]; }
        }
        __syncthreads();
    }
    float* mod = (float*)(p.ws + WS_MOD);
    for (int i = tid; i < NSEQ * 48; i += NTHR) { const int row = i / 48, c = i % 48; mod[(size_t)row * (6 * D) + n0 + c] = red[row * 48 + c] + p.in[7][n0 + c]; }
    __syncthreads();
}
__device__ __forceinline__ void p0_silu(const P& p, int gt, int NT) {
    bf16_t* sil = (bf16_t*)(p.ws + WS_SILU);
    for (int i = gt; i < 144 * D / 4; i += NT) {
        const int row = i / (D / 4), k = (i - row * (D / 4)) * 4;
        f32x4 v = (f32x4){0.f, 0.f, 0.f, 0.f};
        if (row < NSEQ) { v = *(const f32x4*)((row < NPB ? p.in[4] + (size_t)row * D : p.in[5] + (size_t)(row - NPB) * D) + k);
#pragma unroll
            for (int e = 0; e < 4; ++e) v[e] = v[e] * sigmoidf_(v[e]); }
        u32x2v w; w.x = pk2(v[0], v[1]); w.y = pk2(v[2], v[3]); *(u32x2v*)(sil + (size_t)row * D + k) = w;
    }
}
struct TJob { const float* W; bf16_t* WT; int K, N, ldw, kofs, item; bool swz; };
__device__ __forceinline__ void tr_load(const TJob& j, float (&tv)[32], int lane) {
    const int nblk = j.N / 32, kb = j.item / nblk, nb = j.item - kb * nblk;
    const float* w = j.W + (size_t)(64 * kb) * j.N + 32 * nb;
    const unsigned lo = (unsigned)((lane >> 5) * j.N + (lane & 31)) * 4u, rs2 = (unsigned)j.N * 8u;
#pragma unroll
    for (int i = 0; i < 32; ++i) tv[i] = ldu<float>(w, lo + (unsigned)i * rs2);
}
__device__ __forceinline__ void tr_store(const TJob& j, const float (&tv)[32], LAS float* scr, int lane) {
    const int nblk = j.N / 32, kb = j.item / nblk, nb = j.item - kb * nblk, k0 = 64 * kb, n0 = 32 * nb;
    int r0 = n0;
    if (j.swz) { r0 = n0 < DFF ? 256 * (n0 >> 7) + (n0 & 127) : 256 * ((n0 - DFF) >> 7) + 128 + ((n0 - DFF) & 127); }
#pragma unroll
    for (int i = 0; i < 32; ++i) scr[(2 * i + (lane >> 5)) * 33 + (lane & 31)] = tv[i];
    LDS_WAIT(); asm volatile("" ::: "memory");
    const int c = lane & 7;
#pragma unroll
    for (int jj = 0; jj < 4; ++jj) { const int n = (lane >> 3) + 8 * jj; const LAS float* s = scr + (8 * c) * 33 + n;
        u32x4 o; o.x = pk2(s[0 * 33], s[1 * 33]); o.y = pk2(s[2 * 33], s[3 * 33]); o.z = pk2(s[4 * 33], s[5 * 33]); o.w = pk2(s[6 * 33], s[7 * 33]);
        *(u32x4*)(j.WT + (size_t)(r0 + n) * j.ldw + j.kofs + k0 + 8 * c) = o; }
    LDS_WAIT(); asm volatile("" ::: "memory");
}
__device__ __forceinline__ bool tr_job(const P& p, int part, int it, TJob& j) {
    constexpr int I_IN = (D / 64) * (CIN / 32), I_BA = (RW / 64) * (D / 32), I_OUT = (D / 64) * (D / 32), I_FI = (D / 64) * (2 * DFF / 32), I_FO = (DFF / 64) * (D / 32);
    constexpr int I_L64 = (RW / 32), I_L128 = 2 * (RW / 32);
    unsigned char* ws = p.ws; int r = it;
    j.swz = false; j.kofs = 0;
    if (part == 0) {
        if (r < I_IN) { j.W = p.in[9]; j.WT = (bf16_t*)(ws + WS_WIN); j.K = D; j.N = CIN; j.ldw = D; j.item = r; return true; } r -= I_IN;
        if (r < I_L64) { j.W = p.in[12]; j.WT = (bf16_t*)(ws + WS_LORA); j.K = 64; j.N = RW; j.ldw = 64; j.item = r; return true; } r -= I_L64;
        if (r < I_L64) { j.W = p.in[14]; j.WT = (bf16_t*)(ws + WS_LORA) + RW * 64; j.K = 64; j.N = RW; j.ldw = 64; j.item = r; return true; } r -= I_L64;
        if (r < I_L128) { j.W = p.in[15]; j.WT = (bf16_t*)(ws + WS_LORA) + 2 * RW * 64; j.K = 128; j.N = RW; j.ldw = 128; j.item = r; return true; }
        return false;
    } else if (part == 1) {
        if (r < I_BA) { j.W = p.in[25]; j.WT = (bf16_t*)(ws + WS_WBA); j.K = RW; j.N = D; j.ldw = 2 * RW; j.item = r; return true; } r -= I_BA;
        if (r < I_BA) { j.W = p.in[26]; j.WT = (bf16_t*)(ws + WS_WBA); j.K = RW; j.N = D; j.ldw = 2 * RW; j.kofs = RW; j.item = r; return true; } r -= I_BA;
        if (r < I_OUT) { j.W = p.in[27]; j.WT = (bf16_t*)(ws + WS_WOUT); j.K = D; j.N = D; j.ldw = D; j.item = r; return true; } r -= I_OUT;
        if (r < I_FI) { j.W = p.in[29]; j.WT = (bf16_t*)(ws + WS_WFI); j.K = D; j.N = 2 * DFF; j.ldw = D; j.swz = true; j.item = r; return true; } r -= I_FI;
        if (r < I_FO) { j.W = p.in[30]; j.WT = (bf16_t*)(ws + WS_WFO); j.K = DFF; j.N = D; j.ldw = DFF; j.item = r; return true; }
        return false;
    } else {
        if (r < I_FO) { j.W = p.in[30]; j.WT = (bf16_t*)(ws + WS_WFO); j.K = DFF; j.N = D; j.ldw = DFF; j.item = r; return true; }
        return false;
    }
}
__device__ __forceinline__ void p0_transposes(const P& p, LAS float* scr, int part, int gw, int NGW, int lane) {
    TJob ja, jb; float ta[32], tb[32];
    int it = gw;
    if (!tr_job(p, part, it, ja)) return;
    tr_load(ja, ta, lane);
    for (;;) {
        const bool hb = tr_job(p, part, it + NGW, jb);
        if (hb) tr_load(jb, tb, lane);
        tr_store(ja, ta, scr, lane);
        if (!hb) break;
        const bool ha = tr_job(p, part, it + 2 * NGW, ja);
        if (ha) tr_load(ja, ta, lane);
        tr_store(jb, tb, scr, lane);
        if (!ha) break;
        it += 2 * NGW;
    }
}
__device__ __forceinline__ void norm_row(const float* x, const float* g, const float* scale, const float* shift, bf16_t* h, int lane) {
    f32x4 v[8]; float s = 0.f;
#pragma unroll
    for (int j = 0; j < 8; ++j) { v[j] = *(const f32x4*)(x + 4 * lane + 256 * j); s += (v[j][0] * v[j][0] + v[j][1] * v[j][1]) + (v[j][2] * v[j][2] + v[j][3] * v[j][3]); }
    const float rstd = rsqrtf(wave_sum(s) * (1.f / D) + 1e-6f);
#pragma unroll
    for (int j = 0; j < 8; ++j) { const int k = 4 * lane + 256 * j;
        const f32x4 gg = *(const f32x4*)(g + k), sc = *(const f32x4*)(scale + k), sh = *(const f32x4*)(shift + k);
        const f32x4 o = v[j] * rstd * gg * (sc + 1.f) + sh;
        u32x2v w; w.x = pk2(o[0], o[1]); w.y = pk2(o[2], o[3]); *(u32x2v*)(h + k) = w; }
}
__device__ __forceinline__ void phase_norm(const P& p, int which, int gw, int NGW, int lane) {
    const float* g = which == 0 ? p.in[8] : p.in[28];
    for (int row = gw; row < M; row += NGW) {
        const float* x = which == 0 ? (row < MP ? p.in[0] + (size_t)row * D : p.in[1] + (size_t)(row - MP) * D) : p.out + (size_t)row * D;
        const float* mod = (const float*)(p.ws + WS_MOD) + (size_t)seq_of_row(row) * (6 * D);
        norm_row(x, g, mod + (which == 0 ? 1 : 4) * D, mod + (which == 0 ? 0 : 3) * D, (bf16_t*)(p.ws + WS_H) + (size_t)row * D, lane);
    }
}
__device__ __forceinline__ void phase_lnv(const P& p, int gw, int NGW, int lane) {
    for (int row = gw; row < M; row += NGW) {
        const bf16_t* zv = (const bf16_t*)(p.ws + WS_ZUG) + (size_t)row * ZUGW + ZU_V;
        float v[16]; float s = 0.f;
#pragma unroll
        for (int j = 0; j < 2; ++j) { const u32x4 w = *(const u32x4*)(zv + 8 * lane + 512 * j);
            v[8 * j + 0] = bflo(w.x); v[8 * j + 1] = bfhi(w.x); v[8 * j + 2] = bflo(w.y); v[8 * j + 3] = bfhi(w.y);
            v[8 * j + 4] = bflo(w.z); v[8 * j + 5] = bfhi(w.z); v[8 * j + 6] = bflo(w.w); v[8 * j + 7] = bfhi(w.w); }
#pragma unroll
        for (int i = 0; i < 16; ++i) s += v[i];
        const float mean = wave_sum(s) * (1.f / MLPW);
        float q = 0.f;
#pragma unroll
        for (int i = 0; i < 16; ++i) { v[i] -= mean; q += v[i] * v[i]; }
        const float rstd = rsqrtf(wave_sum(q) * (1.f / MLPW) + 1e-5f);
        bf16_t* vn = (bf16_t*)(p.ws + WS_VN) + (size_t)row * MLPW;
#pragma unroll
        for (int j = 0; j < 2; ++j) { const int c = 8 * lane + 512 * j; float o[8];
#pragma unroll
            for (int e = 0; e < 8; ++e) o[e] = v[8 * j + e] * rstd * p.in[21][c + e] + p.in[22][c + e];
            u32x4 w; w.x = pk2(o[0], o[1]); w.y = pk2(o[2], o[3]); w.z = pk2(o[4], o[5]); w.w = pk2(o[6], o[7]);
            *(u32x4*)(vn + c) = w;
            if (row >= MP) { float* vs = p.out + O_VS + (size_t)(row - MP) * MLPW + c;
                *(f32x4*)vs = (f32x4){o[0], o[1], o[2], o[3]}; *(f32x4*)(vs + 4) = (f32x4){o[4], o[5], o[6], o[7]}; }
        }
    }
}
__device__ __forceinline__ void phase_final(const P& p, int gw, int NGW, int lane) {
    for (int row = gw; row < M; row += NGW) {
        float* x = p.out + (size_t)row * D;
        f32x4 v[8]; float s = 0.f;
#pragma unroll
        for (int j = 0; j < 8; ++j) { v[j] = *(const f32x4*)(x + 4 * lane + 256 * j); s += (v[j][0] * v[j][0] + v[j][1] * v[j][1]) + (v[j][2] * v[j][2] + v[j][3] * v[j][3]); }
        const float rstd = rsqrtf(wave_sum(s) * (1.f / D) + 1e-6f);
#pragma unroll
        for (int j = 0; j < 8; ++j) { const int k = 4 * lane + 256 * j; *(f32x4*)(x + k) = v[j] * rstd * *(const f32x4*)(p.in[31] + k); }
    }
}
__device__ __forceinline__ void mix_naive_row(const P& p, int row, int tid, int nthr) {
    const int t = (row - MP) & (TS - 1), rowc0 = row - t;
    const bf16_t* vn = (const bf16_t*)(p.ws + WS_VN) + (size_t)rowc0 * MLPW;
    const bf16_t* zu = (const bf16_t*)(p.ws + WS_ZUG) + (size_t)row * ZUGW + ZU_U;
    bf16_t* ub = (bf16_t*)(p.ws + WS_OA) + (size_t)row * (2 * RW) + RW;
    for (int c = tid; c < MLPW; c += nthr) {
        const int g = c >> 7; const float* wsg = p.in[23] + ((size_t)g * 128 + t) * 128;
        float wv[TS], vv[TS];
#pragma unroll
        for (int s = 0; s < TS; ++s) { wv[s] = wsg[s]; vv[s] = bf2f(vn[(size_t)s * MLPW + c]); }
        float acc = p.in[24][g * 128 + t];
#pragma unroll
        for (int s = 0; s < TS; ++s) acc += (s <= t ? wv[s] : 0.f) * vv[s];
        ub[c] = f2bf(bf2f(zu[c]) * acc);
    }
}

#define PHASE_IDS() int tid = threadIdx.x; asm volatile("" : "+v"(tid)); const int lane = tid & 63, wave = __builtin_amdgcn_readfirstlane(tid >> 6); \
    const int gw = bx * NWAVES + wave, NGW = G * NWAVES; (void)lane; (void)gw; (void)NGW
__global__ void __launch_bounds__(NTHR, 2) mega_fwd(P p) {
    extern __shared__ __attribute__((aligned(16))) unsigned char lds_raw[];
    LAS unsigned char* lds = (LAS unsigned char*)lds_raw;
    const int G = gridDim.x, bx = blockIdx.x;
    unsigned char* ws = p.ws;
#define FLAGS(k) ((unsigned*)(ws + WS_CTL) + CW_FLAGS + (k) * 256)
    { PHASE_IDS();
      for (int u = tid; u < (LDS_BYTES - LDSCTL_OFF) / 4; u += NTHR) ((LAS unsigned*)(lds + LDSCTL_OFF))[u] = 0u; }
    __syncthreads();
    XcdBarrier bar = xcd_barrier_post((unsigned*)(ws + WS_CTL) + CW_BAR, (volatile LAS unsigned*)(lds + MISC_OFF) + 8);
#ifdef TSMASK
    unsigned long long* tsw = (unsigned long long*)(ws + WS_CTL + 524288); int nst = 0;
#define STAMP() do { if (bx == 0 && threadIdx.x == 0) tsw[nst] = __builtin_amdgcn_s_memrealtime(); ++nst; } while (0)
#else
#define STAMP() do { } while (0)
#endif
    STAMP();

    { PHASE_IDS();
      p0_silu(p, bx * NTHR + tid, G * NTHR);
      p0_transposes(p, (LAS float*)(lds + wave * 16384), 0, gw, NGW, lane); }
    xcd_barrier(bar); STAMP();
    { PHASE_IDS();
      for (int slab = bx; slab < 256; slab += G) p0_mod_slab(p, lds, slab, tid, lane, wave); }
    xcd_barrier(bar); STAMP();
    { PHASE_IDS(); phase_norm(p, 0, gw, NGW, lane); }
    xcd_barrier(bar); STAMP();
    {
        pg8::Gemm g{(const bf16_t*)(ws + WS_H), (const bf16_t*)(ws + WS_WIN), M, CIN, D}; SliceOrder S; S.init(M, CIN, D, bx, FLAGS(0), (float*)(ws + WS_VN));
        EpiZ E{(bf16_t*)(ws + WS_ZRW), (bf16_t*)(ws + WS_ZUG), p.out};
        pg8::gemm_phase<EpiZ, SliceOrder, PG8_ALIGN, PG8_SP2>(lds, g, S, E);
    }
    xcd_barrier(bar); STAMP();
    { PHASE_IDS();
      phase_lnv(p, gw, NGW, lane);
      STAMP();
      for (int rec = gw; rec < NREC; rec += NGW) prep_record(p, lds + wave * 16384, rec, lane); }
    xcd_barrier(bar); STAMP();
    { PHASE_IDS();
        const int NPC = NPB * NH;
        volatile LAS unsigned* prog = (volatile LAS unsigned*)(lds + MISC_OFF) + 16;
        if (bx < NPC) {
            if (wave < 2) scan_chain_prompt(p, bx >> 4, bx & 15, wave, lane, prog);
            else if (wave == 4 || wave == 5) scan_prefetch(p, prog, bx >> 4, bx & 15, wave - 4, lane);
            STAMP();
        }
        else {
            const int wid = (bx - NPC) * NWAVES + wave, NW = (G - NPC) * NWAVES;
            scan_samples(p, wid, NW, lane);
            for (int item = bx - NPC; item < NPB * 16 * 8; item += G - NPC) mix_item(p, item, wave, lane);
            for (int row = MP + bx - NPC; row < M; row += G - NPC) mix_naive_row(p, row, tid, NTHR);
            p0_transposes(p, (LAS float*)(lds + wave * 16384), 1, wid, NW, lane);
        }
    }
    xcd_barrier(bar); STAMP();
    { PHASE_IDS(); post_rows(p, gw, NGW, lane); }
    xcd_barrier(bar); STAMP();
    {
        pg8::Gemm g{(const bf16_t*)(ws + WS_OA), (const bf16_t*)(ws + WS_WBA), M, D, 2 * RW}; SliceOrder S; S.init(M, D, 2 * RW, bx, FLAGS(1), p.out);
        EpiMerge E{(const bf16_t*)(ws + WS_ZUG), (bf16_t*)(ws + WS_H)};
        pg8::gemm_phase<EpiMerge, SliceOrder, PG8_ALIGN, PG8_SP2>(lds, g, S, E);
    }
    xcd_barrier(bar); STAMP();
    {
        pg8::Gemm g{(const bf16_t*)(ws + WS_H), (const bf16_t*)(ws + WS_WOUT), M, D, D}; SliceOrder S; S.init(M, D, D, bx, FLAGS(2), (float*)(ws + WS_VN));
        EpiRes1 E{p.in[0], p.in[1], (const float*)(ws + WS_MOD), p.out};
        pg8::gemm_phase<EpiRes1, SliceOrder, PG8_ALIGN, PG8_SP2>(lds, g, S, E);
    }
    xcd_barrier(bar); STAMP();
    { PHASE_IDS(); phase_norm(p, 1, gw, NGW, lane); }
    xcd_barrier(bar); STAMP();
    {
        pg8::Gemm g{(const bf16_t*)(ws + WS_H), (const bf16_t*)(ws + WS_WFI), M, 2 * DFF, D}; SliceOrder S; S.init(M, 2 * DFF, D, bx, FLAGS(3), (float*)(ws + WS_VN));
        EpiSwiglu E{(bf16_t*)(ws + WS_ZUG)};
        pg8::gemm_phase<EpiSwiglu, SliceOrder, PG8_ALIGN, PG8_SP2>(lds, g, S, E);
    }
    xcd_barrier(bar); STAMP();
    {
        pg8::Gemm g{(const bf16_t*)(ws + WS_ZUG), (const bf16_t*)(ws + WS_WFO), M, D, DFF}; SliceOrder S; S.init(M, D, DFF, bx, FLAGS(4), (float*)(ws + WS_VN));
        EpiRes2 E{(const float*)(ws + WS_MOD), p.out};
        pg8::gemm_phase<EpiRes2, SliceOrder, PG8_ALIGN, PG8_SP2>(lds, g, S, E);
    }
    xcd_barrier(bar); STAMP();
    { PHASE_IDS(); phase_final(p, gw, NGW, lane); }
#ifdef TSMASK
    STAMP();
    if (bx == 0 && threadIdx.x == 0) {
        unsigned long long tot = 0;
        for (int k = 0; k < nst - 1; ++k) if ((TSMASK >> k) & 1) tot += tsw[k + 1] - tsw[k];
        p.out[0] += (float)tot * (1.0f / 20000.0f);
    }
#endif
}

extern "C" void kernel_launch(void* const* d_in, const int* in_sizes, int n_in, void* d_out, int out_size, void* d_ws, size_t ws_size, hipStream_t stream) {
    static int grid = 0;
    if (grid == 0) {
        if (n_in != 32 || (size_t)out_size != O_END || ws_size < WS_END) { fprintf(stderr, "kernel_launch: unexpected shapes n_in=%d out=%d ws=%zu (need %zu)\n", n_in, out_size, ws_size, (size_t)WS_END); grid = -1; return; }
        int dev = 0, cus = 0, per_cu = 0;
        if (hipGetDevice(&dev) != hipSuccess || hipDeviceGetAttribute(&cus, hipDeviceAttributeMultiprocessorCount, dev) != hipSuccess) { grid = -1; return; }
        if (hipFuncSetAttribute((const void*)mega_fwd, hipFuncAttributeMaxDynamicSharedMemorySize, LDS_BYTES) != hipSuccess) { fprintf(stderr, "kernel_launch: hipFuncSetAttribute failed\n"); grid = -1; return; }
        if (hipOccupancyMaxActiveBlocksPerMultiprocessor(&per_cu, (const void*)mega_fwd, NTHR, LDS_BYTES) != hipSuccess || per_cu < 1) { fprintf(stderr, "kernel_launch: occupancy query says %d blocks per CU\n", per_cu); }
        (void)hipGetLastError();
        grid = cus;
        if (grid != 256) { fprintf(stderr, "kernel_launch: built for 256 CUs (got %d)\n", cus); grid = -1; return; }
        if (grid < 128) { fprintf(stderr, "kernel_launch: this kernel's phase plan needs >= 128 CUs (got %d)\n", cus); grid = -1; return; }
    }
    if (grid < 0) return;
    if (hipMemsetAsync((char*)d_ws + WS_CTL, 0, CTL_ZERO_BYTES, stream) != hipSuccess) { fprintf(stderr, "kernel_launch: memset failed\n"); return; }
    P p{};
    for (int i = 0; i < 32; ++i) p.in[i] = (const float*)d_in[i];
    p.out = (float*)d_out; p.ws = (unsigned char*)d_ws;
    hipLaunchKernelGGL(mega_fwd, dim3(grid), dim3(NTHR), LDS_BYTES, stream, p);
    const hipError_t le = hipPeekAtLastError();
    if (le != hipSuccess) fprintf(stderr, "kernel_launch: launch failed: %s\n", hipGetErrorName(le));
}
```

```cpp
#include <hip/hip_runtime.h>
#include <cstdio>
#include <cstdint>

constexpr int D = 2048, NPB = 4, TP = 2048, NSB = 128, TS = 8;
constexpr int MP = NPB * TP, MS = NSB * TS, M = MP + MS;
constexpr int RW = 1024, NH = 16, HS = 64;
constexpr int CSH = 3328, CIN = 9472, DFF = 5632, MLPW = 1024;
constexpr int C_U = CSH, C_V = CSH + 1024, C_G0 = CSH + 2048, C_G1 = C_G0 + 2048;
constexpr int ZUGW = CIN - CSH, ZU_U = 0, ZU_V = 1024, ZU_G0 = 2048, ZU_G1 = 4096;
constexpr int NSEQ = NPB + NSB;
constexpr size_t O_YP = 0, O_YS = O_YP + (size_t)MP * D, O_WKVP = O_YS + (size_t)MS * D, O_SHP = O_WKVP + (size_t)NPB * NH * HS * HS,
                 O_WKVS = O_SHP + (size_t)NPB * CSH, O_SHS = O_WKVS + (size_t)NSB * NH * HS * HS, O_VS = O_SHS + (size_t)NSB * CSH,
                 O_END = O_VS + (size_t)MS * MLPW;
constexpr size_t WS_CTL = 0, CTL_BYTES = 1u << 20, CTL_ZERO_BYTES = 160u << 10;
constexpr size_t WS_WIN = CTL_BYTES;
constexpr size_t WS_WBA = WS_WIN + (size_t)CIN * D * 2;
constexpr size_t WS_WBB = WS_WBA + (size_t)D * RW * 2;
constexpr size_t WS_WOUT = WS_WBB + (size_t)D * RW * 2;
constexpr size_t WS_WFI = WS_WOUT + (size_t)D * D * 2;
constexpr size_t WS_WFO = WS_WFI + (size_t)2 * DFF * D * 2;
constexpr size_t WS_MOD = WS_WFO + (size_t)D * DFF * 2;
constexpr size_t WS_H = WS_MOD + (size_t)NSEQ * 6 * D * 4;
constexpr size_t WS_ZRW = WS_H + (size_t)M * D * 2;
constexpr size_t WS_ZUG = WS_ZRW + (size_t)M * CSH * 2;
constexpr size_t WS_VN = WS_ZUG + (size_t)M * ZUGW * 2;
constexpr size_t WS_OA = WS_VN + (size_t)M * MLPW * 2;
constexpr size_t WS_UB = WS_OA + (size_t)M * RW * 2;
constexpr size_t WS_C2 = WS_UB + (size_t)M * MLPW * 2;
constexpr size_t WS_LORA = WS_C2 + (size_t)M * RW * 2;
constexpr size_t WS_SILU = WS_LORA + (size_t)RW * 256 * 2;
constexpr size_t WS_FRA_S = WS_SILU + (size_t)144 * D * 2;
constexpr size_t WS_FRB_S = WS_FRA_S + (size_t)NSB * NH * 4096;
constexpr size_t WS_END = WS_FRB_S + (size_t)NSB * NH * 8448;
constexpr int NREC_P = NPB * 128 * NH, NREC = NREC_P + NSB * NH;
constexpr int RECA = 4096, RECB = 8448;
static_assert(WS_C2 + (size_t)M * RW * 2 - WS_VN >= (size_t)256 * 262144, "stream-K slabs (256 x 256 KiB) fit VN | OA|UB | C2");
static_assert((size_t)NREC_P * RECA <= (size_t)M * D * 2 && (size_t)NREC_P * RECB <= (size_t)M * D * 4, "prompt fragment records fit the H buffer / the y region of d_out");
constexpr int CW_BAR = 4096, CW_SILU = 16384, CW_FLAGS = 32768;

typedef float f32x2v __attribute__((ext_vector_type(2)));
typedef __bf16 bf16x2v __attribute__((ext_vector_type(2)));
typedef unsigned u32x2v __attribute__((ext_vector_type(2)));

struct P { const float* in[32]; float* out; unsigned char* ws; };

__device__ __forceinline__ unsigned pk2(float lo, float hi) { return __builtin_bit_cast(unsigned, __builtin_convertvector((f32x2v){lo, hi}, bf16x2v)); }
__device__ __forceinline__ unsigned short f2bf(float f) { return (unsigned short)(pk2(f, 0.f) & 0xffffu); }
__device__ __forceinline__ float bf2f(unsigned short h) { return __uint_as_float(((unsigned)h) << 16); }
__device__ __forceinline__ float bflo(unsigned w) { return __uint_as_float(w << 16); }
__device__ __forceinline__ float bfhi(unsigned w) { return __uint_as_float(w & 0xffff0000u); }
__device__ __forceinline__ float sigmoidf_(float x) { return __builtin_amdgcn_rcpf(1.f + __expf(-x)); }
__device__ __forceinline__ float gelu_tanh(float x) {
    const float u = 0.7978845608028654f * (x + 0.044715f * x * x * x); return x * __builtin_amdgcn_rcpf(1.f + __expf(-2.f * u)); }
__device__ __forceinline__ float wave_sum(float v) {
#pragma unroll
    for (int o = 1; o < 64; o <<= 1) v += __shfl_xor(v, o);
    return v;
}
__device__ __forceinline__ int seq_of_row(int row) { return row < MP ? row / TP : NPB + (row - MP) / TS; }

namespace pg8 {
#define PG8_LAS __attribute__((address_space(3)))
typedef unsigned short bf16_t;
typedef short bf16x8 __attribute__((ext_vector_type(8)));
typedef float f32x4 __attribute__((ext_vector_type(4)));
typedef unsigned u32x4 __attribute__((ext_vector_type(4)));
constexpr int BM = 256, BK = 64, HALF = 128, HTB = HALF * BK * 2  , STAGE_BYTES = 8 * HTB, NXCD = 8, WGM = 8;

__host__ __device__ __forceinline__ int lds_byte(int r, int c) { const int st = (r >> 4) * 2 + (c >> 5), rr = r & 15, cc = c & 31, ob = rr * 64 + cc * 2; return st * 1024 + (ob ^ (((ob >> 9) & 1) << 5)); }
__host__ __device__ __forceinline__ void stage_rc(int b, int& R, int& C) { const int st = b / 1024, sb = b % 1024, swz = sb ^ (((sb >> 9) & 1) << 5); R = (st >> 1) * 16 + swz / 64; C = (st & 1) * 32 + (swz % 64) / 2; }
__host__ __device__ __forceinline__ int perm32(int rho) { const int n = rho >> 4, i = rho & 15; return 8 * (i >> 2) + 4 * n + (i & 3); }

struct Unit { int pm, pn, kb, nk, kind, peer; };
struct Gemm { const bf16_t* A; const bf16_t* Bt; int M, N, K; };

struct StaticOrder {
    int nM, nN, nwg, G, c;
    __host__ __device__ void init(int M, int N, int G_, int c_) { nM = M / BM; nN = N / BM; nwg = nM * nN; G = G_; c = c_; }
    __host__ __device__ bool next(int i, Unit& u) const {
        const long L = (long)i * G + c; if (L >= nwg) return false;
        int wgid = (int)L; { const int q = nwg / NXCD, r = nwg % NXCD, xcd = wgid % NXCD, off = wgid / NXCD; wgid = (xcd < r ? xcd * (q + 1) : r * (q + 1) + (xcd - r) * q) + off; }
        const int nig = WGM * nN, gid = wgid / nig, fm = gid * WGM, gsz = (nM - fm) < WGM ? (nM - fm) : WGM;
        u.pm = fm + ((wgid % nig) % gsz); u.pn = (wgid % nig) / gsz; return true;
    }
    __device__ __forceinline__ void a_ready(const Unit&) const {}
    __device__ __forceinline__ void done(const Unit&) const {}
};
template <class Epi, class Sched, bool ALIGN_EPI = false, bool SP2 = false>
__device__ __forceinline__ void gemm_phase(PG8_LAS unsigned char* lds, const Gemm g, const Sched& S, const Epi& E) {
    int tid_ = threadIdx.x; asm volatile("" : "+v"(tid_));
    const int tid = tid_, wid = __builtin_amdgcn_readfirstlane(tid >> 6), lane = tid & 63, wr = wid >> 2, wc = wid & 3, fr = lane & 15, fq = lane >> 4;
    const int K = g.K;
    unsigned voffA[2], voffB[2];
#pragma unroll
    for (int i = 0; i < 2; ++i) { int R, C; stage_rc(tid * 16 + i * 8192, R, C); const int Rb = Epi::PERM ? ((R & ~31) + perm32(R & 31)) : R;
        voffA[i] = (unsigned)(R * K + C) * 2u; voffB[i] = (unsigned)(Rb * K + C) * 2u; }
    const size_t kstep = (size_t)(BK * 2);
    const size_t hstep = (size_t)HALF * K * 2;
    const size_t tstep = 2 * hstep;
    const unsigned ldsw = (unsigned)wid * 1024u;
    const int aoff = lds_byte(wr * 64 + fr, fq * 8), boff = lds_byte(wc * 32 + fr, fq * 8);
#define PG8_SA(b, h) (((b) * 2 + (h)) * HTB)
#define PG8_SB(b, h) ((4 + (b) * 2 + (h)) * HTB)
#define PG8_STAGE(bufoff, gbase, voff) do { _Pragma("unroll") for (int _i = 0; _i < 2; ++_i) \
        __builtin_amdgcn_global_load_lds((const unsigned*)((const char*)(gbase) + (voff)[_i]), (PG8_LAS unsigned*)(lds + (bufoff) + ldsw + _i * 8192), 16, 0, 0); } while (0)
#define PG8_LDA(dst, b, h) do { _Pragma("unroll") for (int m = 0; m < 4; ++m) _Pragma("unroll") for (int k = 0; k < 2; ++k) dst[m][k] = *(const PG8_LAS bf16x8*)(lds + PG8_SA(b, h) + aoff + m * 2048 + k * 1024); } while (0)
#define PG8_LDB(dst, b, h) do { _Pragma("unroll") for (int n = 0; n < 2; ++n) _Pragma("unroll") for (int k = 0; k < 2; ++k) dst[n][k] = *(const PG8_LAS bf16x8*)(lds + PG8_SB(b, h) + boff + n * 2048 + k * 1024); } while (0)
#define PG8_MMA(ai, bj, At, Bt) do { __builtin_amdgcn_s_setprio(1); _Pragma("unroll") for (int m = 0; m < 4; ++m) _Pragma("unroll") for (int n = 0; n < 2; ++n) _Pragma("unroll") for (int k = 0; k < 2; ++k) \
        acc[ai][bj][m][n] = __builtin_amdgcn_mfma_f32_16x16x32_bf16(Bt[n][k], At[m][k], acc[ai][bj][m][n], 0, 0, 0); __builtin_amdgcn_s_setprio(0); } while (0)
#define PG8_WAIT_V(n) asm volatile("s_waitcnt vmcnt(" #n ")" ::: "memory")
#define PG8_WAIT_L(n) asm volatile("s_waitcnt lgkmcnt(" #n ")" ::: "memory")
#define PG8_BAR __builtin_amdgcn_s_barrier()
#define PG8_SCHED __builtin_amdgcn_sched_barrier(0)
    Unit cur, nxt; int ui = 0;
    if (!S.next(0, cur)) return;
    f32x4 acc[2][2][4][2];
#pragma unroll
    for (int a = 0; a < 2; ++a)
#pragma unroll
        for (int b = 0; b < 2; ++b)
#pragma unroll
            for (int m = 0; m < 4; ++m)
#pragma unroll
                for (int n = 0; n < 2; ++n) acc[a][b][m][n] = (f32x4){0.f, 0.f, 0.f, 0.f};
    bf16x8 At[4][2], B0[2][2], B1[2][2];
    const char* cA = (const char*)g.A + (size_t)cur.pm * tstep + (size_t)cur.kb * kstep; const char* cB = (const char*)g.Bt + (size_t)cur.pn * tstep + (size_t)cur.kb * kstep;
    S.a_ready(cur);
    if constexpr (SP2) {
        PG8_STAGE(PG8_SB(0, 0), cB, voffB); PG8_STAGE(PG8_SB(0, 1), cB + hstep, voffB); PG8_STAGE(PG8_SA(0, 0), cA, voffA); PG8_STAGE(PG8_SA(0, 1), cA + hstep, voffA);
        if (wr == 1) PG8_BAR;
        PG8_WAIT_V(2); PG8_BAR;
        PG8_STAGE(PG8_SB(1, 0), cB + kstep, voffB); PG8_STAGE(PG8_SA(1, 0), cA + kstep, voffA); PG8_STAGE(PG8_SB(1, 1), cB + hstep + kstep, voffB);
        PG8_WAIT_V(6); PG8_BAR;
    } else {
        PG8_STAGE(PG8_SB(0, 0), cB, voffB); PG8_STAGE(PG8_SA(0, 0), cA, voffA); PG8_STAGE(PG8_SB(0, 1), cB + hstep, voffB); PG8_STAGE(PG8_SA(0, 1), cA + hstep, voffA);
        if (wr == 1) PG8_BAR;
        PG8_WAIT_V(4); PG8_BAR;
        PG8_STAGE(PG8_SB(1, 0), cB + kstep, voffB); PG8_STAGE(PG8_SA(1, 0), cA + kstep, voffA); PG8_STAGE(PG8_SB(1, 1), cB + hstep + kstep, voffB);
        PG8_WAIT_V(6); PG8_BAR;
    }
    for (;;) {
        const bool has_next = S.next(ui + 1, nxt);
        const char* nA = has_next ? (const char*)g.A + (size_t)nxt.pm * tstep + (size_t)nxt.kb * kstep : cA; const char* nB = has_next ? (const char*)g.Bt + (size_t)nxt.pn * tstep + (size_t)nxt.kb * kstep : cB;
        const int nt = cur.nk;
        for (int t = 0; t < nt; t += 2) {
            const bool last = (t == nt - 2);
            if constexpr (Epi::HOOK_TILE > 0) { if (cur.kb + t == Epi::HOOK_TILE && t > 0) E.mid(acc, cur, wr, wc, fr, fq); }
            const char* a1 = cA + (size_t)(t + 1) * kstep;
            const char* a2 = last ? nA : cA + (size_t)(t + 2) * kstep; const char* b2 = last ? nB : cB + (size_t)(t + 2) * kstep;
            const char* a3 = a2 + kstep; const char* b3 = b2 + kstep;
            if (last && has_next) S.a_ready(nxt);
            if constexpr (SP2) {
            PG8_LDB(B0, 0, 0); PG8_LDB(B1, 0, 1); PG8_SCHED; PG8_LDA(At, 0, 0); PG8_STAGE(PG8_SA(1, 1), a1 + hstep, voffA);
            PG8_WAIT_V(8); PG8_WAIT_L(0); PG8_BAR; PG8_MMA(0, 0, At, B0); PG8_MMA(0, 1, At, B1); PG8_BAR; PG8_SCHED;
            PG8_LDA(At, 0, 1); PG8_STAGE(PG8_SB(0, 0), b2, voffB); PG8_STAGE(PG8_SB(0, 1), b2 + hstep, voffB); PG8_STAGE(PG8_SA(0, 0), a2, voffA);
            PG8_WAIT_V(8); PG8_WAIT_L(0); PG8_BAR; PG8_MMA(1, 0, At, B0); PG8_MMA(1, 1, At, B1); PG8_BAR; PG8_SCHED;
            PG8_LDB(B0, 1, 0); PG8_LDB(B1, 1, 1); PG8_SCHED; PG8_LDA(At, 1, 0); PG8_STAGE(PG8_SA(0, 1), a2 + hstep, voffA);
            PG8_WAIT_V(8); PG8_WAIT_L(0); PG8_BAR; PG8_MMA(0, 0, At, B0); PG8_MMA(0, 1, At, B1); PG8_BAR; PG8_SCHED;
            PG8_LDA(At, 1, 1); PG8_STAGE(PG8_SB(1, 0), b3, voffB); PG8_STAGE(PG8_SB(1, 1), b3 + hstep, voffB); PG8_STAGE(PG8_SA(1, 0), a3, voffA);
            PG8_WAIT_V(8); PG8_WAIT_L(0); PG8_BAR; PG8_MMA(1, 0, At, B0); PG8_MMA(1, 1, At, B1); PG8_BAR; PG8_SCHED;
            } else {
            PG8_LDB(B0, 0, 0); PG8_SCHED; PG8_LDA(At, 0, 0); PG8_STAGE(PG8_SA(1, 1), a1 + hstep, voffA);
            PG8_WAIT_L(8); PG8_BAR; PG8_WAIT_L(0); PG8_MMA(0, 0, At, B0); PG8_BAR; PG8_SCHED;
            PG8_LDB(B1, 0, 1); PG8_STAGE(PG8_SB(0, 0), b2, voffB);
            PG8_BAR; PG8_WAIT_L(0); PG8_MMA(0, 1, At, B1); PG8_BAR;
            PG8_LDA(At, 0, 1); PG8_STAGE(PG8_SA(0, 0), a2, voffA);
            PG8_BAR; PG8_WAIT_L(0); PG8_MMA(1, 0, At, B0); PG8_BAR; PG8_SCHED;
            PG8_STAGE(PG8_SB(0, 1), b2 + hstep, voffB);
            PG8_WAIT_V(6); PG8_BAR; PG8_MMA(1, 1, At, B1); PG8_BAR;
            PG8_LDB(B0, 1, 0); PG8_SCHED; PG8_LDA(At, 1, 0); PG8_STAGE(PG8_SA(0, 1), a2 + hstep, voffA);
            PG8_WAIT_L(8); PG8_BAR; PG8_WAIT_L(0); PG8_MMA(0, 0, At, B0); PG8_BAR; PG8_SCHED;
            PG8_LDB(B1, 1, 1); PG8_STAGE(PG8_SB(1, 0), b3, voffB);
            PG8_BAR; PG8_WAIT_L(0); PG8_MMA(0, 1, At, B1); PG8_BAR;
            PG8_LDA(At, 1, 1); PG8_STAGE(PG8_SA(1, 0), a3, voffA);
            PG8_BAR; PG8_WAIT_L(0); PG8_MMA(1, 0, At, B0); PG8_BAR; PG8_SCHED;
            PG8_STAGE(PG8_SB(1, 1), b3 + hstep, voffB);
            PG8_WAIT_V(6); PG8_BAR; PG8_MMA(1, 1, At, B1); PG8_BAR;
            }
        }
        if constexpr (ALIGN_EPI) { if (wr == 0) PG8_BAR; }
        if constexpr (Epi::HOOK_TILE > 0) { if (cur.kb + cur.nk <= Epi::HOOK_TILE) E.mid(acc, cur, wr, wc, fr, fq); }
        if (cur.kind == 3) {
            int fr_ = fr; asm volatile("" : "+v"(fr_));
            const int ti4 = (wid * 64 + fq * 16 + fr_) * 4;
            {
                unsigned char* slw = (unsigned char*)S.slab + (size_t)(cur.peer * S.nsl + S.s) * 131072;
                const __amdgpu_buffer_rsrc_t rs = __builtin_amdgcn_make_buffer_rsrc(slw, 0, 131072, 0x00020000);
#pragma unroll
                for (int a = 0; a < 2; ++a)
#pragma unroll
                    for (int m = 0; m < 4; ++m) {
                        if ((a * 4 + m) % S.nsl == S.s) continue;
#pragma unroll
                        for (int b = 0; b < 2; ++b) {
                            u32x4 w; const f32x4 p0 = acc[a][b][m][0], p1 = acc[a][b][m][1];
                            w.x = pk2(p0[0], p0[1]); w.y = pk2(p0[2], p0[3]); w.z = pk2(p1[0], p1[1]); w.w = pk2(p1[2], p1[3]);
                            __builtin_amdgcn_raw_buffer_store_b128(w, rs, ti4 * 4 + ((a * 2 + b) * 4 + m) * 8192, 0, 16);
                        }
                    }
            }
            PG8_WAIT_V(0); PG8_BAR;
            if (wid == 0 && (fq | fr) == 0) {
                __hip_atomic_fetch_add(S.cnt + cur.peer, 1u, __ATOMIC_RELAXED, __HIP_MEMORY_SCOPE_AGENT);
                unsigned sp = 0; while (__hip_atomic_load(S.cnt + cur.peer, __ATOMIC_RELAXED, __HIP_MEMORY_SCOPE_AGENT) < (unsigned)S.nsl && ++sp < (1u << 22)) __builtin_amdgcn_s_sleep(2);
                __builtin_amdgcn_fence(__ATOMIC_ACQUIRE, "agent"); PG8_WAIT_V(0);
            }
            PG8_BAR; asm volatile("" ::: "memory");
            const int no = S.nsl - 1;
#define PG8_RED(Q, Q0) { u32x4 t[Q][2]; \
                    _Pragma("unroll") for (int q = Q0; q < Q0 + Q; ++q) { int o = S.s + 1 + (q < no ? q : 0); o -= o >= S.nsl ? S.nsl : 0; \
                        t[q - Q0][0] = *(const u32x4*)(sb + (size_t)o * 131072); t[q - Q0][1] = *(const u32x4*)(sb + (size_t)o * 131072 + 4 * 8192); } \
                    _Pragma("unroll") for (int q = Q0; q < Q0 + Q; ++q) _Pragma("unroll") for (int b = 0; b < 2; ++b) { const bool on = q < no; const u32x4 w = t[q - Q0][b]; \
                        r[2 * b] += (f32x4){on ? bflo(w.x) : 0.f, on ? bfhi(w.x) : 0.f, on ? bflo(w.y) : 0.f, on ? bfhi(w.y) : 0.f}; \
                        r[2 * b + 1] += (f32x4){on ? bflo(w.z) : 0.f, on ? bfhi(w.z) : 0.f, on ? bflo(w.w) : 0.f, on ? bfhi(w.w) : 0.f}; } }
#pragma unroll
            for (int a = 0; a < 2; ++a)
#pragma unroll
                for (int m0 = 0; m0 < 4; ++m0) {
                    if ((a * 4 + m0) % S.nsl != S.s) continue;
                    f32x4 r[4] = {acc[a][0][m0][0], acc[a][0][m0][1], acc[a][1][m0][0], acc[a][1][m0][1]};
                    const unsigned char* sb = (const unsigned char*)S.slab + (size_t)(cur.peer * S.nsl) * 131072 + ti4 * 4 + ((a * 2) * 4 + m0) * 8192;
                    PG8_RED(4, 0)
                    if (no > 4) PG8_RED(4, 4)
                    E.rg(r[0], r[1], r[2], r[3], cur, a, m0, wr, wc, fr, fq);
                }
#undef PG8_RED
        } else {
            E(acc, cur, wr, wc, fr, fq);
        }
        if (!has_next) break;
#pragma unroll
        for (int a = 0; a < 2; ++a)
#pragma unroll
            for (int b = 0; b < 2; ++b)
#pragma unroll
                for (int m = 0; m < 4; ++m)
#pragma unroll
                    for (int n = 0; n < 2; ++n) acc[a][b][m][n] = (f32x4){0.f, 0.f, 0.f, 0.f};
        cur = nxt; cA = nA; cB = nB; ++ui;
        if constexpr (ALIGN_EPI) { if (wr == 1) PG8_BAR; }
    }
    PG8_WAIT_V(0);
    if constexpr (!ALIGN_EPI) { if (wr == 0) PG8_BAR; }
    PG8_BAR;
    if constexpr (Epi::AFTER_DRAIN) { E.fused(acc, cur, wr, wc, fr, fq, lds, wid, lane); S.done(cur); }
#undef PG8_SA
#undef PG8_SB
#undef PG8_STAGE
#undef PG8_LDA
#undef PG8_LDB
#undef PG8_MMA
#undef PG8_WAIT_V
#undef PG8_WAIT_L
#undef PG8_BAR
#undef PG8_SCHED
}
}
#define PG8_SP2 true
#define PG8_ALIGN true

using pg8::f32x4; using pg8::Unit; using pg8::BM; using pg8::HALF; typedef pg8::u32x4 u32x4;
typedef unsigned short bf16_t;

#define EPI_WALK() __device__ __forceinline__ void operator()(const f32x4 (&acc)[2][2][4][2], const Unit& u, int wr, int wc, int fr, int fq) const { \
        _Pragma("unroll") for (int ai = 0; ai < 2; ++ai) _Pragma("unroll") for (int m = 0; m < 4; ++m) { \
            rg(acc[ai][0][m][0], acc[ai][0][m][1], acc[ai][1][m][0], acc[ai][1][m][1], u, ai, m, wr, wc, fr, fq); if (m == 3) asm volatile("" ::: "memory"); } }

#define EPI_WALK_BODY(NB, FIN) \
        _Pragma("unroll") for (int g0 = 0; g0 < 8; g0 += NB) { L x[NB]; \
            _Pragma("unroll") for (int g = 0; g < NB; ++g) x[g] = ld(u, (g0 + g) >> 2, (g0 + g) & 3, wr, wc, fr, fq); \
            _Pragma("unroll") for (int g = 0; g < NB; ++g) { const int ai = (g0 + g) >> 2, m = (g0 + g) & 3; \
                FIN(x[g], pre, acc[ai][0][m][0], acc[ai][0][m][1], acc[ai][1][m][0], acc[ai][1][m][1], u, ai, m, wr, wc, fr, fq); } \
            asm volatile("" ::: "memory"); }
#define EPI_WALK_LD(NB) __device__ __forceinline__ void operator()(const f32x4 (&acc)[2][2][4][2], const Unit& u, int wr, int wc, int fr, int fq) const { \
        const Pre pre{}; EPI_WALK_BODY(NB, fin) } \
    __device__ __forceinline__ void rg(f32x4 v00, f32x4 v01, f32x4 v10, f32x4 v11, const Unit& u, int ai, int m, int wr, int wc, int fr, int fq) const { \
        fin(ld(u, ai, m, wr, wc, fr, fq), Pre{}, v00, v01, v10, v11, u, ai, m, wr, wc, fr, fq); }
#define EPI_WALK_LDU(NB) __device__ __forceinline__ void operator()(const f32x4 (&acc)[2][2][4][2], const Unit& u, int wr, int wc, int fr, int fq) const { \
        if (u.pm < MP / BM) { asm volatile("" : "+v"(fq)); const Pre pre = prep(u, wc, fq); EPI_WALK_BODY(NB, fin<true>) } \
        else { const Pre pre{}; EPI_WALK_BODY(NB, fin<false>) } } \
    __device__ __forceinline__ void rg(f32x4 v00, f32x4 v01, f32x4 v10, f32x4 v11, const Unit& u, int ai, int m, int wr, int wc, int fr, int fq) const { \
        fin<false>(ld(u, ai, m, wr, wc, fr, fq), Pre{}, v00, v01, v10, v11, u, ai, m, wr, wc, fr, fq); }

struct EpiZ {
    static constexpr int HOOK_TILE = 0;
    static constexpr bool PERM = true, AFTER_DRAIN = false;
    bf16_t* zrw; bf16_t* zug; float* out;
    __device__ __forceinline__ void rg(f32x4 v00, f32x4 v01, f32x4 v10, f32x4 v11, const Unit& u, int ai, int m, int wr, int wc, int fr, int fq) const {
        const int colt = u.pn * BM;
        const int mode = colt < CSH ? 0 : (colt < C_G0 ? 1 : 2);
        const int row = u.pm * BM + wr * 64 + fr + ai * HALF + m * 16, col0 = colt + wc * 32 + 8 * fq;
        bf16_t* rowp = mode == 0 ? zrw + (size_t)row * CSH + col0 : zug + (size_t)row * ZUGW + (col0 - CSH);
        if (mode == 0) {
            bool last; float* sh;
            if (row < MP) { last = (row & (TP - 1)) == TP - 1; sh = out + O_SHP + (size_t)(row / TP) * CSH + col0; }
            else { const int rs = row - MP; last = (rs & (TS - 1)) == TS - 1; sh = out + O_SHS + (size_t)(rs / TS) * CSH + col0; }
            if (last) { *(f32x4*)sh = v00; *(f32x4*)(sh + 4) = v01; *(f32x4*)(sh + HALF) = v10; *(f32x4*)(sh + HALF + 4) = v11; }
        } else if (mode == 1) {
#pragma unroll
            for (int e = 0; e < 4; ++e) { v00[e] = gelu_tanh(v00[e]); v01[e] = gelu_tanh(v01[e]); v10[e] = gelu_tanh(v10[e]); v11[e] = gelu_tanh(v11[e]); }
        } else {
#pragma unroll
            for (int e = 0; e < 4; ++e) { v00[e] = sigmoidf_(v00[e]); v01[e] = sigmoidf_(v01[e]); v10[e] = sigmoidf_(v10[e]); v11[e] = sigmoidf_(v11[e]); }
        }
        u32x4 w; w.x = pk2(v00[0], v00[1]); w.y = pk2(v00[2], v00[3]); w.z = pk2(v01[0], v01[1]); w.w = pk2(v01[2], v01[3]);
        *(u32x4*)rowp = w;
        w.x = pk2(v10[0], v10[1]); w.y = pk2(v10[2], v10[3]); w.z = pk2(v11[0], v11[1]); w.w = pk2(v11[2], v11[3]);
        *(u32x4*)(rowp + HALF) = w;
    }
    EPI_WALK()
};
struct EpiMerge {
    static constexpr int HOOK_TILE = 16, MIDB = 4;
    static constexpr bool PERM = true, AFTER_DRAIN = false;
    const bf16_t* z; bf16_t* mg;
    __device__ __forceinline__ void mid(f32x4 (&acc)[2][2][4][2], const Unit& u, int wr, int wc, int fr, int fq) const {
        asm volatile("" : "+v"(fr));
        const int row0 = u.pm * BM + wr * 64 + fr, col0 = u.pn * BM + wc * 32 + 8 * fq;
#pragma unroll
        for (int h = 0; h < 8 / MIDB; ++h) {
            u32x4 g0[MIDB][2], g1[MIDB][2];
#pragma unroll
            for (int g = 0; g < MIDB; ++g) {
                const int ai = (h * MIDB + g) >> 2, m = (h * MIDB + g) & 3;
                const bf16_t* zr = z + (size_t)(row0 + ai * HALF + m * 16) * ZUGW + col0;
#pragma unroll
                for (int bj = 0; bj < 2; ++bj) { g0[g][bj] = *(const u32x4*)(zr + ZU_G0 + bj * HALF); g1[g][bj] = *(const u32x4*)(zr + ZU_G1 + bj * HALF); }
            }
#pragma unroll
            for (int g = 0; g < MIDB; ++g)
#pragma unroll
                for (int bj = 0; bj < 2; ++bj) {
                    const int ai = (h * MIDB + g) >> 2, m = (h * MIDB + g) & 3;
                    const u32x4 a = g0[g][bj], c = g1[g][bj];
                    f32x4& v0 = acc[ai][bj][m][0]; f32x4& v1 = acc[ai][bj][m][1];
                    v0[0] *= bflo(a.x) * __builtin_amdgcn_rcpf(fmaxf(bflo(c.x), 1e-30f)); v0[1] *= bfhi(a.x) * __builtin_amdgcn_rcpf(fmaxf(bfhi(c.x), 1e-30f));
                    v0[2] *= bflo(a.y) * __builtin_amdgcn_rcpf(fmaxf(bflo(c.y), 1e-30f)); v0[3] *= bfhi(a.y) * __builtin_amdgcn_rcpf(fmaxf(bfhi(c.y), 1e-30f));
                    v1[0] *= bflo(a.z) * __builtin_amdgcn_rcpf(fmaxf(bflo(c.z), 1e-30f)); v1[1] *= bfhi(a.z) * __builtin_amdgcn_rcpf(fmaxf(bfhi(c.z), 1e-30f));
                    v1[2] *= bflo(a.w) * __builtin_amdgcn_rcpf(fmaxf(bflo(c.w), 1e-30f)); v1[3] *= bfhi(a.w) * __builtin_amdgcn_rcpf(fmaxf(bfhi(c.w), 1e-30f));
                }
            asm volatile("" ::: "memory");
        }
    }
    struct L { u32x4 ga, gb; }; struct Pre { };
    __device__ __forceinline__ L ld(const Unit& u, int ai, int m, int wr, int wc, int fr, int fq) const {
        const int row = u.pm * BM + wr * 64 + fr + ai * HALF + m * 16, col0 = u.pn * BM + wc * 32 + 8 * fq;
        const bf16_t* zr = z + (size_t)row * ZUGW + ZU_G1 + col0;
        return L{*(const u32x4*)zr, *(const u32x4*)(zr + HALF)};
    }
    __device__ __forceinline__ void fin(const L& x, const Pre&, f32x4 v00, f32x4 v01, f32x4 v10, f32x4 v11, const Unit& u, int ai, int m, int wr, int wc, int fr, int fq) const {
        const int row = u.pm * BM + wr * 64 + fr + ai * HALF + m * 16, col0 = u.pn * BM + wc * 32 + 8 * fq;
        const u32x4 ga = x.ga, gb = x.gb;
        u32x4 w;
        w.x = pk2(bflo(ga.x) * v00[0], bfhi(ga.x) * v00[1]); w.y = pk2(bflo(ga.y) * v00[2], bfhi(ga.y) * v00[3]);
        w.z = pk2(bflo(ga.z) * v01[0], bfhi(ga.z) * v01[1]); w.w = pk2(bflo(ga.w) * v01[2], bfhi(ga.w) * v01[3]);
        *(u32x4*)(mg + (size_t)row * D + col0) = w;
        w.x = pk2(bflo(gb.x) * v10[0], bfhi(gb.x) * v10[1]); w.y = pk2(bflo(gb.y) * v10[2], bfhi(gb.y) * v10[3]);
        w.z = pk2(bflo(gb.z) * v11[0], bfhi(gb.z) * v11[1]); w.w = pk2(bflo(gb.w) * v11[2], bfhi(gb.w) * v11[3]);
        *(u32x4*)(mg + (size_t)row * D + col0 + HALF) = w;
    }
    EPI_WALK_LD(8)
};
struct EpiRes1 {
    static constexpr int HOOK_TILE = 0;
    static constexpr bool PERM = true, AFTER_DRAIN = false;
    const float* xp; const float* xs; const float* mod; bf16_t* x1;
    struct L { f32x4 a, b, c, d; }; struct Pre { f32x4 g[4]; };
    __device__ __forceinline__ Pre prep(const Unit& u, int wc, int fq) const {
        const float* gm = mod + (size_t)((u.pm * BM) / TP) * (6 * D) + 2 * D + u.pn * BM + wc * 32 + 8 * fq;
        return Pre{{*(const f32x4*)gm, *(const f32x4*)(gm + 4), *(const f32x4*)(gm + HALF), *(const f32x4*)(gm + HALF + 4)}};
    }
    __device__ __forceinline__ L ld(const Unit& u, int ai, int m, int wr, int wc, int fr, int fq) const {
        const int row = u.pm * BM + wr * 64 + fr + ai * HALF + m * 16, col0 = u.pn * BM + wc * 32 + 8 * fq;
        const float* xr = (row < MP ? xp + (size_t)row * D : xs + (size_t)(row - MP) * D) + col0;
        return L{*(const f32x4*)xr, *(const f32x4*)(xr + 4), *(const f32x4*)(xr + HALF), *(const f32x4*)(xr + HALF + 4)};
    }
    template <bool UNI> __device__ __forceinline__ void fin(const L& x, const Pre& q, f32x4 v00, f32x4 v01, f32x4 v10, f32x4 v11, const Unit& u, int ai, int m, int wr, int wc, int fr, int fq) const {
        const int row = u.pm * BM + wr * 64 + fr + ai * HALF + m * 16, col0 = u.pn * BM + wc * 32 + 8 * fq;
        f32x4 g0 = q.g[0], g1 = q.g[1], g2 = q.g[2], g3 = q.g[3];
        if constexpr (!UNI) { const float* gm = mod + (size_t)seq_of_row(row) * (6 * D) + 2 * D + col0;
            g0 = *(const f32x4*)gm; g1 = *(const f32x4*)(gm + 4); g2 = *(const f32x4*)(gm + HALF); g3 = *(const f32x4*)(gm + HALF + 4); }
        const f32x4 a = x.a + g0 * v00, b = x.b + g1 * v01, c = x.c + g2 * v10, d = x.d + g3 * v11;
        u32x4 w; w.x = pk2(a[0], a[1]); w.y = pk2(a[2], a[3]); w.z = pk2(b[0], b[1]); w.w = pk2(b[2], b[3]);
        *(u32x4*)(x1 + (size_t)row * D + col0) = w;
        w.x = pk2(c[0], c[1]); w.y = pk2(c[2], c[3]); w.z = pk2(d[0], d[1]); w.w = pk2(d[2], d[3]);
        *(u32x4*)(x1 + (size_t)row * D + col0 + HALF) = w;
    }
    EPI_WALK_LDU(4)
};
struct EpiSwiglu {
    static constexpr int HOOK_TILE = 0;
    static constexpr bool PERM = true, AFTER_DRAIN = false;
    bf16_t* act;
    __device__ __forceinline__ void rg(f32x4 v00, f32x4 v01, f32x4 v10, f32x4 v11, const Unit& u, int ai, int m, int wr, int wc, int fr, int fq) const {
        const int row = u.pm * BM + wr * 64 + fr + ai * HALF + m * 16, col0 = u.pn * HALF + wc * 32 + 8 * fq;
        float r[8];
#pragma unroll
        for (int e = 0; e < 4; ++e) { r[e] = v00[e] * sigmoidf_(v00[e]) * v10[e]; r[4 + e] = v01[e] * sigmoidf_(v01[e]) * v11[e]; }
        u32x4 w; w.x = pk2(r[0], r[1]); w.y = pk2(r[2], r[3]); w.z = pk2(r[4], r[5]); w.w = pk2(r[6], r[7]);
        *(u32x4*)(act + (size_t)row * DFF + col0) = w;
    }
    EPI_WALK()
};
struct EpiRes2 {
    static constexpr int HOOK_TILE = 0;
    static constexpr bool PERM = true, AFTER_DRAIN = false;
    const float* mod; bf16_t* x1;
    struct L { u32x4 a, b; }; struct Pre { f32x4 g[4]; };
    __device__ __forceinline__ Pre prep(const Unit& u, int wc, int fq) const {
        const float* gf = mod + (size_t)((u.pm * BM) / TP) * (6 * D) + 5 * D + u.pn * BM + wc * 32 + 8 * fq;
        return Pre{{*(const f32x4*)gf, *(const f32x4*)(gf + 4), *(const f32x4*)(gf + HALF), *(const f32x4*)(gf + HALF + 4)}};
    }
    __device__ __forceinline__ L ld(const Unit& u, int ai, int m, int wr, int wc, int fr, int fq) const {
        const int row = u.pm * BM + wr * 64 + fr + ai * HALF + m * 16, col0 = u.pn * BM + wc * 32 + 8 * fq;
        const bf16_t* o = x1 + (size_t)row * D + col0;
        return L{*(const u32x4*)o, *(const u32x4*)(o + HALF)};
    }
    template <bool UNI> __device__ __forceinline__ void fin(const L& x, const Pre& q, f32x4 v00, f32x4 v01, f32x4 v10, f32x4 v11, const Unit& u, int ai, int m, int wr, int wc, int fr, int fq) const {
        const int row = u.pm * BM + wr * 64 + fr + ai * HALF + m * 16, col0 = u.pn * BM + wc * 32 + 8 * fq;
        f32x4 g0 = q.g[0], g1 = q.g[1], g2 = q.g[2], g3 = q.g[3];
        if constexpr (!UNI) { const float* gf = mod + (size_t)seq_of_row(row) * (6 * D) + 5 * D + col0;
            g0 = *(const f32x4*)gf; g1 = *(const f32x4*)(gf + 4); g2 = *(const f32x4*)(gf + HALF); g3 = *(const f32x4*)(gf + HALF + 4); }
        bf16_t* o = x1 + (size_t)row * D + col0;
        const u32x4 xa = x.a, xb = x.b;
        u32x4 w;
        w.x = pk2(bflo(xa.x) + g0[0] * v00[0], bfhi(xa.x) + g0[1] * v00[1]); w.y = pk2(bflo(xa.y) + g0[2] * v00[2], bfhi(xa.y) + g0[3] * v00[3]);
        w.z = pk2(bflo(xa.z) + g1[0] * v01[0], bfhi(xa.z) + g1[1] * v01[1]); w.w = pk2(bflo(xa.w) + g1[2] * v01[2], bfhi(xa.w) + g1[3] * v01[3]);
        *(u32x4*)o = w;
        w.x = pk2(bflo(xb.x) + g2[0] * v10[0], bfhi(xb.x) + g2[1] * v10[1]); w.y = pk2(bflo(xb.y) + g2[2] * v10[2], bfhi(xb.y) + g2[3] * v10[3]);
        w.z = pk2(bflo(xb.z) + g3[0] * v11[0], bfhi(xb.z) + g3[1] * v11[1]); w.w = pk2(bflo(xb.w) + g3[2] * v11[2], bfhi(xb.w) + g3[3] * v11[3]);
        *(u32x4*)(o + HALF) = w;
    }
    EPI_WALK_LDU(4)
};
struct SliceOrder {
    int nM, nN, nwg, KT, R1, c, nleft, nsl, l, s;
    unsigned* cnt; float* slab;
    __device__ __forceinline__ void init(int M_, int N_, int K_, int c_, unsigned* cnt_, float* slab_) {
        nM = M_ / BM; nN = N_ / BM; nwg = nM * nN; KT = K_ / 64; c = c_; cnt = cnt_; slab = slab_;
        R1 = nwg / 256; nleft = nwg - R1 * 256; nsl = nleft ? 256 / nleft : 1; if (nsl > 8) nsl = 8;
        l = nleft ? c % nleft : 0; s = nleft ? c / nleft : nsl;
    }
    __device__ __forceinline__ int kbnd(int i) const { return i >= nsl ? KT : (((KT * i) / nsl + 1) & ~1); }
    __device__ __forceinline__ void pmpn(int L, Unit& u) const {
        int wgid = L; { const int q = nwg / pg8::NXCD, r = nwg % pg8::NXCD, xcd = wgid % pg8::NXCD, off = wgid / pg8::NXCD; wgid = (xcd < r ? xcd * (q + 1) : r * (q + 1) + (xcd - r) * q) + off; }
        const int nig = pg8::WGM * nN, gid = wgid / nig, fm = gid * pg8::WGM, gsz = (nM - fm) < pg8::WGM ? (nM - fm) : pg8::WGM;
        u.pm = fm + ((wgid % nig) % gsz); u.pn = (wgid % nig) / gsz;
    }
    __device__ __forceinline__ bool next(int i, Unit& u) const {
        if (i < R1) { pmpn(i * 256 + c, u); u.kb = 0; u.nk = KT; u.kind = 0; u.peer = 0; return true; }
        if (i == R1 && nleft && s < nsl) { pmpn(R1 * 256 + l, u); u.kb = kbnd(s); u.nk = kbnd(s + 1) - u.kb; u.kind = 3; u.peer = l; return true; }
        return false;
    }
    __device__ __forceinline__ void a_ready(const Unit&) const {}
    __device__ __forceinline__ void done(const Unit&) const {}
};

#define GAS __attribute__((address_space(1)))
#define LAS __attribute__((address_space(3)))
typedef GAS unsigned gu32;
#define RLX_AGENT __ATOMIC_RELAXED, __HIP_MEMORY_SCOPE_AGENT
#define LDS_WAIT() asm volatile("s_waitcnt lgkmcnt(0)" ::: "memory")
#define VM_WAIT() asm volatile("s_waitcnt vmcnt(0)" ::: "memory")
#define XB_TMO      128
#define XB_XCNT(j)  (256  + 64 * (j))
#define XB_XSUB(j)  (1280 + 64 * (j))
#define XB_XGEN(j)  (2304 + 64 * (j))
#define XB_TOP      3328
#define XB_TOPGEN   3392
#define XCD_BAR_WORDS 3456
#define XB_SPIN_CAP (1u << 18)

__device__ __forceinline__ unsigned xb_ld(unsigned* p)              { return __hip_atomic_load(p, __ATOMIC_RELAXED, __HIP_MEMORY_SCOPE_AGENT); }
__device__ __forceinline__ unsigned xb_add(unsigned* p, unsigned v) { return __hip_atomic_fetch_add(p, v, __ATOMIC_RELAXED, __HIP_MEMORY_SCOPE_AGENT); }
__device__ __forceinline__ unsigned xb_xcc_id() { return (unsigned)__builtin_amdgcn_s_getreg((3 << 11) | 20) & 0xFu; }
#define XB_SPIN(cond, bar) do { unsigned _sp = 0; while (cond) { __builtin_amdgcn_s_sleep(1); \
    if ((++_sp & 255u) == 0u) { if (xb_ld(&(bar)[XB_TMO])) break; if (_sp > XB_SPIN_CAP) { atomicAdd(&(bar)[XB_TMO], 1u); break; } } } } while (0)

struct XcdBarrier {
    unsigned* bar; unsigned x;
    volatile LAS unsigned* st;
};

__device__ __forceinline__ XcdBarrier xcd_barrier_post(unsigned* bar, volatile LAS unsigned* st) {
    XcdBarrier b; b.bar = bar; b.x = xb_xcc_id(); b.st = st;
    if (threadIdx.x == 0) (void)xb_add(&bar[XB_XCNT(b.x)], 1u);
    return b;
}
__device__ __forceinline__ void xcd_barrier_complete(unsigned* bar, unsigned x, unsigned& nloc, unsigned& nx) {
    const unsigned G = gridDim.x * gridDim.y * gridDim.z;
    unsigned sum, cnt, mine, sp = 0u;
    for (;;) {
        sum = 0u; cnt = 0u; mine = 0u;
#pragma unroll
        for (unsigned j = 0; j < 16; ++j) { const unsigned c = xb_ld(&bar[XB_XCNT(j)]); sum += c; cnt += (c > 0u) ? 1u : 0u; mine = (j == x) ? c : mine; }
        if (sum == G) break;
        __builtin_amdgcn_s_sleep(1);
        if ((++sp & 255u) == 0u) { if (xb_ld(&bar[XB_TMO])) break; if (sp > XB_SPIN_CAP) { atomicAdd(&bar[XB_TMO], 1u); break; } }
    }
    nloc = mine > 0u ? mine : 1u; nx = cnt > 0u ? cnt : 1u;
}

__device__ __forceinline__ void xcd_barrier(const XcdBarrier& b) {
    asm volatile("s_waitcnt vmcnt(0)" ::: "memory");
    __syncthreads();
    if (threadIdx.x == 0) {
        unsigned* bar = b.bar;
        __builtin_amdgcn_s_waitcnt(0);
        unsigned nloc = b.st[0], nx = b.st[1];
        if (nloc == 0u) { xcd_barrier_complete(bar, b.x, nloc, nx); b.st[0] = nloc; b.st[1] = nx; }
        const unsigned old = xb_add(&bar[XB_XSUB(b.x)], 1u);
        const unsigned gen = old / nloc;
        if (old + 1u == (gen + 1u) * nloc) {
            __builtin_amdgcn_fence(__ATOMIC_RELEASE, "agent");
            asm volatile("s_waitcnt vmcnt(0)" ::: "memory");
            const unsigned og = xb_add(&bar[XB_TOP], 1u);
            const unsigned tg = og / nx;
            if (og + 1u == (tg + 1u) * nx) xb_add(&bar[XB_TOPGEN], 1u);
            else XB_SPIN(xb_ld(&bar[XB_TOPGEN]) == tg, bar);
            __builtin_amdgcn_fence(__ATOMIC_ACQUIRE, "agent");
            xb_add(&bar[XB_XGEN(b.x)], 1u);
            asm volatile("s_waitcnt vmcnt(0)" ::: "memory");
        } else {
            XB_SPIN(xb_ld(&bar[XB_XGEN(b.x)]) == gen, bar);
            __builtin_amdgcn_fence(__ATOMIC_ACQUIRE, "agent");
            asm volatile("s_waitcnt vmcnt(0)" ::: "memory");
        }
    }
    __syncthreads();
}

typedef pg8::bf16x8 bf16x8;
#define MFMA16(a, b, c) __builtin_amdgcn_mfma_f32_16x16x32_bf16((a), (b), (c), 0, 0, 0)
constexpr int RB_P1 = 0, RB_RT = 2048, RB_QP = 4096, RB_RAK = 5120, RB_VM = 6144, RB_WL = 8192;

__device__ __forceinline__ f32x4 ld_bf4(const bf16_t* p) { const u32x2v w = *(const u32x2v*)p; return (f32x4){bflo(w.x), bfhi(w.x), bflo(w.y), bfhi(w.y)}; }
__device__ __forceinline__ bf16x8 mk_frag(const f32x4 a, const f32x4 b) { u32x4 w; w.x = pk2(a[0], a[1]); w.y = pk2(a[2], a[3]); w.z = pk2(b[0], b[1]); w.w = pk2(b[2], b[3]); return __builtin_bit_cast(bf16x8, w); }
__device__ __forceinline__ unsigned char* recA_ptr(const P& p, int rec) { return rec < NREC_P ? p.ws + WS_H + (size_t)rec * RECA : p.ws + WS_FRA_S + (size_t)(rec - NREC_P) * RECA; }
__device__ __forceinline__ unsigned char* recB_ptr(const P& p, int rec) { return rec < NREC_P ? (unsigned char*)p.out + (size_t)rec * RECB : p.ws + WS_FRB_S + (size_t)(rec - NREC_P) * RECB; }
__device__ __forceinline__ f32x4 sig4(f32x4 x) { return (f32x4){sigmoidf_(x[0]), sigmoidf_(x[1]), sigmoidf_(x[2]), sigmoidf_(x[3])}; }
__device__ __forceinline__ f32x4 exp4(f32x4 x) { return (f32x4){__expf(x[0]), __expf(x[1]), __expf(x[2]), __expf(x[3])}; }

template <class T> __device__ __forceinline__ T ldu(const void* ubase, unsigned voff) { return *(const T*)((const char*)ubase + voff); }
__device__ __forceinline__ f32x4 bf4(const u32x2v w) { return (f32x4){bflo(w.x), bfhi(w.x), bflo(w.y), bfhi(w.y)}; }
template <int N> __device__ __forceinline__ float row_shr(float x) {
    return __builtin_bit_cast(float, __builtin_amdgcn_update_dpp(0, __builtin_bit_cast(int, x), 0x110 + N, 0xf, 0xf, true));
}
struct ShiftCtx { const bf16_t* zrw; const float* ss; const float* mu; unsigned zoc, zop; float fv, fpz, fps; };
__device__ __forceinline__ f32x4 shift4(const ShiftCtx& k, int cu, unsigned lp) {
    const u32x2v cw = ldu<u32x2v>(k.zrw + cu, k.zoc + lp * 2u), pw = ldu<u32x2v>(k.zrw + cu, k.zop + lp * 2u);
    const f32x4 sv = ldu<f32x4>(k.ss + cu, lp * 4u), m = ldu<f32x4>(k.mu + cu, lp * 4u);
    const f32x4 cur = bf4(cw) * k.fv;
    const f32x4 pv = bf4(pw) * k.fpz + sv * k.fps;
    return cur + (pv - cur) * m;
}

struct ZRaw { u32x2v c, p; };
__device__ __forceinline__ ZRaw shift4_ld(const ShiftCtx& k, int cu, unsigned lp) { return ZRaw{ldu<u32x2v>(k.zrw + cu, k.zoc + lp * 2u), ldu<u32x2v>(k.zrw + cu, k.zop + lp * 2u)}; }
__device__ __forceinline__ f32x4 shift4_fin(const ShiftCtx& k, const ZRaw& z, int cu, unsigned lp) {
    const f32x4 sv = ldu<f32x4>(k.ss + cu, lp * 4u), m = ldu<f32x4>(k.mu + cu, lp * 4u);
    const f32x4 cur = bf4(z.c) * k.fv;
    const f32x4 pv = bf4(z.p) * k.fpz + sv * k.fps;
    return cur + (pv - cur) * m;
}

struct RecCtx { ShiftCtx K; int head, c, row, i, q; bool prompt, valid; };
__device__ __forceinline__ RecCtx rec_ctx(const P& p, int rec, int lane) {
    RecCtx R;
    const int head = rec & 15, chunkid = rec >> 4;
    const bool prompt = chunkid < NPB * 128;
    const int sq = prompt ? (chunkid >> 7) : NPB + (chunkid - NPB * 128);
    const int c = prompt ? (chunkid & 127) : 0;
    const int row0 = prompt ? sq * TP + c * 16 : MP + (sq - NPB) * TS;
    const int nvalid = prompt ? 16 : TS;
    const int i = lane & 15, q = lane >> 4;
    const bool valid = i < nvalid, first = (c == 0);
    const bool pz = valid && (i > 0 || !first), ps = valid && (i == 0) && first && !prompt;
    const int row = row0 + (valid ? i : 0);
    R.K.zrw = (const bf16_t*)(p.ws + WS_ZRW); R.K.ss = p.in[3] + (size_t)(prompt ? 0 : sq - NPB) * CSH; R.K.mu = p.in[10];
    R.K.zoc = (unsigned)row * (unsigned)(CSH * 2); R.K.zop = pz ? R.K.zoc - (unsigned)(CSH * 2) : R.K.zoc; R.K.fv = valid ? 1.f : 0.f; R.K.fpz = pz ? 1.f : 0.f; R.K.fps = ps ? 1.f : 0.f;
    R.head = head; R.c = c; R.row = row; R.i = i; R.q = q; R.prompt = prompt; R.valid = valid;
    return R;
}
__device__ __forceinline__ bf16x8 lora_frag(const P& p, int rec, int f, int lane) {
    const RecCtx R = rec_ctx(p, rec, lane);
    const unsigned q8 = (unsigned)R.q * 8u;
    const int col = f < 2 ? 3072 + 32 * f : (f < 4 ? 3136 + 32 * (f - 2) : 3200 + 32 * (f - 4));
    f32x4 x0 = shift4(R.K, col, q8), x1 = shift4(R.K, col + 4, q8);
    if (f < 2) {
#pragma unroll
        for (int e = 0; e < 4; ++e) { x0[e] = 2.f * sigmoidf_(2.f * x0[e]) - 1.f; x1[e] = 2.f * sigmoidf_(2.f * x1[e]) - 1.f; }
    } else if (f >= 4) { x0 = sig4(x0); x1 = sig4(x1); }
    return mk_frag(x0, x1);
}

__device__ __forceinline__ void prep_record(const P& p, LAS unsigned char* wl, const LAS unsigned char* shf, int rec, int lane_in) {
    int lane = lane_in; asm volatile("" : "+v"(lane));
    const int head = rec & 15, chunkid = rec >> 4;
    const bool prompt = chunkid < NPB * 128;
    const int sq = prompt ? (chunkid >> 7) : NPB + (chunkid - NPB * 128);
    const int c = prompt ? (chunkid & 127) : 0;
    const int row0 = prompt ? sq * TP + c * 16 : MP + (sq - NPB) * TS;
    const int nvalid = prompt ? 16 : TS;
    const int i = lane & 15, q = lane >> 4;
    const bool valid = i < nvalid, first = (c == 0);
    const bool pz = valid && (i > 0 || !first), ps = valid && (i == 0) && first && !prompt;
    const int row = row0 + (valid ? i : 0);
    ShiftCtx K;
    K.zrw = (const bf16_t*)(p.ws + WS_ZRW); K.ss = p.in[3] + (size_t)(prompt ? 0 : sq - NPB) * CSH; K.mu = p.in[10];
    K.zoc = (unsigned)row * (unsigned)(CSH * 2); K.zop = pz ? K.zoc - (unsigned)(CSH * 2) : K.zoc; K.fv = valid ? 1.f : 0.f; K.fpz = pz ? 1.f : 0.f; K.fps = ps ? 1.f : 0.f;
    const unsigned q4 = (unsigned)q * 4u, q8 = (unsigned)q * 8u;
    const unsigned wlo64 = (unsigned)(i * 64 + q * 8) * 2u, wlo128 = (unsigned)(i * 128 + q * 8) * 2u;
    const bf16_t* WDUT = (const bf16_t*)(p.ws + WS_LORA); const bf16_t* WAUT = WDUT + RW * 64; const bf16_t* WGUT = WAUT + RW * 64;
    const f32x4 z4 = (f32x4){0.f, 0.f, 0.f, 0.f};

    ZRaw zk[4], zr[4], zv[4];
#pragma unroll
    for (int ct = 0; ct < 4; ++ct) { const int cbu = head * 64 + 16 * ct; zk[ct] = shift4_ld(K, RW + cbu, q4); zr[ct] = shift4_ld(K, cbu, q4); zv[ct] = shift4_ld(K, 2 * RW + cbu, q4); }
    f32x4 accw[4], acca[4];
#pragma unroll
    for (int ct = 0; ct < 4; ++ct) { accw[ct] = z4; acca[ct] = z4; }
#pragma unroll
    for (int s = 0; s < 2; ++s) {
        const bf16x8 td = *(const LAS bf16x8*)(shf + s * 1024 + lane * 16), ad = *(const LAS bf16x8*)(shf + (2 + s) * 1024 + lane * 16);
#pragma unroll
        for (int ct = 0; ct < 4; ++ct) {
            const int wo = (head * 64 + 16 * ct) * 64 + 32 * s;
            accw[ct] = MFMA16(ldu<bf16x8>(WDUT + wo, wlo64), td, accw[ct]);
            acca[ct] = MFMA16(ldu<bf16x8>(WAUT + wo, wlo64), ad, acca[ct]);
        }
    }
    f32x4 lw[4], av[4], ks[4];
    float ssq = 0.f;
#pragma unroll
    for (int ct = 0; ct < 4; ++ct) {
        const int cbu = head * 64 + 16 * ct;
        lw[ct] = sig4(ldu<f32x4>(p.in[11] + cbu, q4 * 4u) + accw[ct]) * (-0.6065306597126334f);
        lw[ct] = lw[ct] * K.fv;
        av[ct] = sig4(ldu<f32x4>(p.in[13] + cbu, q4 * 4u) + acca[ct]);
        ks[ct] = shift4_fin(K, zk[ct], RW + cbu, q4);
        const f32x4 kk0 = ks[ct] * ldu<f32x4>(p.in[16] + cbu, q4 * 4u);
        ssq += (kk0[0] * kk0[0] + kk0[1] * kk0[1]) + (kk0[2] * kk0[2] + kk0[3] * kk0[3]);
    }
    ssq += __shfl_xor(ssq, 16); ssq += __shfl_xor(ssq, 32);
    const float kinv = __builtin_amdgcn_rcpf(fmaxf(sqrtf(ssq), 1e-12f));
    f32x4 lwc[4];
#pragma unroll
    for (int ct = 0; ct < 4; ++ct) lwc[ct] = lw[ct];
#pragma unroll
    for (int ct = 0; ct < 4; ++ct)
#pragma unroll
        for (int e = 0; e < 4; ++e) { float x = lwc[ct][e]; x += row_shr<1>(x); x += row_shr<2>(x); x += row_shr<4>(x); x += row_shr<8>(x); lwc[ct][e] = x; }
    unsigned char* rb = recB_ptr(p, rec); unsigned char* ra = recA_ptr(p, rec);
    LAS float* MT = (LAS float*)(wl + 8192);
    u32x2v kapP[4], alpP[4], ktP[4], rtP[4];
    f32x4 wl15[4];
    float bsum = 0.f;
#pragma unroll
    for (int ct = 0; ct < 4; ++ct) {
        const int cbu = head * 64 + 16 * ct;
        const f32x4 Wt = exp4(lwc[ct]), Wtm1 = exp4(lwc[ct] - lw[ct]), Winv = exp4(-lwc[ct]);
        const f32x4 kkn = ks[ct] * ldu<f32x4>(p.in[16] + cbu, q4 * 4u) * kinv;
        const f32x4 kmod = ks[ct] * ((av[ct] - 1.f) * ldu<f32x4>(p.in[17] + cbu, q4 * 4u) + 1.f);
        const f32x4 kap = kkn * Wtm1, alp = kkn * av[ct] * Winv, kt = kmod * Winv;
        const f32x4 rs = shift4_fin(K, zr[ct], cbu, q4);
        const f32x4 rt = rs * Wt;
        const f32x4 rk = rs * kmod * ldu<f32x4>(p.in[18] + cbu, q4 * 4u);
        bsum += (rk[0] + rk[1]) + (rk[2] + rk[3]);
#pragma unroll
        for (int e = 0; e < 4; ++e) wl15[ct][e] = __shfl(Wt[e], 15, 16);
        kapP[ct].x = pk2(kap[0], kap[1]); kapP[ct].y = pk2(kap[2], kap[3]); alpP[ct].x = pk2(alp[0], alp[1]); alpP[ct].y = pk2(alp[2], alp[3]);
        ktP[ct].x = pk2(kt[0], kt[1]); ktP[ct].y = pk2(kt[2], kt[3]); rtP[ct].x = pk2(rt[0], rt[1]); rtP[ct].y = pk2(rt[2], rt[3]);
    }
    bsum += __shfl_xor(bsum, 16); bsum += __shfl_xor(bsum, 32);
    u32x2v c1P[4], c2P[4], vP[4];
    {
        f32x4 accg[4];
#pragma unroll
        for (int ct = 0; ct < 4; ++ct) accg[ct] = z4;
#pragma unroll
        for (int s = 0; s < 4; ++s) {
            const bf16x8 gd = *(const LAS bf16x8*)(shf + (4 + s) * 1024 + lane * 16);
#pragma unroll
            for (int ct = 0; ct < 4; ++ct) accg[ct] = MFMA16(ldu<bf16x8>(WGUT + (head * 64 + 16 * ct) * 128 + 32 * s, wlo128), gd, accg[ct]);
        }
#pragma unroll
        for (int ct = 0; ct < 4; ++ct) {
            const int cbu = head * 64 + 16 * ct;
            const f32x4 c1 = ldu<f32x4>(p.in[19] + cbu, q4 * 4u) * accg[ct];
            const f32x4 vsf = shift4_fin(K, zv[ct], 2 * RW + cbu, q4);
            const f32x4 c2 = (ldu<f32x4>(p.in[20] + cbu, q4 * 4u) + vsf * bsum) * accg[ct];
            c1P[ct].x = pk2(c1[0], c1[1]); c1P[ct].y = pk2(c1[2], c1[3]); c2P[ct].x = pk2(c2[0], c2[1]); c2P[ct].y = pk2(c2[2], c2[3]);
            vP[ct].x = pk2(vsf[0], vsf[1]); vP[ct].y = pk2(vsf[2], vsf[3]);
        }
    }
    bf16x8 kapF[2], alpF[2], ktF[2], rtF[2];
#pragma unroll
    for (int s = 0; s < 2; ++s) {
        kapF[s] = __builtin_bit_cast(bf16x8, (u32x4){kapP[2 * s].x, kapP[2 * s].y, kapP[2 * s + 1].x, kapP[2 * s + 1].y});
        alpF[s] = __builtin_bit_cast(bf16x8, (u32x4){alpP[2 * s].x, alpP[2 * s].y, alpP[2 * s + 1].x, alpP[2 * s + 1].y});
        ktF[s] = __builtin_bit_cast(bf16x8, (u32x4){ktP[2 * s].x, ktP[2 * s].y, ktP[2 * s + 1].x, ktP[2 * s + 1].y});
        rtF[s] = __builtin_bit_cast(bf16x8, (u32x4){rtP[2 * s].x, rtP[2 * s].y, rtP[2 * s + 1].x, rtP[2 * s + 1].y});
    }
    u32x2v kapT[4], alpT[4], ktT[4], vT[4];
    {
        unsigned iw0 = 0u, iw1 = 0u;
        if ((i >> 2) == q) { const unsigned one = 0x3F80u << (16 * (i & 1)); if ((i & 3) < 2) iw0 = one; else iw1 = one; }
        const bf16x8 IdA = __builtin_bit_cast(bf16x8, (u32x4){iw0, iw1, 0u, 0u}), IdB = __builtin_bit_cast(bf16x8, (u32x4){0u, 0u, iw0, iw1});
        bf16x8 vF[2];
#pragma unroll
        for (int s = 0; s < 2; ++s) vF[s] = __builtin_bit_cast(bf16x8, (u32x4){vP[2 * s].x, vP[2 * s].y, vP[2 * s + 1].x, vP[2 * s + 1].y});
#pragma unroll
        for (int nt = 0; nt < 4; ++nt) {
            const bf16x8 id = (nt & 1) ? IdB : IdA;
            const f32x4 a = MFMA16(kapF[nt >> 1], id, z4), b = MFMA16(alpF[nt >> 1], id, z4), c3 = MFMA16(ktF[nt >> 1], id, z4), d = MFMA16(vF[nt >> 1], id, z4);
            kapT[nt].x = pk2(a[0], a[1]); kapT[nt].y = pk2(a[2], a[3]); alpT[nt].x = pk2(b[0], b[1]); alpT[nt].y = pk2(b[2], b[3]);
            ktT[nt].x = pk2(c3[0], c3[1]); ktT[nt].y = pk2(c3[2], c3[3]); vT[nt].x = pk2(d[0], d[1]); vT[nt].y = pk2(d[2], d[3]);
        }
    }
    f32x4 Maa = z4, Mak = z4, RAt = z4, RKt = z4;
#pragma unroll
    for (int s = 0; s < 2; ++s) {
        Maa = MFMA16(kapF[s], alpF[s], Maa); Mak = MFMA16(kapF[s], ktF[s], Mak);
        RAt = MFMA16(alpF[s], rtF[s], RAt); RKt = MFMA16(ktF[s], rtF[s], RKt);
    }
#pragma unroll
    for (int r = 0; r < 4; ++r) { const int rw_ = 4 * q + r;
        if (!(rw_ > i)) { Maa[r] = 0.f; Mak[r] = 0.f; }
        if (!(i >= rw_)) { RAt[r] = 0.f; RKt[r] = 0.f; } }
    *(LAS f32x4*)(MT + i * 16 + 4 * q) = Maa;
    u32x4 rakW; rakW.x = pk2(RAt[0], RAt[1]); rakW.y = pk2(RAt[2], RAt[3]); rakW.z = pk2(RKt[0], RKt[1]); rakW.w = pk2(RKt[2], RKt[3]);
    LDS_WAIT(); asm volatile("" ::: "memory");
    float t[16];
#pragma unroll
    for (int cc = 15; cc >= 0; --cc) {
        float acc = (i == cc) ? 1.f : 0.f;
        f32x4 mrow[4];
#pragma unroll
        for (int b = 0; b < 4; ++b) mrow[b] = *(const LAS f32x4*)(MT + cc * 16 + 4 * b);
#pragma unroll
        for (int j = cc + 1; j < 16; ++j) acc -= t[j] * mrow[j >> 2][j & 3];
        t[cc] = acc;
    }
    f32x4 tsel;
#pragma unroll
    for (int e = 0; e < 4; ++e) tsel[e] = -(q == 0 ? t[e] : (q == 1 ? t[4 + e] : (q == 2 ? t[8 + e] : t[12 + e])));
    const bf16x8 Tfrag = mk_frag(tsel, z4);
    f32x4 P1E[4];
#pragma unroll
    for (int ct = 0; ct < 4; ++ct) { u32x4 aw; aw.x = kapT[ct].x; aw.y = kapT[ct].y; aw.z = 0u; aw.w = 0u; P1E[ct] = MFMA16(__builtin_bit_cast(bf16x8, aw), Tfrag, z4); }
    *(u32x4*)(rb + RB_RT + lane * 16) = __builtin_bit_cast(u32x4, rtF[0]); *(u32x4*)(rb + RB_RT + 1024 + lane * 16) = __builtin_bit_cast(u32x4, rtF[1]);
    *(u32x4*)(rb + RB_RAK + lane * 16) = rakW;
#pragma unroll
    for (int ct = 0; ct < 4; ++ct) {
        if (i == 0) *(f32x4*)(rb + RB_WL + (16 * ct + 4 * q) * 4) = wl15[ct];
        if (valid) { const int cbu = head * 64 + 16 * ct;
            *(u32x2v*)((char*)((bf16_t*)(p.ws + WS_OA) + cbu) + ((unsigned)row * (2 * RW) + q4) * 2u) = c1P[ct];
            *(u32x2v*)((char*)((bf16_t*)(p.ws + WS_C2) + cbu) + ((unsigned)row * RW + q4) * 2u) = c2P[ct]; }
    }
    *(u32x4*)(rb + RB_P1 + lane * 16) = __builtin_bit_cast(u32x4, mk_frag(P1E[0], P1E[1]));
    *(u32x4*)(rb + RB_P1 + 1024 + lane * 16) = __builtin_bit_cast(u32x4, mk_frag(P1E[2], P1E[3]));
    { const f32x4 Qt = MFMA16(mk_frag(Mak, z4), Tfrag, z4);
      u32x4 w; w.x = 0u; w.y = 0u; w.z = pk2(Qt[0], Qt[1]); w.w = pk2(Qt[2], Qt[3]); *(u32x4*)(rb + RB_QP + lane * 16) = w; }
#pragma unroll
    for (int tt = 0; tt < 4; ++tt) {
        u32x4 w; w.x = alpT[tt].x; w.y = alpT[tt].y; w.z = ktT[tt].x; w.w = ktT[tt].y; *(u32x4*)(ra + tt * 1024 + lane * 16) = w;
        *(u32x2v*)(rb + RB_VM + tt * 512 + lane * 8) = vT[tt];
    }
    LDS_WAIT(); asm volatile("" ::: "memory");
}

struct ScanFr { bf16x8 P10, P11, RT0, RT1, QP, RAK, AK0, AK1, AK2, AK3; u32x2v vm; f32x4 WL0, WL1, WL2, WL3; };
__device__ __forceinline__ void scan_load(ScanFr& f, const P& p, int rec, int vs, int lane) {
    const unsigned char* ra = recA_ptr(p, rec); const unsigned char* rb = recB_ptr(p, rec);
    const unsigned l16 = (unsigned)lane * 16u, q16 = (unsigned)(lane >> 4) * 16u;
    f.P10 = ldu<bf16x8>(rb + RB_P1, l16); f.P11 = ldu<bf16x8>(rb + RB_P1 + 1024, l16);
    f.RT0 = ldu<bf16x8>(rb + RB_RT, l16); f.RT1 = ldu<bf16x8>(rb + RB_RT + 1024, l16);
    f.QP = ldu<bf16x8>(rb + RB_QP, l16); f.RAK = ldu<bf16x8>(rb + RB_RAK, l16);
    f.vm = ldu<u32x2v>(rb + RB_VM + vs * 512, (unsigned)lane * 8u);
    f.AK0 = ldu<bf16x8>(ra, l16); f.AK1 = ldu<bf16x8>(ra + 1024, l16); f.AK2 = ldu<bf16x8>(ra + 2048, l16); f.AK3 = ldu<bf16x8>(ra + 3072, l16);
    f.WL0 = ldu<f32x4>(rb + RB_WL, q16); f.WL1 = ldu<f32x4>(rb + RB_WL + 64, q16); f.WL2 = ldu<f32x4>(rb + RB_WL + 128, q16); f.WL3 = ldu<f32x4>(rb + RB_WL + 192, q16);
}
template <int NS>
__device__ __forceinline__ void scan_step(const ScanFr& f, const u32x2v (&vm)[NS], f32x4 (&St)[NS][4], bf16_t* oraw, int c, int q, bool prompt) {
    const f32x4 z4 = (f32x4){0.f, 0.f, 0.f, 0.f};
#pragma unroll
    for (int i = 0; i < NS; ++i) {
        const bf16x8 SB0 = mk_frag(St[i][0], St[i][1]), SB1 = mk_frag(St[i][2], St[i][3]);
        u32x4 vw; vw.x = 0u; vw.y = 0u; vw.z = vm[i].x; vw.w = vm[i].y;
        f32x4 U = MFMA16(f.QP, __builtin_bit_cast(bf16x8, vw), z4);
        U = MFMA16(f.P10, SB0, U); U = MFMA16(f.P11, SB1, U);
        u32x4 uw; uw.x = pk2(U[0], U[1]); uw.y = pk2(U[2], U[3]); uw.z = vm[i].x; uw.w = vm[i].y;
        const bf16x8 UB = __builtin_bit_cast(bf16x8, uw);
        f32x4 O = MFMA16(f.RT0, SB0, z4); O = MFMA16(f.RT1, SB1, O); O = MFMA16(f.RAK, UB, O);
        St[i][0] = MFMA16(f.AK0, UB, St[i][0]) * f.WL0; St[i][1] = MFMA16(f.AK1, UB, St[i][1]) * f.WL1;
        St[i][2] = MFMA16(f.AK2, UB, St[i][2]) * f.WL2; St[i][3] = MFMA16(f.AK3, UB, St[i][3]) * f.WL3;
#pragma unroll
        for (int r = 0; r < 4; ++r) { const int tk = 4 * q + r; if (prompt || tk < TS) oraw[(size_t)(16 * c + tk) * RW + 16 * i] = f2bf(O[r]); }
    }
}
__device__ __forceinline__ void scan_chain_prompt(const P& p, int sq, int head, int vp, int lane, volatile LAS unsigned* prog) {
    constexpr int nch = TP / 16;
    const int rec0 = sq * nch * NH + head, vl = lane & 15, q = lane >> 4;
    f32x4 St[2][4];
    float* sout = p.out + O_WKVP + ((size_t)sq * NH + head) * HS * HS + (size_t)(32 * vp + vl) * HS + 4 * q;
    bf16_t* oraw = (bf16_t*)(p.ws + WS_ZRW) + (size_t)(sq * TP) * RW + head * HS + 32 * vp + vl;
    ScanFr f0, f1, f2; u32x2v v0[2], v1[2], v2[2];
#define SCAN_LD(f, v, cc) do { const int rec_ = rec0 + (cc) * NH; scan_load(f, p, rec_, 2 * vp, lane); v[0] = f.vm; v[1] = ldu<u32x2v>(recB_ptr(p, rec_) + RB_VM + (2 * vp + 1) * 512, (unsigned)lane * 8u); } while (0)
    SCAN_LD(f0, v0, 0); SCAN_LD(f1, v1, 1); SCAN_LD(f2, v2, 2);
#pragma unroll
    for (int i = 0; i < 2; ++i)
#pragma unroll
        for (int t = 0; t < 4; ++t) St[i][t] = (f32x4){0.f, 0.f, 0.f, 0.f};
    const bool pw = vp == 0 && lane == 0;
    int c = 0;
    for (; c + 3 <= nch; c += 3) {
        if (pw) *prog = (unsigned)c;
        scan_step<2>(f0, v0, St, oraw, c, q, true);     SCAN_LD(f0, v0, c + 3 < nch ? c + 3 : nch - 1);
        scan_step<2>(f1, v1, St, oraw, c + 1, q, true); SCAN_LD(f1, v1, c + 4 < nch ? c + 4 : nch - 1);
        scan_step<2>(f2, v2, St, oraw, c + 2, q, true); SCAN_LD(f2, v2, c + 5 < nch ? c + 5 : nch - 1);
    }
    if (c < nch) { scan_step<2>(f0, v0, St, oraw, c, q, true); ++c; }
    if (c < nch) { scan_step<2>(f1, v1, St, oraw, c, q, true); }
#undef SCAN_LD
#pragma unroll
    for (int i = 0; i < 2; ++i)
#pragma unroll
        for (int t = 0; t < 4; ++t) *(f32x4*)(sout + (size_t)(16 * i) * HS + 16 * t) = St[i][t];
}
struct SampleTask { ScanFr f; f32x4 St[4]; };
__device__ __forceinline__ void sample_load(SampleTask& t, const P& p, int j, int lane) {
    const int s = j >> 6, head = (j >> 2) & 15, vs = j & 3, vl = lane & 15, q = lane >> 4;
    scan_load(t.f, p, NREC_P + s * NH + head, vs, lane);
    const float* sin = p.in[2] + ((size_t)s * NH + head) * HS * HS + (size_t)(16 * vs + vl) * HS + 4 * q;
#pragma unroll
    for (int tt = 0; tt < 4; ++tt) t.St[tt] = *(const f32x4*)(sin + 16 * tt);
}
__device__ __forceinline__ void sample_run(SampleTask& t, const P& p, int j, int lane) {
    const int s = j >> 6, head = (j >> 2) & 15, vs = j & 3, vl = lane & 15, q = lane >> 4;
    f32x4 St[1][4]; u32x2v vm[1]; vm[0] = t.f.vm;
#pragma unroll
    for (int tt = 0; tt < 4; ++tt) St[0][tt] = t.St[tt];
    scan_step<1>(t.f, vm, St, (bf16_t*)(p.ws + WS_ZRW) + (size_t)(MP + s * TS) * RW + head * HS + 16 * vs + vl, 0, q, false);
    float* sout = p.out + O_WKVS + ((size_t)s * NH + head) * HS * HS + (size_t)(16 * vs + vl) * HS + 4 * q;
#pragma unroll
    for (int tt = 0; tt < 4; ++tt) *(f32x4*)(sout + 16 * tt) = St[0][tt];
}
__device__ __forceinline__ void scan_samples(const P& p, int j0, int stride, int lane) {
    constexpr int NT = NSB * NH * 4;
    if (j0 >= NT) return;
    SampleTask a, b;
    sample_load(a, p, j0, lane);
    for (int j = j0;;) {
        const int jb = j + stride; const bool hb = jb < NT;
        if (hb) sample_load(b, p, jb, lane);
        sample_run(a, p, j, lane);
        if (!hb) break;
        const int ja = jb + stride; const bool ha = ja < NT;
        if (ha) sample_load(a, p, ja, lane);
        sample_run(b, p, jb, lane);
        if (!ha) break;
        j = ja;
    }
}

constexpr int SCAN_AHEAD = 10;
__device__ __forceinline__ void scan_prefetch(const P& p, volatile LAS unsigned* prog, int sq, int head, int k, int lane) {
    const int rec0 = sq * (TP / 16) * NH + head;
    const unsigned l16 = (unsigned)lane * 16u;
    for (int c = k; c < TP / 16; c += 2) {
        while ((int)*prog < c - SCAN_AHEAD) __builtin_amdgcn_s_sleep(8);
        const unsigned char* ra = recA_ptr(p, rec0 + c * NH); const unsigned char* rb = recB_ptr(p, rec0 + c * NH);
        u32x4 x[12];
#pragma unroll
        for (int j = 0; j < 4; ++j) x[j] = ldu<u32x4>(ra + j * 1024, l16);
#pragma unroll
        for (int j = 0; j < 8; ++j) x[4 + j] = ldu<u32x4>(rb + j * 1024, l16);
        const u32x4 y = ldu<u32x4>(rb + 8192, (unsigned)(lane & 15) * 16u);
#pragma unroll
        for (int j = 0; j < 12; ++j) asm volatile("" :: "v"(x[j].x));
        asm volatile("" :: "v"(y.x));
    }
}

__device__ __forceinline__ void mix_item(const P& p, int item, int wave, int lane) {
    const int g = item & 7, row0 = (item >> 3) * 128;
    const int dl = lane & 15, q = lane >> 4, col = g * 128 + wave * 16;
    const bf16_t* vn = (const bf16_t*)(p.ws + WS_VN) + (size_t)row0 * MLPW + col + dl;
    bf16x8 A[4];
#pragma unroll
    for (int sb = 0; sb < 4; ++sb)
#pragma unroll
        for (int j = 0; j < 8; ++j) A[sb][j] = (short)vn[(size_t)(32 * sb + 8 * q + j) * MLPW];
    const float* wsg = p.in[23] + ((size_t)g * 128 + dl) * 128 + 8 * q;
    const bf16_t* zu = (const bf16_t*)(p.ws + WS_ZUG) + (size_t)(row0 + dl) * ZUGW + ZU_U + col + 4 * q;
    bf16_t* ub = (bf16_t*)(p.ws + WS_OA) + (size_t)(row0 + dl) * (2 * RW) + RW + col + 4 * q;
    u32x2v res[8];
#pragma unroll
    for (int tt = 0; tt < 8; ++tt) {
        const int t = 16 * tt + dl;
        f32x4 acc = (f32x4){0.f, 0.f, 0.f, 0.f};
#pragma unroll
        for (int sb = 0; sb <= tt / 2; ++sb) {
            const float* wr = wsg + (size_t)(16 * tt) * 128 + 32 * sb;
            f32x4 w0 = *(const f32x4*)wr, w1 = *(const f32x4*)(wr + 4);
            if (sb == tt / 2) {
#pragma unroll
                for (int e = 0; e < 4; ++e) { if (32 * sb + 8 * q + e > t) w0[e] = 0.f; if (32 * sb + 8 * q + 4 + e > t) w1[e] = 0.f; }
            }
            acc = MFMA16(A[sb], mk_frag(w0, w1), acc);
        }
        const float bias = p.in[24][g * 128 + t];
        const f32x4 u = ld_bf4(zu + (size_t)(16 * tt) * ZUGW);
        const f32x4 o = (acc + bias) * u;
        res[tt].x = pk2(o[0], o[1]); res[tt].y = pk2(o[2], o[3]);
    }
#pragma unroll
    for (int tt = 0; tt < 8; ++tt) *(u32x2v*)(ub + (size_t)(16 * tt) * (2 * RW)) = res[tt];
}

__device__ __forceinline__ void post_rows(const P& p, int gw, int NGW, int lane) {
    const bf16_t* oraw = (const bf16_t*)(p.ws + WS_ZRW);
    const int r0 = (int)(((long long)gw * M) / NGW), r1 = (int)(((long long)(gw + 1) * M) / NGW);
    for (int rowa = r0; rowa < r1; rowa += 2) {
        u32x4 ow[2][2], c1[2][2], c2[2][2];
#pragma unroll
        for (int k = 0; k < 2; ++k) {
            const int row = rowa + k < r1 ? rowa + k : rowa;
            const size_t off = (size_t)row * RW + lane * 16;
            const bf16_t* oa = (const bf16_t*)(p.ws + WS_OA) + (size_t)row * (2 * RW) + lane * 16; const bf16_t* c2p = (const bf16_t*)(p.ws + WS_C2) + off;
#pragma unroll
            for (int h = 0; h < 2; ++h) { ow[k][h] = *(const u32x4*)(oraw + off + 8 * h); c1[k][h] = *(const u32x4*)(oa + 8 * h); c2[k][h] = *(const u32x4*)(c2p + 8 * h); }
        }
#pragma unroll
        for (int k = 0; k < 2; ++k) {
            if (rowa + k >= r1) break;
            const int row = rowa + k;
            f32x4 o[4]; float s = 0.f;
#pragma unroll
            for (int h = 0; h < 2; ++h) { const u32x4 x = ow[k][h]; o[2 * h] = (f32x4){bflo(x.x), bfhi(x.x), bflo(x.y), bfhi(x.y)}; o[2 * h + 1] = (f32x4){bflo(x.z), bfhi(x.z), bflo(x.w), bfhi(x.w)}; }
#pragma unroll
            for (int j = 0; j < 4; ++j) s += (o[j][0] + o[j][1]) + (o[j][2] + o[j][3]);
            s += __shfl_xor(s, 1); s += __shfl_xor(s, 2);
            const float mean = s * (1.f / HS); float qv = 0.f;
#pragma unroll
            for (int j = 0; j < 4; ++j) { o[j] = o[j] - mean; qv += (o[j][0] * o[j][0] + o[j][1] * o[j][1]) + (o[j][2] * o[j][2] + o[j][3] * o[j][3]); }
            qv += __shfl_xor(qv, 1); qv += __shfl_xor(qv, 2);
            const float rstd = rsqrtf(qv * (1.f / HS) + 64e-5f);
            bf16_t* oa = (bf16_t*)(p.ws + WS_OA) + (size_t)row * (2 * RW) + lane * 16;
#pragma unroll
            for (int h = 0; h < 2; ++h) {
                const u32x4 a1 = c1[k][h], a2 = c2[k][h];
                const f32x4 a = o[2 * h] * rstd, b = o[2 * h + 1] * rstd;
                u32x4 w;
                w.x = pk2(a[0] * bflo(a1.x) + bflo(a2.x), a[1] * bfhi(a1.x) + bfhi(a2.x)); w.y = pk2(a[2] * bflo(a1.y) + bflo(a2.y), a[3] * bfhi(a1.y) + bfhi(a2.y));
                w.z = pk2(b[0] * bflo(a1.z) + bflo(a2.z), b[1] * bfhi(a1.z) + bfhi(a2.z)); w.w = pk2(b[2] * bflo(a1.w) + bflo(a2.w), b[3] * bfhi(a1.w) + bfhi(a2.w));
                *(u32x4*)(oa + 8 * h) = w;
            }
        }
    }
}

constexpr int NWAVES = 8, NTHR = NWAVES * 64;
constexpr int RING_BYTES = 131072, LDSCTL_OFF = RING_BYTES, MISC_OFF = LDSCTL_OFF + 320, LDS_BYTES = 147456;

__device__ __forceinline__ void p0_mod_slab(const P& p, LAS unsigned char* lds, int slab, int tid, int lane, int wave) {
    LAS float* red = (LAS float*)(lds + 3 * 27648);
    LAS float* Bl = (LAS float*)(lds + wave * 12288);
    const int n0 = slab * 48, fr = lane & 15, fq = lane >> 4;
    const float* W = p.in[6] + n0;
    f32x4 acc[9][3];
#pragma unroll
    for (int a = 0; a < 9; ++a)
#pragma unroll
        for (int b = 0; b < 3; ++b) acc[a][b] = (f32x4){0.f, 0.f, 0.f, 0.f};
    for (int sc = 0; sc < 4; ++sc) {
        const int kb0 = ((wave + (slab >> 1)) & 7) * 256 + ((sc + (slab >> 4)) & 3) * 64;
        f32x4 v[12];
        int ln = lane; asm volatile("" : "+v"(ln));
        const float* Wk = W + (size_t)kb0 * (6 * D);
        { int r = ln / 12, c4 = ln - r * 12;
#pragma unroll
          for (int t = 0; t < 12; ++t) { v[t] = ldu<f32x4>(Wk, (unsigned)(r * (6 * D) + 4 * c4) * 4u); c4 += 4; r += 5; if (c4 >= 12) { c4 -= 12; r += 1; } } }
        { int r = ln / 12, c4 = ln - r * 12;
#pragma unroll
          for (int t = 0; t < 12; ++t) { *(LAS f32x4*)(Bl + r * 48 + 4 * c4) = v[t]; c4 += 4; r += 5; if (c4 >= 12) { c4 -= 12; r += 1; } } }
        LDS_WAIT(); asm volatile("" ::: "memory");
#pragma unroll
        for (int kb2 = 0; kb2 < 2; ++kb2) {
            const int k0 = kb0 + kb2 * 32 + fq * 8;
            bf16x8 bfr[3];
#pragma unroll
            for (int nt = 0; nt < 3; ++nt) { const LAS float* bp = Bl + (kb2 * 32 + fq * 8) * 48 + nt * 16 + fr;
                u32x4 w; w.x = pk2(bp[0], bp[48]); w.y = pk2(bp[96], bp[144]); w.z = pk2(bp[192], bp[240]); w.w = pk2(bp[288], bp[336]);
                bfr[nt] = __builtin_bit_cast(bf16x8, w); }
            const bf16_t* sil = (const bf16_t*)(p.ws + WS_SILU) + (size_t)fr * D + k0;
            bf16x8 afr[9];
#pragma unroll
            for (int mt = 0; mt < 9; ++mt) afr[mt] = *(const bf16x8*)(sil + (size_t)(mt * 16) * D);
#pragma unroll
            for (int mt = 0; mt < 9; ++mt)
#pragma unroll
                for (int nt = 0; nt < 3; ++nt) acc[mt][nt] = __builtin_amdgcn_mfma_f32_16x16x32_bf16(afr[mt], bfr[nt], acc[mt][nt], 0, 0, 0);
        }
        LDS_WAIT(); asm volatile("" ::: "memory");
    }
    __syncthreads();
#pragma unroll
    for (int half = 4; half >= 1; half >>= 1) {
        LAS float* buf = (LAS float*)(lds + (wave & (half - 1)) * 27648);
        if (wave >= half && wave < 2 * half) {
#pragma unroll
            for (int mt = 0; mt < 9; ++mt)
#pragma unroll
                for (int nt = 0; nt < 3; ++nt) *(LAS f32x4*)(buf + ((mt * 3 + nt) * 64 + lane) * 4) = acc[mt][nt];
        }
        __syncthreads();
        if (wave < half) {
#pragma unroll
            for (int mt = 0; mt < 9; ++mt)
#pragma unroll
                for (int nt = 0; nt < 3; ++nt) acc[mt][nt] += *(const LAS f32x4*)(buf + ((mt * 3 + nt) * 64 + lane) * 4);
        }
        __syncthreads();
    }
    if (wave == 0) {
#pragma unroll
        for (int mt = 0; mt < 9; ++mt)
#pragma unroll
            for (int nt = 0; nt < 3; ++nt)
#pragma unroll
                for (int r = 0; r < 4; ++r) red[(mt * 16 + 4 * fq + r) * 48 + nt * 16 + fr] = acc[mt][nt][r];
    }
    __syncthreads();
    float* mod = (float*)(p.ws + WS_MOD);
    for (int i = tid; i < NSEQ * 48; i += NTHR) { const int row = i / 48, c = i % 48; mod[(size_t)row * (6 * D) + n0 + c] = red[row * 48 + c] + p.in[7][n0 + c]; }
    __syncthreads();
}
__device__ __forceinline__ void p0_silu(const P& p, int gt, int NT) {
    const __amdgpu_buffer_rsrc_t rs = __builtin_amdgcn_make_buffer_rsrc(p.ws + WS_SILU, 0, 144 * D * 2, 0x00020000);
    for (int i = gt; i < 144 * D / 4; i += NT) {
        const int row = i / (D / 4), k = (i - row * (D / 4)) * 4;
        f32x4 v = (f32x4){0.f, 0.f, 0.f, 0.f};
        if (row < NSEQ) { v = *(const f32x4*)((row < NPB ? p.in[4] + (size_t)row * D : p.in[5] + (size_t)(row - NPB) * D) + k);
#pragma unroll
            for (int e = 0; e < 4; ++e) v[e] = v[e] * sigmoidf_(v[e]); }
        u32x2v w; w.x = pk2(v[0], v[1]); w.y = pk2(v[2], v[3]);
        __builtin_amdgcn_raw_buffer_store_b64(w, rs, (unsigned)(row * D + k) * 2u, 0, 16);
    }
}
struct TJob { const float* W; bf16_t* WT; int K, N, ldw, kofs, item; bool swz; };
__device__ __forceinline__ void tr_load(const TJob& j, float (&tv)[32], int lane) {
    const int nblk = j.N / 32, kb = j.item / nblk, nb = j.item - kb * nblk;
    const float* w = j.W + (size_t)(64 * kb) * j.N + 32 * nb;
    const unsigned lo = (unsigned)((lane >> 5) * j.N + (lane & 31)) * 4u, rs2 = (unsigned)j.N * 8u;
#pragma unroll
    for (int i = 0; i < 32; ++i) tv[i] = ldu<float>(w, lo + (unsigned)i * rs2);
}
__device__ __forceinline__ void tr_store(const TJob& j, const float (&tv)[32], LAS float* scr, int lane) {
    const int nblk = j.N / 32, kb = j.item / nblk, nb = j.item - kb * nblk, k0 = 64 * kb, n0 = 32 * nb;
    int r0 = n0;
    if (j.swz) { r0 = n0 < DFF ? 256 * (n0 >> 7) + (n0 & 127) : 256 * ((n0 - DFF) >> 7) + 128 + ((n0 - DFF) & 127); }
#pragma unroll
    for (int i = 0; i < 32; ++i) scr[(2 * i + (lane >> 5)) * 33 + (lane & 31)] = tv[i];
    LDS_WAIT(); asm volatile("" ::: "memory");
    const int c = lane & 7;
#pragma unroll
    for (int jj = 0; jj < 4; ++jj) { const int n = (lane >> 3) + 8 * jj; const LAS float* s = scr + (8 * c) * 33 + n;
        u32x4 o; o.x = pk2(s[0 * 33], s[1 * 33]); o.y = pk2(s[2 * 33], s[3 * 33]); o.z = pk2(s[4 * 33], s[5 * 33]); o.w = pk2(s[6 * 33], s[7 * 33]);
        *(u32x4*)(j.WT + (size_t)(r0 + n) * j.ldw + j.kofs + k0 + 8 * c) = o; }
    LDS_WAIT(); asm volatile("" ::: "memory");
}
__device__ __forceinline__ bool tr_job(const P& p, int part, int it, TJob& j) {
    constexpr int I_IN = (D / 64) * (CIN / 32), I_BA = (RW / 64) * (D / 32), I_OUT = (D / 64) * (D / 32), I_FI = (D / 64) * (2 * DFF / 32), I_FO = (DFF / 64) * (D / 32);
    constexpr int I_L64 = (RW / 32), I_L128 = 2 * (RW / 32);
    unsigned char* ws = p.ws; int r = it;
    j.swz = false; j.kofs = 0;
    if (part == 0) {
        if (r < I_IN) { j.W = p.in[9]; j.WT = (bf16_t*)(ws + WS_WIN); j.K = D; j.N = CIN; j.ldw = D; j.item = r; return true; } r -= I_IN;
        if (r < I_L64) { j.W = p.in[12]; j.WT = (bf16_t*)(ws + WS_LORA); j.K = 64; j.N = RW; j.ldw = 64; j.item = r; return true; } r -= I_L64;
        if (r < I_L64) { j.W = p.in[14]; j.WT = (bf16_t*)(ws + WS_LORA) + RW * 64; j.K = 64; j.N = RW; j.ldw = 64; j.item = r; return true; } r -= I_L64;
        if (r < I_L128) { j.W = p.in[15]; j.WT = (bf16_t*)(ws + WS_LORA) + 2 * RW * 64; j.K = 128; j.N = RW; j.ldw = 128; j.item = r; return true; } r -= I_L128;
        if (r < I_BA) { j.W = p.in[25]; j.WT = (bf16_t*)(ws + WS_WBA); j.K = RW; j.N = D; j.ldw = 2 * RW; j.item = r; return true; } r -= I_BA;
        if (r < I_BA) { j.W = p.in[26]; j.WT = (bf16_t*)(ws + WS_WBA); j.K = RW; j.N = D; j.ldw = 2 * RW; j.kofs = RW; j.item = r; return true; } r -= I_BA;
        if (r < I_OUT) { j.W = p.in[27]; j.WT = (bf16_t*)(ws + WS_WOUT); j.K = D; j.N = D; j.ldw = D; j.item = r; return true; } r -= I_OUT;
        return false;
    } else if (part == 1) {
        if (r < I_FI) { j.W = p.in[29]; j.WT = (bf16_t*)(ws + WS_WFI); j.K = D; j.N = 2 * DFF; j.ldw = D; j.swz = true; j.item = r; return true; } r -= I_FI;
        if (r < I_FO) { j.W = p.in[30]; j.WT = (bf16_t*)(ws + WS_WFO); j.K = DFF; j.N = D; j.ldw = DFF; j.item = r; return true; }
        return false;
    } else {
        if (r < I_FO) { j.W = p.in[30]; j.WT = (bf16_t*)(ws + WS_WFO); j.K = DFF; j.N = D; j.ldw = DFF; j.item = r; return true; }
        return false;
    }
}
__device__ __forceinline__ void p0_transposes(const P& p, LAS float* scr, int part, int gw, int NGW, int lane) {
    TJob ja, jb; float ta[32], tb[32];
    int it = gw;
    if (!tr_job(p, part, it, ja)) return;
    tr_load(ja, ta, lane);
    for (;;) {
        const bool hb = tr_job(p, part, it + NGW, jb);
        if (hb) tr_load(jb, tb, lane);
        tr_store(ja, ta, scr, lane);
        if (!hb) break;
        const bool ha = tr_job(p, part, it + 2 * NGW, ja);
        if (ha) tr_load(ja, ta, lane);
        tr_store(jb, tb, scr, lane);
        if (!ha) break;
        it += 2 * NGW;
    }
}
__device__ __forceinline__ void tr64_load(const TJob& j, f32x4 (&tv)[16], int lane) {
    const int nblk = j.N / 64, kb = j.item / nblk, nb = j.item - kb * nblk;
    const float* w = j.W + (size_t)(64 * kb) * j.N + 64 * nb;
    const unsigned lo = (unsigned)((lane >> 4) * j.N + 4 * (lane & 15)) * 4u, rs4 = (unsigned)j.N * 16u;
#pragma unroll
    for (int t = 0; t < 16; ++t) tv[t] = ldu<f32x4>(w, lo + (unsigned)t * rs4);
}
__device__ __forceinline__ void tr64_store(const TJob& j, const f32x4 (&tv)[16], LAS float* scr, int lane) {
    const int nblk = j.N / 64, kb = j.item / nblk, nb = j.item - kb * nblk, k0 = 64 * kb, n0 = 64 * nb;
    int r0 = n0;
    if (j.swz) { r0 = n0 < DFF ? 256 * (n0 >> 7) + (n0 & 127) : 256 * ((n0 - DFF) >> 7) + 128 + ((n0 - DFF) & 127); }
#pragma unroll
    for (int t = 0; t < 16; ++t) { const int k = 4 * t + (lane >> 4); *(LAS f32x4*)(scr + k * 64 + (((lane & 15) ^ ((k >> 3) & 7)) << 2)) = tv[t]; }
    LDS_WAIT(); asm volatile("" ::: "memory");
    const int c = lane & 7;
#pragma unroll
    for (int jj = 0; jj < 8; ++jj) { const int n = (lane >> 3) + 8 * jj; const LAS float* s = scr + (8 * c) * 64 + ((((n >> 2) ^ c) << 2) | (n & 3));
        u32x4 o; o.x = pk2(s[0 * 64], s[1 * 64]); o.y = pk2(s[2 * 64], s[3 * 64]); o.z = pk2(s[4 * 64], s[5 * 64]); o.w = pk2(s[6 * 64], s[7 * 64]);
        *(u32x4*)(j.WT + (size_t)(r0 + n) * j.ldw + j.kofs + k0 + 8 * c) = o; }
    LDS_WAIT(); asm volatile("" ::: "memory");
}
__device__ __forceinline__ bool tr64_job(const P& p, int part, int it, TJob& j) {
    constexpr int I_IN = (D / 64) * (CIN / 64), I_BA = (RW / 64) * (D / 64), I_OUT = (D / 64) * (D / 64), I_FI = (D / 64) * (2 * DFF / 64), I_FO = (DFF / 64) * (D / 64);
    constexpr int I_L64 = (RW / 64), I_L128 = 2 * (RW / 64);
    unsigned char* ws = p.ws; int r = it; j.kofs = 0; j.swz = false;
    if (part == 0) {
        if (r < I_IN) { j.W = p.in[9]; j.WT = (bf16_t*)(ws + WS_WIN); j.K = D; j.N = CIN; j.ldw = D; j.item = r; return true; } r -= I_IN;
        if (r < I_L64) { j.W = p.in[12]; j.WT = (bf16_t*)(ws + WS_LORA); j.K = 64; j.N = RW; j.ldw = 64; j.item = r; return true; } r -= I_L64;
        if (r < I_L64) { j.W = p.in[14]; j.WT = (bf16_t*)(ws + WS_LORA) + RW * 64; j.K = 64; j.N = RW; j.ldw = 64; j.item = r; return true; } r -= I_L64;
        if (r < I_L128) { j.W = p.in[15]; j.WT = (bf16_t*)(ws + WS_LORA) + 2 * RW * 64; j.K = 128; j.N = RW; j.ldw = 128; j.item = r; return true; } r -= I_L128;
        if (r < I_BA) { j.W = p.in[25]; j.WT = (bf16_t*)(ws + WS_WBA); j.K = RW; j.N = D; j.ldw = 2 * RW; j.item = r; return true; } r -= I_BA;
        if (r < I_BA) { j.W = p.in[26]; j.WT = (bf16_t*)(ws + WS_WBA); j.K = RW; j.N = D; j.ldw = 2 * RW; j.kofs = RW; j.item = r; return true; } r -= I_BA;
        if (r < I_OUT) { j.W = p.in[27]; j.WT = (bf16_t*)(ws + WS_WOUT); j.K = D; j.N = D; j.ldw = D; j.item = r; return true; }
        return false;
    }
    if (r < I_FI) { j.W = p.in[29]; j.WT = (bf16_t*)(ws + WS_WFI); j.K = D; j.N = 2 * DFF; j.ldw = D; j.swz = true; j.item = r; return true; } r -= I_FI;
    if (r < I_FO) { j.W = p.in[30]; j.WT = (bf16_t*)(ws + WS_WFO); j.K = DFF; j.N = D; j.ldw = DFF; j.item = r; return true; }
    return false;
}
__device__ __forceinline__ void p0_transposes64(const P& p, LAS float* scr, int part, int gw, int NGW, int lane, int lim = 1 << 30) {
    TJob ja, jb; f32x4 ta[16], tb[16];
    int it = gw;
    if (it >= lim || !tr64_job(p, part, it, ja)) return;
    tr64_load(ja, ta, lane);
    for (;;) {
        const bool hb = it + NGW < lim && tr64_job(p, part, it + NGW, jb);
        if (hb) tr64_load(jb, tb, lane);
        tr64_store(ja, ta, scr, lane);
        if (!hb) break;
        const bool ha = it + 2 * NGW < lim && tr64_job(p, part, it + 2 * NGW, ja);
        if (ha) tr64_load(ja, ta, lane);
        tr64_store(jb, tb, scr, lane);
        if (!ha) break;
        it += 2 * NGW;
    }
}
template <int WHICH>
__device__ __forceinline__ void phase_norm(const P& p, int gw, int NGW, int lane) {
    const float* g = WHICH == 0 ? p.in[8] : p.in[28];
    const int r0 = (int)(((long long)gw * M) / NGW), r1 = (int)(((long long)(gw + 1) * M) / NGW);
    f32x4 gs[8], sh[8]; int cs = -1;
    const bf16_t* x1 = (const bf16_t*)(p.ws + WS_ZRW);
    for (int row = r0; row < r1; ++row) {
        f32x4 v[8];
        if constexpr (WHICH == 0) {
            const float* x = row < MP ? p.in[0] + (size_t)row * D : p.in[1] + (size_t)(row - MP) * D;
#pragma unroll
            for (int j = 0; j < 8; ++j) v[j] = *(const f32x4*)(x + 8 * lane + 512 * (j >> 1) + 4 * (j & 1));
        } else {
#pragma unroll
            for (int j = 0; j < 4; ++j) { const u32x4 w = *(const u32x4*)(x1 + (size_t)row * D + 8 * lane + 512 * j);
                v[2 * j] = (f32x4){bflo(w.x), bfhi(w.x), bflo(w.y), bfhi(w.y)}; v[2 * j + 1] = (f32x4){bflo(w.z), bfhi(w.z), bflo(w.w), bfhi(w.w)}; }
        }
        const int seq = seq_of_row(row);
        if (seq != cs) {
            cs = seq;
            const float* mod = (const float*)(p.ws + WS_MOD) + (size_t)seq * (6 * D);
            const float* scale = mod + (WHICH == 0 ? 1 : 4) * D; const float* shift = mod + (WHICH == 0 ? 0 : 3) * D;
#pragma unroll
            for (int j = 0; j < 8; ++j) { const int k = 8 * lane + 512 * (j >> 1) + 4 * (j & 1);
                gs[j] = *(const f32x4*)(g + k) * (*(const f32x4*)(scale + k) + 1.f); sh[j] = *(const f32x4*)(shift + k); }
        }
        float s = 0.f;
#pragma unroll
        for (int j = 0; j < 8; ++j) s += (v[j][0] * v[j][0] + v[j][1] * v[j][1]) + (v[j][2] * v[j][2] + v[j][3] * v[j][3]);
        const float rstd = rsqrtf(wave_sum(s) * (1.f / D) + 1e-6f);
        bf16_t* h = (bf16_t*)(p.ws + WS_H) + (size_t)row * D;
#pragma unroll
        for (int j = 0; j < 4; ++j) {
            const f32x4 a = v[2 * j] * rstd * gs[2 * j] + sh[2 * j], b = v[2 * j + 1] * rstd * gs[2 * j + 1] + sh[2 * j + 1];
            u32x4 w; w.x = pk2(a[0], a[1]); w.y = pk2(a[2], a[3]); w.z = pk2(b[0], b[1]); w.w = pk2(b[2], b[3]);
            *(u32x4*)(h + 8 * lane + 512 * j) = w; }
    }
}
__device__ __forceinline__ void phase_lnv(const P& p, int gw, int NGW, int lane) {
    const int r0 = (int)(((long long)gw * M) / NGW), r1 = (int)(((long long)(gw + 1) * M) / NGW);
    f32x4 lg[4], lb[4];
#pragma unroll
    for (int j = 0; j < 2; ++j) { const int c = 8 * lane + 512 * j;
        lg[2 * j] = *(const f32x4*)(p.in[21] + c); lg[2 * j + 1] = *(const f32x4*)(p.in[21] + c + 4); lb[2 * j] = *(const f32x4*)(p.in[22] + c); lb[2 * j + 1] = *(const f32x4*)(p.in[22] + c + 4); }
    for (int rowa = r0; rowa < r1; rowa += 2) {
        u32x4 zw[2][2];
#pragma unroll
        for (int k = 0; k < 2; ++k) { const int row = rowa + k < r1 ? rowa + k : rowa;
            const bf16_t* zv = (const bf16_t*)(p.ws + WS_ZUG) + (size_t)row * ZUGW + ZU_V;
            zw[k][0] = *(const u32x4*)(zv + 8 * lane); zw[k][1] = *(const u32x4*)(zv + 8 * lane + 512); }
#pragma unroll
        for (int k = 0; k < 2; ++k) {
            if (rowa + k >= r1) break;
            const int row = rowa + k;
            f32x4 v[4]; float s = 0.f;
#pragma unroll
            for (int j = 0; j < 2; ++j) { const u32x4 w = zw[k][j]; v[2 * j] = (f32x4){bflo(w.x), bfhi(w.x), bflo(w.y), bfhi(w.y)}; v[2 * j + 1] = (f32x4){bflo(w.z), bfhi(w.z), bflo(w.w), bfhi(w.w)}; }
#pragma unroll
            for (int i = 0; i < 4; ++i) s += (v[i][0] + v[i][1]) + (v[i][2] + v[i][3]);
            const float mean = wave_sum(s) * (1.f / MLPW);
            float q = 0.f;
#pragma unroll
            for (int i = 0; i < 4; ++i) { v[i] = v[i] - mean; q += (v[i][0] * v[i][0] + v[i][1] * v[i][1]) + (v[i][2] * v[i][2] + v[i][3] * v[i][3]); }
            const float rstd = rsqrtf(wave_sum(q) * (1.f / MLPW) + 1e-5f);
            bf16_t* vn = (bf16_t*)(p.ws + WS_VN) + (size_t)row * MLPW;
#pragma unroll
            for (int j = 0; j < 2; ++j) { const int c = 8 * lane + 512 * j;
                const f32x4 a = v[2 * j] * rstd * lg[2 * j] + lb[2 * j], b = v[2 * j + 1] * rstd * lg[2 * j + 1] + lb[2 * j + 1];
                u32x4 w; w.x = pk2(a[0], a[1]); w.y = pk2(a[2], a[3]); w.z = pk2(b[0], b[1]); w.w = pk2(b[2], b[3]);
                *(u32x4*)(vn + c) = w;
                if (row >= MP) { float* vs = p.out + O_VS + (size_t)(row - MP) * MLPW + c; *(f32x4*)vs = a; *(f32x4*)(vs + 4) = b; }
            }
        }
    }
}
__device__ __forceinline__ void phase_final(const P& p, int gw, int NGW, int lane) {
    const int r0 = (int)(((long long)gw * M) / NGW), r1 = (int)(((long long)(gw + 1) * M) / NGW);
    f32x4 g[8];
#pragma unroll
    for (int j = 0; j < 8; ++j) g[j] = *(const f32x4*)(p.in[31] + 8 * lane + 512 * (j >> 1) + 4 * (j & 1));
    const bf16_t* x2 = (const bf16_t*)(p.ws + WS_ZRW);
    for (int row = r0; row < r1; ++row) {
        f32x4 v[8]; float s = 0.f;
#pragma unroll
        for (int j = 0; j < 4; ++j) { const u32x4 w = *(const u32x4*)(x2 + (size_t)row * D + 8 * lane + 512 * j);
            v[2 * j] = (f32x4){bflo(w.x), bfhi(w.x), bflo(w.y), bfhi(w.y)}; v[2 * j + 1] = (f32x4){bflo(w.z), bfhi(w.z), bflo(w.w), bfhi(w.w)}; }
#pragma unroll
        for (int j = 0; j < 8; ++j) s += (v[j][0] * v[j][0] + v[j][1] * v[j][1]) + (v[j][2] * v[j][2] + v[j][3] * v[j][3]);
        const float rstd = rsqrtf(wave_sum(s) * (1.f / D) + 1e-6f);
        float* y = p.out + (size_t)row * D;
#pragma unroll
        for (int j = 0; j < 8; ++j) *(f32x4*)(y + 8 * lane + 512 * (j >> 1) + 4 * (j & 1)) = v[j] * rstd * g[j];
    }
}
__device__ __forceinline__ void mix_naive_row(const P& p, int row, int tid, int nthr) {
    const int t = (row - MP) & (TS - 1), rowc0 = row - t;
    const bf16_t* vn = (const bf16_t*)(p.ws + WS_VN) + (size_t)rowc0 * MLPW;
    const bf16_t* zu = (const bf16_t*)(p.ws + WS_ZUG) + (size_t)row * ZUGW + ZU_U;
    bf16_t* ub = (bf16_t*)(p.ws + WS_OA) + (size_t)row * (2 * RW) + RW;
    for (int c = tid; c < MLPW; c += nthr) {
        const int g = c >> 7; const float* wsg = p.in[23] + ((size_t)g * 128 + t) * 128;
        float wv[TS], vv[TS];
#pragma unroll
        for (int s = 0; s < TS; ++s) { wv[s] = wsg[s]; vv[s] = bf2f(vn[(size_t)s * MLPW + c]); }
        float acc = p.in[24][g * 128 + t];
#pragma unroll
        for (int s = 0; s < TS; ++s) acc += (s <= t ? wv[s] : 0.f) * vv[s];
        ub[c] = f2bf(bf2f(zu[c]) * acc);
    }
}

#define PHASE_IDS() int tid = threadIdx.x; asm volatile("" : "+v"(tid)); const int lane = tid & 63, wave = __builtin_amdgcn_readfirstlane(tid >> 6); \
    const int gw = bx * NWAVES + wave, NGW = G * NWAVES; (void)lane; (void)gw; (void)NGW
__global__ void __launch_bounds__(NTHR, 2) mega_fwd(P p) {
    extern __shared__ __attribute__((aligned(16))) unsigned char lds_raw[];
    LAS unsigned char* lds = (LAS unsigned char*)lds_raw;
    const int G = gridDim.x, bx = blockIdx.x;
    unsigned char* ws = p.ws;
#define FLAGS(k) ((unsigned*)(ws + WS_CTL) + CW_FLAGS + (k) * 256)
    { PHASE_IDS();
      for (int u = tid; u < (LDS_BYTES - LDSCTL_OFF) / 4; u += NTHR) ((LAS unsigned*)(lds + LDSCTL_OFF))[u] = 0u; }
    __syncthreads();
    XcdBarrier bar = xcd_barrier_post((unsigned*)(ws + WS_CTL) + CW_BAR, (volatile LAS unsigned*)(lds + MISC_OFF) + 8);
#ifdef TSMASK
    unsigned long long* tsw = (unsigned long long*)(ws + WS_CTL + 524288); int nst = 0;
#define STAMP() do { if (bx == 0 && threadIdx.x == 0) tsw[nst] = __builtin_amdgcn_s_memrealtime(); ++nst; } while (0)
#else
#define STAMP() do { } while (0)
#endif
    STAMP();

    { PHASE_IDS();
      p0_silu(p, bx * NTHR + tid, G * NTHR);
      asm volatile("s_waitcnt vmcnt(0)" ::: "memory"); __syncthreads();
      if (tid == 0) __hip_atomic_fetch_add((unsigned*)(ws + WS_CTL) + CW_SILU, 1u, __ATOMIC_RELAXED, __HIP_MEMORY_SCOPE_AGENT);
      p0_transposes(p, (LAS float*)(lds + wave * 16384), 0, gw, NGW, lane); }
    STAMP();
    { PHASE_IDS();
      if (tid == 0) { unsigned* cw = (unsigned*)(ws + WS_CTL) + CW_SILU; unsigned sp = 0;
          while (__hip_atomic_load(cw, __ATOMIC_RELAXED, __HIP_MEMORY_SCOPE_AGENT) < (unsigned)G && ++sp < (1u << 22)) __builtin_amdgcn_s_sleep(2);
          __builtin_amdgcn_fence(__ATOMIC_ACQUIRE, "agent"); asm volatile("s_waitcnt vmcnt(0)" ::: "memory"); }
      __syncthreads();
      p0_mod_slab(p, lds, ((bx >> 4) << 4) | ((bx & 7) << 1) | ((bx >> 3) & 1), tid, lane, wave); }
    xcd_barrier(bar); STAMP();
    { PHASE_IDS(); phase_norm<0>(p, gw, NGW, lane); }
    xcd_barrier(bar); STAMP();
    {
        pg8::Gemm g{(const bf16_t*)(ws + WS_H), (const bf16_t*)(ws + WS_WIN), M, CIN, D}; SliceOrder S; S.init(M, CIN, D, bx, FLAGS(0), (float*)(ws + WS_VN));
        EpiZ E{(bf16_t*)(ws + WS_ZRW), (bf16_t*)(ws + WS_ZUG), p.out};
        pg8::gemm_phase<EpiZ, SliceOrder, PG8_ALIGN, PG8_SP2>(lds, g, S, E);
    }
    xcd_barrier(bar); STAMP();
    { PHASE_IDS();
      phase_lnv(p, gw, NGW, lane);
      STAMP();
      static_assert(NREC % (256 * NWAVES) == 0, "every wave runs the same number of record rounds (barrier inside)");
      for (int rec = gw, k = 0; rec < NREC; rec += NGW, ++k) {
          int t_ = (int)threadIdx.x; asm volatile("" : "+v"(t_));
          LAS unsigned char* shf = lds + (k & 1) * 16384;
          *(LAS bf16x8*)(shf + wave * 1024 + (t_ & 63) * 16) = lora_frag(p, rec, wave, t_ & 63);
          LDS_WAIT(); __syncthreads();
          prep_record(p, lds + wave * 16384, shf, rec, t_ & 63);
      } }
    xcd_barrier(bar); STAMP();
    { PHASE_IDS();
        constexpr int NSW = NPB * NH, NOW = 256 - NSW;
        if (bx < NSW) {
            volatile LAS unsigned* prog = (volatile LAS unsigned*)(lds + MISC_OFF) + 16;
            if (wave < 2) scan_chain_prompt(p, bx >> 4, bx & 15, wave, lane, prog);
            else if (wave == 4 || wave == 5) scan_prefetch(p, prog, bx >> 4, bx & 15, wave - 4, lane);
            STAMP();
        }
        else {
            const int ob = bx - NSW, wid = ob * NWAVES + wave, NW = NOW * NWAVES;
            scan_samples(p, wid, NW, lane);
            constexpr int NMIX = NPB * 16 * 8;
            for (int item = ob; item < NMIX; item += NOW) mix_item(p, item, wave, lane);
            for (int row = MP + ob; row < M; row += NOW) mix_naive_row(p, row, tid, NTHR);
            p0_transposes64(p, (LAS float*)(lds + wave * 16384), 1, wid, NW, lane);
        }
    }
    xcd_barrier(bar); STAMP();
    { PHASE_IDS(); post_rows(p, gw, NGW, lane); }
    xcd_barrier(bar); STAMP();
    {
        pg8::Gemm g{(const bf16_t*)(ws + WS_OA), (const bf16_t*)(ws + WS_WBA), M, D, 2 * RW}; SliceOrder S; S.init(M, D, 2 * RW, bx, FLAGS(1), p.out);
        EpiMerge E{(const bf16_t*)(ws + WS_ZUG), (bf16_t*)(ws + WS_H)};
        pg8::gemm_phase<EpiMerge, SliceOrder, PG8_ALIGN, PG8_SP2>(lds, g, S, E);
    }
    xcd_barrier(bar); STAMP();
    {
        pg8::Gemm g{(const bf16_t*)(ws + WS_H), (const bf16_t*)(ws + WS_WOUT), M, D, D}; SliceOrder S; S.init(M, D, D, bx, FLAGS(2), (float*)(ws + WS_VN));
        EpiRes1 E{p.in[0], p.in[1], (const float*)(ws + WS_MOD), (bf16_t*)(ws + WS_ZRW)};
        pg8::gemm_phase<EpiRes1, SliceOrder, PG8_ALIGN, PG8_SP2>(lds, g, S, E);
    }
    xcd_barrier(bar); STAMP();
    { PHASE_IDS(); phase_norm<1>(p, gw, NGW, lane); }
    xcd_barrier(bar); STAMP();
    {
        pg8::Gemm g{(const bf16_t*)(ws + WS_H), (const bf16_t*)(ws + WS_WFI), M, 2 * DFF, D}; SliceOrder S; S.init(M, 2 * DFF, D, bx, FLAGS(3), (float*)(ws + WS_VN));
        EpiSwiglu E{(bf16_t*)(ws + WS_ZUG)};
        pg8::gemm_phase<EpiSwiglu, SliceOrder, PG8_ALIGN, PG8_SP2>(lds, g, S, E);
    }
    xcd_barrier(bar); STAMP();
    {
        pg8::Gemm g{(const bf16_t*)(ws + WS_ZUG), (const bf16_t*)(ws + WS_WFO), M, D, DFF}; SliceOrder S; S.init(M, D, DFF, bx, FLAGS(4), (float*)(ws + WS_VN));
        EpiRes2 E{(const float*)(ws + WS_MOD), (bf16_t*)(ws + WS_ZRW)};
        pg8::gemm_phase<EpiRes2, SliceOrder, PG8_ALIGN, PG8_SP2>(lds, g, S, E);
    }
    xcd_barrier(bar); STAMP();
    { PHASE_IDS(); phase_final(p, gw, NGW, lane); }
#ifdef TSMASK
    STAMP();
    if (bx == 0 && threadIdx.x == 0) {
        unsigned long long tot = 0;
        for (int k = 0; k < nst - 1; ++k) if ((TSMASK >> k) & 1) tot += tsw[k + 1] - tsw[k];
        p.out[0] += (float)tot * (1.0f / 20000.0f);
    }
#endif
}

extern "C" void kernel_launch(void* const* d_in, const int* in_sizes, int n_in, void* d_out, int out_size, void* d_ws, size_t ws_size, hipStream_t stream) {
    static int grid = 0;
    if (grid == 0) {
        if (n_in != 32 || (size_t)out_size != O_END || ws_size < WS_END) { fprintf(stderr, "kernel_launch: unexpected shapes n_in=%d out=%d ws=%zu (need %zu)\n", n_in, out_size, ws_size, (size_t)WS_END); grid = -1; return; }
        int dev = 0, cus = 0, per_cu = 0;
        if (hipGetDevice(&dev) != hipSuccess || hipDeviceGetAttribute(&cus, hipDeviceAttributeMultiprocessorCount, dev) != hipSuccess) { grid = -1; return; }
        if (hipFuncSetAttribute((const void*)mega_fwd, hipFuncAttributeMaxDynamicSharedMemorySize, LDS_BYTES) != hipSuccess) { fprintf(stderr, "kernel_launch: hipFuncSetAttribute failed\n"); grid = -1; return; }
        if (hipOccupancyMaxActiveBlocksPerMultiprocessor(&per_cu, (const void*)mega_fwd, NTHR, LDS_BYTES) != hipSuccess || per_cu < 1) { fprintf(stderr, "kernel_launch: occupancy query says %d blocks per CU\n", per_cu); }
        (void)hipGetLastError();
        grid = cus;
        if (grid != 256) { fprintf(stderr, "kernel_launch: built for 256 CUs (got %d)\n", cus); grid = -1; return; }
        if (grid < 128) { fprintf(stderr, "kernel_launch: this kernel's phase plan needs >= 128 CUs (got %d)\n", cus); grid = -1; return; }
    }
    if (grid < 0) return;
#ifdef TSMASK
    constexpr size_t kZero = CTL_BYTES;
#else
    constexpr size_t kZero = CTL_ZERO_BYTES;
#endif
    if (hipMemsetAsync((char*)d_ws + WS_CTL, 0, kZero, stream) != hipSuccess) { fprintf(stderr, "kernel_launch: memset failed\n"); return; }
    P p{};
    for (int i = 0; i < 32; ++i) p.in[i] = (const float*)d_in[i];
    p.out = (float*)d_out; p.ws = (unsigned char*)d_ws;
    hipLaunchKernelGGL(mega_fwd, dim3(grid), dim3(NTHR), LDS_BYTES, stream, p);
    const hipError_t le = hipPeekAtLastError();
    if (le != hipSuccess) fprintf(stderr, "kernel_launch: launch failed: %s\n", hipGetErrorName(le));
}
```

```cpp
#include <hip/hip_runtime.h>
#include <cstdio>
#include <cstdint>

constexpr int D = 2048, NPB = 4, TP = 2048, NSB = 128, TS = 8;
constexpr int MP = NPB * TP, MS = NSB * TS, M = MP + MS;
constexpr int RW = 1024, NH = 16, HS = 64;
constexpr int CSH = 3328, CIN = 9472, DFF = 5632, MLPW = 1024;
constexpr int C_U = CSH, C_V = CSH + 1024, C_G0 = CSH + 2048, C_G1 = C_G0 + 2048;
constexpr int ZUGW = CIN - CSH, ZU_U = 0, ZU_V = 1024, ZU_G0 = 2048, ZU_G1 = 4096;
constexpr int NSEQ = NPB + NSB;
constexpr size_t O_YP = 0, O_YS = O_YP + (size_t)MP * D, O_WKVP = O_YS + (size_t)MS * D, O_SHP = O_WKVP + (size_t)NPB * NH * HS * HS,
                 O_WKVS = O_SHP + (size_t)NPB * CSH, O_SHS = O_WKVS + (size_t)NSB * NH * HS * HS, O_VS = O_SHS + (size_t)NSB * CSH,
                 O_END = O_VS + (size_t)MS * MLPW;
constexpr size_t WS_CTL = 0, CTL_BYTES = 1u << 20, CTL_ZERO_BYTES = 160u << 10;
constexpr size_t WS_WIN = CTL_BYTES;
constexpr size_t WS_WBA = WS_WIN + (size_t)CIN * D * 2;
constexpr size_t WS_WBB = WS_WBA + (size_t)D * RW * 2;
constexpr size_t WS_WOUT = WS_WBB + (size_t)D * RW * 2;
constexpr size_t WS_WFI = WS_WOUT + (size_t)D * D * 2;
constexpr size_t WS_WFO = WS_WFI + (size_t)2 * DFF * D * 2;
constexpr size_t WS_MOD = WS_WFO + (size_t)D * DFF * 2;
constexpr size_t WS_H = WS_MOD + (size_t)NSEQ * 6 * D * 4;
constexpr size_t WS_ZRW = WS_H + (size_t)M * D * 2;
constexpr size_t WS_ZUG = WS_ZRW + (size_t)M * CSH * 2;
constexpr size_t WS_VN = WS_ZUG + (size_t)M * ZUGW * 2;
constexpr size_t WS_OA = WS_VN + (size_t)M * MLPW * 2;
constexpr size_t WS_UB = WS_OA + (size_t)M * RW * 2;
constexpr size_t WS_C2 = WS_UB + (size_t)M * MLPW * 2;
constexpr size_t WS_LORA = WS_C2 + (size_t)M * RW * 2;
constexpr size_t WS_SILU = WS_LORA + (size_t)RW * 256 * 2;
constexpr size_t WS_FRA_S = WS_SILU + (size_t)144 * D * 2;
constexpr size_t WS_FRB_S = WS_FRA_S + (size_t)NSB * NH * 4096;
constexpr size_t WS_END = WS_FRB_S + (size_t)NSB * NH * 8448;
constexpr int NREC_P = NPB * 128 * NH, NREC = NREC_P + NSB * NH;
constexpr int RECA = 4096, RECB = 8448;
static_assert(WS_C2 + (size_t)M * RW * 2 - WS_VN >= (size_t)256 * 262144, "stream-K slabs (256 x 256 KiB) fit VN | OA|UB | C2");
static_assert((size_t)NREC_P * RECA <= (size_t)M * D * 2 && (size_t)NREC_P * RECB <= (size_t)M * D * 4, "prompt fragment records fit the H buffer / the y region of d_out");
constexpr int CW_BAR = 4096, CW_SILU = 16384, CW_FLAGS = 32768;

typedef float f32x2v __attribute__((ext_vector_type(2)));
typedef __bf16 bf16x2v __attribute__((ext_vector_type(2)));
typedef unsigned u32x2v __attribute__((ext_vector_type(2)));

struct P { const float* in[32]; float* out; unsigned char* ws; };

__device__ __forceinline__ unsigned pk2(float lo, float hi) { return __builtin_bit_cast(unsigned, __builtin_convertvector((f32x2v){lo, hi}, bf16x2v)); }
__device__ __forceinline__ unsigned short f2bf(float f) { return (unsigned short)(pk2(f, 0.f) & 0xffffu); }
__device__ __forceinline__ float bf2f(unsigned short h) { return __uint_as_float(((unsigned)h) << 16); }
__device__ __forceinline__ float bflo(unsigned w) { return __uint_as_float(w << 16); }
__device__ __forceinline__ float bfhi(unsigned w) { return __uint_as_float(w & 0xffff0000u); }
__device__ __forceinline__ float sigmoidf_(float x) { return __builtin_amdgcn_rcpf(1.f + __expf(-x)); }
__device__ __forceinline__ float gelu_tanh(float x) {
    const float u = 0.7978845608028654f * (x + 0.044715f * x * x * x); return x * __builtin_amdgcn_rcpf(1.f + __expf(-2.f * u)); }
__device__ __forceinline__ float wave_sum(float v) {
#pragma unroll
    for (int o = 1; o < 64; o <<= 1) v += __shfl_xor(v, o);
    return v;
}
__device__ __forceinline__ int seq_of_row(int row) { return row < MP ? row / TP : NPB + (row - MP) / TS; }

namespace pg8 {
#define PG8_LAS __attribute__((address_space(3)))
typedef unsigned short bf16_t;
typedef short bf16x8 __attribute__((ext_vector_type(8)));
typedef float f32x4 __attribute__((ext_vector_type(4)));
typedef unsigned u32x4 __attribute__((ext_vector_type(4)));
constexpr int BM = 256, BK = 64, HALF = 128, HTB = HALF * BK * 2  , STAGE_BYTES = 8 * HTB, NXCD = 8, WGM = 8;

__host__ __device__ __forceinline__ int lds_byte(int r, int c) { const int st = (r >> 4) * 2 + (c >> 5), rr = r & 15, cc = c & 31, ob = rr * 64 + cc * 2; return st * 1024 + (ob ^ (((ob >> 9) & 1) << 5)); }
__host__ __device__ __forceinline__ void stage_rc(int b, int& R, int& C) { const int st = b / 1024, sb = b % 1024, swz = sb ^ (((sb >> 9) & 1) << 5); R = (st >> 1) * 16 + swz / 64; C = (st & 1) * 32 + (swz % 64) / 2; }
__host__ __device__ __forceinline__ int perm32(int rho) { const int n = rho >> 4, i = rho & 15; return 8 * (i >> 2) + 4 * n + (i & 3); }

struct Unit { int pm, pn, kb, nk, kind, peer; };
struct Gemm { const bf16_t* A; const bf16_t* Bt; int M, N, K; };

struct StaticOrder {
    int nM, nN, nwg, G, c;
    __host__ __device__ void init(int M, int N, int G_, int c_) { nM = M / BM; nN = N / BM; nwg = nM * nN; G = G_; c = c_; }
    __host__ __device__ bool next(int i, Unit& u) const {
        const long L = (long)i * G + c; if (L >= nwg) return false;
        int wgid = (int)L; { const int q = nwg / NXCD, r = nwg % NXCD, xcd = wgid % NXCD, off = wgid / NXCD; wgid = (xcd < r ? xcd * (q + 1) : r * (q + 1) + (xcd - r) * q) + off; }
        const int nig = WGM * nN, gid = wgid / nig, fm = gid * WGM, gsz = (nM - fm) < WGM ? (nM - fm) : WGM;
        u.pm = fm + ((wgid % nig) % gsz); u.pn = (wgid % nig) / gsz; return true;
    }
    __device__ __forceinline__ void a_ready(const Unit&) const {}
    __device__ __forceinline__ void done(const Unit&) const {}
};
template <class Epi, class Sched, bool ALIGN_EPI = false, bool SP2 = false>
__device__ __forceinline__ void gemm_phase(PG8_LAS unsigned char* lds, const Gemm g, const Sched& S, const Epi& E) {
    int tid_ = threadIdx.x; asm volatile("" : "+v"(tid_));
    const int tid = tid_, wid = __builtin_amdgcn_readfirstlane(tid >> 6), lane = tid & 63, wr = wid >> 2, wc = wid & 3, fr = lane & 15, fq = lane >> 4;
    const int K = g.K;
    unsigned voffA[2], voffB[2];
#pragma unroll
    for (int i = 0; i < 2; ++i) { int R, C; stage_rc(tid * 16 + i * 8192, R, C); const int Rb = Epi::PERM ? ((R & ~31) + perm32(R & 31)) : R;
        voffA[i] = (unsigned)(R * K + C) * 2u; voffB[i] = (unsigned)(Rb * K + C) * 2u; }
    const size_t kstep = (size_t)(BK * 2);
    const size_t hstep = (size_t)HALF * K * 2;
    const size_t tstep = 2 * hstep;
    const unsigned ldsw = (unsigned)wid * 1024u;
    const int aoff = lds_byte(wr * 64 + fr, fq * 8), boff = lds_byte(wc * 32 + fr, fq * 8);
#define PG8_SA(b, h) (((b) * 2 + (h)) * HTB)
#define PG8_SB(b, h) ((4 + (b) * 2 + (h)) * HTB)
#define PG8_STAGE(bufoff, gbase, voff) do { _Pragma("unroll") for (int _i = 0; _i < 2; ++_i) \
        __builtin_amdgcn_global_load_lds((const unsigned*)((const char*)(gbase) + (voff)[_i]), (PG8_LAS unsigned*)(lds + (bufoff) + ldsw + _i * 8192), 16, 0, 0); } while (0)
#define PG8_LDA(dst, b, h) do { _Pragma("unroll") for (int m = 0; m < 4; ++m) _Pragma("unroll") for (int k = 0; k < 2; ++k) dst[m][k] = *(const PG8_LAS bf16x8*)(lds + PG8_SA(b, h) + aoff + m * 2048 + k * 1024); } while (0)
#define PG8_LDB(dst, b, h) do { _Pragma("unroll") for (int n = 0; n < 2; ++n) _Pragma("unroll") for (int k = 0; k < 2; ++k) dst[n][k] = *(const PG8_LAS bf16x8*)(lds + PG8_SB(b, h) + boff + n * 2048 + k * 1024); } while (0)
#define PG8_MMA(ai, bj, At, Bt) do { __builtin_amdgcn_s_setprio(1); _Pragma("unroll") for (int m = 0; m < 4; ++m) _Pragma("unroll") for (int n = 0; n < 2; ++n) _Pragma("unroll") for (int k = 0; k < 2; ++k) \
        acc[ai][bj][m][n] = __builtin_amdgcn_mfma_f32_16x16x32_bf16(Bt[n][k], At[m][k], acc[ai][bj][m][n], 0, 0, 0); __builtin_amdgcn_s_setprio(0); } while (0)
#define PG8_WAIT_V(n) asm volatile("s_waitcnt vmcnt(" #n ")" ::: "memory")
#define PG8_WAIT_L(n) asm volatile("s_waitcnt lgkmcnt(" #n ")" ::: "memory")
#define PG8_BAR __builtin_amdgcn_s_barrier()
#define PG8_SCHED __builtin_amdgcn_sched_barrier(0)
    Unit cur, nxt; int ui = 0;
    if (!S.next(0, cur)) return;
    f32x4 acc[2][2][4][2];
#pragma unroll
    for (int a = 0; a < 2; ++a)
#pragma unroll
        for (int b = 0; b < 2; ++b)
#pragma unroll
            for (int m = 0; m < 4; ++m)
#pragma unroll
                for (int n = 0; n < 2; ++n) acc[a][b][m][n] = (f32x4){0.f, 0.f, 0.f, 0.f};
    bf16x8 At[4][2], B0[2][2], B1[2][2];
    const char* cA = (const char*)g.A + (size_t)cur.pm * tstep + (size_t)cur.kb * kstep; const char* cB = (const char*)g.Bt + (size_t)cur.pn * tstep + (size_t)cur.kb * kstep;
    S.a_ready(cur);
    if constexpr (SP2) {
        PG8_STAGE(PG8_SB(0, 0), cB, voffB); PG8_STAGE(PG8_SB(0, 1), cB + hstep, voffB); PG8_STAGE(PG8_SA(0, 0), cA, voffA); PG8_STAGE(PG8_SA(0, 1), cA + hstep, voffA);
        if (wr == 1) PG8_BAR;
        PG8_WAIT_V(2); PG8_BAR;
        PG8_STAGE(PG8_SB(1, 0), cB + kstep, voffB); PG8_STAGE(PG8_SA(1, 0), cA + kstep, voffA); PG8_STAGE(PG8_SB(1, 1), cB + hstep + kstep, voffB);
        PG8_WAIT_V(6); PG8_BAR;
    } else {
        PG8_STAGE(PG8_SB(0, 0), cB, voffB); PG8_STAGE(PG8_SA(0, 0), cA, voffA); PG8_STAGE(PG8_SB(0, 1), cB + hstep, voffB); PG8_STAGE(PG8_SA(0, 1), cA + hstep, voffA);
        if (wr == 1) PG8_BAR;
        PG8_WAIT_V(4); PG8_BAR;
        PG8_STAGE(PG8_SB(1, 0), cB + kstep, voffB); PG8_STAGE(PG8_SA(1, 0), cA + kstep, voffA); PG8_STAGE(PG8_SB(1, 1), cB + hstep + kstep, voffB);
        PG8_WAIT_V(6); PG8_BAR;
    }
    for (;;) {
        const bool has_next = S.next(ui + 1, nxt);
        const char* nA = has_next ? (const char*)g.A + (size_t)nxt.pm * tstep + (size_t)nxt.kb * kstep : cA; const char* nB = has_next ? (const char*)g.Bt + (size_t)nxt.pn * tstep + (size_t)nxt.kb * kstep : cB;
        const int nt = cur.nk;
        for (int t = 0; t < nt; t += 2) {
            const bool last = (t == nt - 2);
            if constexpr (Epi::HOOK_TILE > 0) { if (cur.kb + t == Epi::HOOK_TILE && t > 0) E.mid(acc, cur, wr, wc, fr, fq); }
            const char* a1 = cA + (size_t)(t + 1) * kstep;
            const char* a2 = last ? nA : cA + (size_t)(t + 2) * kstep; const char* b2 = last ? nB : cB + (size_t)(t + 2) * kstep;
            const char* a3 = a2 + kstep; const char* b3 = b2 + kstep;
            if (last && has_next) S.a_ready(nxt);
            if constexpr (SP2) {
            PG8_LDB(B0, 0, 0); PG8_LDB(B1, 0, 1); PG8_SCHED; PG8_LDA(At, 0, 0); PG8_STAGE(PG8_SA(1, 1), a1 + hstep, voffA);
            PG8_WAIT_V(8); PG8_WAIT_L(0); PG8_BAR; PG8_MMA(0, 0, At, B0); PG8_MMA(0, 1, At, B1); PG8_BAR; PG8_SCHED;
            PG8_LDA(At, 0, 1); PG8_STAGE(PG8_SB(0, 0), b2, voffB); PG8_STAGE(PG8_SB(0, 1), b2 + hstep, voffB); PG8_STAGE(PG8_SA(0, 0), a2, voffA);
            PG8_WAIT_V(8); PG8_WAIT_L(0); PG8_BAR; PG8_MMA(1, 0, At, B0); PG8_MMA(1, 1, At, B1); PG8_BAR; PG8_SCHED;
            PG8_LDB(B0, 1, 0); PG8_LDB(B1, 1, 1); PG8_SCHED; PG8_LDA(At, 1, 0); PG8_STAGE(PG8_SA(0, 1), a2 + hstep, voffA);
            PG8_WAIT_V(8); PG8_WAIT_L(0); PG8_BAR; PG8_MMA(0, 0, At, B0); PG8_MMA(0, 1, At, B1); PG8_BAR; PG8_SCHED;
            PG8_LDA(At, 1, 1); PG8_STAGE(PG8_SB(1, 0), b3, voffB); PG8_STAGE(PG8_SB(1, 1), b3 + hstep, voffB); PG8_STAGE(PG8_SA(1, 0), a3, voffA);
            PG8_WAIT_V(8); PG8_WAIT_L(0); PG8_BAR; PG8_MMA(1, 0, At, B0); PG8_MMA(1, 1, At, B1); PG8_BAR; PG8_SCHED;
            } else {
            PG8_LDB(B0, 0, 0); PG8_SCHED; PG8_LDA(At, 0, 0); PG8_STAGE(PG8_SA(1, 1), a1 + hstep, voffA);
            PG8_WAIT_L(8); PG8_BAR; PG8_WAIT_L(0); PG8_MMA(0, 0, At, B0); PG8_BAR; PG8_SCHED;
            PG8_LDB(B1, 0, 1); PG8_STAGE(PG8_SB(0, 0), b2, voffB);
            PG8_BAR; PG8_WAIT_L(0); PG8_MMA(0, 1, At, B1); PG8_BAR;
            PG8_LDA(At, 0, 1); PG8_STAGE(PG8_SA(0, 0), a2, voffA);
            PG8_BAR; PG8_WAIT_L(0); PG8_MMA(1, 0, At, B0); PG8_BAR; PG8_SCHED;
            PG8_STAGE(PG8_SB(0, 1), b2 + hstep, voffB);
            PG8_WAIT_V(6); PG8_BAR; PG8_MMA(1, 1, At, B1); PG8_BAR;
            PG8_LDB(B0, 1, 0); PG8_SCHED; PG8_LDA(At, 1, 0); PG8_STAGE(PG8_SA(0, 1), a2 + hstep, voffA);
            PG8_WAIT_L(8); PG8_BAR; PG8_WAIT_L(0); PG8_MMA(0, 0, At, B0); PG8_BAR; PG8_SCHED;
            PG8_LDB(B1, 1, 1); PG8_STAGE(PG8_SB(1, 0), b3, voffB);
            PG8_BAR; PG8_WAIT_L(0); PG8_MMA(0, 1, At, B1); PG8_BAR;
            PG8_LDA(At, 1, 1); PG8_STAGE(PG8_SA(1, 0), a3, voffA);
            PG8_BAR; PG8_WAIT_L(0); PG8_MMA(1, 0, At, B0); PG8_BAR; PG8_SCHED;
            PG8_STAGE(PG8_SB(1, 1), b3 + hstep, voffB);
            PG8_WAIT_V(6); PG8_BAR; PG8_MMA(1, 1, At, B1); PG8_BAR;
            }
        }
        if constexpr (ALIGN_EPI) { if (wr == 0) PG8_BAR; }
        if constexpr (Epi::HOOK_TILE > 0) { if (cur.kb + cur.nk <= Epi::HOOK_TILE) E.mid(acc, cur, wr, wc, fr, fq); }
        if (cur.kind == 3) {
            int fr_ = fr; asm volatile("" : "+v"(fr_));
            const int ti4 = (wid * 64 + fq * 16 + fr_) * 4;
            {
                unsigned char* slw = (unsigned char*)S.slab + (size_t)(cur.peer * S.nsl + S.s) * 131072;
                const __amdgpu_buffer_rsrc_t rs = __builtin_amdgcn_make_buffer_rsrc(slw, 0, 131072, 0x00020000);
#pragma unroll
                for (int a = 0; a < 2; ++a)
#pragma unroll
                    for (int m = 0; m < 4; ++m) {
                        if ((a * 4 + m) % S.nsl == S.s) continue;
#pragma unroll
                        for (int b = 0; b < 2; ++b) {
                            u32x4 w; const f32x4 p0 = acc[a][b][m][0], p1 = acc[a][b][m][1];
                            w.x = pk2(p0[0], p0[1]); w.y = pk2(p0[2], p0[3]); w.z = pk2(p1[0], p1[1]); w.w = pk2(p1[2], p1[3]);
                            __builtin_amdgcn_raw_buffer_store_b128(w, rs, ti4 * 4 + ((a * 2 + b) * 4 + m) * 8192, 0, 16);
                        }
                    }
            }
            PG8_WAIT_V(0); PG8_BAR;
            if (wid == 0 && (fq | fr) == 0) {
                __hip_atomic_fetch_add(S.cnt + cur.peer, 1u, __ATOMIC_RELAXED, __HIP_MEMORY_SCOPE_AGENT);
                unsigned sp = 0; while (__hip_atomic_load(S.cnt + cur.peer, __ATOMIC_RELAXED, __HIP_MEMORY_SCOPE_AGENT) < (unsigned)S.nsl && ++sp < (1u << 22)) __builtin_amdgcn_s_sleep(2);
                __builtin_amdgcn_fence(__ATOMIC_ACQUIRE, "agent"); PG8_WAIT_V(0);
            }
            PG8_BAR; asm volatile("" ::: "memory");
            const int no = S.nsl - 1;
#define PG8_RED(Q, Q0) { u32x4 t[Q][2]; \
                    _Pragma("unroll") for (int q = Q0; q < Q0 + Q; ++q) { int o = S.s + 1 + (q < no ? q : 0); o -= o >= S.nsl ? S.nsl : 0; \
                        t[q - Q0][0] = *(const u32x4*)(sb + (size_t)o * 131072); t[q - Q0][1] = *(const u32x4*)(sb + (size_t)o * 131072 + 4 * 8192); } \
                    _Pragma("unroll") for (int q = Q0; q < Q0 + Q; ++q) _Pragma("unroll") for (int b = 0; b < 2; ++b) { const bool on = q < no; const u32x4 w = t[q - Q0][b]; \
                        r[2 * b] += (f32x4){on ? bflo(w.x) : 0.f, on ? bfhi(w.x) : 0.f, on ? bflo(w.y) : 0.f, on ? bfhi(w.y) : 0.f}; \
                        r[2 * b + 1] += (f32x4){on ? bflo(w.z) : 0.f, on ? bfhi(w.z) : 0.f, on ? bflo(w.w) : 0.f, on ? bfhi(w.w) : 0.f}; } }
#pragma unroll
            for (int a = 0; a < 2; ++a)
#pragma unroll
                for (int m0 = 0; m0 < 4; ++m0) {
                    if ((a * 4 + m0) % S.nsl != S.s) continue;
                    f32x4 r[4] = {acc[a][0][m0][0], acc[a][0][m0][1], acc[a][1][m0][0], acc[a][1][m0][1]};
                    const unsigned char* sb = (const unsigned char*)S.slab + (size_t)(cur.peer * S.nsl) * 131072 + ti4 * 4 + ((a * 2) * 4 + m0) * 8192;
                    PG8_RED(4, 0)
                    if (no > 4) PG8_RED(4, 4)
                    E.rg(r[0], r[1], r[2], r[3], cur, a, m0, wr, wc, fr, fq);
                }
#undef PG8_RED
        } else {
            E(acc, cur, wr, wc, fr, fq);
        }
        if (!has_next) break;
#pragma unroll
        for (int a = 0; a < 2; ++a)
#pragma unroll
            for (int b = 0; b < 2; ++b)
#pragma unroll
                for (int m = 0; m < 4; ++m)
#pragma unroll
                    for (int n = 0; n < 2; ++n) acc[a][b][m][n] = (f32x4){0.f, 0.f, 0.f, 0.f};
        cur = nxt; cA = nA; cB = nB; ++ui;
        if constexpr (ALIGN_EPI) { if (wr == 1) PG8_BAR; }
    }
    PG8_WAIT_V(0);
    if constexpr (!ALIGN_EPI) { if (wr == 0) PG8_BAR; }
    PG8_BAR;
    if constexpr (Epi::AFTER_DRAIN) { E.fused(acc, cur, wr, wc, fr, fq, lds, wid, lane); S.done(cur); }
#undef PG8_SA
#undef PG8_SB
#undef PG8_STAGE
#undef PG8_LDA
#undef PG8_LDB
#undef PG8_MMA
#undef PG8_WAIT_V
#undef PG8_WAIT_L
#undef PG8_BAR
#undef PG8_SCHED
}
}
#define PG8_SP2 true
#define PG8_ALIGN true

using pg8::f32x4; using pg8::Unit; using pg8::BM; using pg8::HALF; typedef pg8::u32x4 u32x4;
typedef unsigned short bf16_t;

#define EPI_WALK() __device__ __forceinline__ void operator()(const f32x4 (&acc)[2][2][4][2], const Unit& u, int wr, int wc, int fr, int fq) const { \
        _Pragma("unroll") for (int ai = 0; ai < 2; ++ai) _Pragma("unroll") for (int m = 0; m < 4; ++m) { \
            rg(acc[ai][0][m][0], acc[ai][0][m][1], acc[ai][1][m][0], acc[ai][1][m][1], u, ai, m, wr, wc, fr, fq); if (m == 3) asm volatile("" ::: "memory"); } }

#define EPI_WALK_BODY(NB, FIN) \
        _Pragma("unroll") for (int g0 = 0; g0 < 8; g0 += NB) { L x[NB]; \
            _Pragma("unroll") for (int g = 0; g < NB; ++g) x[g] = ld(u, (g0 + g) >> 2, (g0 + g) & 3, wr, wc, fr, fq); \
            _Pragma("unroll") for (int g = 0; g < NB; ++g) { const int ai = (g0 + g) >> 2, m = (g0 + g) & 3; \
                FIN(x[g], pre, acc[ai][0][m][0], acc[ai][0][m][1], acc[ai][1][m][0], acc[ai][1][m][1], u, ai, m, wr, wc, fr, fq); } \
            asm volatile("" ::: "memory"); }
#define EPI_WALK_LD(NB) __device__ __forceinline__ void operator()(const f32x4 (&acc)[2][2][4][2], const Unit& u, int wr, int wc, int fr, int fq) const { \
        const Pre pre{}; EPI_WALK_BODY(NB, fin) } \
    __device__ __forceinline__ void rg(f32x4 v00, f32x4 v01, f32x4 v10, f32x4 v11, const Unit& u, int ai, int m, int wr, int wc, int fr, int fq) const { \
        fin(ld(u, ai, m, wr, wc, fr, fq), Pre{}, v00, v01, v10, v11, u, ai, m, wr, wc, fr, fq); }
#define EPI_WALK_LDU(NB) __device__ __forceinline__ void operator()(const f32x4 (&acc)[2][2][4][2], const Unit& u, int wr, int wc, int fr, int fq) const { \
        if (u.pm < MP / BM) { asm volatile("" : "+v"(fq)); const Pre pre = prep(u, wc, fq); EPI_WALK_BODY(NB, fin<true>) } \
        else { const Pre pre{}; EPI_WALK_BODY(NB, fin<false>) } } \
    __device__ __forceinline__ void rg(f32x4 v00, f32x4 v01, f32x4 v10, f32x4 v11, const Unit& u, int ai, int m, int wr, int wc, int fr, int fq) const { \
        fin<false>(ld(u, ai, m, wr, wc, fr, fq), Pre{}, v00, v01, v10, v11, u, ai, m, wr, wc, fr, fq); }

struct EpiZ {
    static constexpr int HOOK_TILE = 0;
    static constexpr bool PERM = true, AFTER_DRAIN = false;
    bf16_t* zrw; bf16_t* zug; float* out;
    __device__ __forceinline__ void rg(f32x4 v00, f32x4 v01, f32x4 v10, f32x4 v11, const Unit& u, int ai, int m, int wr, int wc, int fr, int fq) const {
        const int colt = u.pn * BM;
        const int mode = colt < CSH ? 0 : (colt < C_G0 ? 1 : 2);
        const int row = u.pm * BM + wr * 64 + fr + ai * HALF + m * 16, col0 = colt + wc * 32 + 8 * fq;
        bf16_t* rowp = mode == 0 ? zrw + (size_t)row * CSH + col0 : zug + (size_t)row * ZUGW + (col0 - CSH);
        if (mode == 0) {
            bool last; float* sh;
            if (row < MP) { last = (row & (TP - 1)) == TP - 1; sh = out + O_SHP + (size_t)(row / TP) * CSH + col0; }
            else { const int rs = row - MP; last = (rs & (TS - 1)) == TS - 1; sh = out + O_SHS + (size_t)(rs / TS) * CSH + col0; }
            if (last) { *(f32x4*)sh = v00; *(f32x4*)(sh + 4) = v01; *(f32x4*)(sh + HALF) = v10; *(f32x4*)(sh + HALF + 4) = v11; }
        } else if (mode == 1) {
#pragma unroll
            for (int e = 0; e < 4; ++e) { v00[e] = gelu_tanh(v00[e]); v01[e] = gelu_tanh(v01[e]); v10[e] = gelu_tanh(v10[e]); v11[e] = gelu_tanh(v11[e]); }
        } else {
            const int gc = (colt - C_G0) / 2 + wc * 32 + 8 * fq;
            f32x4 r0, r1;
#pragma unroll
            for (int e = 0; e < 4; ++e) { v10[e] = sigmoidf_(v10[e]); v11[e] = sigmoidf_(v11[e]);
                r0[e] = sigmoidf_(v00[e]) * __builtin_amdgcn_rcpf(fmaxf(v10[e], 1e-30f)); r1[e] = sigmoidf_(v01[e]) * __builtin_amdgcn_rcpf(fmaxf(v11[e], 1e-30f)); }
            bf16_t* zr = zug + (size_t)row * ZUGW;
            u32x4 w; w.x = pk2(r0[0], r0[1]); w.y = pk2(r0[2], r0[3]); w.z = pk2(r1[0], r1[1]); w.w = pk2(r1[2], r1[3]);
            *(u32x4*)(zr + ZU_G0 + gc) = w;
            w.x = pk2(v10[0], v10[1]); w.y = pk2(v10[2], v10[3]); w.z = pk2(v11[0], v11[1]); w.w = pk2(v11[2], v11[3]);
            *(u32x4*)(zr + ZU_G1 + gc) = w;
            return;
        }
        u32x4 w; w.x = pk2(v00[0], v00[1]); w.y = pk2(v00[2], v00[3]); w.z = pk2(v01[0], v01[1]); w.w = pk2(v01[2], v01[3]);
        *(u32x4*)rowp = w;
        w.x = pk2(v10[0], v10[1]); w.y = pk2(v10[2], v10[3]); w.z = pk2(v11[0], v11[1]); w.w = pk2(v11[2], v11[3]);
        *(u32x4*)(rowp + HALF) = w;
    }
    EPI_WALK()
};
struct EpiMerge {
    static constexpr int HOOK_TILE = 16, MIDB = 8;
    static constexpr bool PERM = true, AFTER_DRAIN = false;
    const bf16_t* z; bf16_t* mg;
    __device__ __forceinline__ void mid(f32x4 (&acc)[2][2][4][2], const Unit& u, int wr, int wc, int fr, int fq) const {
        asm volatile("" : "+v"(fr));
        const int row0 = u.pm * BM + wr * 64 + fr, col0 = u.pn * BM + wc * 32 + 8 * fq;
#pragma unroll
        for (int h = 0; h < 8 / MIDB; ++h) {
            u32x4 rho[MIDB][2];
#pragma unroll
            for (int g = 0; g < MIDB; ++g) {
                const int ai = (h * MIDB + g) >> 2, m = (h * MIDB + g) & 3;
                const bf16_t* zr = z + (size_t)(row0 + ai * HALF + m * 16) * ZUGW + ZU_G0 + col0;
                rho[g][0] = *(const u32x4*)zr; rho[g][1] = *(const u32x4*)(zr + HALF);
            }
#pragma unroll
            for (int g = 0; g < MIDB; ++g)
#pragma unroll
                for (int bj = 0; bj < 2; ++bj) {
                    const int ai = (h * MIDB + g) >> 2, m = (h * MIDB + g) & 3;
                    const u32x4 a = rho[g][bj];
                    f32x4& v0 = acc[ai][bj][m][0]; f32x4& v1 = acc[ai][bj][m][1];
                    v0[0] *= bflo(a.x); v0[1] *= bfhi(a.x); v0[2] *= bflo(a.y); v0[3] *= bfhi(a.y);
                    v1[0] *= bflo(a.z); v1[1] *= bfhi(a.z); v1[2] *= bflo(a.w); v1[3] *= bfhi(a.w);
                }
            asm volatile("" ::: "memory");
        }
    }
    struct L { u32x4 ga, gb; }; struct Pre { };
    __device__ __forceinline__ L ld(const Unit& u, int ai, int m, int wr, int wc, int fr, int fq) const {
        const int row = u.pm * BM + wr * 64 + fr + ai * HALF + m * 16, col0 = u.pn * BM + wc * 32 + 8 * fq;
        const bf16_t* zr = z + (size_t)row * ZUGW + ZU_G1 + col0;
        return L{*(const u32x4*)zr, *(const u32x4*)(zr + HALF)};
    }
    __device__ __forceinline__ void fin(const L& x, const Pre&, f32x4 v00, f32x4 v01, f32x4 v10, f32x4 v11, const Unit& u, int ai, int m, int wr, int wc, int fr, int fq) const {
        const int row = u.pm * BM + wr * 64 + fr + ai * HALF + m * 16, col0 = u.pn * BM + wc * 32 + 8 * fq;
        const u32x4 ga = x.ga, gb = x.gb;
        u32x4 w;
        w.x = pk2(bflo(ga.x) * v00[0], bfhi(ga.x) * v00[1]); w.y = pk2(bflo(ga.y) * v00[2], bfhi(ga.y) * v00[3]);
        w.z = pk2(bflo(ga.z) * v01[0], bfhi(ga.z) * v01[1]); w.w = pk2(bflo(ga.w) * v01[2], bfhi(ga.w) * v01[3]);
        *(u32x4*)(mg + (size_t)row * D + col0) = w;
        w.x = pk2(bflo(gb.x) * v10[0], bfhi(gb.x) * v10[1]); w.y = pk2(bflo(gb.y) * v10[2], bfhi(gb.y) * v10[3]);
        w.z = pk2(bflo(gb.z) * v11[0], bfhi(gb.z) * v11[1]); w.w = pk2(bflo(gb.w) * v11[2], bfhi(gb.w) * v11[3]);
        *(u32x4*)(mg + (size_t)row * D + col0 + HALF) = w;
    }
    EPI_WALK_LD(8)
};
struct EpiRes1 {
    static constexpr int HOOK_TILE = 0;
    static constexpr bool PERM = true, AFTER_DRAIN = false;
    const float* xp; const float* xs; const float* mod; bf16_t* x1;
    struct L { f32x4 a, b, c, d; }; struct Pre { f32x4 g[4]; };
    __device__ __forceinline__ Pre prep(const Unit& u, int wc, int fq) const {
        const float* gm = mod + (size_t)((u.pm * BM) / TP) * (6 * D) + 2 * D + u.pn * BM + wc * 32 + 8 * fq;
        return Pre{{*(const f32x4*)gm, *(const f32x4*)(gm + 4), *(const f32x4*)(gm + HALF), *(const f32x4*)(gm + HALF + 4)}};
    }
    __device__ __forceinline__ L ld(const Unit& u, int ai, int m, int wr, int wc, int fr, int fq) const {
        const int row = u.pm * BM + wr * 64 + fr + ai * HALF + m * 16, col0 = u.pn * BM + wc * 32 + 8 * fq;
        const float* xr = (row < MP ? xp + (size_t)row * D : xs + (size_t)(row - MP) * D) + col0;
        return L{*(const f32x4*)xr, *(const f32x4*)(xr + 4), *(const f32x4*)(xr + HALF), *(const f32x4*)(xr + HALF + 4)};
    }
    template <bool UNI> __device__ __forceinline__ void fin(const L& x, const Pre& q, f32x4 v00, f32x4 v01, f32x4 v10, f32x4 v11, const Unit& u, int ai, int m, int wr, int wc, int fr, int fq) const {
        const int row = u.pm * BM + wr * 64 + fr + ai * HALF + m * 16, col0 = u.pn * BM + wc * 32 + 8 * fq;
        f32x4 g0 = q.g[0], g1 = q.g[1], g2 = q.g[2], g3 = q.g[3];
        if constexpr (!UNI) { const float* gm = mod + (size_t)seq_of_row(row) * (6 * D) + 2 * D + col0;
            g0 = *(const f32x4*)gm; g1 = *(const f32x4*)(gm + 4); g2 = *(const f32x4*)(gm + HALF); g3 = *(const f32x4*)(gm + HALF + 4); }
        const f32x4 a = x.a + g0 * v00, b = x.b + g1 * v01, c = x.c + g2 * v10, d = x.d + g3 * v11;
        u32x4 w; w.x = pk2(a[0], a[1]); w.y = pk2(a[2], a[3]); w.z = pk2(b[0], b[1]); w.w = pk2(b[2], b[3]);
        *(u32x4*)(x1 + (size_t)row * D + col0) = w;
        w.x = pk2(c[0], c[1]); w.y = pk2(c[2], c[3]); w.z = pk2(d[0], d[1]); w.w = pk2(d[2], d[3]);
        *(u32x4*)(x1 + (size_t)row * D + col0 + HALF) = w;
    }
    EPI_WALK_LDU(4)
};
struct EpiSwiglu {
    static constexpr int HOOK_TILE = 0;
    static constexpr bool PERM = true, AFTER_DRAIN = false;
    bf16_t* act;
    __device__ __forceinline__ void rg(f32x4 v00, f32x4 v01, f32x4 v10, f32x4 v11, const Unit& u, int ai, int m, int wr, int wc, int fr, int fq) const {
        const int row = u.pm * BM + wr * 64 + fr + ai * HALF + m * 16, col0 = u.pn * HALF + wc * 32 + 8 * fq;
        float r[8];
#pragma unroll
        for (int e = 0; e < 4; ++e) { r[e] = v00[e] * sigmoidf_(v00[e]) * v10[e]; r[4 + e] = v01[e] * sigmoidf_(v01[e]) * v11[e]; }
        u32x4 w; w.x = pk2(r[0], r[1]); w.y = pk2(r[2], r[3]); w.z = pk2(r[4], r[5]); w.w = pk2(r[6], r[7]);
        *(u32x4*)(act + (size_t)row * DFF + col0) = w;
    }
    EPI_WALK()
};
struct EpiRes2 {
    static constexpr int HOOK_TILE = 0;
    static constexpr bool PERM = true, AFTER_DRAIN = false;
    const float* mod; bf16_t* x1;
    struct L { u32x4 a, b; }; struct Pre { f32x4 g[4]; };
    __device__ __forceinline__ Pre prep(const Unit& u, int wc, int fq) const {
        const float* gf = mod + (size_t)((u.pm * BM) / TP) * (6 * D) + 5 * D + u.pn * BM + wc * 32 + 8 * fq;
        return Pre{{*(const f32x4*)gf, *(const f32x4*)(gf + 4), *(const f32x4*)(gf + HALF), *(const f32x4*)(gf + HALF + 4)}};
    }
    __device__ __forceinline__ L ld(const Unit& u, int ai, int m, int wr, int wc, int fr, int fq) const {
        const int row = u.pm * BM + wr * 64 + fr + ai * HALF + m * 16, col0 = u.pn * BM + wc * 32 + 8 * fq;
        const bf16_t* o = x1 + (size_t)row * D + col0;
        return L{*(const u32x4*)o, *(const u32x4*)(o + HALF)};
    }
    template <bool UNI> __device__ __forceinline__ void fin(const L& x, const Pre& q, f32x4 v00, f32x4 v01, f32x4 v10, f32x4 v11, const Unit& u, int ai, int m, int wr, int wc, int fr, int fq) const {
        const int row = u.pm * BM + wr * 64 + fr + ai * HALF + m * 16, col0 = u.pn * BM + wc * 32 + 8 * fq;
        f32x4 g0 = q.g[0], g1 = q.g[1], g2 = q.g[2], g3 = q.g[3];
        if constexpr (!UNI) { const float* gf = mod + (size_t)seq_of_row(row) * (6 * D) + 5 * D + col0;
            g0 = *(const f32x4*)gf; g1 = *(const f32x4*)(gf + 4); g2 = *(const f32x4*)(gf + HALF); g3 = *(const f32x4*)(gf + HALF + 4); }
        bf16_t* o = x1 + (size_t)row * D + col0;
        const u32x4 xa = x.a, xb = x.b;
        u32x4 w;
        w.x = pk2(bflo(xa.x) + g0[0] * v00[0], bfhi(xa.x) + g0[1] * v00[1]); w.y = pk2(bflo(xa.y) + g0[2] * v00[2], bfhi(xa.y) + g0[3] * v00[3]);
        w.z = pk2(bflo(xa.z) + g1[0] * v01[0], bfhi(xa.z) + g1[1] * v01[1]); w.w = pk2(bflo(xa.w) + g1[2] * v01[2], bfhi(xa.w) + g1[3] * v01[3]);
        *(u32x4*)o = w;
        w.x = pk2(bflo(xb.x) + g2[0] * v10[0], bfhi(xb.x) + g2[1] * v10[1]); w.y = pk2(bflo(xb.y) + g2[2] * v10[2], bfhi(xb.y) + g2[3] * v10[3]);
        w.z = pk2(bflo(xb.z) + g3[0] * v11[0], bfhi(xb.z) + g3[1] * v11[1]); w.w = pk2(bflo(xb.w) + g3[2] * v11[2], bfhi(xb.w) + g3[3] * v11[3]);
        *(u32x4*)(o + HALF) = w;
    }
    EPI_WALK_LDU(4)
};
struct SliceOrder {
    int nM, nN, nwg, KT, R1, c, nleft, nsl, l, s;
    unsigned* cnt; float* slab;
    __device__ __forceinline__ void init(int M_, int N_, int K_, int c_, unsigned* cnt_, float* slab_) {
        nM = M_ / BM; nN = N_ / BM; nwg = nM * nN; KT = K_ / 64; c = c_; cnt = cnt_; slab = slab_;
        R1 = nwg / 256; nleft = nwg - R1 * 256; nsl = nleft ? 256 / nleft : 1; if (nsl > 8) nsl = 8;
        l = nleft ? c % nleft : 0; s = nleft ? c / nleft : nsl;
    }
    __device__ __forceinline__ int kbnd(int i) const { return i >= nsl ? KT : (((KT * i) / nsl + 1) & ~1); }
    __device__ __forceinline__ void pmpn(int L, Unit& u) const {
        int wgid = L; { const int q = nwg / pg8::NXCD, r = nwg % pg8::NXCD, xcd = wgid % pg8::NXCD, off = wgid / pg8::NXCD; wgid = (xcd < r ? xcd * (q + 1) : r * (q + 1) + (xcd - r) * q) + off; }
        const int nig = pg8::WGM * nN, gid = wgid / nig, fm = gid * pg8::WGM, gsz = (nM - fm) < pg8::WGM ? (nM - fm) : pg8::WGM;
        u.pm = fm + ((wgid % nig) % gsz); u.pn = (wgid % nig) / gsz;
    }
    __device__ __forceinline__ bool next(int i, Unit& u) const {
        if (i < R1) { pmpn(i * 256 + c, u); u.kb = 0; u.nk = KT; u.kind = 0; u.peer = 0; return true; }
        if (i == R1 && nleft && s < nsl) { pmpn(R1 * 256 + l, u); u.kb = kbnd(s); u.nk = kbnd(s + 1) - u.kb; u.kind = 3; u.peer = l; return true; }
        return false;
    }
    __device__ __forceinline__ void a_ready(const Unit&) const {}
    __device__ __forceinline__ void done(const Unit&) const {}
};

#define GAS __attribute__((address_space(1)))
#define LAS __attribute__((address_space(3)))
typedef GAS unsigned gu32;
#define RLX_AGENT __ATOMIC_RELAXED, __HIP_MEMORY_SCOPE_AGENT
#define LDS_WAIT() asm volatile("s_waitcnt lgkmcnt(0)" ::: "memory")
#define VM_WAIT() asm volatile("s_waitcnt vmcnt(0)" ::: "memory")
#define XB_TMO      128
#define XB_XCNT(j)  (256  + 64 * (j))
#define XB_XSUB(j)  (1280 + 64 * (j))
#define XB_XGEN(j)  (2304 + 64 * (j))
#define XB_TOP      3328
#define XB_TOPGEN   3392
#define XCD_BAR_WORDS 3456
#define XB_SPIN_CAP (1u << 18)

__device__ __forceinline__ unsigned xb_ld(unsigned* p)              { return __hip_atomic_load(p, __ATOMIC_RELAXED, __HIP_MEMORY_SCOPE_AGENT); }
__device__ __forceinline__ unsigned xb_add(unsigned* p, unsigned v) { return __hip_atomic_fetch_add(p, v, __ATOMIC_RELAXED, __HIP_MEMORY_SCOPE_AGENT); }
__device__ __forceinline__ unsigned xb_xcc_id() { return (unsigned)__builtin_amdgcn_s_getreg((3 << 11) | 20) & 0xFu; }
#define XB_SPIN(cond, bar) do { unsigned _sp = 0; while (cond) { __builtin_amdgcn_s_sleep(1); \
    if ((++_sp & 255u) == 0u) { if (xb_ld(&(bar)[XB_TMO])) break; if (_sp > XB_SPIN_CAP) { atomicAdd(&(bar)[XB_TMO], 1u); break; } } } } while (0)

struct XcdBarrier {
    unsigned* bar; unsigned x;
    volatile LAS unsigned* st;
};

__device__ __forceinline__ XcdBarrier xcd_barrier_post(unsigned* bar, volatile LAS unsigned* st) {
    XcdBarrier b; b.bar = bar; b.x = xb_xcc_id(); b.st = st;
    if (threadIdx.x == 0) (void)xb_add(&bar[XB_XCNT(b.x)], 1u);
    return b;
}
__device__ __forceinline__ void xcd_barrier_complete(unsigned* bar, unsigned x, unsigned& nloc, unsigned& nx) {
    const unsigned G = gridDim.x * gridDim.y * gridDim.z;
    unsigned sum, cnt, mine, sp = 0u;
    for (;;) {
        sum = 0u; cnt = 0u; mine = 0u;
#pragma unroll
        for (unsigned j = 0; j < 16; ++j) { const unsigned c = xb_ld(&bar[XB_XCNT(j)]); sum += c; cnt += (c > 0u) ? 1u : 0u; mine = (j == x) ? c : mine; }
        if (sum == G) break;
        __builtin_amdgcn_s_sleep(1);
        if ((++sp & 255u) == 0u) { if (xb_ld(&bar[XB_TMO])) break; if (sp > XB_SPIN_CAP) { atomicAdd(&bar[XB_TMO], 1u); break; } }
    }
    nloc = mine > 0u ? mine : 1u; nx = cnt > 0u ? cnt : 1u;
}

__device__ __forceinline__ void xcd_barrier(const XcdBarrier& b) {
    asm volatile("s_waitcnt vmcnt(0)" ::: "memory");
    __syncthreads();
    if (threadIdx.x == 0) {
        unsigned* bar = b.bar;
        __builtin_amdgcn_s_waitcnt(0);
        unsigned nloc = b.st[0], nx = b.st[1];
        if (nloc == 0u) { xcd_barrier_complete(bar, b.x, nloc, nx); b.st[0] = nloc; b.st[1] = nx; }
        const unsigned old = xb_add(&bar[XB_XSUB(b.x)], 1u);
        const unsigned gen = old / nloc;
        if (old + 1u == (gen + 1u) * nloc) {
            __builtin_amdgcn_fence(__ATOMIC_RELEASE, "agent");
            asm volatile("s_waitcnt vmcnt(0)" ::: "memory");
            const unsigned og = xb_add(&bar[XB_TOP], 1u);
            const unsigned tg = og / nx;
            if (og + 1u == (tg + 1u) * nx) xb_add(&bar[XB_TOPGEN], 1u);
            else XB_SPIN(xb_ld(&bar[XB_TOPGEN]) == tg, bar);
            __builtin_amdgcn_fence(__ATOMIC_ACQUIRE, "agent");
            xb_add(&bar[XB_XGEN(b.x)], 1u);
            asm volatile("s_waitcnt vmcnt(0)" ::: "memory");
        } else {
            XB_SPIN(xb_ld(&bar[XB_XGEN(b.x)]) == gen, bar);
            __builtin_amdgcn_fence(__ATOMIC_ACQUIRE, "agent");
            asm volatile("s_waitcnt vmcnt(0)" ::: "memory");
        }
    }
    __syncthreads();
}

typedef pg8::bf16x8 bf16x8;
#define MFMA16(a, b, c) __builtin_amdgcn_mfma_f32_16x16x32_bf16((a), (b), (c), 0, 0, 0)
constexpr int RB_P1 = 0, RB_RT = 2048, RB_QP = 4096, RB_RAK = 5120, RB_VM = 6144, RB_WL = 8192;

__device__ __forceinline__ f32x4 ld_bf4(const bf16_t* p) { const u32x2v w = *(const u32x2v*)p; return (f32x4){bflo(w.x), bfhi(w.x), bflo(w.y), bfhi(w.y)}; }
__device__ __forceinline__ bf16x8 mk_frag(const f32x4 a, const f32x4 b) { u32x4 w; w.x = pk2(a[0], a[1]); w.y = pk2(a[2], a[3]); w.z = pk2(b[0], b[1]); w.w = pk2(b[2], b[3]); return __builtin_bit_cast(bf16x8, w); }
__device__ __forceinline__ unsigned char* recA_ptr(const P& p, int rec) { return rec < NREC_P ? p.ws + WS_H + (size_t)rec * RECA : p.ws + WS_FRA_S + (size_t)(rec - NREC_P) * RECA; }
__device__ __forceinline__ unsigned char* recB_ptr(const P& p, int rec) { return rec < NREC_P ? (unsigned char*)p.out + (size_t)rec * RECB : p.ws + WS_FRB_S + (size_t)(rec - NREC_P) * RECB; }
__device__ __forceinline__ f32x4 sig4(f32x4 x) { return (f32x4){sigmoidf_(x[0]), sigmoidf_(x[1]), sigmoidf_(x[2]), sigmoidf_(x[3])}; }
__device__ __forceinline__ f32x4 exp4(f32x4 x) { return (f32x4){__expf(x[0]), __expf(x[1]), __expf(x[2]), __expf(x[3])}; }

template <class T> __device__ __forceinline__ T ldu(const void* ubase, unsigned voff) { return *(const T*)((const char*)ubase + voff); }
__device__ __forceinline__ f32x4 bf4(const u32x2v w) { return (f32x4){bflo(w.x), bfhi(w.x), bflo(w.y), bfhi(w.y)}; }
template <int N> __device__ __forceinline__ float row_shr(float x) {
    return __builtin_bit_cast(float, __builtin_amdgcn_update_dpp(0, __builtin_bit_cast(int, x), 0x110 + N, 0xf, 0xf, true));
}
struct ShiftCtx { const bf16_t* zrw; const float* ss; const float* mu; unsigned zoc, zop; float fv, fpz, fps; };
__device__ __forceinline__ f32x4 shift4(const ShiftCtx& k, int cu, unsigned lp) {
    const u32x2v cw = ldu<u32x2v>(k.zrw + cu, k.zoc + lp * 2u), pw = ldu<u32x2v>(k.zrw + cu, k.zop + lp * 2u);
    const f32x4 sv = ldu<f32x4>(k.ss + cu, lp * 4u), m = ldu<f32x4>(k.mu + cu, lp * 4u);
    const f32x4 cur = bf4(cw) * k.fv;
    const f32x4 pv = bf4(pw) * k.fpz + sv * k.fps;
    return cur + (pv - cur) * m;
}

struct RecCtx { ShiftCtx K; int head, c, row, i, q; bool prompt, valid; };
__device__ __forceinline__ RecCtx rec_ctx(const P& p, int rec, int lane) {
    RecCtx R;
    const int head = rec & 15, chunkid = rec >> 4;
    const bool prompt = chunkid < NPB * 128;
    const int sq = prompt ? (chunkid >> 7) : NPB + (chunkid - NPB * 128);
    const int c = prompt ? (chunkid & 127) : 0;
    const int row0 = prompt ? sq * TP + c * 16 : MP + (sq - NPB) * TS;
    const int nvalid = prompt ? 16 : TS;
    const int i = lane & 15, q = lane >> 4;
    const bool valid = i < nvalid, first = (c == 0);
    const bool pz = valid && (i > 0 || !first), ps = valid && (i == 0) && first && !prompt;
    const int row = row0 + (valid ? i : 0);
    R.K.zrw = (const bf16_t*)(p.ws + WS_ZRW); R.K.ss = p.in[3] + (size_t)(prompt ? 0 : sq - NPB) * CSH; R.K.mu = p.in[10];
    R.K.zoc = (unsigned)row * (unsigned)(CSH * 2); R.K.zop = pz ? R.K.zoc - (unsigned)(CSH * 2) : R.K.zoc; R.K.fv = valid ? 1.f : 0.f; R.K.fpz = pz ? 1.f : 0.f; R.K.fps = ps ? 1.f : 0.f;
    R.head = head; R.c = c; R.row = row; R.i = i; R.q = q; R.prompt = prompt; R.valid = valid;
    return R;
}
__device__ __forceinline__ bf16x8 lora_frag(const P& p, int rec, int f, int lane) {
    const RecCtx R = rec_ctx(p, rec, lane);
    const unsigned q8 = (unsigned)R.q * 8u;
    const int col = f < 2 ? 3072 + 32 * f : (f < 4 ? 3136 + 32 * (f - 2) : 3200 + 32 * (f - 4));
    f32x4 x0 = shift4(R.K, col, q8), x1 = shift4(R.K, col + 4, q8);
    if (f < 2) {
#pragma unroll
        for (int e = 0; e < 4; ++e) { x0[e] = 2.f * sigmoidf_(2.f * x0[e]) - 1.f; x1[e] = 2.f * sigmoidf_(2.f * x1[e]) - 1.f; }
    } else if (f >= 4) { x0 = sig4(x0); x1 = sig4(x1); }
    return mk_frag(x0, x1);
}

__device__ __forceinline__ void prep_record(const P& p, LAS unsigned char* wl, const LAS unsigned char* shf, int rec, int lane_in) {
    int lane = lane_in; asm volatile("" : "+v"(lane));
    const int head = rec & 15, chunkid = rec >> 4;
    const bool prompt = chunkid < NPB * 128;
    const int sq = prompt ? (chunkid >> 7) : NPB + (chunkid - NPB * 128);
    const int c = prompt ? (chunkid & 127) : 0;
    const int row0 = prompt ? sq * TP + c * 16 : MP + (sq - NPB) * TS;
    const int nvalid = prompt ? 16 : TS;
    const int i = lane & 15, q = lane >> 4;
    const bool valid = i < nvalid, first = (c == 0);
    const bool pz = valid && (i > 0 || !first), ps = valid && (i == 0) && first && !prompt;
    const int row = row0 + (valid ? i : 0);
    ShiftCtx K;
    K.zrw = (const bf16_t*)(p.ws + WS_ZRW); K.ss = p.in[3] + (size_t)(prompt ? 0 : sq - NPB) * CSH; K.mu = p.in[10];
    K.zoc = (unsigned)row * (unsigned)(CSH * 2); K.zop = pz ? K.zoc - (unsigned)(CSH * 2) : K.zoc; K.fv = valid ? 1.f : 0.f; K.fpz = pz ? 1.f : 0.f; K.fps = ps ? 1.f : 0.f;
    const unsigned q4 = (unsigned)q * 4u, q8 = (unsigned)q * 8u;
    const unsigned wlo64 = (unsigned)(i * 64 + q * 8) * 2u, wlo128 = (unsigned)(i * 128 + q * 8) * 2u;
    const bf16_t* WDUT = (const bf16_t*)(p.ws + WS_LORA); const bf16_t* WAUT = WDUT + RW * 64; const bf16_t* WGUT = WAUT + RW * 64;
    const f32x4 z4 = (f32x4){0.f, 0.f, 0.f, 0.f};

    f32x4 accw[4], acca[4];
#pragma unroll
    for (int ct = 0; ct < 4; ++ct) { accw[ct] = z4; acca[ct] = z4; }
#pragma unroll
    for (int s = 0; s < 2; ++s) {
        const bf16x8 td = *(const LAS bf16x8*)(shf + s * 1024 + lane * 16), ad = *(const LAS bf16x8*)(shf + (2 + s) * 1024 + lane * 16);
#pragma unroll
        for (int ct = 0; ct < 4; ++ct) {
            const int wo = (head * 64 + 16 * ct) * 64 + 32 * s;
            accw[ct] = MFMA16(ldu<bf16x8>(WDUT + wo, wlo64), td, accw[ct]);
            acca[ct] = MFMA16(ldu<bf16x8>(WAUT + wo, wlo64), ad, acca[ct]);
        }
    }
    f32x4 lw[4], av[4], ks[4];
    float ssq = 0.f;
#pragma unroll
    for (int ct = 0; ct < 4; ++ct) {
        const int cbu = head * 64 + 16 * ct;
        lw[ct] = sig4(ldu<f32x4>(p.in[11] + cbu, q4 * 4u) + accw[ct]) * (-0.6065306597126334f);
        lw[ct] = lw[ct] * K.fv;
        av[ct] = sig4(ldu<f32x4>(p.in[13] + cbu, q4 * 4u) + acca[ct]);
        ks[ct] = shift4(K, RW + cbu, q4);
        const f32x4 kk0 = ks[ct] * ldu<f32x4>(p.in[16] + cbu, q4 * 4u);
        ssq += (kk0[0] * kk0[0] + kk0[1] * kk0[1]) + (kk0[2] * kk0[2] + kk0[3] * kk0[3]);
    }
    ssq += __shfl_xor(ssq, 16); ssq += __shfl_xor(ssq, 32);
    const float kinv = __builtin_amdgcn_rcpf(fmaxf(sqrtf(ssq), 1e-12f));
    f32x4 lwc[4];
#pragma unroll
    for (int ct = 0; ct < 4; ++ct) lwc[ct] = lw[ct];
#pragma unroll
    for (int ct = 0; ct < 4; ++ct)
#pragma unroll
        for (int e = 0; e < 4; ++e) { float x = lwc[ct][e]; x += row_shr<1>(x); x += row_shr<2>(x); x += row_shr<4>(x); x += row_shr<8>(x); lwc[ct][e] = x; }
    unsigned char* rb = recB_ptr(p, rec); unsigned char* ra = recA_ptr(p, rec);
    LAS float* MT = (LAS float*)(wl + 8192);
    u32x2v kapP[4], alpP[4], ktP[4], rtP[4];
    f32x4 wl15[4];
    float bsum = 0.f;
#pragma unroll
    for (int ct = 0; ct < 4; ++ct) {
        const int cbu = head * 64 + 16 * ct;
        const f32x4 Wt = exp4(lwc[ct]), Wtm1 = exp4(lwc[ct] - lw[ct]), Winv = exp4(-lwc[ct]);
        const f32x4 kkn = ks[ct] * ldu<f32x4>(p.in[16] + cbu, q4 * 4u) * kinv;
        const f32x4 kmod = ks[ct] * ((av[ct] - 1.f) * ldu<f32x4>(p.in[17] + cbu, q4 * 4u) + 1.f);
        const f32x4 kap = kkn * Wtm1, alp = kkn * av[ct] * Winv, kt = kmod * Winv;
        const f32x4 rs = shift4(K, cbu, q4);
        const f32x4 rt = rs * Wt;
        const f32x4 rk = rs * kmod * ldu<f32x4>(p.in[18] + cbu, q4 * 4u);
        bsum += (rk[0] + rk[1]) + (rk[2] + rk[3]);
#pragma unroll
        for (int e = 0; e < 4; ++e) wl15[ct][e] = __shfl(Wt[e], 15, 16);
        kapP[ct].x = pk2(kap[0], kap[1]); kapP[ct].y = pk2(kap[2], kap[3]); alpP[ct].x = pk2(alp[0], alp[1]); alpP[ct].y = pk2(alp[2], alp[3]);
        ktP[ct].x = pk2(kt[0], kt[1]); ktP[ct].y = pk2(kt[2], kt[3]); rtP[ct].x = pk2(rt[0], rt[1]); rtP[ct].y = pk2(rt[2], rt[3]);
    }
    bsum += __shfl_xor(bsum, 16); bsum += __shfl_xor(bsum, 32);
    u32x2v c1P[4], c2P[4], vP[4];
    {
        f32x4 accg[4];
#pragma unroll
        for (int ct = 0; ct < 4; ++ct) accg[ct] = z4;
#pragma unroll
        for (int s = 0; s < 4; ++s) {
            const bf16x8 gd = *(const LAS bf16x8*)(shf + (4 + s) * 1024 + lane * 16);
#pragma unroll
            for (int ct = 0; ct < 4; ++ct) accg[ct] = MFMA16(ldu<bf16x8>(WGUT + (head * 64 + 16 * ct) * 128 + 32 * s, wlo128), gd, accg[ct]);
        }
#pragma unroll
        for (int ct = 0; ct < 4; ++ct) {
            const int cbu = head * 64 + 16 * ct;
            const f32x4 c1 = ldu<f32x4>(p.in[19] + cbu, q4 * 4u) * accg[ct];
            const f32x4 vsf = shift4(K, 2 * RW + cbu, q4);
            const f32x4 c2 = (ldu<f32x4>(p.in[20] + cbu, q4 * 4u) + vsf * bsum) * accg[ct];
            c1P[ct].x = pk2(c1[0], c1[1]); c1P[ct].y = pk2(c1[2], c1[3]); c2P[ct].x = pk2(c2[0], c2[1]); c2P[ct].y = pk2(c2[2], c2[3]);
            vP[ct].x = pk2(vsf[0], vsf[1]); vP[ct].y = pk2(vsf[2], vsf[3]);
        }
    }
    bf16x8 kapF[2], alpF[2], ktF[2], rtF[2];
#pragma unroll
    for (int s = 0; s < 2; ++s) {
        kapF[s] = __builtin_bit_cast(bf16x8, (u32x4){kapP[2 * s].x, kapP[2 * s].y, kapP[2 * s + 1].x, kapP[2 * s + 1].y});
        alpF[s] = __builtin_bit_cast(bf16x8, (u32x4){alpP[2 * s].x, alpP[2 * s].y, alpP[2 * s + 1].x, alpP[2 * s + 1].y});
        ktF[s] = __builtin_bit_cast(bf16x8, (u32x4){ktP[2 * s].x, ktP[2 * s].y, ktP[2 * s + 1].x, ktP[2 * s + 1].y});
        rtF[s] = __builtin_bit_cast(bf16x8, (u32x4){rtP[2 * s].x, rtP[2 * s].y, rtP[2 * s + 1].x, rtP[2 * s + 1].y});
    }
    u32x2v kapT[4], alpT[4], ktT[4], vT[4];
    {
        unsigned iw0 = 0u, iw1 = 0u;
        if ((i >> 2) == q) { const unsigned one = 0x3F80u << (16 * (i & 1)); if ((i & 3) < 2) iw0 = one; else iw1 = one; }
        const bf16x8 IdA = __builtin_bit_cast(bf16x8, (u32x4){iw0, iw1, 0u, 0u}), IdB = __builtin_bit_cast(bf16x8, (u32x4){0u, 0u, iw0, iw1});
        bf16x8 vF[2];
#pragma unroll
        for (int s = 0; s < 2; ++s) vF[s] = __builtin_bit_cast(bf16x8, (u32x4){vP[2 * s].x, vP[2 * s].y, vP[2 * s + 1].x, vP[2 * s + 1].y});
#pragma unroll
        for (int nt = 0; nt < 4; ++nt) {
            const bf16x8 id = (nt & 1) ? IdB : IdA;
            const f32x4 a = MFMA16(kapF[nt >> 1], id, z4), b = MFMA16(alpF[nt >> 1], id, z4), c3 = MFMA16(ktF[nt >> 1], id, z4), d = MFMA16(vF[nt >> 1], id, z4);
            kapT[nt].x = pk2(a[0], a[1]); kapT[nt].y = pk2(a[2], a[3]); alpT[nt].x = pk2(b[0], b[1]); alpT[nt].y = pk2(b[2], b[3]);
            ktT[nt].x = pk2(c3[0], c3[1]); ktT[nt].y = pk2(c3[2], c3[3]); vT[nt].x = pk2(d[0], d[1]); vT[nt].y = pk2(d[2], d[3]);
        }
    }
    f32x4 Maa = z4, Mak = z4, RAt = z4, RKt = z4;
#pragma unroll
    for (int s = 0; s < 2; ++s) {
        Maa = MFMA16(kapF[s], alpF[s], Maa); Mak = MFMA16(kapF[s], ktF[s], Mak);
        RAt = MFMA16(alpF[s], rtF[s], RAt); RKt = MFMA16(ktF[s], rtF[s], RKt);
    }
#pragma unroll
    for (int r = 0; r < 4; ++r) { const int rw_ = 4 * q + r;
        if (!(rw_ > i)) { Maa[r] = 0.f; Mak[r] = 0.f; }
        if (!(i >= rw_)) { RAt[r] = 0.f; RKt[r] = 0.f; } }
    *(LAS f32x4*)(MT + i * 16 + 4 * q) = Maa;
    u32x4 rakW; rakW.x = pk2(RAt[0], RAt[1]); rakW.y = pk2(RAt[2], RAt[3]); rakW.z = pk2(RKt[0], RKt[1]); rakW.w = pk2(RKt[2], RKt[3]);
    LDS_WAIT(); asm volatile("" ::: "memory");
    float t[16];
#pragma unroll
    for (int cc = 15; cc >= 0; --cc) {
        float acc = (i == cc) ? 1.f : 0.f;
        f32x4 mrow[4];
#pragma unroll
        for (int b = 0; b < 4; ++b) mrow[b] = *(const LAS f32x4*)(MT + cc * 16 + 4 * b);
#pragma unroll
        for (int j = cc + 1; j < 16; ++j) acc -= t[j] * mrow[j >> 2][j & 3];
        t[cc] = acc;
    }
    f32x4 tsel;
#pragma unroll
    for (int e = 0; e < 4; ++e) tsel[e] = -(q == 0 ? t[e] : (q == 1 ? t[4 + e] : (q == 2 ? t[8 + e] : t[12 + e])));
    const bf16x8 Tfrag = mk_frag(tsel, z4);
    f32x4 P1E[4];
#pragma unroll
    for (int ct = 0; ct < 4; ++ct) { u32x4 aw; aw.x = kapT[ct].x; aw.y = kapT[ct].y; aw.z = 0u; aw.w = 0u; P1E[ct] = MFMA16(__builtin_bit_cast(bf16x8, aw), Tfrag, z4); }
    *(u32x4*)(rb + RB_RT + lane * 16) = __builtin_bit_cast(u32x4, rtF[0]); *(u32x4*)(rb + RB_RT + 1024 + lane * 16) = __builtin_bit_cast(u32x4, rtF[1]);
    *(u32x4*)(rb + RB_RAK + lane * 16) = rakW;
#pragma unroll
    for (int ct = 0; ct < 4; ++ct) {
        if (i == 0) *(f32x4*)(rb + RB_WL + (16 * ct + 4 * q) * 4) = wl15[ct];
        if (valid) { const int cbu = head * 64 + 16 * ct;
            *(u32x2v*)((char*)((bf16_t*)(p.ws + WS_OA) + cbu) + ((unsigned)row * (2 * RW) + q4) * 2u) = c1P[ct];
            *(u32x2v*)((char*)((bf16_t*)(p.ws + WS_C2) + cbu) + ((unsigned)row * RW + q4) * 2u) = c2P[ct]; }
    }
    *(u32x4*)(rb + RB_P1 + lane * 16) = __builtin_bit_cast(u32x4, mk_frag(P1E[0], P1E[1]));
    *(u32x4*)(rb + RB_P1 + 1024 + lane * 16) = __builtin_bit_cast(u32x4, mk_frag(P1E[2], P1E[3]));
    { const f32x4 Qt = MFMA16(mk_frag(Mak, z4), Tfrag, z4);
      u32x4 w; w.x = 0u; w.y = 0u; w.z = pk2(Qt[0], Qt[1]); w.w = pk2(Qt[2], Qt[3]); *(u32x4*)(rb + RB_QP + lane * 16) = w; }
#pragma unroll
    for (int tt = 0; tt < 4; ++tt) {
        u32x4 w; w.x = alpT[tt].x; w.y = alpT[tt].y; w.z = ktT[tt].x; w.w = ktT[tt].y; *(u32x4*)(ra + tt * 1024 + lane * 16) = w;
        *(u32x2v*)(rb + RB_VM + tt * 512 + lane * 8) = vT[tt];
    }
    LDS_WAIT(); asm volatile("" ::: "memory");
}

struct ScanFr { bf16x8 P10, P11, RT0, RT1, QP, RAK, AK0, AK1, AK2, AK3; u32x2v vm; f32x4 WL0, WL1, WL2, WL3; };
__device__ __forceinline__ void scan_load(ScanFr& f, const P& p, int rec, int vs, int lane) {
    const unsigned char* ra = recA_ptr(p, rec); const unsigned char* rb = recB_ptr(p, rec);
    const unsigned l16 = (unsigned)lane * 16u, q16 = (unsigned)(lane >> 4) * 16u;
    f.P10 = ldu<bf16x8>(rb + RB_P1, l16); f.P11 = ldu<bf16x8>(rb + RB_P1 + 1024, l16);
    f.RT0 = ldu<bf16x8>(rb + RB_RT, l16); f.RT1 = ldu<bf16x8>(rb + RB_RT + 1024, l16);
    f.QP = ldu<bf16x8>(rb + RB_QP, l16); f.RAK = ldu<bf16x8>(rb + RB_RAK, l16);
    f.vm = ldu<u32x2v>(rb + RB_VM + vs * 512, (unsigned)lane * 8u);
    f.AK0 = ldu<bf16x8>(ra, l16); f.AK1 = ldu<bf16x8>(ra + 1024, l16); f.AK2 = ldu<bf16x8>(ra + 2048, l16); f.AK3 = ldu<bf16x8>(ra + 3072, l16);
    f.WL0 = ldu<f32x4>(rb + RB_WL, q16); f.WL1 = ldu<f32x4>(rb + RB_WL + 64, q16); f.WL2 = ldu<f32x4>(rb + RB_WL + 128, q16); f.WL3 = ldu<f32x4>(rb + RB_WL + 192, q16);
}
template <int NS>
__device__ __forceinline__ void scan_step(const ScanFr& f, const u32x2v (&vm)[NS], f32x4 (&St)[NS][4], bf16_t* oraw, int c, int q, bool prompt) {
    const f32x4 z4 = (f32x4){0.f, 0.f, 0.f, 0.f};
#pragma unroll
    for (int i = 0; i < NS; ++i) {
        const bf16x8 SB0 = mk_frag(St[i][0], St[i][1]), SB1 = mk_frag(St[i][2], St[i][3]);
        u32x4 vw; vw.x = 0u; vw.y = 0u; vw.z = vm[i].x; vw.w = vm[i].y;
        f32x4 U = MFMA16(f.QP, __builtin_bit_cast(bf16x8, vw), z4);
        U = MFMA16(f.P10, SB0, U); U = MFMA16(f.P11, SB1, U);
        u32x4 uw; uw.x = pk2(U[0], U[1]); uw.y = pk2(U[2], U[3]); uw.z = vm[i].x; uw.w = vm[i].y;
        const bf16x8 UB = __builtin_bit_cast(bf16x8, uw);
        f32x4 O = MFMA16(f.RT0, SB0, z4); O = MFMA16(f.RT1, SB1, O); O = MFMA16(f.RAK, UB, O);
        St[i][0] = MFMA16(f.AK0, UB, St[i][0]) * f.WL0; St[i][1] = MFMA16(f.AK1, UB, St[i][1]) * f.WL1;
        St[i][2] = MFMA16(f.AK2, UB, St[i][2]) * f.WL2; St[i][3] = MFMA16(f.AK3, UB, St[i][3]) * f.WL3;
#pragma unroll
        for (int r = 0; r < 4; ++r) { const int tk = 4 * q + r; if (prompt || tk < TS) oraw[(size_t)(16 * c + tk) * RW + 16 * i] = f2bf(O[r]); }
    }
}
__device__ __forceinline__ void scan_chain_prompt(const P& p, int sq, int head, int vp, int lane, volatile LAS unsigned* prog) {
    constexpr int nch = TP / 16;
    const int rec0 = sq * nch * NH + head, vl = lane & 15, q = lane >> 4;
    f32x4 St[2][4];
    float* sout = p.out + O_WKVP + ((size_t)sq * NH + head) * HS * HS + (size_t)(32 * vp + vl) * HS + 4 * q;
    bf16_t* oraw = (bf16_t*)(p.ws + WS_ZRW) + (size_t)(sq * TP) * RW + head * HS + 32 * vp + vl;
    ScanFr f0, f1, f2; u32x2v v0[2], v1[2], v2[2];
#define SCAN_LD(f, v, cc) do { const int rec_ = rec0 + (cc) * NH; scan_load(f, p, rec_, 2 * vp, lane); v[0] = f.vm; v[1] = ldu<u32x2v>(recB_ptr(p, rec_) + RB_VM + (2 * vp + 1) * 512, (unsigned)lane * 8u); } while (0)
    SCAN_LD(f0, v0, 0); SCAN_LD(f1, v1, 1); SCAN_LD(f2, v2, 2);
#pragma unroll
    for (int i = 0; i < 2; ++i)
#pragma unroll
        for (int t = 0; t < 4; ++t) St[i][t] = (f32x4){0.f, 0.f, 0.f, 0.f};
    const bool pw = vp == 0 && lane == 0;
    int c = 0;
    for (; c + 3 <= nch; c += 3) {
        if (pw) *prog = (unsigned)c;
        scan_step<2>(f0, v0, St, oraw, c, q, true);     SCAN_LD(f0, v0, c + 3 < nch ? c + 3 : nch - 1);
        scan_step<2>(f1, v1, St, oraw, c + 1, q, true); SCAN_LD(f1, v1, c + 4 < nch ? c + 4 : nch - 1);
        scan_step<2>(f2, v2, St, oraw, c + 2, q, true); SCAN_LD(f2, v2, c + 5 < nch ? c + 5 : nch - 1);
    }
    if (c < nch) { scan_step<2>(f0, v0, St, oraw, c, q, true); ++c; }
    if (c < nch) { scan_step<2>(f1, v1, St, oraw, c, q, true); }
#undef SCAN_LD
#pragma unroll
    for (int i = 0; i < 2; ++i)
#pragma unroll
        for (int t = 0; t < 4; ++t) *(f32x4*)(sout + (size_t)(16 * i) * HS + 16 * t) = St[i][t];
}
struct SampleTask { ScanFr f; f32x4 St[4]; };
__device__ __forceinline__ void sample_load(SampleTask& t, const P& p, int j, int lane) {
    const int s = j >> 6, head = (j >> 2) & 15, vs = j & 3, vl = lane & 15, q = lane >> 4;
    scan_load(t.f, p, NREC_P + s * NH + head, vs, lane);
    const float* sin = p.in[2] + ((size_t)s * NH + head) * HS * HS + (size_t)(16 * vs + vl) * HS + 4 * q;
#pragma unroll
    for (int tt = 0; tt < 4; ++tt) t.St[tt] = *(const f32x4*)(sin + 16 * tt);
}
__device__ __forceinline__ void sample_run(SampleTask& t, const P& p, int j, int lane) {
    const int s = j >> 6, head = (j >> 2) & 15, vs = j & 3, vl = lane & 15, q = lane >> 4;
    f32x4 St[1][4]; u32x2v vm[1]; vm[0] = t.f.vm;
#pragma unroll
    for (int tt = 0; tt < 4; ++tt) St[0][tt] = t.St[tt];
    scan_step<1>(t.f, vm, St, (bf16_t*)(p.ws + WS_ZRW) + (size_t)(MP + s * TS) * RW + head * HS + 16 * vs + vl, 0, q, false);
    float* sout = p.out + O_WKVS + ((size_t)s * NH + head) * HS * HS + (size_t)(16 * vs + vl) * HS + 4 * q;
#pragma unroll
    for (int tt = 0; tt < 4; ++tt) *(f32x4*)(sout + 16 * tt) = St[0][tt];
}
__device__ __forceinline__ void scan_samples(const P& p, int j0, int stride, int lane) {
    constexpr int NT = NSB * NH * 4;
    if (j0 >= NT) return;
    SampleTask a, b;
    sample_load(a, p, j0, lane);
    for (int j = j0;;) {
        const int jb = j + stride; const bool hb = jb < NT;
        if (hb) sample_load(b, p, jb, lane);
        sample_run(a, p, j, lane);
        if (!hb) break;
        const int ja = jb + stride; const bool ha = ja < NT;
        if (ha) sample_load(a, p, ja, lane);
        sample_run(b, p, jb, lane);
        if (!ha) break;
        j = ja;
    }
}

constexpr int SCAN_AHEAD = 10;
__device__ __forceinline__ void scan_prefetch(const P& p, volatile LAS unsigned* prog, int sq, int head, int k, int lane) {
    const int rec0 = sq * (TP / 16) * NH + head;
    const unsigned l16 = (unsigned)lane * 16u;
    for (int c = k; c < TP / 16; c += 2) {
        while ((int)*prog < c - SCAN_AHEAD) __builtin_amdgcn_s_sleep(8);
        const unsigned char* ra = recA_ptr(p, rec0 + c * NH); const unsigned char* rb = recB_ptr(p, rec0 + c * NH);
        u32x4 x[12];
#pragma unroll
        for (int j = 0; j < 4; ++j) x[j] = ldu<u32x4>(ra + j * 1024, l16);
#pragma unroll
        for (int j = 0; j < 8; ++j) x[4 + j] = ldu<u32x4>(rb + j * 1024, l16);
        const u32x4 y = ldu<u32x4>(rb + 8192, (unsigned)(lane & 15) * 16u);
#pragma unroll
        for (int j = 0; j < 12; ++j) asm volatile("" :: "v"(x[j].x));
        asm volatile("" :: "v"(y.x));
    }
}

__device__ __forceinline__ void mix_item(const P& p, int item, int wave, int lane) {
    const int g = item & 7, row0 = (item >> 3) * 128;
    const int dl = lane & 15, q = lane >> 4, col = g * 128 + wave * 16;
    const bf16_t* vn = (const bf16_t*)(p.ws + WS_VN) + (size_t)row0 * MLPW + col + dl;
    bf16x8 A[4];
#pragma unroll
    for (int sb = 0; sb < 4; ++sb)
#pragma unroll
        for (int j = 0; j < 8; ++j) A[sb][j] = (short)vn[(size_t)(32 * sb + 8 * q + j) * MLPW];
    const float* wsg = p.in[23] + ((size_t)g * 128 + dl) * 128 + 8 * q;
    const bf16_t* zu = (const bf16_t*)(p.ws + WS_ZUG) + (size_t)(row0 + dl) * ZUGW + ZU_U + col + 4 * q;
    bf16_t* ub = (bf16_t*)(p.ws + WS_OA) + (size_t)(row0 + dl) * (2 * RW) + RW + col + 4 * q;
    u32x2v res[8];
#pragma unroll
    for (int tt = 0; tt < 8; ++tt) {
        const int t = 16 * tt + dl;
        f32x4 acc = (f32x4){0.f, 0.f, 0.f, 0.f};
#pragma unroll
        for (int sb = 0; sb <= tt / 2; ++sb) {
            const float* wr = wsg + (size_t)(16 * tt) * 128 + 32 * sb;
            f32x4 w0 = *(const f32x4*)wr, w1 = *(const f32x4*)(wr + 4);
            if (sb == tt / 2) {
#pragma unroll
                for (int e = 0; e < 4; ++e) { if (32 * sb + 8 * q + e > t) w0[e] = 0.f; if (32 * sb + 8 * q + 4 + e > t) w1[e] = 0.f; }
            }
            acc = MFMA16(A[sb], mk_frag(w0, w1), acc);
        }
        const float bias = p.in[24][g * 128 + t];
        const f32x4 u = ld_bf4(zu + (size_t)(16 * tt) * ZUGW);
        const f32x4 o = (acc + bias) * u;
        res[tt].x = pk2(o[0], o[1]); res[tt].y = pk2(o[2], o[3]);
    }
#pragma unroll
    for (int tt = 0; tt < 8; ++tt) *(u32x2v*)(ub + (size_t)(16 * tt) * (2 * RW)) = res[tt];
}

__device__ __forceinline__ void post_rows(const P& p, int gw, int NGW, int lane) {
    const bf16_t* oraw = (const bf16_t*)(p.ws + WS_ZRW);
    const int r0 = (int)(((long long)gw * M) / NGW), r1 = (int)(((long long)(gw + 1) * M) / NGW);
    for (int rowa = r0; rowa < r1; rowa += 2) {
        u32x4 ow[2][2], c1[2][2], c2[2][2];
#pragma unroll
        for (int k = 0; k < 2; ++k) {
            const int row = rowa + k < r1 ? rowa + k : rowa;
            const size_t off = (size_t)row * RW + lane * 16;
            const bf16_t* oa = (const bf16_t*)(p.ws + WS_OA) + (size_t)row * (2 * RW) + lane * 16; const bf16_t* c2p = (const bf16_t*)(p.ws + WS_C2) + off;
#pragma unroll
            for (int h = 0; h < 2; ++h) { ow[k][h] = *(const u32x4*)(oraw + off + 8 * h); c1[k][h] = *(const u32x4*)(oa + 8 * h); c2[k][h] = *(const u32x4*)(c2p + 8 * h); }
        }
#pragma unroll
        for (int k = 0; k < 2; ++k) {
            if (rowa + k >= r1) break;
            const int row = rowa + k;
            f32x4 o[4]; float s = 0.f;
#pragma unroll
            for (int h = 0; h < 2; ++h) { const u32x4 x = ow[k][h]; o[2 * h] = (f32x4){bflo(x.x), bfhi(x.x), bflo(x.y), bfhi(x.y)}; o[2 * h + 1] = (f32x4){bflo(x.z), bfhi(x.z), bflo(x.w), bfhi(x.w)}; }
#pragma unroll
            for (int j = 0; j < 4; ++j) s += (o[j][0] + o[j][1]) + (o[j][2] + o[j][3]);
            s += __shfl_xor(s, 1); s += __shfl_xor(s, 2);
            const float mean = s * (1.f / HS); float qv = 0.f;
#pragma unroll
            for (int j = 0; j < 4; ++j) { o[j] = o[j] - mean; qv += (o[j][0] * o[j][0] + o[j][1] * o[j][1]) + (o[j][2] * o[j][2] + o[j][3] * o[j][3]); }
            qv += __shfl_xor(qv, 1); qv += __shfl_xor(qv, 2);
            const float rstd = rsqrtf(qv * (1.f / HS) + 64e-5f);
            bf16_t* oa = (bf16_t*)(p.ws + WS_OA) + (size_t)row * (2 * RW) + lane * 16;
#pragma unroll
            for (int h = 0; h < 2; ++h) {
                const u32x4 a1 = c1[k][h], a2 = c2[k][h];
                const f32x4 a = o[2 * h] * rstd, b = o[2 * h + 1] * rstd;
                u32x4 w;
                w.x = pk2(a[0] * bflo(a1.x) + bflo(a2.x), a[1] * bfhi(a1.x) + bfhi(a2.x)); w.y = pk2(a[2] * bflo(a1.y) + bflo(a2.y), a[3] * bfhi(a1.y) + bfhi(a2.y));
                w.z = pk2(b[0] * bflo(a1.z) + bflo(a2.z), b[1] * bfhi(a1.z) + bfhi(a2.z)); w.w = pk2(b[2] * bflo(a1.w) + bflo(a2.w), b[3] * bfhi(a1.w) + bfhi(a2.w));
                *(u32x4*)(oa + 8 * h) = w;
            }
        }
    }
}

constexpr int NWAVES = 8, NTHR = NWAVES * 64;
constexpr int RING_BYTES = 131072, LDSCTL_OFF = RING_BYTES, MISC_OFF = LDSCTL_OFF + 320, LDS_BYTES = 147456;

__device__ __forceinline__ void p0_mod_slab(const P& p, LAS unsigned char* lds, int slab, int tid, int lane, int wave) {
    LAS float* red = (LAS float*)(lds + 3 * 27648);
    LAS float* Bl = (LAS float*)(lds + wave * 12288);
    const int n0 = slab * 48, fr = lane & 15, fq = lane >> 4;
    const float* W = p.in[6] + n0;
    f32x4 acc[9][3];
#pragma unroll
    for (int a = 0; a < 9; ++a)
#pragma unroll
        for (int b = 0; b < 3; ++b) acc[a][b] = (f32x4){0.f, 0.f, 0.f, 0.f};
    for (int sc = 0; sc < 4; ++sc) {
        const int kb0 = ((wave + (slab >> 1)) & 7) * 256 + ((sc + (slab >> 4)) & 3) * 64;
        f32x4 v[12];
        int ln = lane; asm volatile("" : "+v"(ln));
        const float* Wk = W + (size_t)kb0 * (6 * D);
        { int r = ln / 12, c4 = ln - r * 12;
#pragma unroll
          for (int t = 0; t < 12; ++t) { v[t] = ldu<f32x4>(Wk, (unsigned)(r * (6 * D) + 4 * c4) * 4u); c4 += 4; r += 5; if (c4 >= 12) { c4 -= 12; r += 1; } } }
        { int r = ln / 12, c4 = ln - r * 12;
#pragma unroll
          for (int t = 0; t < 12; ++t) { *(LAS f32x4*)(Bl + r * 48 + 4 * c4) = v[t]; c4 += 4; r += 5; if (c4 >= 12) { c4 -= 12; r += 1; } } }
        LDS_WAIT(); asm volatile("" ::: "memory");
#pragma unroll
        for (int kb2 = 0; kb2 < 2; ++kb2) {
            const int k0 = kb0 + kb2 * 32 + fq * 8;
            bf16x8 bfr[3];
#pragma unroll
            for (int nt = 0; nt < 3; ++nt) { const LAS float* bp = Bl + (kb2 * 32 + fq * 8) * 48 + nt * 16 + fr;
                u32x4 w; w.x = pk2(bp[0], bp[48]); w.y = pk2(bp[96], bp[144]); w.z = pk2(bp[192], bp[240]); w.w = pk2(bp[288], bp[336]);
                bfr[nt] = __builtin_bit_cast(bf16x8, w); }
            const bf16_t* sil = (const bf16_t*)(p.ws + WS_SILU) + (size_t)fr * D + k0;
            bf16x8 afr[9];
#pragma unroll
            for (int mt = 0; mt < 9; ++mt) afr[mt] = *(const bf16x8*)(sil + (size_t)(mt * 16) * D);
#pragma unroll
            for (int mt = 0; mt < 9; ++mt)
#pragma unroll
                for (int nt = 0; nt < 3; ++nt) acc[mt][nt] = __builtin_amdgcn_mfma_f32_16x16x32_bf16(afr[mt], bfr[nt], acc[mt][nt], 0, 0, 0);
        }
        LDS_WAIT(); asm volatile("" ::: "memory");
    }
    __syncthreads();
#pragma unroll
    for (int half = 4; half >= 1; half >>= 1) {
        LAS float* buf = (LAS float*)(lds + (wave & (half - 1)) * 27648);
        if (wave >= half && wave < 2 * half) {
#pragma unroll
            for (int mt = 0; mt < 9; ++mt)
#pragma unroll
                for (int nt = 0; nt < 3; ++nt) *(LAS f32x4*)(buf + ((mt * 3 + nt) * 64 + lane) * 4) = acc[mt][nt];
        }
        __syncthreads();
        if (wave < half) {
#pragma unroll
            for (int mt = 0; mt < 9; ++mt)
#pragma unroll
                for (int nt = 0; nt < 3; ++nt) acc[mt][nt] += *(const LAS f32x4*)(buf + ((mt * 3 + nt) * 64 + lane) * 4);
        }
        __syncthreads();
    }
    if (wave == 0) {
#pragma unroll
        for (int mt = 0; mt < 9; ++mt)
#pragma unroll
            for (int nt = 0; nt < 3; ++nt)
#pragma unroll
                for (int r = 0; r < 4; ++r) red[(mt * 16 + 4 * fq + r) * 48 + nt * 16 + fr] = acc[mt][nt][r];
    }
    __syncthreads();
    float* mod = (float*)(p.ws + WS_MOD);
    for (int i = tid; i < NSEQ * 48; i += NTHR) { const int row = i / 48, c = i % 48; mod[(size_t)row * (6 * D) + n0 + c] = red[row * 48 + c] + p.in[7][n0 + c]; }
    __syncthreads();
}
__device__ __forceinline__ void p0_silu(const P& p, int gt, int NT) {
    const __amdgpu_buffer_rsrc_t rs = __builtin_amdgcn_make_buffer_rsrc(p.ws + WS_SILU, 0, 144 * D * 2, 0x00020000);
    for (int i = gt; i < 144 * D / 4; i += NT) {
        const int row = i / (D / 4), k = (i - row * (D / 4)) * 4;
        f32x4 v = (f32x4){0.f, 0.f, 0.f, 0.f};
        if (row < NSEQ) { v = *(const f32x4*)((row < NPB ? p.in[4] + (size_t)row * D : p.in[5] + (size_t)(row - NPB) * D) + k);
#pragma unroll
            for (int e = 0; e < 4; ++e) v[e] = v[e] * sigmoidf_(v[e]); }
        u32x2v w; w.x = pk2(v[0], v[1]); w.y = pk2(v[2], v[3]);
        __builtin_amdgcn_raw_buffer_store_b64(w, rs, (unsigned)(row * D + k) * 2u, 0, 16);
    }
}
struct TJob { const float* W; bf16_t* WT; int K, N, ldw, kofs, item; int swz; };
__device__ __forceinline__ void tr_load(const TJob& j, float (&tv)[32], int lane) {
    const int nblk = j.N / 32, kb = j.item / nblk, nb = j.item - kb * nblk;
    const float* w = j.W + (size_t)(64 * kb) * j.N + 32 * nb;
    const unsigned lo = (unsigned)((lane >> 5) * j.N + (lane & 31)) * 4u, rs2 = (unsigned)j.N * 8u;
#pragma unroll
    for (int i = 0; i < 32; ++i) tv[i] = ldu<float>(w, lo + (unsigned)i * rs2);
}
__device__ __forceinline__ void tr_store(const TJob& j, const float (&tv)[32], LAS float* scr, int lane) {
    const int nblk = j.N / 32, kb = j.item / nblk, nb = j.item - kb * nblk, k0 = 64 * kb, n0 = 32 * nb;
    int r0 = n0;
    if (j.swz == 1) { r0 = n0 < DFF ? 256 * (n0 >> 7) + (n0 & 127) : 256 * ((n0 - DFF) >> 7) + 128 + ((n0 - DFF) & 127); }
    else if (j.swz == 2 && n0 >= C_G0) { const int g = n0 - C_G0; r0 = g < D ? C_G0 + 256 * (g >> 7) + (g & 127) : C_G0 + 256 * ((g - D) >> 7) + 128 + ((g - D) & 127); }
#pragma unroll
    for (int i = 0; i < 32; ++i) scr[(2 * i + (lane >> 5)) * 33 + (lane & 31)] = tv[i];
    LDS_WAIT(); asm volatile("" ::: "memory");
    const int c = lane & 7;
#pragma unroll
    for (int jj = 0; jj < 4; ++jj) { const int n = (lane >> 3) + 8 * jj; const LAS float* s = scr + (8 * c) * 33 + n;
        u32x4 o; o.x = pk2(s[0 * 33], s[1 * 33]); o.y = pk2(s[2 * 33], s[3 * 33]); o.z = pk2(s[4 * 33], s[5 * 33]); o.w = pk2(s[6 * 33], s[7 * 33]);
        *(u32x4*)(j.WT + (size_t)(r0 + n) * j.ldw + j.kofs + k0 + 8 * c) = o; }
    LDS_WAIT(); asm volatile("" ::: "memory");
}
__device__ __forceinline__ bool tr_job(const P& p, int part, int it, TJob& j) {
    constexpr int I_IN = (D / 64) * (CIN / 32), I_BA = (RW / 64) * (D / 32), I_OUT = (D / 64) * (D / 32), I_FI = (D / 64) * (2 * DFF / 32), I_FO = (DFF / 64) * (D / 32);
    constexpr int I_L64 = (RW / 32), I_L128 = 2 * (RW / 32);
    unsigned char* ws = p.ws; int r = it;
    j.swz = 0; j.kofs = 0;
    if (part == 0) {
        if (r < I_IN) { j.W = p.in[9]; j.WT = (bf16_t*)(ws + WS_WIN); j.K = D; j.N = CIN; j.ldw = D; j.item = r; j.swz = 2; return true; } r -= I_IN;
        if (r < I_L64) { j.W = p.in[12]; j.WT = (bf16_t*)(ws + WS_LORA); j.K = 64; j.N = RW; j.ldw = 64; j.item = r; return true; } r -= I_L64;
        if (r < I_L64) { j.W = p.in[14]; j.WT = (bf16_t*)(ws + WS_LORA) + RW * 64; j.K = 64; j.N = RW; j.ldw = 64; j.item = r; return true; } r -= I_L64;
        if (r < I_L128) { j.W = p.in[15]; j.WT = (bf16_t*)(ws + WS_LORA) + 2 * RW * 64; j.K = 128; j.N = RW; j.ldw = 128; j.item = r; return true; } r -= I_L128;
        if (r < I_BA) { j.W = p.in[25]; j.WT = (bf16_t*)(ws + WS_WBA); j.K = RW; j.N = D; j.ldw = 2 * RW; j.item = r; return true; } r -= I_BA;
        if (r < I_BA) { j.W = p.in[26]; j.WT = (bf16_t*)(ws + WS_WBA); j.K = RW; j.N = D; j.ldw = 2 * RW; j.kofs = RW; j.item = r; return true; } r -= I_BA;
        if (r < I_OUT) { j.W = p.in[27]; j.WT = (bf16_t*)(ws + WS_WOUT); j.K = D; j.N = D; j.ldw = D; j.item = r; return true; } r -= I_OUT;
        return false;
    } else if (part == 1) {
        if (r < I_FI) { j.W = p.in[29]; j.WT = (bf16_t*)(ws + WS_WFI); j.K = D; j.N = 2 * DFF; j.ldw = D; j.swz = 1; j.item = r; return true; } r -= I_FI;
        if (r < I_FO) { j.W = p.in[30]; j.WT = (bf16_t*)(ws + WS_WFO); j.K = DFF; j.N = D; j.ldw = DFF; j.item = r; return true; }
        return false;
    } else {
        if (r < I_FO) { j.W = p.in[30]; j.WT = (bf16_t*)(ws + WS_WFO); j.K = DFF; j.N = D; j.ldw = DFF; j.item = r; return true; }
        return false;
    }
}
__device__ __forceinline__ void p0_transposes(const P& p, LAS float* scr, int part, int gw, int NGW, int lane) {
    TJob ja, jb; float ta[32], tb[32];
    int it = gw;
    if (!tr_job(p, part, it, ja)) return;
    tr_load(ja, ta, lane);
    for (;;) {
        const bool hb = tr_job(p, part, it + NGW, jb);
        if (hb) tr_load(jb, tb, lane);
        tr_store(ja, ta, scr, lane);
        if (!hb) break;
        const bool ha = tr_job(p, part, it + 2 * NGW, ja);
        if (ha) tr_load(ja, ta, lane);
        tr_store(jb, tb, scr, lane);
        if (!ha) break;
        it += 2 * NGW;
    }
}
__device__ __forceinline__ void tr64_load(const TJob& j, f32x4 (&tv)[16], int lane) {
    const int nblk = j.N / 64, kb = j.item / nblk, nb = j.item - kb * nblk;
    const float* w = j.W + (size_t)(64 * kb) * j.N + 64 * nb;
    const unsigned lo = (unsigned)((lane >> 4) * j.N + 4 * (lane & 15)) * 4u, rs4 = (unsigned)j.N * 16u;
#pragma unroll
    for (int t = 0; t < 16; ++t) tv[t] = ldu<f32x4>(w, lo + (unsigned)t * rs4);
}
__device__ __forceinline__ void tr64_store(const TJob& j, const f32x4 (&tv)[16], LAS float* scr, int lane) {
    const int nblk = j.N / 64, kb = j.item / nblk, nb = j.item - kb * nblk, k0 = 64 * kb, n0 = 64 * nb;
    int r0 = n0;
    if (j.swz == 1) { r0 = n0 < DFF ? 256 * (n0 >> 7) + (n0 & 127) : 256 * ((n0 - DFF) >> 7) + 128 + ((n0 - DFF) & 127); }
#pragma unroll
    for (int t = 0; t < 16; ++t) { const int k = 4 * t + (lane >> 4); *(LAS f32x4*)(scr + k * 64 + (((lane & 15) ^ ((k >> 3) & 7)) << 2)) = tv[t]; }
    LDS_WAIT(); asm volatile("" ::: "memory");
    const int c = lane & 7;
#pragma unroll
    for (int jj = 0; jj < 8; ++jj) { const int n = (lane >> 3) + 8 * jj; const LAS float* s = scr + (8 * c) * 64 + ((((n >> 2) ^ c) << 2) | (n & 3));
        u32x4 o; o.x = pk2(s[0 * 64], s[1 * 64]); o.y = pk2(s[2 * 64], s[3 * 64]); o.z = pk2(s[4 * 64], s[5 * 64]); o.w = pk2(s[6 * 64], s[7 * 64]);
        *(u32x4*)(j.WT + (size_t)(r0 + n) * j.ldw + j.kofs + k0 + 8 * c) = o; }
    LDS_WAIT(); asm volatile("" ::: "memory");
}
__device__ __forceinline__ bool tr64_job(const P& p, int part, int it, TJob& j) {
    constexpr int I_IN = (D / 64) * (CIN / 64), I_BA = (RW / 64) * (D / 64), I_OUT = (D / 64) * (D / 64), I_FI = (D / 64) * (2 * DFF / 64), I_FO = (DFF / 64) * (D / 64);
    constexpr int I_L64 = (RW / 64), I_L128 = 2 * (RW / 64);
    unsigned char* ws = p.ws; int r = it; j.kofs = 0; j.swz = 0;
    if (part == 0) {
        if (r < I_IN) { j.W = p.in[9]; j.WT = (bf16_t*)(ws + WS_WIN); j.K = D; j.N = CIN; j.ldw = D; j.item = r; return true; } r -= I_IN;
        if (r < I_L64) { j.W = p.in[12]; j.WT = (bf16_t*)(ws + WS_LORA); j.K = 64; j.N = RW; j.ldw = 64; j.item = r; return true; } r -= I_L64;
        if (r < I_L64) { j.W = p.in[14]; j.WT = (bf16_t*)(ws + WS_LORA) + RW * 64; j.K = 64; j.N = RW; j.ldw = 64; j.item = r; return true; } r -= I_L64;
        if (r < I_L128) { j.W = p.in[15]; j.WT = (bf16_t*)(ws + WS_LORA) + 2 * RW * 64; j.K = 128; j.N = RW; j.ldw = 128; j.item = r; return true; } r -= I_L128;
        if (r < I_BA) { j.W = p.in[25]; j.WT = (bf16_t*)(ws + WS_WBA); j.K = RW; j.N = D; j.ldw = 2 * RW; j.item = r; return true; } r -= I_BA;
        if (r < I_BA) { j.W = p.in[26]; j.WT = (bf16_t*)(ws + WS_WBA); j.K = RW; j.N = D; j.ldw = 2 * RW; j.kofs = RW; j.item = r; return true; } r -= I_BA;
        if (r < I_OUT) { j.W = p.in[27]; j.WT = (bf16_t*)(ws + WS_WOUT); j.K = D; j.N = D; j.ldw = D; j.item = r; return true; }
        return false;
    }
    if (r < I_FI) { j.W = p.in[29]; j.WT = (bf16_t*)(ws + WS_WFI); j.K = D; j.N = 2 * DFF; j.ldw = D; j.swz = 1; j.item = r; return true; } r -= I_FI;
    if (r < I_FO) { j.W = p.in[30]; j.WT = (bf16_t*)(ws + WS_WFO); j.K = DFF; j.N = D; j.ldw = DFF; j.item = r; return true; }
    return false;
}
__device__ __forceinline__ void p0_transposes64(const P& p, LAS float* scr, int part, int gw, int NGW, int lane, int lim = 1 << 30) {
    TJob ja, jb; f32x4 ta[16], tb[16];
    int it = gw;
    if (it >= lim || !tr64_job(p, part, it, ja)) return;
    tr64_load(ja, ta, lane);
    for (;;) {
        const bool hb = it + NGW < lim && tr64_job(p, part, it + NGW, jb);
        if (hb) tr64_load(jb, tb, lane);
        tr64_store(ja, ta, scr, lane);
        if (!hb) break;
        const bool ha = it + 2 * NGW < lim && tr64_job(p, part, it + 2 * NGW, ja);
        if (ha) tr64_load(ja, ta, lane);
        tr64_store(jb, tb, scr, lane);
        if (!ha) break;
        it += 2 * NGW;
    }
}
template <int WHICH>
__device__ __forceinline__ void phase_norm(const P& p, int gw, int NGW, int lane) {
    const float* g = WHICH == 0 ? p.in[8] : p.in[28];
    const int r0 = (int)(((long long)gw * M) / NGW), r1 = (int)(((long long)(gw + 1) * M) / NGW);
    f32x4 gs[8], sh[8]; int cs = -1;
    const bf16_t* x1 = (const bf16_t*)(p.ws + WS_ZRW);
    for (int row = r0; row < r1; ++row) {
        f32x4 v[8];
        if constexpr (WHICH == 0) {
            const float* x = row < MP ? p.in[0] + (size_t)row * D : p.in[1] + (size_t)(row - MP) * D;
#pragma unroll
            for (int j = 0; j < 8; ++j) v[j] = *(const f32x4*)(x + 8 * lane + 512 * (j >> 1) + 4 * (j & 1));
        } else {
#pragma unroll
            for (int j = 0; j < 4; ++j) { const u32x4 w = *(const u32x4*)(x1 + (size_t)row * D + 8 * lane + 512 * j);
                v[2 * j] = (f32x4){bflo(w.x), bfhi(w.x), bflo(w.y), bfhi(w.y)}; v[2 * j + 1] = (f32x4){bflo(w.z), bfhi(w.z), bflo(w.w), bfhi(w.w)}; }
        }
        const int seq = seq_of_row(row);
        if (seq != cs) {
            cs = seq;
            const float* mod = (const float*)(p.ws + WS_MOD) + (size_t)seq * (6 * D);
            const float* scale = mod + (WHICH == 0 ? 1 : 4) * D; const float* shift = mod + (WHICH == 0 ? 0 : 3) * D;
#pragma unroll
            for (int j = 0; j < 8; ++j) { const int k = 8 * lane + 512 * (j >> 1) + 4 * (j & 1);
                gs[j] = *(const f32x4*)(g + k) * (*(const f32x4*)(scale + k) + 1.f); sh[j] = *(const f32x4*)(shift + k); }
        }
        float s = 0.f;
#pragma unroll
        for (int j = 0; j < 8; ++j) s += (v[j][0] * v[j][0] + v[j][1] * v[j][1]) + (v[j][2] * v[j][2] + v[j][3] * v[j][3]);
        const float rstd = rsqrtf(wave_sum(s) * (1.f / D) + 1e-6f);
        bf16_t* h = (bf16_t*)(p.ws + WS_H) + (size_t)row * D;
#pragma unroll
        for (int j = 0; j < 4; ++j) {
            const f32x4 a = v[2 * j] * rstd * gs[2 * j] + sh[2 * j], b = v[2 * j + 1] * rstd * gs[2 * j + 1] + sh[2 * j + 1];
            u32x4 w; w.x = pk2(a[0], a[1]); w.y = pk2(a[2], a[3]); w.z = pk2(b[0], b[1]); w.w = pk2(b[2], b[3]);
            *(u32x4*)(h + 8 * lane + 512 * j) = w; }
    }
}
__device__ __forceinline__ void phase_lnv(const P& p, int gw, int NGW, int lane) {
    const int r0 = (int)(((long long)gw * M) / NGW), r1 = (int)(((long long)(gw + 1) * M) / NGW);
    f32x4 lg[4], lb[4];
#pragma unroll
    for (int j = 0; j < 2; ++j) { const int c = 8 * lane + 512 * j;
        lg[2 * j] = *(const f32x4*)(p.in[21] + c); lg[2 * j + 1] = *(const f32x4*)(p.in[21] + c + 4); lb[2 * j] = *(const f32x4*)(p.in[22] + c); lb[2 * j + 1] = *(const f32x4*)(p.in[22] + c + 4); }
    for (int rowa = r0; rowa < r1; rowa += 2) {
        u32x4 zw[2][2];
#pragma unroll
        for (int k = 0; k < 2; ++k) { const int row = rowa + k < r1 ? rowa + k : rowa;
            const bf16_t* zv = (const bf16_t*)(p.ws + WS_ZUG) + (size_t)row * ZUGW + ZU_V;
            zw[k][0] = *(const u32x4*)(zv + 8 * lane); zw[k][1] = *(const u32x4*)(zv + 8 * lane + 512); }
#pragma unroll
        for (int k = 0; k < 2; ++k) {
            if (rowa + k >= r1) break;
            const int row = rowa + k;
            f32x4 v[4]; float s = 0.f;
#pragma unroll
            for (int j = 0; j < 2; ++j) { const u32x4 w = zw[k][j]; v[2 * j] = (f32x4){bflo(w.x), bfhi(w.x), bflo(w.y), bfhi(w.y)}; v[2 * j + 1] = (f32x4){bflo(w.z), bfhi(w.z), bflo(w.w), bfhi(w.w)}; }
#pragma unroll
            for (int i = 0; i < 4; ++i) s += (v[i][0] + v[i][1]) + (v[i][2] + v[i][3]);
            const float mean = wave_sum(s) * (1.f / MLPW);
            float q = 0.f;
#pragma unroll
            for (int i = 0; i < 4; ++i) { v[i] = v[i] - mean; q += (v[i][0] * v[i][0] + v[i][1] * v[i][1]) + (v[i][2] * v[i][2] + v[i][3] * v[i][3]); }
            const float rstd = rsqrtf(wave_sum(q) * (1.f / MLPW) + 1e-5f);
            bf16_t* vn = (bf16_t*)(p.ws + WS_VN) + (size_t)row * MLPW;
#pragma unroll
            for (int j = 0; j < 2; ++j) { const int c = 8 * lane + 512 * j;
                const f32x4 a = v[2 * j] * rstd * lg[2 * j] + lb[2 * j], b = v[2 * j + 1] * rstd * lg[2 * j + 1] + lb[2 * j + 1];
                u32x4 w; w.x = pk2(a[0], a[1]); w.y = pk2(a[2], a[3]); w.z = pk2(b[0], b[1]); w.w = pk2(b[2], b[3]);
                *(u32x4*)(vn + c) = w;
                if (row >= MP) { float* vs = p.out + O_VS + (size_t)(row - MP) * MLPW + c; *(f32x4*)vs = a; *(f32x4*)(vs + 4) = b; }
            }
        }
    }
}
__device__ __forceinline__ void phase_final(const P& p, int gw, int NGW, int lane) {
    const int r0 = (int)(((long long)gw * M) / NGW), r1 = (int)(((long long)(gw + 1) * M) / NGW);
    f32x4 g[8];
#pragma unroll
    for (int j = 0; j < 8; ++j) g[j] = *(const f32x4*)(p.in[31] + 8 * lane + 512 * (j >> 1) + 4 * (j & 1));
    const bf16_t* x2 = (const bf16_t*)(p.ws + WS_ZRW);
    for (int row = r0; row < r1; ++row) {
        f32x4 v[8]; float s = 0.f;
#pragma unroll
        for (int j = 0; j < 4; ++j) { const u32x4 w = *(const u32x4*)(x2 + (size_t)row * D + 8 * lane + 512 * j);
            v[2 * j] = (f32x4){bflo(w.x), bfhi(w.x), bflo(w.y), bfhi(w.y)}; v[2 * j + 1] = (f32x4){bflo(w.z), bfhi(w.z), bflo(w.w), bfhi(w.w)}; }
#pragma unroll
        for (int j = 0; j < 8; ++j) s += (v[j][0] * v[j][0] + v[j][1] * v[j][1]) + (v[j][2] * v[j][2] + v[j][3] * v[j][3]);
        const float rstd = rsqrtf(wave_sum(s) * (1.f / D) + 1e-6f);
        float* y = p.out + (size_t)row * D;
#pragma unroll
        for (int j = 0; j < 8; ++j) *(f32x4*)(y + 8 * lane + 512 * (j >> 1) + 4 * (j & 1)) = v[j] * rstd * g[j];
    }
}
__device__ __forceinline__ void mix_naive_row(const P& p, int row, int tid, int nthr) {
    const int t = (row - MP) & (TS - 1), rowc0 = row - t;
    const bf16_t* vn = (const bf16_t*)(p.ws + WS_VN) + (size_t)rowc0 * MLPW;
    const bf16_t* zu = (const bf16_t*)(p.ws + WS_ZUG) + (size_t)row * ZUGW + ZU_U;
    bf16_t* ub = (bf16_t*)(p.ws + WS_OA) + (size_t)row * (2 * RW) + RW;
    for (int c = tid; c < MLPW; c += nthr) {
        const int g = c >> 7; const float* wsg = p.in[23] + ((size_t)g * 128 + t) * 128;
        float wv[TS], vv[TS];
#pragma unroll
        for (int s = 0; s < TS; ++s) { wv[s] = wsg[s]; vv[s] = bf2f(vn[(size_t)s * MLPW + c]); }
        float acc = p.in[24][g * 128 + t];
#pragma unroll
        for (int s = 0; s < TS; ++s) acc += (s <= t ? wv[s] : 0.f) * vv[s];
        ub[c] = f2bf(bf2f(zu[c]) * acc);
    }
}

#define PHASE_IDS() int tid = threadIdx.x; asm volatile("" : "+v"(tid)); const int lane = tid & 63, wave = __builtin_amdgcn_readfirstlane(tid >> 6); \
    const int gw = bx * NWAVES + wave, NGW = G * NWAVES; (void)lane; (void)gw; (void)NGW
__global__ void __launch_bounds__(NTHR, 2) mega_fwd(P p) {
    extern __shared__ __attribute__((aligned(16))) unsigned char lds_raw[];
    LAS unsigned char* lds = (LAS unsigned char*)lds_raw;
    const int G = gridDim.x, bx = blockIdx.x;
    unsigned char* ws = p.ws;
#define FLAGS(k) ((unsigned*)(ws + WS_CTL) + CW_FLAGS + (k) * 256)
    { PHASE_IDS();
      for (int u = tid; u < (LDS_BYTES - LDSCTL_OFF) / 4; u += NTHR) ((LAS unsigned*)(lds + LDSCTL_OFF))[u] = 0u; }
    __syncthreads();
    XcdBarrier bar = xcd_barrier_post((unsigned*)(ws + WS_CTL) + CW_BAR, (volatile LAS unsigned*)(lds + MISC_OFF) + 8);
#ifdef TSMASK
    unsigned long long* tsw = (unsigned long long*)(ws + WS_CTL + 524288); int nst = 0;
#define STAMP() do { if (bx == 0 && threadIdx.x == 0) tsw[nst] = __builtin_amdgcn_s_memrealtime(); ++nst; } while (0)
#else
#define STAMP() do { } while (0)
#endif
    STAMP();

    { PHASE_IDS();
      p0_silu(p, bx * NTHR + tid, G * NTHR);
      asm volatile("s_waitcnt vmcnt(0)" ::: "memory"); __syncthreads();
      if (tid == 0) __hip_atomic_fetch_add((unsigned*)(ws + WS_CTL) + CW_SILU, 1u, __ATOMIC_RELAXED, __HIP_MEMORY_SCOPE_AGENT);
      p0_transposes(p, (LAS float*)(lds + wave * 16384), 0, gw, NGW, lane); }
    STAMP();
    { PHASE_IDS();
      if (tid == 0) { unsigned* cw = (unsigned*)(ws + WS_CTL) + CW_SILU; unsigned sp = 0;
          while (__hip_atomic_load(cw, __ATOMIC_RELAXED, __HIP_MEMORY_SCOPE_AGENT) < (unsigned)G && ++sp < (1u << 22)) __builtin_amdgcn_s_sleep(2);
          __builtin_amdgcn_fence(__ATOMIC_ACQUIRE, "agent"); asm volatile("s_waitcnt vmcnt(0)" ::: "memory"); }
      __syncthreads();
      p0_mod_slab(p, lds, ((bx >> 4) << 4) | ((bx & 7) << 1) | ((bx >> 3) & 1), tid, lane, wave); }
    xcd_barrier(bar); STAMP();
    { PHASE_IDS(); phase_norm<0>(p, gw, NGW, lane); }
    xcd_barrier(bar); STAMP();
    {
        pg8::Gemm g{(const bf16_t*)(ws + WS_H), (const bf16_t*)(ws + WS_WIN), M, CIN, D}; SliceOrder S; S.init(M, CIN, D, bx, FLAGS(0), (float*)(ws + WS_VN));
        EpiZ E{(bf16_t*)(ws + WS_ZRW), (bf16_t*)(ws + WS_ZUG), p.out};
        pg8::gemm_phase<EpiZ, SliceOrder, PG8_ALIGN, PG8_SP2>(lds, g, S, E);
    }
    xcd_barrier(bar); STAMP();
    { PHASE_IDS();
      phase_lnv(p, gw, NGW, lane);
      STAMP();
      static_assert(NREC % (256 * NWAVES) == 0, "every wave runs the same number of record rounds (barrier inside)");
      for (int rec = gw, k = 0; rec < NREC; rec += NGW, ++k) {
          int t_ = (int)threadIdx.x; asm volatile("" : "+v"(t_));
          LAS unsigned char* shf = lds + (k & 1) * 16384;
          *(LAS bf16x8*)(shf + wave * 1024 + (t_ & 63) * 16) = lora_frag(p, rec, wave, t_ & 63);
          LDS_WAIT(); __syncthreads();
          prep_record(p, lds + wave * 16384, shf, rec, t_ & 63);
      } }
    xcd_barrier(bar); STAMP();
    { PHASE_IDS();
        constexpr int NSW = NPB * NH, NOW = 256 - NSW;
        if (bx < NSW) {
            volatile LAS unsigned* prog = (volatile LAS unsigned*)(lds + MISC_OFF) + 16;
            if (wave < 2) scan_chain_prompt(p, bx >> 4, bx & 15, wave, lane, prog);
            else if (wave == 4 || wave == 5) scan_prefetch(p, prog, bx >> 4, bx & 15, wave - 4, lane);
            STAMP();
        }
        else {
            const int ob = bx - NSW, wid = ob * NWAVES + wave, NW = NOW * NWAVES;
            scan_samples(p, wid, NW, lane);
            constexpr int NMIX = NPB * 16 * 8;
            for (int item = ob; item < NMIX; item += NOW) mix_item(p, item, wave, lane);
            for (int row = MP + ob; row < M; row += NOW) mix_naive_row(p, row, tid, NTHR);
            p0_transposes64(p, (LAS float*)(lds + wave * 16384), 1, wid, NW, lane);
        }
    }
    xcd_barrier(bar); STAMP();
    { PHASE_IDS(); post_rows(p, gw, NGW, lane); }
    xcd_barrier(bar); STAMP();
    {
        pg8::Gemm g{(const bf16_t*)(ws + WS_OA), (const bf16_t*)(ws + WS_WBA), M, D, 2 * RW}; SliceOrder S; S.init(M, D, 2 * RW, bx, FLAGS(1), p.out);
        EpiMerge E{(const bf16_t*)(ws + WS_ZUG), (bf16_t*)(ws + WS_H)};
        pg8::gemm_phase<EpiMerge, SliceOrder, PG8_ALIGN, PG8_SP2>(lds, g, S, E);
    }
    xcd_barrier(bar); STAMP();
    {
        pg8::Gemm g{(const bf16_t*)(ws + WS_H), (const bf16_t*)(ws + WS_WOUT), M, D, D}; SliceOrder S; S.init(M, D, D, bx, FLAGS(2), (float*)(ws + WS_VN));
        EpiRes1 E{p.in[0], p.in[1], (const float*)(ws + WS_MOD), (bf16_t*)(ws + WS_ZRW)};
        pg8::gemm_phase<EpiRes1, SliceOrder, PG8_ALIGN, PG8_SP2>(lds, g, S, E);
    }
    xcd_barrier(bar); STAMP();
    { PHASE_IDS(); phase_norm<1>(p, gw, NGW, lane); }
    xcd_barrier(bar); STAMP();
    {
        pg8::Gemm g{(const bf16_t*)(ws + WS_H), (const bf16_t*)(ws + WS_WFI), M, 2 * DFF, D}; SliceOrder S; S.init(M, 2 * DFF, D, bx, FLAGS(3), (float*)(ws + WS_VN));
        EpiSwiglu E{(bf16_t*)(ws + WS_ZUG)};
        pg8::gemm_phase<EpiSwiglu, SliceOrder, PG8_ALIGN, PG8_SP2>(lds, g, S, E);
    }
    xcd_barrier(bar); STAMP();
    {
        pg8::Gemm g{(const bf16_t*)(ws + WS_ZUG), (const bf16_t*)(ws + WS_WFO), M, D, DFF}; SliceOrder S; S.init(M, D, DFF, bx, FLAGS(4), (float*)(ws + WS_VN));
        EpiRes2 E{(const float*)(ws + WS_MOD), (bf16_t*)(ws + WS_ZRW)};
        pg8::gemm_phase<EpiRes2, SliceOrder, PG8_ALIGN, PG8_SP2>(lds, g, S, E);
    }
    xcd_barrier(bar); STAMP();
    { PHASE_IDS(); phase_final(p, gw, NGW, lane); }
#ifdef TSMASK
    STAMP();
    if (bx == 0 && threadIdx.x == 0) {
        unsigned long long tot = 0;
        for (int k = 0; k < nst - 1; ++k) if ((TSMASK >> k) & 1) tot += tsw[k + 1] - tsw[k];
        p.out[0] += (float)tot * (1.0f / 20000.0f);
    }
#endif
}

extern "C" void kernel_launch(void* const* d_in, const int* in_sizes, int n_in, void* d_out, int out_size, void* d_ws, size_t ws_size, hipStream_t stream) {
    static int grid = 0;
    if (grid == 0) {
        if (n_in != 32 || (size_t)out_size != O_END || ws_size < WS_END) { fprintf(stderr, "kernel_launch: unexpected shapes n_in=%d out=%d ws=%zu (need %zu)\n", n_in, out_size, ws_size, (size_t)WS_END); grid = -1; return; }
        int dev = 0, cus = 0, per_cu = 0;
        if (hipGetDevice(&dev) != hipSuccess || hipDeviceGetAttribute(&cus, hipDeviceAttributeMultiprocessorCount, dev) != hipSuccess) { grid = -1; return; }
        if (hipFuncSetAttribute((const void*)mega_fwd, hipFuncAttributeMaxDynamicSharedMemorySize, LDS_BYTES) != hipSuccess) { fprintf(stderr, "kernel_launch: hipFuncSetAttribute failed\n"); grid = -1; return; }
        if (hipOccupancyMaxActiveBlocksPerMultiprocessor(&per_cu, (const void*)mega_fwd, NTHR, LDS_BYTES) != hipSuccess || per_cu < 1) { fprintf(stderr, "kernel_launch: occupancy query says %d blocks per CU\n", per_cu); }
        (void)hipGetLastError();
        grid = cus;
        if (grid != 256) { fprintf(stderr, "kernel_launch: built for 256 CUs (got %d)\n", cus); grid = -1; return; }
        if (grid < 128) { fprintf(stderr, "kernel_launch: this kernel's phase plan needs >= 128 CUs (got %d)\n", cus); grid = -1; return; }
    }
    if (grid < 0) return;
#ifdef TSMASK
    constexpr size_t kZero = CTL_BYTES;
#else
    constexpr size_t kZero = CTL_ZERO_BYTES;
#endif
    if (hipMemsetAsync((char*)d_ws + WS_CTL, 0, kZero, stream) != hipSuccess) { fprintf(stderr, "kernel_launch: memset failed\n"); return; }
    P p{};
    for (int i = 0; i < 32; ++i) p.in[i] = (const float*)d_in[i];
    p.out = (float*)d_out; p.ws = (unsigned char*)d_ws;
    hipLaunchKernelGGL(mega_fwd, dim3(grid), dim3(NTHR), LDS_BYTES, stream, p);
    const hipError_t le = hipPeekAtLastError();
    if (le != hipSuccess) fprintf(stderr, "kernel_launch: launch failed: %s\n", hipGetErrorName(le));
}
```

```cpp
#include <hip/hip_runtime.h>
#include <cstdio>
#include <cstdint>

constexpr int D = 2048, NPB = 4, TP = 2048, NSB = 128, TS = 8;
constexpr int MP = NPB * TP, MS = NSB * TS, M = MP + MS;
constexpr int RW = 1024, NH = 16, HS = 64;
constexpr int CSH = 3328, CIN = 9472, DFF = 5632, MLPW = 1024;
constexpr int C_U = CSH, C_V = CSH + 1024, C_G0 = CSH + 2048, C_G1 = C_G0 + 2048;
constexpr int ZUGW = CIN - CSH, ZU_U = 0, ZU_V = 1024, ZU_G0 = 2048, ZU_G1 = 4096;
constexpr int NSEQ = NPB + NSB;
constexpr size_t O_YP = 0, O_YS = O_YP + (size_t)MP * D, O_WKVP = O_YS + (size_t)MS * D, O_SHP = O_WKVP + (size_t)NPB * NH * HS * HS,
                 O_WKVS = O_SHP + (size_t)NPB * CSH, O_SHS = O_WKVS + (size_t)NSB * NH * HS * HS, O_VS = O_SHS + (size_t)NSB * CSH,
                 O_END = O_VS + (size_t)MS * MLPW;
constexpr size_t WS_CTL = 0, CTL_BYTES = 1u << 20, CTL_ZERO_BYTES = 160u << 10;
constexpr size_t WS_WIN = CTL_BYTES;
constexpr size_t WS_WBA = WS_WIN + (size_t)CIN * D * 2;
constexpr size_t WS_WBB = WS_WBA + (size_t)D * RW * 2;
constexpr size_t WS_WOUT = WS_WBB + (size_t)D * RW * 2;
constexpr size_t WS_WFI = WS_WOUT + (size_t)D * D * 2;
constexpr size_t WS_WFO = WS_WFI + (size_t)2 * DFF * D * 2;
constexpr size_t WS_MOD = WS_WFO + (size_t)D * DFF * 2;
constexpr size_t WS_H = WS_MOD + (size_t)NSEQ * 6 * D * 4;
constexpr size_t WS_ZRW = WS_H + (size_t)M * D * 2;
constexpr size_t WS_ZUG = WS_ZRW + (size_t)M * CSH * 2;
constexpr size_t WS_VN = WS_ZUG + (size_t)M * ZUGW * 2;
constexpr size_t WS_OA = WS_VN + (size_t)M * MLPW * 2;
constexpr size_t WS_UB = WS_OA + (size_t)M * RW * 2;
constexpr size_t WS_C2 = WS_UB + (size_t)M * MLPW * 2;
constexpr size_t WS_LORA = WS_C2 + (size_t)M * RW * 2;
constexpr size_t WS_SILU = WS_LORA + (size_t)RW * 256 * 2;
constexpr size_t WS_FRA_S = WS_SILU + (size_t)144 * D * 2;
constexpr size_t WS_FRB_S = WS_FRA_S + (size_t)NSB * NH * 4096;
constexpr size_t WS_END = WS_FRB_S + (size_t)NSB * NH * 8448;
constexpr int NREC_P = NPB * 128 * NH, NREC = NREC_P + NSB * NH;
constexpr int RECA = 4096, RECB = 8448;
static_assert(WS_C2 + (size_t)M * RW * 2 - WS_VN >= (size_t)256 * 262144, "stream-K slabs (256 x 256 KiB) fit VN | OA|UB | C2");
static_assert((size_t)NREC_P * RECA <= (size_t)M * D * 2 && (size_t)NREC_P * RECB <= (size_t)M * D * 4, "prompt fragment records fit the H buffer / the y region of d_out");
constexpr int CW_BAR = 4096, CW_SILU = 16384, CW_FLAGS = 32768;

typedef float f32x2v __attribute__((ext_vector_type(2)));
typedef __bf16 bf16x2v __attribute__((ext_vector_type(2)));
typedef unsigned u32x2v __attribute__((ext_vector_type(2)));

struct P { const float* in[32]; float* out; unsigned char* ws; };

__device__ __forceinline__ unsigned pk2(float lo, float hi) { return __builtin_bit_cast(unsigned, __builtin_convertvector((f32x2v){lo, hi}, bf16x2v)); }
__device__ __forceinline__ unsigned short f2bf(float f) { return (unsigned short)(pk2(f, 0.f) & 0xffffu); }
__device__ __forceinline__ float bf2f(unsigned short h) { return __uint_as_float(((unsigned)h) << 16); }
__device__ __forceinline__ float bflo(unsigned w) { return __uint_as_float(w << 16); }
__device__ __forceinline__ float bfhi(unsigned w) { return __uint_as_float(w & 0xffff0000u); }
__device__ __forceinline__ float sigmoidf_(float x) { return __builtin_amdgcn_rcpf(1.f + __expf(-x)); }
__device__ __forceinline__ float gelu_tanh(float x) {
    const float u = 0.7978845608028654f * (x + 0.044715f * x * x * x); return x * __builtin_amdgcn_rcpf(1.f + __expf(-2.f * u)); }
__device__ __forceinline__ float wave_sum(float v) {
#pragma unroll
    for (int o = 1; o < 64; o <<= 1) v += __shfl_xor(v, o);
    return v;
}
__device__ __forceinline__ int seq_of_row(int row) { return row < MP ? row / TP : NPB + (row - MP) / TS; }

namespace pg8 {
#define PG8_LAS __attribute__((address_space(3)))
typedef unsigned short bf16_t;
typedef short bf16x8 __attribute__((ext_vector_type(8)));
typedef float f32x4 __attribute__((ext_vector_type(4)));
typedef unsigned u32x4 __attribute__((ext_vector_type(4)));
constexpr int BM = 256, BK = 64, HALF = 128, HTB = HALF * BK * 2  , STAGE_BYTES = 8 * HTB, NXCD = 8, WGM = 8;

__host__ __device__ __forceinline__ int lds_byte(int r, int c) { const int st = (r >> 4) * 2 + (c >> 5), rr = r & 15, cc = c & 31, ob = rr * 64 + cc * 2; return st * 1024 + (ob ^ (((ob >> 9) & 1) << 5)); }
__host__ __device__ __forceinline__ void stage_rc(int b, int& R, int& C) { const int st = b / 1024, sb = b % 1024, swz = sb ^ (((sb >> 9) & 1) << 5); R = (st >> 1) * 16 + swz / 64; C = (st & 1) * 32 + (swz % 64) / 2; }
__host__ __device__ __forceinline__ int perm32(int rho) { const int n = rho >> 4, i = rho & 15; return 8 * (i >> 2) + 4 * n + (i & 3); }

struct Unit { int pm, pn, kb, nk, kind, peer; };
struct Gemm { const bf16_t* A; const bf16_t* Bt; int M, N, K; };

struct StaticOrder {
    int nM, nN, nwg, G, c;
    __host__ __device__ void init(int M, int N, int G_, int c_) { nM = M / BM; nN = N / BM; nwg = nM * nN; G = G_; c = c_; }
    __host__ __device__ bool next(int i, Unit& u) const {
        const long L = (long)i * G + c; if (L >= nwg) return false;
        int wgid = (int)L; { const int q = nwg / NXCD, r = nwg % NXCD, xcd = wgid % NXCD, off = wgid / NXCD; wgid = (xcd < r ? xcd * (q + 1) : r * (q + 1) + (xcd - r) * q) + off; }
        const int nig = WGM * nN, gid = wgid / nig, fm = gid * WGM, gsz = (nM - fm) < WGM ? (nM - fm) : WGM;
        u.pm = fm + ((wgid % nig) % gsz); u.pn = (wgid % nig) / gsz; return true;
    }
    __device__ __forceinline__ void a_ready(const Unit&) const {}
    __device__ __forceinline__ void done(const Unit&) const {}
};
#ifdef TSGEMM
__device__ unsigned long long g_ts[16];
#define GSTAMP(k) do { if (Epi::TSID == TSGEMM && blockIdx.x == 0 && threadIdx.x == 0) g_ts[k] = __builtin_amdgcn_s_memrealtime(); } while (0)
#else
#define GSTAMP(k) do { } while (0)
#endif
template <class Epi, class Sched, bool ALIGN_EPI = false, bool SP2 = false>
__device__ __forceinline__ void gemm_phase(PG8_LAS unsigned char* lds, const Gemm g, const Sched& S, const Epi& E) {
    int tid_ = threadIdx.x; asm volatile("" : "+v"(tid_));
    const int tid = tid_, wid = __builtin_amdgcn_readfirstlane(tid >> 6), lane = tid & 63, wr = wid >> 2, wc = wid & 3, fr = lane & 15, fq = lane >> 4;
    const int K = g.K;
    unsigned voffA[2], voffB[2];
#pragma unroll
    for (int i = 0; i < 2; ++i) { int R, C; stage_rc(tid * 16 + i * 8192, R, C); const int Rb = Epi::PERM ? ((R & ~31) + perm32(R & 31)) : R;
        voffA[i] = (unsigned)(R * K + C) * 2u; voffB[i] = (unsigned)(Rb * K + C) * 2u; }
    const size_t kstep = (size_t)(BK * 2);
    const size_t hstep = (size_t)HALF * K * 2;
    const size_t tstep = 2 * hstep;
    const unsigned ldsw = (unsigned)wid * 1024u;
    const int aoff = lds_byte(wr * 64 + fr, fq * 8), boff = lds_byte(wc * 32 + fr, fq * 8);
#define PG8_SA(b, h) (((b) * 2 + (h)) * HTB)
#define PG8_SB(b, h) ((4 + (b) * 2 + (h)) * HTB)
#define PG8_STAGE(bufoff, gbase, voff) do { _Pragma("unroll") for (int _i = 0; _i < 2; ++_i) \
        __builtin_amdgcn_global_load_lds((const unsigned*)((const char*)(gbase) + (voff)[_i]), (PG8_LAS unsigned*)(lds + (bufoff) + ldsw + _i * 8192), 16, 0, 0); } while (0)
#define PG8_LDA(dst, b, h) do { _Pragma("unroll") for (int m = 0; m < 4; ++m) _Pragma("unroll") for (int k = 0; k < 2; ++k) dst[m][k] = *(const PG8_LAS bf16x8*)(lds + PG8_SA(b, h) + aoff + m * 2048 + k * 1024); } while (0)
#define PG8_LDB(dst, b, h) do { _Pragma("unroll") for (int n = 0; n < 2; ++n) _Pragma("unroll") for (int k = 0; k < 2; ++k) dst[n][k] = *(const PG8_LAS bf16x8*)(lds + PG8_SB(b, h) + boff + n * 2048 + k * 1024); } while (0)
#define PG8_MMA(ai, bj, At, Bt) do { __builtin_amdgcn_s_setprio(1); _Pragma("unroll") for (int m = 0; m < 4; ++m) _Pragma("unroll") for (int n = 0; n < 2; ++n) _Pragma("unroll") for (int k = 0; k < 2; ++k) \
        acc[ai][bj][m][n] = __builtin_amdgcn_mfma_f32_16x16x32_bf16(Bt[n][k], At[m][k], acc[ai][bj][m][n], 0, 0, 0); __builtin_amdgcn_s_setprio(0); } while (0)
#define PG8_WAIT_V(n) asm volatile("s_waitcnt vmcnt(" #n ")" ::: "memory")
#define PG8_WAIT_L(n) asm volatile("s_waitcnt lgkmcnt(" #n ")" ::: "memory")
#define PG8_BAR __builtin_amdgcn_s_barrier()
#define PG8_SCHED __builtin_amdgcn_sched_barrier(0)
    Unit cur, nxt; int ui = 0; GSTAMP(0);
    if (!S.next(0, cur)) return;
    f32x4 acc[2][2][4][2];
#pragma unroll
    for (int a = 0; a < 2; ++a)
#pragma unroll
        for (int b = 0; b < 2; ++b)
#pragma unroll
            for (int m = 0; m < 4; ++m)
#pragma unroll
                for (int n = 0; n < 2; ++n) acc[a][b][m][n] = (f32x4){0.f, 0.f, 0.f, 0.f};
    bf16x8 At[4][2], B0[2][2], B1[2][2];
    const char* cA = (const char*)g.A + (size_t)cur.pm * tstep + (size_t)cur.kb * kstep; const char* cB = (const char*)g.Bt + (size_t)cur.pn * tstep + (size_t)cur.kb * kstep;
    S.a_ready(cur);
    if constexpr (SP2) {
        PG8_STAGE(PG8_SB(0, 0), cB, voffB); PG8_STAGE(PG8_SB(0, 1), cB + hstep, voffB); PG8_STAGE(PG8_SA(0, 0), cA, voffA); PG8_STAGE(PG8_SA(0, 1), cA + hstep, voffA);
        if (wr == 1) PG8_BAR;
        PG8_WAIT_V(2); PG8_BAR;
        PG8_STAGE(PG8_SB(1, 0), cB + kstep, voffB); PG8_STAGE(PG8_SA(1, 0), cA + kstep, voffA); PG8_STAGE(PG8_SB(1, 1), cB + hstep + kstep, voffB);
        PG8_WAIT_V(6); PG8_BAR;
    } else {
        PG8_STAGE(PG8_SB(0, 0), cB, voffB); PG8_STAGE(PG8_SA(0, 0), cA, voffA); PG8_STAGE(PG8_SB(0, 1), cB + hstep, voffB); PG8_STAGE(PG8_SA(0, 1), cA + hstep, voffA);
        if (wr == 1) PG8_BAR;
        PG8_WAIT_V(4); PG8_BAR;
        PG8_STAGE(PG8_SB(1, 0), cB + kstep, voffB); PG8_STAGE(PG8_SA(1, 0), cA + kstep, voffA); PG8_STAGE(PG8_SB(1, 1), cB + hstep + kstep, voffB);
        PG8_WAIT_V(6); PG8_BAR;
    }
    for (;;) {
        const bool has_next = S.next(ui + 1, nxt);
        const char* nA = has_next ? (const char*)g.A + (size_t)nxt.pm * tstep + (size_t)nxt.kb * kstep : cA; const char* nB = has_next ? (const char*)g.Bt + (size_t)nxt.pn * tstep + (size_t)nxt.kb * kstep : cB;
        const int nt = cur.nk;
        for (int t = 0; t < nt; t += 2) {
            const bool last = (t == nt - 2);
            if constexpr (Epi::HOOK_TILE > 0) { if (cur.kb + t == Epi::HOOK_TILE && t > 0) E.mid(acc, cur, wr, wc, fr, fq); }
            const char* a1 = cA + (size_t)(t + 1) * kstep;
            const char* a2 = last ? nA : cA + (size_t)(t + 2) * kstep; const char* b2 = last ? nB : cB + (size_t)(t + 2) * kstep;
            const char* a3 = a2 + kstep; const char* b3 = b2 + kstep;
            if (last && has_next) S.a_ready(nxt);
            if constexpr (SP2) {
            PG8_LDB(B0, 0, 0); PG8_LDB(B1, 0, 1); PG8_SCHED; PG8_LDA(At, 0, 0); PG8_STAGE(PG8_SA(1, 1), a1 + hstep, voffA);
            PG8_WAIT_V(8); PG8_WAIT_L(0); PG8_BAR; PG8_MMA(0, 0, At, B0); PG8_MMA(0, 1, At, B1); PG8_BAR; PG8_SCHED;
            PG8_LDA(At, 0, 1); PG8_STAGE(PG8_SB(0, 0), b2, voffB); PG8_STAGE(PG8_SB(0, 1), b2 + hstep, voffB); PG8_STAGE(PG8_SA(0, 0), a2, voffA);
            PG8_WAIT_V(8); PG8_WAIT_L(0); PG8_BAR; PG8_MMA(1, 0, At, B0); PG8_MMA(1, 1, At, B1); PG8_BAR; PG8_SCHED;
            PG8_LDB(B0, 1, 0); PG8_LDB(B1, 1, 1); PG8_SCHED; PG8_LDA(At, 1, 0); PG8_STAGE(PG8_SA(0, 1), a2 + hstep, voffA);
            PG8_WAIT_V(8); PG8_WAIT_L(0); PG8_BAR; PG8_MMA(0, 0, At, B0); PG8_MMA(0, 1, At, B1); PG8_BAR; PG8_SCHED;
            PG8_LDA(At, 1, 1); PG8_STAGE(PG8_SB(1, 0), b3, voffB); PG8_STAGE(PG8_SB(1, 1), b3 + hstep, voffB); PG8_STAGE(PG8_SA(1, 0), a3, voffA);
            PG8_WAIT_V(8); PG8_WAIT_L(0); PG8_BAR; PG8_MMA(1, 0, At, B0); PG8_MMA(1, 1, At, B1); PG8_BAR; PG8_SCHED;
            } else {
            PG8_LDB(B0, 0, 0); PG8_SCHED; PG8_LDA(At, 0, 0); PG8_STAGE(PG8_SA(1, 1), a1 + hstep, voffA);
            PG8_WAIT_L(8); PG8_BAR; PG8_WAIT_L(0); PG8_MMA(0, 0, At, B0); PG8_BAR; PG8_SCHED;
            PG8_LDB(B1, 0, 1); PG8_STAGE(PG8_SB(0, 0), b2, voffB);
            PG8_BAR; PG8_WAIT_L(0); PG8_MMA(0, 1, At, B1); PG8_BAR;
            PG8_LDA(At, 0, 1); PG8_STAGE(PG8_SA(0, 0), a2, voffA);
            PG8_BAR; PG8_WAIT_L(0); PG8_MMA(1, 0, At, B0); PG8_BAR; PG8_SCHED;
            PG8_STAGE(PG8_SB(0, 1), b2 + hstep, voffB);
            PG8_WAIT_V(6); PG8_BAR; PG8_MMA(1, 1, At, B1); PG8_BAR;
            PG8_LDB(B0, 1, 0); PG8_SCHED; PG8_LDA(At, 1, 0); PG8_STAGE(PG8_SA(0, 1), a2 + hstep, voffA);
            PG8_WAIT_L(8); PG8_BAR; PG8_WAIT_L(0); PG8_MMA(0, 0, At, B0); PG8_BAR; PG8_SCHED;
            PG8_LDB(B1, 1, 1); PG8_STAGE(PG8_SB(1, 0), b3, voffB);
            PG8_BAR; PG8_WAIT_L(0); PG8_MMA(0, 1, At, B1); PG8_BAR;
            PG8_LDA(At, 1, 1); PG8_STAGE(PG8_SA(1, 0), a3, voffA);
            PG8_BAR; PG8_WAIT_L(0); PG8_MMA(1, 0, At, B0); PG8_BAR; PG8_SCHED;
            PG8_STAGE(PG8_SB(1, 1), b3 + hstep, voffB);
            PG8_WAIT_V(6); PG8_BAR; PG8_MMA(1, 1, At, B1); PG8_BAR;
            }
        }
        if constexpr (ALIGN_EPI) { if (wr == 0) PG8_BAR; }
        if (cur.kind == 3) GSTAMP(3); else if (ui == 0) GSTAMP(1);
        if constexpr (Epi::HOOK_TILE > 0) { if (cur.kb + cur.nk <= Epi::HOOK_TILE) E.mid(acc, cur, wr, wc, fr, fq); }
        if (cur.kind == 3) {
            int fr_ = fr; asm volatile("" : "+v"(fr_));
            const int ti4 = (wid * 64 + fq * 16 + fr_) * 4;
            {
                unsigned char* slw = (unsigned char*)S.slab + (size_t)(cur.peer * S.nsl + S.s) * 131072;
                const __amdgpu_buffer_rsrc_t rs = __builtin_amdgcn_make_buffer_rsrc(slw, 0, 131072, 0x00020000);
#pragma unroll
                for (int a = 0; a < 2; ++a)
#pragma unroll
                    for (int m = 0; m < 4; ++m) {
                        if ((a * 4 + m) % S.nsl == S.s) continue;
#pragma unroll
                        for (int b = 0; b < 2; ++b) {
                            u32x4 w; const f32x4 p0 = acc[a][b][m][0], p1 = acc[a][b][m][1];
                            w.x = pk2(p0[0], p0[1]); w.y = pk2(p0[2], p0[3]); w.z = pk2(p1[0], p1[1]); w.w = pk2(p1[2], p1[3]);
                            __builtin_amdgcn_raw_buffer_store_b128(w, rs, ti4 * 4 + ((a * 2 + b) * 4 + m) * 8192, 0, 16);
                        }
                    }
            }
            PG8_WAIT_V(0); PG8_BAR; GSTAMP(4);
            if (wid == 0 && (fq | fr) == 0) {
                __hip_atomic_fetch_add(S.cnt + cur.peer, 1u, __ATOMIC_RELAXED, __HIP_MEMORY_SCOPE_AGENT);
                unsigned sp = 0; while (__hip_atomic_load(S.cnt + cur.peer, __ATOMIC_RELAXED, __HIP_MEMORY_SCOPE_AGENT) < (unsigned)S.nsl && ++sp < (1u << 22)) __builtin_amdgcn_s_sleep(2);
                __builtin_amdgcn_fence(__ATOMIC_ACQUIRE, "agent"); PG8_WAIT_V(0);
            }
            PG8_BAR; asm volatile("" ::: "memory"); GSTAMP(5);
            const int no = S.nsl - 1;
#define PG8_RED(Q, Q0) { u32x4 t[Q][2]; \
                    _Pragma("unroll") for (int q = Q0; q < Q0 + Q; ++q) { int o = S.s + 1 + (q < no ? q : 0); o -= o >= S.nsl ? S.nsl : 0; \
                        t[q - Q0][0] = *(const u32x4*)(sb + (size_t)o * 131072); t[q - Q0][1] = *(const u32x4*)(sb + (size_t)o * 131072 + 4 * 8192); } \
                    _Pragma("unroll") for (int q = Q0; q < Q0 + Q; ++q) _Pragma("unroll") for (int b = 0; b < 2; ++b) { const bool on = q < no; const u32x4 w = t[q - Q0][b]; \
                        r[2 * b] += (f32x4){on ? bflo(w.x) : 0.f, on ? bfhi(w.x) : 0.f, on ? bflo(w.y) : 0.f, on ? bfhi(w.y) : 0.f}; \
                        r[2 * b + 1] += (f32x4){on ? bflo(w.z) : 0.f, on ? bfhi(w.z) : 0.f, on ? bflo(w.w) : 0.f, on ? bfhi(w.w) : 0.f}; } }
#pragma unroll
            for (int a = 0; a < 2; ++a)
#pragma unroll
                for (int m0 = 0; m0 < 4; ++m0) {
                    if ((a * 4 + m0) % S.nsl != S.s) continue;
                    f32x4 r[4] = {acc[a][0][m0][0], acc[a][0][m0][1], acc[a][1][m0][0], acc[a][1][m0][1]};
                    const unsigned char* sb = (const unsigned char*)S.slab + (size_t)(cur.peer * S.nsl) * 131072 + ti4 * 4 + ((a * 2) * 4 + m0) * 8192;
                    PG8_RED(4, 0)
                    if (no > 4) PG8_RED(4, 4)
                    E.rg(r[0], r[1], r[2], r[3], cur, a, m0, wr, wc, fr, fq);
                }
#undef PG8_RED
            GSTAMP(6);
        } else {
            E(acc, cur, wr, wc, fr, fq);
            if (ui == 0) GSTAMP(2);
        }
        if (!has_next) break;
#pragma unroll
        for (int a = 0; a < 2; ++a)
#pragma unroll
            for (int b = 0; b < 2; ++b)
#pragma unroll
                for (int m = 0; m < 4; ++m)
#pragma unroll
                    for (int n = 0; n < 2; ++n) acc[a][b][m][n] = (f32x4){0.f, 0.f, 0.f, 0.f};
        cur = nxt; cA = nA; cB = nB; ++ui;
        if constexpr (ALIGN_EPI) { if (wr == 1) PG8_BAR; }
    }
    PG8_WAIT_V(0);
    if constexpr (!ALIGN_EPI) { if (wr == 0) PG8_BAR; }
    PG8_BAR;
    if constexpr (Epi::AFTER_DRAIN) { E.fused(acc, cur, wr, wc, fr, fq, lds, wid, lane); S.done(cur); }
#undef PG8_SA
#undef PG8_SB
#undef PG8_STAGE
#undef PG8_LDA
#undef PG8_LDB
#undef PG8_MMA
#undef PG8_WAIT_V
#undef PG8_WAIT_L
#undef PG8_BAR
#undef PG8_SCHED
}
}
#define PG8_SP2 true
#define PG8_ALIGN true

using pg8::f32x4; using pg8::Unit; using pg8::BM; using pg8::HALF; typedef pg8::u32x4 u32x4;
typedef unsigned short bf16_t;

#define EPI_WALK() __device__ __forceinline__ void operator()(const f32x4 (&acc)[2][2][4][2], const Unit& u, int wr, int wc, int fr, int fq) const { \
        _Pragma("unroll") for (int ai = 0; ai < 2; ++ai) _Pragma("unroll") for (int m = 0; m < 4; ++m) { \
            rg(acc[ai][0][m][0], acc[ai][0][m][1], acc[ai][1][m][0], acc[ai][1][m][1], u, ai, m, wr, wc, fr, fq); if (m == 3) asm volatile("" ::: "memory"); } }

#define EPI_WALK_BODY(NB, FIN) \
        _Pragma("unroll") for (int g0 = 0; g0 < 8; g0 += NB) { L x[NB]; \
            _Pragma("unroll") for (int g = 0; g < NB; ++g) x[g] = ld(u, (g0 + g) >> 2, (g0 + g) & 3, wr, wc, fr, fq); \
            _Pragma("unroll") for (int g = 0; g < NB; ++g) { const int ai = (g0 + g) >> 2, m = (g0 + g) & 3; \
                FIN(x[g], pre, acc[ai][0][m][0], acc[ai][0][m][1], acc[ai][1][m][0], acc[ai][1][m][1], u, ai, m, wr, wc, fr, fq); } \
            asm volatile("" ::: "memory"); }
#define EPI_WALK_LD(NB) __device__ __forceinline__ void operator()(const f32x4 (&acc)[2][2][4][2], const Unit& u, int wr, int wc, int fr, int fq) const { \
        const Pre pre{}; EPI_WALK_BODY(NB, fin) } \
    __device__ __forceinline__ void rg(f32x4 v00, f32x4 v01, f32x4 v10, f32x4 v11, const Unit& u, int ai, int m, int wr, int wc, int fr, int fq) const { \
        fin(ld(u, ai, m, wr, wc, fr, fq), Pre{}, v00, v01, v10, v11, u, ai, m, wr, wc, fr, fq); }
#define EPI_WALK_LDU(NB) __device__ __forceinline__ void operator()(const f32x4 (&acc)[2][2][4][2], const Unit& u, int wr, int wc, int fr, int fq) const { \
        if (u.pm < MP / BM) { asm volatile("" : "+v"(fq)); const Pre pre = prep(u, wc, fq); EPI_WALK_BODY(NB, fin<true>) } \
        else { const Pre pre{}; EPI_WALK_BODY(NB, fin<false>) } } \
    __device__ __forceinline__ void rg(f32x4 v00, f32x4 v01, f32x4 v10, f32x4 v11, const Unit& u, int ai, int m, int wr, int wc, int fr, int fq) const { \
        fin<false>(ld(u, ai, m, wr, wc, fr, fq), Pre{}, v00, v01, v10, v11, u, ai, m, wr, wc, fr, fq); }

struct EpiZ {
    static constexpr int TSID = 1;
    static constexpr int HOOK_TILE = 0;
    static constexpr bool PERM = true, AFTER_DRAIN = false;
    bf16_t* zrw; bf16_t* zug; float* out;
    __device__ __forceinline__ void rg(f32x4 v00, f32x4 v01, f32x4 v10, f32x4 v11, const Unit& u, int ai, int m, int wr, int wc, int fr, int fq) const {
        const int colt = u.pn * BM;
        const int mode = colt < CSH ? 0 : (colt < C_G0 ? 1 : 2);
        const int row = u.pm * BM + wr * 64 + fr + ai * HALF + m * 16, col0 = colt + wc * 32 + 8 * fq;
        bf16_t* rowp = mode == 0 ? zrw + (size_t)row * CSH + col0 : zug + (size_t)row * ZUGW + (col0 - CSH);
        if (mode == 0) {
            bool last; float* sh;
            if (row < MP) { last = (row & (TP - 1)) == TP - 1; sh = out + O_SHP + (size_t)(row / TP) * CSH + col0; }
            else { const int rs = row - MP; last = (rs & (TS - 1)) == TS - 1; sh = out + O_SHS + (size_t)(rs / TS) * CSH + col0; }
            if (last) { *(f32x4*)sh = v00; *(f32x4*)(sh + 4) = v01; *(f32x4*)(sh + HALF) = v10; *(f32x4*)(sh + HALF + 4) = v11; }
        } else if (mode == 1) {
#pragma unroll
            for (int e = 0; e < 4; ++e) { v00[e] = gelu_tanh(v00[e]); v01[e] = gelu_tanh(v01[e]); v10[e] = gelu_tanh(v10[e]); v11[e] = gelu_tanh(v11[e]); }
        } else {
            const int gc = (colt - C_G0) / 2 + wc * 32 + 8 * fq;
            f32x4 r0, r1;
#pragma unroll
            for (int e = 0; e < 4; ++e) { v10[e] = sigmoidf_(v10[e]); v11[e] = sigmoidf_(v11[e]);
                r0[e] = sigmoidf_(v00[e]) * __builtin_amdgcn_rcpf(fmaxf(v10[e], 1e-30f)); r1[e] = sigmoidf_(v01[e]) * __builtin_amdgcn_rcpf(fmaxf(v11[e], 1e-30f)); }
            bf16_t* zr = zug + (size_t)row * ZUGW;
            u32x4 w; w.x = pk2(r0[0], r0[1]); w.y = pk2(r0[2], r0[3]); w.z = pk2(r1[0], r1[1]); w.w = pk2(r1[2], r1[3]);
            *(u32x4*)(zr + ZU_G0 + gc) = w;
            w.x = pk2(v10[0], v10[1]); w.y = pk2(v10[2], v10[3]); w.z = pk2(v11[0], v11[1]); w.w = pk2(v11[2], v11[3]);
            *(u32x4*)(zr + ZU_G1 + gc) = w;
            return;
        }
        u32x4 w; w.x = pk2(v00[0], v00[1]); w.y = pk2(v00[2], v00[3]); w.z = pk2(v01[0], v01[1]); w.w = pk2(v01[2], v01[3]);
        *(u32x4*)rowp = w;
        w.x = pk2(v10[0], v10[1]); w.y = pk2(v10[2], v10[3]); w.z = pk2(v11[0], v11[1]); w.w = pk2(v11[2], v11[3]);
        *(u32x4*)(rowp + HALF) = w;
    }
    EPI_WALK()
};
struct EpiMerge {
    static constexpr int TSID = 2;
    static constexpr int HOOK_TILE = 16, MIDB = 8;
    static constexpr bool PERM = true, AFTER_DRAIN = false;
    const bf16_t* z; bf16_t* mg;
    __device__ __forceinline__ void mid(f32x4 (&acc)[2][2][4][2], const Unit& u, int wr, int wc, int fr, int fq) const {
        asm volatile("" : "+v"(fr));
        const int row0 = u.pm * BM + wr * 64 + fr, col0 = u.pn * BM + wc * 32 + 8 * fq;
#pragma unroll
        for (int h = 0; h < 8 / MIDB; ++h) {
            u32x4 rho[MIDB][2];
#pragma unroll
            for (int g = 0; g < MIDB; ++g) {
                const int ai = (h * MIDB + g) >> 2, m = (h * MIDB + g) & 3;
                const bf16_t* zr = z + (size_t)(row0 + ai * HALF + m * 16) * ZUGW + ZU_G0 + col0;
                rho[g][0] = *(const u32x4*)zr; rho[g][1] = *(const u32x4*)(zr + HALF);
            }
#pragma unroll
            for (int g = 0; g < MIDB; ++g)
#pragma unroll
                for (int bj = 0; bj < 2; ++bj) {
                    const int ai = (h * MIDB + g) >> 2, m = (h * MIDB + g) & 3;
                    const u32x4 a = rho[g][bj];
                    f32x4& v0 = acc[ai][bj][m][0]; f32x4& v1 = acc[ai][bj][m][1];
                    v0[0] *= bflo(a.x); v0[1] *= bfhi(a.x); v0[2] *= bflo(a.y); v0[3] *= bfhi(a.y);
                    v1[0] *= bflo(a.z); v1[1] *= bfhi(a.z); v1[2] *= bflo(a.w); v1[3] *= bfhi(a.w);
                }
            asm volatile("" ::: "memory");
        }
    }
    struct L { u32x4 ga, gb; }; struct Pre { };
    __device__ __forceinline__ L ld(const Unit& u, int ai, int m, int wr, int wc, int fr, int fq) const {
        const int row = u.pm * BM + wr * 64 + fr + ai * HALF + m * 16, col0 = u.pn * BM + wc * 32 + 8 * fq;
        const bf16_t* zr = z + (size_t)row * ZUGW + ZU_G1 + col0;
        return L{*(const u32x4*)zr, *(const u32x4*)(zr + HALF)};
    }
    __device__ __forceinline__ void fin(const L& x, const Pre&, f32x4 v00, f32x4 v01, f32x4 v10, f32x4 v11, const Unit& u, int ai, int m, int wr, int wc, int fr, int fq) const {
        const int row = u.pm * BM + wr * 64 + fr + ai * HALF + m * 16, col0 = u.pn * BM + wc * 32 + 8 * fq;
        const u32x4 ga = x.ga, gb = x.gb;
        u32x4 w;
        w.x = pk2(bflo(ga.x) * v00[0], bfhi(ga.x) * v00[1]); w.y = pk2(bflo(ga.y) * v00[2], bfhi(ga.y) * v00[3]);
        w.z = pk2(bflo(ga.z) * v01[0], bfhi(ga.z) * v01[1]); w.w = pk2(bflo(ga.w) * v01[2], bfhi(ga.w) * v01[3]);
        *(u32x4*)(mg + (size_t)row * D + col0) = w;
        w.x = pk2(bflo(gb.x) * v10[0], bfhi(gb.x) * v10[1]); w.y = pk2(bflo(gb.y) * v10[2], bfhi(gb.y) * v10[3]);
        w.z = pk2(bflo(gb.z) * v11[0], bfhi(gb.z) * v11[1]); w.w = pk2(bflo(gb.w) * v11[2], bfhi(gb.w) * v11[3]);
        *(u32x4*)(mg + (size_t)row * D + col0 + HALF) = w;
    }
    EPI_WALK_LD(8)
};
struct EpiRes1 {
    static constexpr int TSID = 3;
    static constexpr int HOOK_TILE = 0;
    static constexpr bool PERM = true, AFTER_DRAIN = false;
    const float* xp; const float* xs; const float* mod; bf16_t* x1;
    struct L { f32x4 a, b, c, d; }; struct Pre { f32x4 g[4]; };
    __device__ __forceinline__ Pre prep(const Unit& u, int wc, int fq) const {
        const float* gm = mod + (size_t)((u.pm * BM) / TP) * (6 * D) + 2 * D + u.pn * BM + wc * 32 + 8 * fq;
        return Pre{{*(const f32x4*)gm, *(const f32x4*)(gm + 4), *(const f32x4*)(gm + HALF), *(const f32x4*)(gm + HALF + 4)}};
    }
    __device__ __forceinline__ L ld(const Unit& u, int ai, int m, int wr, int wc, int fr, int fq) const {
        const int row = u.pm * BM + wr * 64 + fr + ai * HALF + m * 16, col0 = u.pn * BM + wc * 32 + 8 * fq;
        const float* xr = (row < MP ? xp + (size_t)row * D : xs + (size_t)(row - MP) * D) + col0;
        return L{__builtin_nontemporal_load((const f32x4*)xr), __builtin_nontemporal_load((const f32x4*)(xr + 4)), __builtin_nontemporal_load((const f32x4*)(xr + HALF)), __builtin_nontemporal_load((const f32x4*)(xr + HALF + 4))};
    }
    template <bool UNI> __device__ __forceinline__ void fin(const L& x, const Pre& q, f32x4 v00, f32x4 v01, f32x4 v10, f32x4 v11, const Unit& u, int ai, int m, int wr, int wc, int fr, int fq) const {
        const int row = u.pm * BM + wr * 64 + fr + ai * HALF + m * 16, col0 = u.pn * BM + wc * 32 + 8 * fq;
        f32x4 g0 = q.g[0], g1 = q.g[1], g2 = q.g[2], g3 = q.g[3];
        if constexpr (!UNI) { const float* gm = mod + (size_t)seq_of_row(row) * (6 * D) + 2 * D + col0;
            g0 = *(const f32x4*)gm; g1 = *(const f32x4*)(gm + 4); g2 = *(const f32x4*)(gm + HALF); g3 = *(const f32x4*)(gm + HALF + 4); }
        const f32x4 a = x.a + g0 * v00, b = x.b + g1 * v01, c = x.c + g2 * v10, d = x.d + g3 * v11;
        u32x4 w; w.x = pk2(a[0], a[1]); w.y = pk2(a[2], a[3]); w.z = pk2(b[0], b[1]); w.w = pk2(b[2], b[3]);
        *(u32x4*)(x1 + (size_t)row * D + col0) = w;
        w.x = pk2(c[0], c[1]); w.y = pk2(c[2], c[3]); w.z = pk2(d[0], d[1]); w.w = pk2(d[2], d[3]);
        *(u32x4*)(x1 + (size_t)row * D + col0 + HALF) = w;
    }
    EPI_WALK_LDU(4)
};
struct EpiSwiglu {
    static constexpr int TSID = 4;
    static constexpr int HOOK_TILE = 0;
    static constexpr bool PERM = true, AFTER_DRAIN = false;
    bf16_t* act;
    __device__ __forceinline__ void rg(f32x4 v00, f32x4 v01, f32x4 v10, f32x4 v11, const Unit& u, int ai, int m, int wr, int wc, int fr, int fq) const {
        const int row = u.pm * BM + wr * 64 + fr + ai * HALF + m * 16, col0 = u.pn * HALF + wc * 32 + 8 * fq;
        float r[8];
#pragma unroll
        for (int e = 0; e < 4; ++e) { r[e] = v00[e] * sigmoidf_(v00[e]) * v10[e]; r[4 + e] = v01[e] * sigmoidf_(v01[e]) * v11[e]; }
        u32x4 w; w.x = pk2(r[0], r[1]); w.y = pk2(r[2], r[3]); w.z = pk2(r[4], r[5]); w.w = pk2(r[6], r[7]);
        *(u32x4*)(act + (size_t)row * DFF + col0) = w;
    }
    EPI_WALK()
};
struct EpiRes2 {
    static constexpr int TSID = 5;
    static constexpr int HOOK_TILE = 0;
    static constexpr bool PERM = true, AFTER_DRAIN = false;
    const float* mod; bf16_t* x1;
    struct L { u32x4 a, b; }; struct Pre { f32x4 g[4]; };
    __device__ __forceinline__ Pre prep(const Unit& u, int wc, int fq) const {
        const float* gf = mod + (size_t)((u.pm * BM) / TP) * (6 * D) + 5 * D + u.pn * BM + wc * 32 + 8 * fq;
        return Pre{{*(const f32x4*)gf, *(const f32x4*)(gf + 4), *(const f32x4*)(gf + HALF), *(const f32x4*)(gf + HALF + 4)}};
    }
    __device__ __forceinline__ L ld(const Unit& u, int ai, int m, int wr, int wc, int fr, int fq) const {
        const int row = u.pm * BM + wr * 64 + fr + ai * HALF + m * 16, col0 = u.pn * BM + wc * 32 + 8 * fq;
        const bf16_t* o = x1 + (size_t)row * D + col0;
        return L{*(const u32x4*)o, *(const u32x4*)(o + HALF)};
    }
    template <bool UNI> __device__ __forceinline__ void fin(const L& x, const Pre& q, f32x4 v00, f32x4 v01, f32x4 v10, f32x4 v11, const Unit& u, int ai, int m, int wr, int wc, int fr, int fq) const {
        const int row = u.pm * BM + wr * 64 + fr + ai * HALF + m * 16, col0 = u.pn * BM + wc * 32 + 8 * fq;
        f32x4 g0 = q.g[0], g1 = q.g[1], g2 = q.g[2], g3 = q.g[3];
        if constexpr (!UNI) { const float* gf = mod + (size_t)seq_of_row(row) * (6 * D) + 5 * D + col0;
            g0 = *(const f32x4*)gf; g1 = *(const f32x4*)(gf + 4); g2 = *(const f32x4*)(gf + HALF); g3 = *(const f32x4*)(gf + HALF + 4); }
        bf16_t* o = x1 + (size_t)row * D + col0;
        const u32x4 xa = x.a, xb = x.b;
        u32x4 w;
        w.x = pk2(bflo(xa.x) + g0[0] * v00[0], bfhi(xa.x) + g0[1] * v00[1]); w.y = pk2(bflo(xa.y) + g0[2] * v00[2], bfhi(xa.y) + g0[3] * v00[3]);
        w.z = pk2(bflo(xa.z) + g1[0] * v01[0], bfhi(xa.z) + g1[1] * v01[1]); w.w = pk2(bflo(xa.w) + g1[2] * v01[2], bfhi(xa.w) + g1[3] * v01[3]);
        *(u32x4*)o = w;
        w.x = pk2(bflo(xb.x) + g2[0] * v10[0], bfhi(xb.x) + g2[1] * v10[1]); w.y = pk2(bflo(xb.y) + g2[2] * v10[2], bfhi(xb.y) + g2[3] * v10[3]);
        w.z = pk2(bflo(xb.z) + g3[0] * v11[0], bfhi(xb.z) + g3[1] * v11[1]); w.w = pk2(bflo(xb.w) + g3[2] * v11[2], bfhi(xb.w) + g3[3] * v11[3]);
        *(u32x4*)(o + HALF) = w;
    }
    EPI_WALK_LDU(4)
};
struct SliceOrder {
    int nM, nN, nwg, KT, R1, c, nleft, nsl, l, s;
    unsigned* cnt; float* slab;
    __device__ __forceinline__ void init(int M_, int N_, int K_, int c_, unsigned* cnt_, float* slab_, int nslmax = 8) {
        nM = M_ / BM; nN = N_ / BM; nwg = nM * nN; KT = K_ / 64; c = c_; cnt = cnt_; slab = slab_;
        R1 = nwg / 256; nleft = nwg - R1 * 256; nsl = nleft ? 256 / nleft : 1; if (nsl > nslmax) nsl = nslmax;
        l = nleft ? c % nleft : 0; s = nleft ? c / nleft : nsl;
    }
    __device__ __forceinline__ int kbnd(int i) const { return i >= nsl ? KT : (((KT * i) / nsl + 1) & ~1); }
    __device__ __forceinline__ void pmpn(int L, Unit& u) const {
        int wgid = L; { const int q = nwg / pg8::NXCD, r = nwg % pg8::NXCD, xcd = wgid % pg8::NXCD, off = wgid / pg8::NXCD; wgid = (xcd < r ? xcd * (q + 1) : r * (q + 1) + (xcd - r) * q) + off; }
        const int nig = pg8::WGM * nN, gid = wgid / nig, fm = gid * pg8::WGM, gsz = (nM - fm) < pg8::WGM ? (nM - fm) : pg8::WGM;
        u.pm = fm + ((wgid % nig) % gsz); u.pn = (wgid % nig) / gsz;
    }
    __device__ __forceinline__ bool next(int i, Unit& u) const {
        if (i < R1) { pmpn(i * 256 + c, u); u.kb = 0; u.nk = KT; u.kind = 0; u.peer = 0; return true; }
        if (i == R1 && nleft && s < nsl) { pmpn(R1 * 256 + l, u); u.kb = kbnd(s); u.nk = kbnd(s + 1) - u.kb; u.kind = 3; u.peer = l; return true; }
        return false;
    }
    __device__ __forceinline__ void a_ready(const Unit&) const {}
    __device__ __forceinline__ void done(const Unit&) const {}
};

#define GAS __attribute__((address_space(1)))
#define LAS __attribute__((address_space(3)))
typedef GAS unsigned gu32;
#define RLX_AGENT __ATOMIC_RELAXED, __HIP_MEMORY_SCOPE_AGENT
#define LDS_WAIT() asm volatile("s_waitcnt lgkmcnt(0)" ::: "memory")
#define VM_WAIT() asm volatile("s_waitcnt vmcnt(0)" ::: "memory")
#define XB_TMO      128
#define XB_XCNT(j)  (256  + 64 * (j))
#define XB_XSUB(j)  (1280 + 64 * (j))
#define XB_XGEN(j)  (2304 + 64 * (j))
#define XB_TOP      3328
#define XB_TOPGEN   3392
#define XCD_BAR_WORDS 3456
#define XB_SPIN_CAP (1u << 18)

__device__ __forceinline__ unsigned xb_ld(unsigned* p)              { return __hip_atomic_load(p, __ATOMIC_RELAXED, __HIP_MEMORY_SCOPE_AGENT); }
__device__ __forceinline__ unsigned xb_add(unsigned* p, unsigned v) { return __hip_atomic_fetch_add(p, v, __ATOMIC_RELAXED, __HIP_MEMORY_SCOPE_AGENT); }
__device__ __forceinline__ unsigned xb_xcc_id() { return (unsigned)__builtin_amdgcn_s_getreg((3 << 11) | 20) & 0xFu; }
#define XB_SPIN(cond, bar) do { unsigned _sp = 0; while (cond) { __builtin_amdgcn_s_sleep(1); \
    if ((++_sp & 255u) == 0u) { if (xb_ld(&(bar)[XB_TMO])) break; if (_sp > XB_SPIN_CAP) { atomicAdd(&(bar)[XB_TMO], 1u); break; } } } } while (0)

struct XcdBarrier {
    unsigned* bar; unsigned x;
    volatile LAS unsigned* st;
};

__device__ __forceinline__ XcdBarrier xcd_barrier_post(unsigned* bar, volatile LAS unsigned* st) {
    XcdBarrier b; b.bar = bar; b.x = xb_xcc_id(); b.st = st;
    if (threadIdx.x == 0) (void)xb_add(&bar[XB_XCNT(b.x)], 1u);
    return b;
}
__device__ __forceinline__ void xcd_barrier_complete(unsigned* bar, unsigned x, unsigned& nloc, unsigned& nx) {
    const unsigned G = gridDim.x * gridDim.y * gridDim.z;
    unsigned sum, cnt, mine, sp = 0u;
    for (;;) {
        sum = 0u; cnt = 0u; mine = 0u;
#pragma unroll
        for (unsigned j = 0; j < 16; ++j) { const unsigned c = xb_ld(&bar[XB_XCNT(j)]); sum += c; cnt += (c > 0u) ? 1u : 0u; mine = (j == x) ? c : mine; }
        if (sum == G) break;
        __builtin_amdgcn_s_sleep(1);
        if ((++sp & 255u) == 0u) { if (xb_ld(&bar[XB_TMO])) break; if (sp > XB_SPIN_CAP) { atomicAdd(&bar[XB_TMO], 1u); break; } }
    }
    nloc = mine > 0u ? mine : 1u; nx = cnt > 0u ? cnt : 1u;
}

__device__ __forceinline__ void xcd_barrier(const XcdBarrier& b) {
    asm volatile("s_waitcnt vmcnt(0)" ::: "memory");
    __syncthreads();
    if (threadIdx.x == 0) {
        unsigned* bar = b.bar;
        __builtin_amdgcn_s_waitcnt(0);
        unsigned nloc = b.st[0], nx = b.st[1];
        if (nloc == 0u) { xcd_barrier_complete(bar, b.x, nloc, nx); b.st[0] = nloc; b.st[1] = nx; }
        const unsigned old = xb_add(&bar[XB_XSUB(b.x)], 1u);
        const unsigned gen = old / nloc;
        if (old + 1u == (gen + 1u) * nloc) {
            __builtin_amdgcn_fence(__ATOMIC_RELEASE, "agent");
            asm volatile("s_waitcnt vmcnt(0)" ::: "memory");
            const unsigned og = xb_add(&bar[XB_TOP], 1u);
            const unsigned tg = og / nx;
            if (og + 1u == (tg + 1u) * nx) xb_add(&bar[XB_TOPGEN], 1u);
            else XB_SPIN(xb_ld(&bar[XB_TOPGEN]) == tg, bar);
            __builtin_amdgcn_fence(__ATOMIC_ACQUIRE, "agent");
            xb_add(&bar[XB_XGEN(b.x)], 1u);
            asm volatile("s_waitcnt vmcnt(0)" ::: "memory");
        } else {
            XB_SPIN(xb_ld(&bar[XB_XGEN(b.x)]) == gen, bar);
            __builtin_amdgcn_fence(__ATOMIC_ACQUIRE, "agent");
            asm volatile("s_waitcnt vmcnt(0)" ::: "memory");
        }
    }
    __syncthreads();
}

typedef pg8::bf16x8 bf16x8;
#define MFMA16(a, b, c) __builtin_amdgcn_mfma_f32_16x16x32_bf16((a), (b), (c), 0, 0, 0)
constexpr int RB_P1 = 0, RB_RT = 2048, RB_QP = 4096, RB_RAK = 5120, RB_VM = 6144, RB_WL = 8192;

__device__ __forceinline__ f32x4 ld_bf4(const bf16_t* p) { const u32x2v w = *(const u32x2v*)p; return (f32x4){bflo(w.x), bfhi(w.x), bflo(w.y), bfhi(w.y)}; }
__device__ __forceinline__ bf16x8 mk_frag(const f32x4 a, const f32x4 b) { u32x4 w; w.x = pk2(a[0], a[1]); w.y = pk2(a[2], a[3]); w.z = pk2(b[0], b[1]); w.w = pk2(b[2], b[3]); return __builtin_bit_cast(bf16x8, w); }
__device__ __forceinline__ unsigned char* recA_ptr(const P& p, int rec) { return rec < NREC_P ? p.ws + WS_H + (size_t)rec * RECA : p.ws + WS_FRA_S + (size_t)(rec - NREC_P) * RECA; }
__device__ __forceinline__ unsigned char* recB_ptr(const P& p, int rec) { return rec < NREC_P ? (unsigned char*)p.out + (size_t)rec * RECB : p.ws + WS_FRB_S + (size_t)(rec - NREC_P) * RECB; }
__device__ __forceinline__ f32x4 sig4(f32x4 x) { return (f32x4){sigmoidf_(x[0]), sigmoidf_(x[1]), sigmoidf_(x[2]), sigmoidf_(x[3])}; }
__device__ __forceinline__ f32x4 exp4(f32x4 x) { return (f32x4){__expf(x[0]), __expf(x[1]), __expf(x[2]), __expf(x[3])}; }

template <class T> __device__ __forceinline__ T ldu(const void* ubase, unsigned voff) { return *(const T*)((const char*)ubase + voff); }
template <class T> __device__ __forceinline__ T ldu_nt(const void* ubase, unsigned voff) { return __builtin_nontemporal_load((const T*)((const char*)ubase + voff)); }
__device__ __forceinline__ f32x4 bf4(const u32x2v w) { return (f32x4){bflo(w.x), bfhi(w.x), bflo(w.y), bfhi(w.y)}; }
template <int N> __device__ __forceinline__ float row_shr(float x) {
    return __builtin_bit_cast(float, __builtin_amdgcn_update_dpp(0, __builtin_bit_cast(int, x), 0x110 + N, 0xf, 0xf, true));
}
struct ShiftCtx { const bf16_t* zrw; const float* ss; const float* mu; unsigned zoc, zop; float fv, fpz, fps; };
__device__ __forceinline__ f32x4 shift4(const ShiftCtx& k, int cu, unsigned lp) {
    const u32x2v cw = ldu<u32x2v>(k.zrw + cu, k.zoc + lp * 2u), pw = ldu<u32x2v>(k.zrw + cu, k.zop + lp * 2u);
    const f32x4 sv = ldu<f32x4>(k.ss + cu, lp * 4u), m = ldu<f32x4>(k.mu + cu, lp * 4u);
    const f32x4 cur = bf4(cw) * k.fv;
    const f32x4 pv = bf4(pw) * k.fpz + sv * k.fps;
    return cur + (pv - cur) * m;
}

struct RecCtx { ShiftCtx K; int head, c, row, i, q; bool prompt, valid; };
__device__ __forceinline__ RecCtx rec_ctx(const P& p, int rec, int lane) {
    RecCtx R;
    const int head = rec & 15, chunkid = rec >> 4;
    const bool prompt = chunkid < NPB * 128;
    const int sq = prompt ? (chunkid >> 7) : NPB + (chunkid - NPB * 128);
    const int c = prompt ? (chunkid & 127) : 0;
    const int row0 = prompt ? sq * TP + c * 16 : MP + (sq - NPB) * TS;
    const int nvalid = prompt ? 16 : TS;
    const int i = lane & 15, q = lane >> 4;
    const bool valid = i < nvalid, first = (c == 0);
    const bool pz = valid && (i > 0 || !first), ps = valid && (i == 0) && first && !prompt;
    const int row = row0 + (valid ? i : 0);
    R.K.zrw = (const bf16_t*)(p.ws + WS_ZRW); R.K.ss = p.in[3] + (size_t)(prompt ? 0 : sq - NPB) * CSH; R.K.mu = p.in[10];
    R.K.zoc = (unsigned)row * (unsigned)(CSH * 2); R.K.zop = pz ? R.K.zoc - (unsigned)(CSH * 2) : R.K.zoc; R.K.fv = valid ? 1.f : 0.f; R.K.fpz = pz ? 1.f : 0.f; R.K.fps = ps ? 1.f : 0.f;
    R.head = head; R.c = c; R.row = row; R.i = i; R.q = q; R.prompt = prompt; R.valid = valid;
    return R;
}
__device__ __forceinline__ bf16x8 lora_frag(const P& p, int rec, int f, int lane) {
    const RecCtx R = rec_ctx(p, rec, lane);
    const unsigned q8 = (unsigned)R.q * 8u;
    const int col = f < 2 ? 3072 + 32 * f : (f < 4 ? 3136 + 32 * (f - 2) : 3200 + 32 * (f - 4));
    f32x4 x0 = shift4(R.K, col, q8), x1 = shift4(R.K, col + 4, q8);
    if (f < 2) {
#pragma unroll
        for (int e = 0; e < 4; ++e) { x0[e] = 2.f * sigmoidf_(2.f * x0[e]) - 1.f; x1[e] = 2.f * sigmoidf_(2.f * x1[e]) - 1.f; }
    } else if (f >= 4) { x0 = sig4(x0); x1 = sig4(x1); }
    return mk_frag(x0, x1);
}

__device__ __forceinline__ void prep_record(const P& p, LAS unsigned char* wl, const LAS unsigned char* shf, int rec, int lane_in) {
    int lane = lane_in; asm volatile("" : "+v"(lane));
    const int head = rec & 15, chunkid = rec >> 4;
    const bool prompt = chunkid < NPB * 128;
    const int sq = prompt ? (chunkid >> 7) : NPB + (chunkid - NPB * 128);
    const int c = prompt ? (chunkid & 127) : 0;
    const int row0 = prompt ? sq * TP + c * 16 : MP + (sq - NPB) * TS;
    const int nvalid = prompt ? 16 : TS;
    const int i = lane & 15, q = lane >> 4;
    const bool valid = i < nvalid, first = (c == 0);
    const bool pz = valid && (i > 0 || !first), ps = valid && (i == 0) && first && !prompt;
    const int row = row0 + (valid ? i : 0);
    ShiftCtx K;
    K.zrw = (const bf16_t*)(p.ws + WS_ZRW); K.ss = p.in[3] + (size_t)(prompt ? 0 : sq - NPB) * CSH; K.mu = p.in[10];
    K.zoc = (unsigned)row * (unsigned)(CSH * 2); K.zop = pz ? K.zoc - (unsigned)(CSH * 2) : K.zoc; K.fv = valid ? 1.f : 0.f; K.fpz = pz ? 1.f : 0.f; K.fps = ps ? 1.f : 0.f;
    const unsigned q4 = (unsigned)q * 4u, q8 = (unsigned)q * 8u;
    const unsigned wlo64 = (unsigned)(i * 64 + q * 8) * 2u, wlo128 = (unsigned)(i * 128 + q * 8) * 2u;
    const bf16_t* WDUT = (const bf16_t*)(p.ws + WS_LORA); const bf16_t* WAUT = WDUT + RW * 64; const bf16_t* WGUT = WAUT + RW * 64;
    const f32x4 z4 = (f32x4){0.f, 0.f, 0.f, 0.f};

    f32x4 accw[4], acca[4];
#pragma unroll
    for (int ct = 0; ct < 4; ++ct) { accw[ct] = z4; acca[ct] = z4; }
#pragma unroll
    for (int s = 0; s < 2; ++s) {
        const bf16x8 td = *(const LAS bf16x8*)(shf + s * 1024 + lane * 16), ad = *(const LAS bf16x8*)(shf + (2 + s) * 1024 + lane * 16);
#pragma unroll
        for (int ct = 0; ct < 4; ++ct) {
            const int wo = (head * 64 + 16 * ct) * 64 + 32 * s;
            accw[ct] = MFMA16(ldu<bf16x8>(WDUT + wo, wlo64), td, accw[ct]);
            acca[ct] = MFMA16(ldu<bf16x8>(WAUT + wo, wlo64), ad, acca[ct]);
        }
    }
    f32x4 lw[4], av[4], ks[4];
    float ssq = 0.f;
#pragma unroll
    for (int ct = 0; ct < 4; ++ct) {
        const int cbu = head * 64 + 16 * ct;
        lw[ct] = sig4(ldu<f32x4>(p.in[11] + cbu, q4 * 4u) + accw[ct]) * (-0.6065306597126334f);
        lw[ct] = lw[ct] * K.fv;
        av[ct] = sig4(ldu<f32x4>(p.in[13] + cbu, q4 * 4u) + acca[ct]);
        ks[ct] = shift4(K, RW + cbu, q4);
        const f32x4 kk0 = ks[ct] * ldu<f32x4>(p.in[16] + cbu, q4 * 4u);
        ssq += (kk0[0] * kk0[0] + kk0[1] * kk0[1]) + (kk0[2] * kk0[2] + kk0[3] * kk0[3]);
    }
    ssq += __shfl_xor(ssq, 16); ssq += __shfl_xor(ssq, 32);
    const float kinv = __builtin_amdgcn_rcpf(fmaxf(sqrtf(ssq), 1e-12f));
    f32x4 lwc[4];
#pragma unroll
    for (int ct = 0; ct < 4; ++ct) lwc[ct] = lw[ct];
#pragma unroll
    for (int ct = 0; ct < 4; ++ct)
#pragma unroll
        for (int e = 0; e < 4; ++e) { float x = lwc[ct][e]; x += row_shr<1>(x); x += row_shr<2>(x); x += row_shr<4>(x); x += row_shr<8>(x); lwc[ct][e] = x; }
    unsigned char* rb = recB_ptr(p, rec); unsigned char* ra = recA_ptr(p, rec);
    LAS float* MT = (LAS float*)(wl + 8192);
    u32x2v kapP[4], alpP[4], ktP[4], rtP[4];
    f32x4 wl15[4];
    float bsum = 0.f;
#pragma unroll
    for (int ct = 0; ct < 4; ++ct) {
        const int cbu = head * 64 + 16 * ct;
        const f32x4 Wt = exp4(lwc[ct]), Wtm1 = exp4(lwc[ct] - lw[ct]), Winv = exp4(-lwc[ct]);
        const f32x4 kkn = ks[ct] * ldu<f32x4>(p.in[16] + cbu, q4 * 4u) * kinv;
        const f32x4 kmod = ks[ct] * ((av[ct] - 1.f) * ldu<f32x4>(p.in[17] + cbu, q4 * 4u) + 1.f);
        const f32x4 kap = kkn * Wtm1, alp = kkn * av[ct] * Winv, kt = kmod * Winv;
        const f32x4 rs = shift4(K, cbu, q4);
        const f32x4 rt = rs * Wt;
        const f32x4 rk = rs * kmod * ldu<f32x4>(p.in[18] + cbu, q4 * 4u);
        bsum += (rk[0] + rk[1]) + (rk[2] + rk[3]);
#pragma unroll
        for (int e = 0; e < 4; ++e) wl15[ct][e] = __shfl(Wt[e], 15, 16);
        kapP[ct].x = pk2(kap[0], kap[1]); kapP[ct].y = pk2(kap[2], kap[3]); alpP[ct].x = pk2(alp[0], alp[1]); alpP[ct].y = pk2(alp[2], alp[3]);
        ktP[ct].x = pk2(kt[0], kt[1]); ktP[ct].y = pk2(kt[2], kt[3]); rtP[ct].x = pk2(rt[0], rt[1]); rtP[ct].y = pk2(rt[2], rt[3]);
    }
    bsum += __shfl_xor(bsum, 16); bsum += __shfl_xor(bsum, 32);
    u32x2v c1P[4], c2P[4], vP[4];
    {
        f32x4 accg[4];
#pragma unroll
        for (int ct = 0; ct < 4; ++ct) accg[ct] = z4;
#pragma unroll
        for (int s = 0; s < 4; ++s) {
            const bf16x8 gd = *(const LAS bf16x8*)(shf + (4 + s) * 1024 + lane * 16);
#pragma unroll
            for (int ct = 0; ct < 4; ++ct) accg[ct] = MFMA16(ldu<bf16x8>(WGUT + (head * 64 + 16 * ct) * 128 + 32 * s, wlo128), gd, accg[ct]);
        }
#pragma unroll
        for (int ct = 0; ct < 4; ++ct) {
            const int cbu = head * 64 + 16 * ct;
            const f32x4 c1 = ldu<f32x4>(p.in[19] + cbu, q4 * 4u) * accg[ct];
            const f32x4 vsf = shift4(K, 2 * RW + cbu, q4);
            const f32x4 c2 = (ldu<f32x4>(p.in[20] + cbu, q4 * 4u) + vsf * bsum) * accg[ct];
            c1P[ct].x = pk2(c1[0], c1[1]); c1P[ct].y = pk2(c1[2], c1[3]); c2P[ct].x = pk2(c2[0], c2[1]); c2P[ct].y = pk2(c2[2], c2[3]);
            vP[ct].x = pk2(vsf[0], vsf[1]); vP[ct].y = pk2(vsf[2], vsf[3]);
        }
    }
    bf16x8 kapF[2], alpF[2], ktF[2], rtF[2];
#pragma unroll
    for (int s = 0; s < 2; ++s) {
        kapF[s] = __builtin_bit_cast(bf16x8, (u32x4){kapP[2 * s].x, kapP[2 * s].y, kapP[2 * s + 1].x, kapP[2 * s + 1].y});
        alpF[s] = __builtin_bit_cast(bf16x8, (u32x4){alpP[2 * s].x, alpP[2 * s].y, alpP[2 * s + 1].x, alpP[2 * s + 1].y});
        ktF[s] = __builtin_bit_cast(bf16x8, (u32x4){ktP[2 * s].x, ktP[2 * s].y, ktP[2 * s + 1].x, ktP[2 * s + 1].y});
        rtF[s] = __builtin_bit_cast(bf16x8, (u32x4){rtP[2 * s].x, rtP[2 * s].y, rtP[2 * s + 1].x, rtP[2 * s + 1].y});
    }
    u32x2v kapT[4], alpT[4], ktT[4], vT[4];
    {
        unsigned iw0 = 0u, iw1 = 0u;
        if ((i >> 2) == q) { const unsigned one = 0x3F80u << (16 * (i & 1)); if ((i & 3) < 2) iw0 = one; else iw1 = one; }
        const bf16x8 IdA = __builtin_bit_cast(bf16x8, (u32x4){iw0, iw1, 0u, 0u}), IdB = __builtin_bit_cast(bf16x8, (u32x4){0u, 0u, iw0, iw1});
        bf16x8 vF[2];
#pragma unroll
        for (int s = 0; s < 2; ++s) vF[s] = __builtin_bit_cast(bf16x8, (u32x4){vP[2 * s].x, vP[2 * s].y, vP[2 * s + 1].x, vP[2 * s + 1].y});
#pragma unroll
        for (int nt = 0; nt < 4; ++nt) {
            const bf16x8 id = (nt & 1) ? IdB : IdA;
            const f32x4 a = MFMA16(kapF[nt >> 1], id, z4), b = MFMA16(alpF[nt >> 1], id, z4), c3 = MFMA16(ktF[nt >> 1], id, z4), d = MFMA16(vF[nt >> 1], id, z4);
            kapT[nt].x = pk2(a[0], a[1]); kapT[nt].y = pk2(a[2], a[3]); alpT[nt].x = pk2(b[0], b[1]); alpT[nt].y = pk2(b[2], b[3]);
            ktT[nt].x = pk2(c3[0], c3[1]); ktT[nt].y = pk2(c3[2], c3[3]); vT[nt].x = pk2(d[0], d[1]); vT[nt].y = pk2(d[2], d[3]);
        }
    }
    f32x4 Maa = z4, Mak = z4, RAt = z4, RKt = z4;
#pragma unroll
    for (int s = 0; s < 2; ++s) {
        Maa = MFMA16(kapF[s], alpF[s], Maa); Mak = MFMA16(kapF[s], ktF[s], Mak);
        RAt = MFMA16(alpF[s], rtF[s], RAt); RKt = MFMA16(ktF[s], rtF[s], RKt);
    }
#pragma unroll
    for (int r = 0; r < 4; ++r) { const int rw_ = 4 * q + r;
        if (!(rw_ > i)) { Maa[r] = 0.f; Mak[r] = 0.f; }
        if (!(i >= rw_)) { RAt[r] = 0.f; RKt[r] = 0.f; } }
    *(LAS f32x4*)(MT + i * 16 + 4 * q) = Maa;
    u32x4 rakW; rakW.x = pk2(RAt[0], RAt[1]); rakW.y = pk2(RAt[2], RAt[3]); rakW.z = pk2(RKt[0], RKt[1]); rakW.w = pk2(RKt[2], RKt[3]);
    LDS_WAIT(); asm volatile("" ::: "memory");
    float t[16];
#pragma unroll
    for (int cc = 15; cc >= 0; --cc) {
        float acc = (i == cc) ? 1.f : 0.f;
        f32x4 mrow[4];
#pragma unroll
        for (int b = 0; b < 4; ++b) mrow[b] = *(const LAS f32x4*)(MT + cc * 16 + 4 * b);
#pragma unroll
        for (int j = cc + 1; j < 16; ++j) acc -= t[j] * mrow[j >> 2][j & 3];
        t[cc] = acc;
    }
    f32x4 tsel;
#pragma unroll
    for (int e = 0; e < 4; ++e) tsel[e] = -(q == 0 ? t[e] : (q == 1 ? t[4 + e] : (q == 2 ? t[8 + e] : t[12 + e])));
    const bf16x8 Tfrag = mk_frag(tsel, z4);
    f32x4 P1E[4];
#pragma unroll
    for (int ct = 0; ct < 4; ++ct) { u32x4 aw; aw.x = kapT[ct].x; aw.y = kapT[ct].y; aw.z = 0u; aw.w = 0u; P1E[ct] = MFMA16(__builtin_bit_cast(bf16x8, aw), Tfrag, z4); }
    *(u32x4*)(rb + RB_RT + lane * 16) = __builtin_bit_cast(u32x4, rtF[0]); *(u32x4*)(rb + RB_RT + 1024 + lane * 16) = __builtin_bit_cast(u32x4, rtF[1]);
    *(u32x4*)(rb + RB_RAK + lane * 16) = rakW;
#pragma unroll
    for (int ct = 0; ct < 4; ++ct) {
        if (i == 0) *(f32x4*)(rb + RB_WL + (16 * ct + 4 * q) * 4) = wl15[ct];
        if (valid) { const int cbu = head * 64 + 16 * ct;
            *(u32x2v*)((char*)((bf16_t*)(p.ws + WS_OA) + cbu) + ((unsigned)row * (2 * RW) + q4) * 2u) = c1P[ct];
            *(u32x2v*)((char*)((bf16_t*)(p.ws + WS_C2) + cbu) + ((unsigned)row * RW + q4) * 2u) = c2P[ct]; }
    }
    *(u32x4*)(rb + RB_P1 + lane * 16) = __builtin_bit_cast(u32x4, mk_frag(P1E[0], P1E[1]));
    *(u32x4*)(rb + RB_P1 + 1024 + lane * 16) = __builtin_bit_cast(u32x4, mk_frag(P1E[2], P1E[3]));
    { const f32x4 Qt = MFMA16(mk_frag(Mak, z4), Tfrag, z4);
      u32x4 w; w.x = 0u; w.y = 0u; w.z = pk2(Qt[0], Qt[1]); w.w = pk2(Qt[2], Qt[3]); *(u32x4*)(rb + RB_QP + lane * 16) = w; }
#pragma unroll
    for (int tt = 0; tt < 4; ++tt) {
        u32x4 w; w.x = alpT[tt].x; w.y = alpT[tt].y; w.z = ktT[tt].x; w.w = ktT[tt].y; *(u32x4*)(ra + tt * 1024 + lane * 16) = w;
        *(u32x2v*)(rb + RB_VM + tt * 512 + lane * 8) = vT[tt];
    }
    LDS_WAIT(); asm volatile("" ::: "memory");
}

struct ScanFr { bf16x8 P10, P11, RT0, RT1, QP, RAK, AK0, AK1, AK2, AK3; u32x2v vm; f32x4 WL0, WL1, WL2, WL3; };
__device__ __forceinline__ void scan_load(ScanFr& f, const P& p, int rec, int vs, int lane) {
    const unsigned char* ra = recA_ptr(p, rec); const unsigned char* rb = recB_ptr(p, rec);
    const unsigned l16 = (unsigned)lane * 16u, q16 = (unsigned)(lane >> 4) * 16u;
    f.P10 = ldu<bf16x8>(rb + RB_P1, l16); f.P11 = ldu<bf16x8>(rb + RB_P1 + 1024, l16);
    f.RT0 = ldu<bf16x8>(rb + RB_RT, l16); f.RT1 = ldu<bf16x8>(rb + RB_RT + 1024, l16);
    f.QP = ldu<bf16x8>(rb + RB_QP, l16); f.RAK = ldu<bf16x8>(rb + RB_RAK, l16);
    f.vm = ldu<u32x2v>(rb + RB_VM + vs * 512, (unsigned)lane * 8u);
    f.AK0 = ldu<bf16x8>(ra, l16); f.AK1 = ldu<bf16x8>(ra + 1024, l16); f.AK2 = ldu<bf16x8>(ra + 2048, l16); f.AK3 = ldu<bf16x8>(ra + 3072, l16);
    f.WL0 = ldu<f32x4>(rb + RB_WL, q16); f.WL1 = ldu<f32x4>(rb + RB_WL + 64, q16); f.WL2 = ldu<f32x4>(rb + RB_WL + 128, q16); f.WL3 = ldu<f32x4>(rb + RB_WL + 192, q16);
}
template <int NS>
__device__ __forceinline__ void scan_step(const ScanFr& f, const u32x2v (&vm)[NS], f32x4 (&St)[NS][4], bf16_t* oraw, int c, int q, bool prompt) {
    const f32x4 z4 = (f32x4){0.f, 0.f, 0.f, 0.f};
#pragma unroll
    for (int i = 0; i < NS; ++i) {
        const bf16x8 SB0 = mk_frag(St[i][0], St[i][1]), SB1 = mk_frag(St[i][2], St[i][3]);
        u32x4 vw; vw.x = 0u; vw.y = 0u; vw.z = vm[i].x; vw.w = vm[i].y;
        f32x4 U = MFMA16(f.QP, __builtin_bit_cast(bf16x8, vw), z4);
        U = MFMA16(f.P10, SB0, U); U = MFMA16(f.P11, SB1, U);
        u32x4 uw; uw.x = pk2(U[0], U[1]); uw.y = pk2(U[2], U[3]); uw.z = vm[i].x; uw.w = vm[i].y;
        const bf16x8 UB = __builtin_bit_cast(bf16x8, uw);
        f32x4 O = MFMA16(f.RT0, SB0, z4); O = MFMA16(f.RT1, SB1, O); O = MFMA16(f.RAK, UB, O);
        St[i][0] = MFMA16(f.AK0, UB, St[i][0]) * f.WL0; St[i][1] = MFMA16(f.AK1, UB, St[i][1]) * f.WL1;
        St[i][2] = MFMA16(f.AK2, UB, St[i][2]) * f.WL2; St[i][3] = MFMA16(f.AK3, UB, St[i][3]) * f.WL3;
#pragma unroll
        for (int r = 0; r < 4; ++r) { const int tk = 4 * q + r; if (prompt || tk < TS) oraw[(size_t)(16 * c + tk) * RW + 16 * i] = f2bf(O[r]); }
    }
}
__device__ __forceinline__ void scan_chain_prompt(const P& p, int sq, int head, int vp, int lane, volatile LAS unsigned* prog) {
    constexpr int nch = TP / 16;
    const int rec0 = sq * nch * NH + head, vl = lane & 15, q = lane >> 4;
    f32x4 St[2][4];
    float* sout = p.out + O_WKVP + ((size_t)sq * NH + head) * HS * HS + (size_t)(32 * vp + vl) * HS + 4 * q;
    bf16_t* oraw = (bf16_t*)(p.ws + WS_ZRW) + (size_t)(sq * TP) * RW + head * HS + 32 * vp + vl;
    ScanFr f0, f1, f2; u32x2v v0[2], v1[2], v2[2];
#define SCAN_LD(f, v, cc) do { const int rec_ = rec0 + (cc) * NH; scan_load(f, p, rec_, 2 * vp, lane); v[0] = f.vm; v[1] = ldu<u32x2v>(recB_ptr(p, rec_) + RB_VM + (2 * vp + 1) * 512, (unsigned)lane * 8u); } while (0)
    SCAN_LD(f0, v0, 0); SCAN_LD(f1, v1, 1); SCAN_LD(f2, v2, 2);
#pragma unroll
    for (int i = 0; i < 2; ++i)
#pragma unroll
        for (int t = 0; t < 4; ++t) St[i][t] = (f32x4){0.f, 0.f, 0.f, 0.f};
    const bool pw = vp == 0 && lane == 0;
    int c = 0;
    for (; c + 3 <= nch; c += 3) {
        if (pw) *prog = (unsigned)c;
        scan_step<2>(f0, v0, St, oraw, c, q, true);     SCAN_LD(f0, v0, c + 3 < nch ? c + 3 : nch - 1);
        scan_step<2>(f1, v1, St, oraw, c + 1, q, true); SCAN_LD(f1, v1, c + 4 < nch ? c + 4 : nch - 1);
        scan_step<2>(f2, v2, St, oraw, c + 2, q, true); SCAN_LD(f2, v2, c + 5 < nch ? c + 5 : nch - 1);
    }
    if (c < nch) { scan_step<2>(f0, v0, St, oraw, c, q, true); ++c; }
    if (c < nch) { scan_step<2>(f1, v1, St, oraw, c, q, true); }
#undef SCAN_LD
#pragma unroll
    for (int i = 0; i < 2; ++i)
#pragma unroll
        for (int t = 0; t < 4; ++t) *(f32x4*)(sout + (size_t)(16 * i) * HS + 16 * t) = St[i][t];
}
struct SampleTask { ScanFr f; f32x4 St[4]; };
__device__ __forceinline__ void sample_load(SampleTask& t, const P& p, int j, int lane) {
    const int s = j >> 6, head = (j >> 2) & 15, vs = j & 3, vl = lane & 15, q = lane >> 4;
    scan_load(t.f, p, NREC_P + s * NH + head, vs, lane);
    const float* sin = p.in[2] + ((size_t)s * NH + head) * HS * HS + (size_t)(16 * vs + vl) * HS + 4 * q;
#pragma unroll
    for (int tt = 0; tt < 4; ++tt) t.St[tt] = *(const f32x4*)(sin + 16 * tt);
}
__device__ __forceinline__ void sample_run(SampleTask& t, const P& p, int j, int lane) {
    const int s = j >> 6, head = (j >> 2) & 15, vs = j & 3, vl = lane & 15, q = lane >> 4;
    f32x4 St[1][4]; u32x2v vm[1]; vm[0] = t.f.vm;
#pragma unroll
    for (int tt = 0; tt < 4; ++tt) St[0][tt] = t.St[tt];
    scan_step<1>(t.f, vm, St, (bf16_t*)(p.ws + WS_ZRW) + (size_t)(MP + s * TS) * RW + head * HS + 16 * vs + vl, 0, q, false);
    float* sout = p.out + O_WKVS + ((size_t)s * NH + head) * HS * HS + (size_t)(16 * vs + vl) * HS + 4 * q;
#pragma unroll
    for (int tt = 0; tt < 4; ++tt) *(f32x4*)(sout + 16 * tt) = St[0][tt];
}
__device__ __forceinline__ void scan_samples(const P& p, int j0, int stride, int lane) {
    constexpr int NT = NSB * NH * 4;
    if (j0 >= NT) return;
    SampleTask a, b;
    sample_load(a, p, j0, lane);
    for (int j = j0;;) {
        const int jb = j + stride; const bool hb = jb < NT;
        if (hb) sample_load(b, p, jb, lane);
        sample_run(a, p, j, lane);
        if (!hb) break;
        const int ja = jb + stride; const bool ha = ja < NT;
        if (ha) sample_load(a, p, ja, lane);
        sample_run(b, p, jb, lane);
        if (!ha) break;
        j = ja;
    }
}

constexpr int SCAN_AHEAD = 10;
__device__ __forceinline__ void scan_prefetch(const P& p, volatile LAS unsigned* prog, int sq, int head, int k, int lane) {
    const int rec0 = sq * (TP / 16) * NH + head;
    const unsigned l16 = (unsigned)lane * 16u;
    for (int c = k; c < TP / 16; c += 2) {
        while ((int)*prog < c - SCAN_AHEAD) __builtin_amdgcn_s_sleep(8);
        const unsigned char* ra = recA_ptr(p, rec0 + c * NH); const unsigned char* rb = recB_ptr(p, rec0 + c * NH);
        u32x4 x[12];
#pragma unroll
        for (int j = 0; j < 4; ++j) x[j] = ldu<u32x4>(ra + j * 1024, l16);
#pragma unroll
        for (int j = 0; j < 8; ++j) x[4 + j] = ldu<u32x4>(rb + j * 1024, l16);
        const u32x4 y = ldu<u32x4>(rb + 8192, (unsigned)(lane & 15) * 16u);
#pragma unroll
        for (int j = 0; j < 12; ++j) asm volatile("" :: "v"(x[j].x));
        asm volatile("" :: "v"(y.x));
    }
}

__device__ __forceinline__ void mix_item(const P& p, int item, int wave, int lane) {
    const int g = item & 7, row0 = (item >> 3) * 128;
    const int dl = lane & 15, q = lane >> 4, col = g * 128 + wave * 16;
    const bf16_t* vn = (const bf16_t*)(p.ws + WS_VN) + (size_t)row0 * MLPW + col + dl;
    bf16x8 A[4];
#pragma unroll
    for (int sb = 0; sb < 4; ++sb)
#pragma unroll
        for (int j = 0; j < 8; ++j) A[sb][j] = (short)vn[(size_t)(32 * sb + 8 * q + j) * MLPW];
    const float* wsg = p.in[23] + ((size_t)g * 128 + dl) * 128 + 8 * q;
    const bf16_t* zu = (const bf16_t*)(p.ws + WS_ZUG) + (size_t)(row0 + dl) * ZUGW + ZU_U + col + 4 * q;
    bf16_t* ub = (bf16_t*)(p.ws + WS_OA) + (size_t)(row0 + dl) * (2 * RW) + RW + col + 4 * q;
    u32x2v res[8];
#pragma unroll
    for (int tt = 0; tt < 8; ++tt) {
        const int t = 16 * tt + dl;
        f32x4 acc = (f32x4){0.f, 0.f, 0.f, 0.f};
#pragma unroll
        for (int sb = 0; sb <= tt / 2; ++sb) {
            const float* wr = wsg + (size_t)(16 * tt) * 128 + 32 * sb;
            f32x4 w0 = *(const f32x4*)wr, w1 = *(const f32x4*)(wr + 4);
            if (sb == tt / 2) {
#pragma unroll
                for (int e = 0; e < 4; ++e) { if (32 * sb + 8 * q + e > t) w0[e] = 0.f; if (32 * sb + 8 * q + 4 + e > t) w1[e] = 0.f; }
            }
            acc = MFMA16(A[sb], mk_frag(w0, w1), acc);
        }
        const float bias = p.in[24][g * 128 + t];
        const f32x4 u = ld_bf4(zu + (size_t)(16 * tt) * ZUGW);
        const f32x4 o = (acc + bias) * u;
        res[tt].x = pk2(o[0], o[1]); res[tt].y = pk2(o[2], o[3]);
    }
#pragma unroll
    for (int tt = 0; tt < 8; ++tt) *(u32x2v*)(ub + (size_t)(16 * tt) * (2 * RW)) = res[tt];
}

__device__ __forceinline__ void post_rows(const P& p, int gw, int NGW, int lane) {
    const bf16_t* oraw = (const bf16_t*)(p.ws + WS_ZRW);
    const int r0 = (int)(((long long)gw * M) / NGW), r1 = (int)(((long long)(gw + 1) * M) / NGW);
    for (int rowa = r0; rowa < r1; rowa += 2) {
        u32x4 ow[2][2], c1[2][2], c2[2][2];
#pragma unroll
        for (int k = 0; k < 2; ++k) {
            const int row = rowa + k < r1 ? rowa + k : rowa;
            const size_t off = (size_t)row * RW + lane * 16;
            const bf16_t* oa = (const bf16_t*)(p.ws + WS_OA) + (size_t)row * (2 * RW) + lane * 16; const bf16_t* c2p = (const bf16_t*)(p.ws + WS_C2) + off;
#pragma unroll
            for (int h = 0; h < 2; ++h) { ow[k][h] = *(const u32x4*)(oraw + off + 8 * h); c1[k][h] = *(const u32x4*)(oa + 8 * h); c2[k][h] = *(const u32x4*)(c2p + 8 * h); }
        }
#pragma unroll
        for (int k = 0; k < 2; ++k) {
            if (rowa + k >= r1) break;
            const int row = rowa + k;
            f32x4 o[4]; float s = 0.f;
#pragma unroll
            for (int h = 0; h < 2; ++h) { const u32x4 x = ow[k][h]; o[2 * h] = (f32x4){bflo(x.x), bfhi(x.x), bflo(x.y), bfhi(x.y)}; o[2 * h + 1] = (f32x4){bflo(x.z), bfhi(x.z), bflo(x.w), bfhi(x.w)}; }
#pragma unroll
            for (int j = 0; j < 4; ++j) s += (o[j][0] + o[j][1]) + (o[j][2] + o[j][3]);
            s += __shfl_xor(s, 1); s += __shfl_xor(s, 2);
            const float mean = s * (1.f / HS); float qv = 0.f;
#pragma unroll
            for (int j = 0; j < 4; ++j) { o[j] = o[j] - mean; qv += (o[j][0] * o[j][0] + o[j][1] * o[j][1]) + (o[j][2] * o[j][2] + o[j][3] * o[j][3]); }
            qv += __shfl_xor(qv, 1); qv += __shfl_xor(qv, 2);
            const float rstd = rsqrtf(qv * (1.f / HS) + 64e-5f);
            bf16_t* oa = (bf16_t*)(p.ws + WS_OA) + (size_t)row * (2 * RW) + lane * 16;
#pragma unroll
            for (int h = 0; h < 2; ++h) {
                const u32x4 a1 = c1[k][h], a2 = c2[k][h];
                const f32x4 a = o[2 * h] * rstd, b = o[2 * h + 1] * rstd;
                u32x4 w;
                w.x = pk2(a[0] * bflo(a1.x) + bflo(a2.x), a[1] * bfhi(a1.x) + bfhi(a2.x)); w.y = pk2(a[2] * bflo(a1.y) + bflo(a2.y), a[3] * bfhi(a1.y) + bfhi(a2.y));
                w.z = pk2(b[0] * bflo(a1.z) + bflo(a2.z), b[1] * bfhi(a1.z) + bfhi(a2.z)); w.w = pk2(b[2] * bflo(a1.w) + bflo(a2.w), b[3] * bfhi(a1.w) + bfhi(a2.w));
                *(u32x4*)(oa + 8 * h) = w;
            }
        }
    }
}

constexpr int NWAVES = 8, NTHR = NWAVES * 64;
constexpr int RING_BYTES = 131072, LDSCTL_OFF = RING_BYTES, MISC_OFF = LDSCTL_OFF + 320, LDS_BYTES = 147456;

__device__ __forceinline__ void p0_mod_slab(const P& p, LAS unsigned char* lds, int slab, int tid, int lane, int wave) {
    LAS float* red = (LAS float*)(lds + 3 * 27648);
    LAS float* Bl = (LAS float*)(lds + wave * 12288);
    const int n0 = slab * 48, fr = lane & 15, fq = lane >> 4;
    const float* W = p.in[6] + n0;
    f32x4 acc[9][3];
#pragma unroll
    for (int a = 0; a < 9; ++a)
#pragma unroll
        for (int b = 0; b < 3; ++b) acc[a][b] = (f32x4){0.f, 0.f, 0.f, 0.f};
    for (int sc = 0; sc < 4; ++sc) {
        const int kb0 = ((wave + (slab >> 1)) & 7) * 256 + ((sc + (slab >> 4)) & 3) * 64;
        f32x4 v[12];
        int ln = lane; asm volatile("" : "+v"(ln));
        const float* Wk = W + (size_t)kb0 * (6 * D);
        { int r = ln / 12, c4 = ln - r * 12;
#pragma unroll
          for (int t = 0; t < 12; ++t) { v[t] = ldu<f32x4>(Wk, (unsigned)(r * (6 * D) + 4 * c4) * 4u); c4 += 4; r += 5; if (c4 >= 12) { c4 -= 12; r += 1; } } }
        { int r = ln / 12, c4 = ln - r * 12;
#pragma unroll
          for (int t = 0; t < 12; ++t) { *(LAS f32x4*)(Bl + r * 48 + 4 * c4) = v[t]; c4 += 4; r += 5; if (c4 >= 12) { c4 -= 12; r += 1; } } }
        LDS_WAIT(); asm volatile("" ::: "memory");
#pragma unroll
        for (int kb2 = 0; kb2 < 2; ++kb2) {
            const int k0 = kb0 + kb2 * 32 + fq * 8;
            bf16x8 bfr[3];
#pragma unroll
            for (int nt = 0; nt < 3; ++nt) { const LAS float* bp = Bl + (kb2 * 32 + fq * 8) * 48 + nt * 16 + fr;
                u32x4 w; w.x = pk2(bp[0], bp[48]); w.y = pk2(bp[96], bp[144]); w.z = pk2(bp[192], bp[240]); w.w = pk2(bp[288], bp[336]);
                bfr[nt] = __builtin_bit_cast(bf16x8, w); }
            const bf16_t* sil = (const bf16_t*)(p.ws + WS_SILU) + (size_t)fr * D + k0;
            bf16x8 afr[9];
#pragma unroll
            for (int mt = 0; mt < 9; ++mt) afr[mt] = *(const bf16x8*)(sil + (size_t)(mt * 16) * D);
#pragma unroll
            for (int mt = 0; mt < 9; ++mt)
#pragma unroll
                for (int nt = 0; nt < 3; ++nt) acc[mt][nt] = __builtin_amdgcn_mfma_f32_16x16x32_bf16(afr[mt], bfr[nt], acc[mt][nt], 0, 0, 0);
        }
        LDS_WAIT(); asm volatile("" ::: "memory");
    }
    __syncthreads();
#pragma unroll
    for (int half = 4; half >= 1; half >>= 1) {
        LAS float* buf = (LAS float*)(lds + (wave & (half - 1)) * 27648);
        if (wave >= half && wave < 2 * half) {
#pragma unroll
            for (int mt = 0; mt < 9; ++mt)
#pragma unroll
                for (int nt = 0; nt < 3; ++nt) *(LAS f32x4*)(buf + ((mt * 3 + nt) * 64 + lane) * 4) = acc[mt][nt];
        }
        __syncthreads();
        if (wave < half) {
#pragma unroll
            for (int mt = 0; mt < 9; ++mt)
#pragma unroll
                for (int nt = 0; nt < 3; ++nt) acc[mt][nt] += *(const LAS f32x4*)(buf + ((mt * 3 + nt) * 64 + lane) * 4);
        }
        __syncthreads();
    }
    if (wave == 0) {
#pragma unroll
        for (int mt = 0; mt < 9; ++mt)
#pragma unroll
            for (int nt = 0; nt < 3; ++nt)
#pragma unroll
                for (int r = 0; r < 4; ++r) red[(mt * 16 + 4 * fq + r) * 48 + nt * 16 + fr] = acc[mt][nt][r];
    }
    __syncthreads();
    float* mod = (float*)(p.ws + WS_MOD);
    for (int i = tid; i < NSEQ * 48; i += NTHR) { const int row = i / 48, c = i % 48; mod[(size_t)row * (6 * D) + n0 + c] = red[row * 48 + c] + p.in[7][n0 + c]; }
    __syncthreads();
}
__device__ __forceinline__ void p0_silu(const P& p, int gt, int NT) {
    const __amdgpu_buffer_rsrc_t rs = __builtin_amdgcn_make_buffer_rsrc(p.ws + WS_SILU, 0, 144 * D * 2, 0x00020000);
    for (int i = gt; i < 144 * D / 4; i += NT) {
        const int row = i / (D / 4), k = (i - row * (D / 4)) * 4;
        f32x4 v = (f32x4){0.f, 0.f, 0.f, 0.f};
        if (row < NSEQ) { v = *(const f32x4*)((row < NPB ? p.in[4] + (size_t)row * D : p.in[5] + (size_t)(row - NPB) * D) + k);
#pragma unroll
            for (int e = 0; e < 4; ++e) v[e] = v[e] * sigmoidf_(v[e]); }
        u32x2v w; w.x = pk2(v[0], v[1]); w.y = pk2(v[2], v[3]);
        __builtin_amdgcn_raw_buffer_store_b64(w, rs, (unsigned)(row * D + k) * 2u, 0, 16);
    }
}
struct TJob { const float* W; bf16_t* WT; int K, N, ldw, kofs, item; int swz; };
__device__ __forceinline__ void tr_load(const TJob& j, float (&tv)[32], int lane) {
    const int nblk = j.N / 32, kb = j.item / nblk, nb = j.item - kb * nblk;
    const float* w = j.W + (size_t)(64 * kb) * j.N + 32 * nb;
    const unsigned lo = (unsigned)((lane >> 5) * j.N + (lane & 31)) * 4u, rs2 = (unsigned)j.N * 8u;
#pragma unroll
    for (int i = 0; i < 32; ++i) tv[i] = ldu_nt<float>(w, lo + (unsigned)i * rs2);
}
__device__ __forceinline__ void tr_store(const TJob& j, const float (&tv)[32], LAS float* scr, int lane) {
    const int nblk = j.N / 32, kb = j.item / nblk, nb = j.item - kb * nblk, k0 = 64 * kb, n0 = 32 * nb;
    int r0 = n0;
    if (j.swz == 1) { r0 = n0 < DFF ? 256 * (n0 >> 7) + (n0 & 127) : 256 * ((n0 - DFF) >> 7) + 128 + ((n0 - DFF) & 127); }
    else if (j.swz == 2 && n0 >= C_G0) { const int g = n0 - C_G0; r0 = g < D ? C_G0 + 256 * (g >> 7) + (g & 127) : C_G0 + 256 * ((g - D) >> 7) + 128 + ((g - D) & 127); }
#pragma unroll
    for (int i = 0; i < 32; ++i) scr[(2 * i + (lane >> 5)) * 33 + (lane & 31)] = tv[i];
    LDS_WAIT(); asm volatile("" ::: "memory");
    const int c = lane & 7;
#pragma unroll
    for (int jj = 0; jj < 4; ++jj) { const int n = (lane >> 3) + 8 * jj; const LAS float* s = scr + (8 * c) * 33 + n;
        u32x4 o; o.x = pk2(s[0 * 33], s[1 * 33]); o.y = pk2(s[2 * 33], s[3 * 33]); o.z = pk2(s[4 * 33], s[5 * 33]); o.w = pk2(s[6 * 33], s[7 * 33]);
        *(u32x4*)(j.WT + (size_t)(r0 + n) * j.ldw + j.kofs + k0 + 8 * c) = o; }
    LDS_WAIT(); asm volatile("" ::: "memory");
}
__device__ __forceinline__ bool tr_job(const P& p, int part, int it, TJob& j) {
    constexpr int I_IN = (D / 64) * (CIN / 32), I_BA = (RW / 64) * (D / 32), I_OUT = (D / 64) * (D / 32), I_FI = (D / 64) * (2 * DFF / 32), I_FO = (DFF / 64) * (D / 32);
    constexpr int I_L64 = (RW / 32), I_L128 = 2 * (RW / 32);
    unsigned char* ws = p.ws; int r = it;
    j.swz = 0; j.kofs = 0;
    if (part == 0) {
        if (r < I_IN) { j.W = p.in[9]; j.WT = (bf16_t*)(ws + WS_WIN); j.K = D; j.N = CIN; j.ldw = D; j.item = r; j.swz = 2; return true; } r -= I_IN;
        if (r < I_L64) { j.W = p.in[12]; j.WT = (bf16_t*)(ws + WS_LORA); j.K = 64; j.N = RW; j.ldw = 64; j.item = r; return true; } r -= I_L64;
        if (r < I_L64) { j.W = p.in[14]; j.WT = (bf16_t*)(ws + WS_LORA) + RW * 64; j.K = 64; j.N = RW; j.ldw = 64; j.item = r; return true; } r -= I_L64;
        if (r < I_L128) { j.W = p.in[15]; j.WT = (bf16_t*)(ws + WS_LORA) + 2 * RW * 64; j.K = 128; j.N = RW; j.ldw = 128; j.item = r; return true; } r -= I_L128;
        if (r < I_BA) { j.W = p.in[25]; j.WT = (bf16_t*)(ws + WS_WBA); j.K = RW; j.N = D; j.ldw = 2 * RW; j.item = r; return true; } r -= I_BA;
        if (r < I_BA) { j.W = p.in[26]; j.WT = (bf16_t*)(ws + WS_WBA); j.K = RW; j.N = D; j.ldw = 2 * RW; j.kofs = RW; j.item = r; return true; } r -= I_BA;
        if (r < I_OUT) { j.W = p.in[27]; j.WT = (bf16_t*)(ws + WS_WOUT); j.K = D; j.N = D; j.ldw = D; j.item = r; return true; } r -= I_OUT;
        return false;
    } else if (part == 1) {
        if (r < I_FI) { j.W = p.in[29]; j.WT = (bf16_t*)(ws + WS_WFI); j.K = D; j.N = 2 * DFF; j.ldw = D; j.swz = 1; j.item = r; return true; } r -= I_FI;
        if (r < I_FO) { j.W = p.in[30]; j.WT = (bf16_t*)(ws + WS_WFO); j.K = DFF; j.N = D; j.ldw = DFF; j.item = r; return true; }
        return false;
    } else {
        if (r < I_FO) { j.W = p.in[30]; j.WT = (bf16_t*)(ws + WS_WFO); j.K = DFF; j.N = D; j.ldw = DFF; j.item = r; return true; }
        return false;
    }
}
__device__ __forceinline__ void p0_transposes(const P& p, LAS float* scr, int part, int gw, int NGW, int lane) {
    TJob ja, jb; float ta[32], tb[32];
    int it = gw;
    if (!tr_job(p, part, it, ja)) return;
    tr_load(ja, ta, lane);
    for (;;) {
        const bool hb = tr_job(p, part, it + NGW, jb);
        if (hb) tr_load(jb, tb, lane);
        tr_store(ja, ta, scr, lane);
        if (!hb) break;
        const bool ha = tr_job(p, part, it + 2 * NGW, ja);
        if (ha) tr_load(ja, ta, lane);
        tr_store(jb, tb, scr, lane);
        if (!ha) break;
        it += 2 * NGW;
    }
}
__device__ __forceinline__ void tr64_load(const TJob& j, f32x4 (&tv)[16], int lane) {
    const int nblk = j.N / 64, kb = j.item / nblk, nb = j.item - kb * nblk;
    const float* w = j.W + (size_t)(64 * kb) * j.N + 64 * nb;
    const unsigned lo = (unsigned)((lane >> 4) * j.N + 4 * (lane & 15)) * 4u, rs4 = (unsigned)j.N * 16u;
#pragma unroll
    for (int t = 0; t < 16; ++t) tv[t] = ldu_nt<f32x4>(w, lo + (unsigned)t * rs4);
}
__device__ __forceinline__ void tr64_store(const TJob& j, const f32x4 (&tv)[16], LAS float* scr, int lane) {
    const int nblk = j.N / 64, kb = j.item / nblk, nb = j.item - kb * nblk, k0 = 64 * kb, n0 = 64 * nb;
    int r0 = n0;
    if (j.swz == 1) { r0 = n0 < DFF ? 256 * (n0 >> 7) + (n0 & 127) : 256 * ((n0 - DFF) >> 7) + 128 + ((n0 - DFF) & 127); }
#pragma unroll
    for (int t = 0; t < 16; ++t) { const int k = 4 * t + (lane >> 4); *(LAS f32x4*)(scr + k * 64 + (((lane & 15) ^ ((k >> 3) & 7)) << 2)) = tv[t]; }
    LDS_WAIT(); asm volatile("" ::: "memory");
    const int c = lane & 7;
#pragma unroll
    for (int jj = 0; jj < 8; ++jj) { const int n = (lane >> 3) + 8 * jj; const LAS float* s = scr + (8 * c) * 64 + ((((n >> 2) ^ c) << 2) | (n & 3));
        u32x4 o; o.x = pk2(s[0 * 64], s[1 * 64]); o.y = pk2(s[2 * 64], s[3 * 64]); o.z = pk2(s[4 * 64], s[5 * 64]); o.w = pk2(s[6 * 64], s[7 * 64]);
        *(u32x4*)(j.WT + (size_t)(r0 + n) * j.ldw + j.kofs + k0 + 8 * c) = o; }
    LDS_WAIT(); asm volatile("" ::: "memory");
}
__device__ __forceinline__ bool tr64_job(const P& p, int part, int it, TJob& j) {
    constexpr int I_IN = (D / 64) * (CIN / 64), I_BA = (RW / 64) * (D / 64), I_OUT = (D / 64) * (D / 64), I_FI = (D / 64) * (2 * DFF / 64), I_FO = (DFF / 64) * (D / 64);
    constexpr int I_L64 = (RW / 64), I_L128 = 2 * (RW / 64);
    unsigned char* ws = p.ws; int r = it; j.kofs = 0; j.swz = 0;
    if (part == 0) {
        if (r < I_IN) { j.W = p.in[9]; j.WT = (bf16_t*)(ws + WS_WIN); j.K = D; j.N = CIN; j.ldw = D; j.item = r; return true; } r -= I_IN;
        if (r < I_L64) { j.W = p.in[12]; j.WT = (bf16_t*)(ws + WS_LORA); j.K = 64; j.N = RW; j.ldw = 64; j.item = r; return true; } r -= I_L64;
        if (r < I_L64) { j.W = p.in[14]; j.WT = (bf16_t*)(ws + WS_LORA) + RW * 64; j.K = 64; j.N = RW; j.ldw = 64; j.item = r; return true; } r -= I_L64;
        if (r < I_L128) { j.W = p.in[15]; j.WT = (bf16_t*)(ws + WS_LORA) + 2 * RW * 64; j.K = 128; j.N = RW; j.ldw = 128; j.item = r; return true; } r -= I_L128;
        if (r < I_BA) { j.W = p.in[25]; j.WT = (bf16_t*)(ws + WS_WBA); j.K = RW; j.N = D; j.ldw = 2 * RW; j.item = r; return true; } r -= I_BA;
        if (r < I_BA) { j.W = p.in[26]; j.WT = (bf16_t*)(ws + WS_WBA); j.K = RW; j.N = D; j.ldw = 2 * RW; j.kofs = RW; j.item = r; return true; } r -= I_BA;
        if (r < I_OUT) { j.W = p.in[27]; j.WT = (bf16_t*)(ws + WS_WOUT); j.K = D; j.N = D; j.ldw = D; j.item = r; return true; }
        return false;
    }
    if (r < I_FI) { j.W = p.in[29]; j.WT = (bf16_t*)(ws + WS_WFI); j.K = D; j.N = 2 * DFF; j.ldw = D; j.swz = 1; j.item = r; return true; } r -= I_FI;
    if (r < I_FO) { j.W = p.in[30]; j.WT = (bf16_t*)(ws + WS_WFO); j.K = DFF; j.N = D; j.ldw = DFF; j.item = r; return true; }
    return false;
}
__device__ __forceinline__ void p0_transposes64(const P& p, LAS float* scr, int part, int gw, int NGW, int lane, int lim = 1 << 30) {
    TJob ja, jb; f32x4 ta[16], tb[16];
    int it = gw;
    if (it >= lim || !tr64_job(p, part, it, ja)) return;
    tr64_load(ja, ta, lane);
    for (;;) {
        const bool hb = it + NGW < lim && tr64_job(p, part, it + NGW, jb);
        if (hb) tr64_load(jb, tb, lane);
        tr64_store(ja, ta, scr, lane);
        if (!hb) break;
        const bool ha = it + 2 * NGW < lim && tr64_job(p, part, it + 2 * NGW, ja);
        if (ha) tr64_load(ja, ta, lane);
        tr64_store(jb, tb, scr, lane);
        if (!ha) break;
        it += 2 * NGW;
    }
}
template <int WHICH>
__device__ __forceinline__ void phase_norm(const P& p, int gw, int NGW, int lane) {
    const float* g = WHICH == 0 ? p.in[8] : p.in[28];
    const int r0 = (int)(((long long)gw * M) / NGW), r1 = (int)(((long long)(gw + 1) * M) / NGW);
    f32x4 gs[8], sh[8]; int cs = -1;
    const bf16_t* x1 = (const bf16_t*)(p.ws + WS_ZRW);
    for (int row = r0; row < r1; ++row) {
        f32x4 v[8];
        if constexpr (WHICH == 0) {
            const float* x = row < MP ? p.in[0] + (size_t)row * D : p.in[1] + (size_t)(row - MP) * D;
#pragma unroll
            for (int j = 0; j < 8; ++j) v[j] = __builtin_nontemporal_load((const f32x4*)(x + 8 * lane + 512 * (j >> 1) + 4 * (j & 1)));
        } else {
#pragma unroll
            for (int j = 0; j < 4; ++j) { const u32x4 w = *(const u32x4*)(x1 + (size_t)row * D + 8 * lane + 512 * j);
                v[2 * j] = (f32x4){bflo(w.x), bfhi(w.x), bflo(w.y), bfhi(w.y)}; v[2 * j + 1] = (f32x4){bflo(w.z), bfhi(w.z), bflo(w.w), bfhi(w.w)}; }
        }
        const int seq = seq_of_row(row);
        if (seq != cs) {
            cs = seq;
            const float* mod = (const float*)(p.ws + WS_MOD) + (size_t)seq * (6 * D);
            const float* scale = mod + (WHICH == 0 ? 1 : 4) * D; const float* shift = mod + (WHICH == 0 ? 0 : 3) * D;
#pragma unroll
            for (int j = 0; j < 8; ++j) { const int k = 8 * lane + 512 * (j >> 1) + 4 * (j & 1);
                gs[j] = *(const f32x4*)(g + k) * (*(const f32x4*)(scale + k) + 1.f); sh[j] = *(const f32x4*)(shift + k); }
        }
        float s = 0.f;
#pragma unroll
        for (int j = 0; j < 8; ++j) s += (v[j][0] * v[j][0] + v[j][1] * v[j][1]) + (v[j][2] * v[j][2] + v[j][3] * v[j][3]);
        const float rstd = rsqrtf(wave_sum(s) * (1.f / D) + 1e-6f);
        bf16_t* h = (bf16_t*)(p.ws + WS_H) + (size_t)row * D;
#pragma unroll
        for (int j = 0; j < 4; ++j) {
            const f32x4 a = v[2 * j] * rstd * gs[2 * j] + sh[2 * j], b = v[2 * j + 1] * rstd * gs[2 * j + 1] + sh[2 * j + 1];
            u32x4 w; w.x = pk2(a[0], a[1]); w.y = pk2(a[2], a[3]); w.z = pk2(b[0], b[1]); w.w = pk2(b[2], b[3]);
            *(u32x4*)(h + 8 * lane + 512 * j) = w; }
    }
}
__device__ __forceinline__ void phase_lnv(const P& p, int gw, int NGW, int lane) {
    const int r0 = (int)(((long long)gw * M) / NGW), r1 = (int)(((long long)(gw + 1) * M) / NGW);
    f32x4 lg[4], lb[4];
#pragma unroll
    for (int j = 0; j < 2; ++j) { const int c = 8 * lane + 512 * j;
        lg[2 * j] = *(const f32x4*)(p.in[21] + c); lg[2 * j + 1] = *(const f32x4*)(p.in[21] + c + 4); lb[2 * j] = *(const f32x4*)(p.in[22] + c); lb[2 * j + 1] = *(const f32x4*)(p.in[22] + c + 4); }
    for (int rowa = r0; rowa < r1; rowa += 2) {
        u32x4 zw[2][2];
#pragma unroll
        for (int k = 0; k < 2; ++k) { const int row = rowa + k < r1 ? rowa + k : rowa;
            const bf16_t* zv = (const bf16_t*)(p.ws + WS_ZUG) + (size_t)row * ZUGW + ZU_V;
            zw[k][0] = *(const u32x4*)(zv + 8 * lane); zw[k][1] = *(const u32x4*)(zv + 8 * lane + 512); }
#pragma unroll
        for (int k = 0; k < 2; ++k) {
            if (rowa + k >= r1) break;
            const int row = rowa + k;
            f32x4 v[4]; float s = 0.f;
#pragma unroll
            for (int j = 0; j < 2; ++j) { const u32x4 w = zw[k][j]; v[2 * j] = (f32x4){bflo(w.x), bfhi(w.x), bflo(w.y), bfhi(w.y)}; v[2 * j + 1] = (f32x4){bflo(w.z), bfhi(w.z), bflo(w.w), bfhi(w.w)}; }
#pragma unroll
            for (int i = 0; i < 4; ++i) s += (v[i][0] + v[i][1]) + (v[i][2] + v[i][3]);
            const float mean = wave_sum(s) * (1.f / MLPW);
            float q = 0.f;
#pragma unroll
            for (int i = 0; i < 4; ++i) { v[i] = v[i] - mean; q += (v[i][0] * v[i][0] + v[i][1] * v[i][1]) + (v[i][2] * v[i][2] + v[i][3] * v[i][3]); }
            const float rstd = rsqrtf(wave_sum(q) * (1.f / MLPW) + 1e-5f);
            bf16_t* vn = (bf16_t*)(p.ws + WS_VN) + (size_t)row * MLPW;
#pragma unroll
            for (int j = 0; j < 2; ++j) { const int c = 8 * lane + 512 * j;
                const f32x4 a = v[2 * j] * rstd * lg[2 * j] + lb[2 * j], b = v[2 * j + 1] * rstd * lg[2 * j + 1] + lb[2 * j + 1];
                u32x4 w; w.x = pk2(a[0], a[1]); w.y = pk2(a[2], a[3]); w.z = pk2(b[0], b[1]); w.w = pk2(b[2], b[3]);
                *(u32x4*)(vn + c) = w;
                if (row >= MP) { float* vs = p.out + O_VS + (size_t)(row - MP) * MLPW + c; *(f32x4*)vs = a; *(f32x4*)(vs + 4) = b; }
            }
        }
    }
}
__device__ __forceinline__ void phase_final(const P& p, int gw, int NGW, int lane) {
    const int r0 = (int)(((long long)gw * M) / NGW), r1 = (int)(((long long)(gw + 1) * M) / NGW);
    f32x4 g[8];
#pragma unroll
    for (int j = 0; j < 8; ++j) g[j] = *(const f32x4*)(p.in[31] + 8 * lane + 512 * (j >> 1) + 4 * (j & 1));
    const bf16_t* x2 = (const bf16_t*)(p.ws + WS_ZRW);
    for (int row = r0; row < r1; ++row) {
        f32x4 v[8]; float s = 0.f;
#pragma unroll
        for (int j = 0; j < 4; ++j) { const u32x4 w = *(const u32x4*)(x2 + (size_t)row * D + 8 * lane + 512 * j);
            v[2 * j] = (f32x4){bflo(w.x), bfhi(w.x), bflo(w.y), bfhi(w.y)}; v[2 * j + 1] = (f32x4){bflo(w.z), bfhi(w.z), bflo(w.w), bfhi(w.w)}; }
#pragma unroll
        for (int j = 0; j < 8; ++j) s += (v[j][0] * v[j][0] + v[j][1] * v[j][1]) + (v[j][2] * v[j][2] + v[j][3] * v[j][3]);
        const float rstd = rsqrtf(wave_sum(s) * (1.f / D) + 1e-6f);
        float* y = p.out + (size_t)row * D;
#pragma unroll
        for (int j = 0; j < 8; ++j) __builtin_nontemporal_store(v[j] * rstd * g[j], (f32x4*)(y + 8 * lane + 512 * (j >> 1) + 4 * (j & 1)));
    }
}
__device__ __forceinline__ void mix_naive_row(const P& p, int row, int tid, int nthr) {
    const int t = (row - MP) & (TS - 1), rowc0 = row - t;
    const bf16_t* vn = (const bf16_t*)(p.ws + WS_VN) + (size_t)rowc0 * MLPW;
    const bf16_t* zu = (const bf16_t*)(p.ws + WS_ZUG) + (size_t)row * ZUGW + ZU_U;
    bf16_t* ub = (bf16_t*)(p.ws + WS_OA) + (size_t)row * (2 * RW) + RW;
    for (int c = tid; c < MLPW; c += nthr) {
        const int g = c >> 7; const float* wsg = p.in[23] + ((size_t)g * 128 + t) * 128;
        float wv[TS], vv[TS];
#pragma unroll
        for (int s = 0; s < TS; ++s) { wv[s] = wsg[s]; vv[s] = bf2f(vn[(size_t)s * MLPW + c]); }
        float acc = p.in[24][g * 128 + t];
#pragma unroll
        for (int s = 0; s < TS; ++s) acc += (s <= t ? wv[s] : 0.f) * vv[s];
        ub[c] = f2bf(bf2f(zu[c]) * acc);
    }
}

#define PHASE_IDS() int tid = threadIdx.x; asm volatile("" : "+v"(tid)); const int lane = tid & 63, wave = __builtin_amdgcn_readfirstlane(tid >> 6); \
    const int gw = bx * NWAVES + wave, NGW = G * NWAVES; (void)lane; (void)gw; (void)NGW
__global__ void __launch_bounds__(NTHR, 2) mega_fwd(P p) {
    extern __shared__ __attribute__((aligned(16))) unsigned char lds_raw[];
    LAS unsigned char* lds = (LAS unsigned char*)lds_raw;
    const int G = gridDim.x, bx = blockIdx.x;
    unsigned char* ws = p.ws;
#define FLAGS(k) ((unsigned*)(ws + WS_CTL) + CW_FLAGS + (k) * 256)
    { PHASE_IDS();
      for (int u = tid; u < (LDS_BYTES - LDSCTL_OFF) / 4; u += NTHR) ((LAS unsigned*)(lds + LDSCTL_OFF))[u] = 0u; }
    __syncthreads();
    XcdBarrier bar = xcd_barrier_post((unsigned*)(ws + WS_CTL) + CW_BAR, (volatile LAS unsigned*)(lds + MISC_OFF) + 8);
#ifdef TSMASK
    unsigned long long* tsw = (unsigned long long*)(ws + WS_CTL + 524288); int nst = 0;
#define STAMP() do { if (bx == 0 && threadIdx.x == 0) tsw[nst] = __builtin_amdgcn_s_memrealtime(); ++nst; } while (0)
#else
#define STAMP() do { } while (0)
#endif
    STAMP();

    { PHASE_IDS();
      p0_silu(p, bx * NTHR + tid, G * NTHR);
      asm volatile("s_waitcnt vmcnt(0)" ::: "memory"); __syncthreads();
      if (tid == 0) __hip_atomic_fetch_add((unsigned*)(ws + WS_CTL) + CW_SILU, 1u, __ATOMIC_RELAXED, __HIP_MEMORY_SCOPE_AGENT);
      p0_transposes(p, (LAS float*)(lds + wave * 16384), 0, gw, NGW, lane); }
    STAMP();
    { PHASE_IDS();
      if (tid == 0) { unsigned* cw = (unsigned*)(ws + WS_CTL) + CW_SILU; unsigned sp = 0;
          while (__hip_atomic_load(cw, __ATOMIC_RELAXED, __HIP_MEMORY_SCOPE_AGENT) < (unsigned)G && ++sp < (1u << 22)) __builtin_amdgcn_s_sleep(2);
          __builtin_amdgcn_fence(__ATOMIC_ACQUIRE, "agent"); asm volatile("s_waitcnt vmcnt(0)" ::: "memory"); }
      __syncthreads();
      p0_mod_slab(p, lds, ((bx >> 4) << 4) | ((bx & 7) << 1) | ((bx >> 3) & 1), tid, lane, wave); }
    xcd_barrier(bar); STAMP();
    { PHASE_IDS(); phase_norm<0>(p, gw, NGW, lane); }
    xcd_barrier(bar); STAMP();
    {
        pg8::Gemm g{(const bf16_t*)(ws + WS_H), (const bf16_t*)(ws + WS_WIN), M, CIN, D}; SliceOrder S; S.init(M, CIN, D, bx, FLAGS(0), (float*)(ws + WS_VN));
        EpiZ E{(bf16_t*)(ws + WS_ZRW), (bf16_t*)(ws + WS_ZUG), p.out};
        pg8::gemm_phase<EpiZ, SliceOrder, PG8_ALIGN, PG8_SP2>(lds, g, S, E);
    }
    xcd_barrier(bar); STAMP();
    { PHASE_IDS();
      phase_lnv(p, gw, NGW, lane);
      STAMP();
      static_assert(NREC % (256 * NWAVES) == 0, "every wave runs the same number of record rounds (barrier inside)");
      for (int rec = gw, k = 0; rec < NREC; rec += NGW, ++k) {
          int t_ = (int)threadIdx.x; asm volatile("" : "+v"(t_));
          LAS unsigned char* shf = lds + (k & 1) * 16384;
          *(LAS bf16x8*)(shf + wave * 1024 + (t_ & 63) * 16) = lora_frag(p, rec, wave, t_ & 63);
          LDS_WAIT(); __syncthreads();
          prep_record(p, lds + wave * 16384, shf, rec, t_ & 63);
      } }
    xcd_barrier(bar); STAMP();
    { PHASE_IDS();
        constexpr int NSW = NPB * NH, NOW = 256 - NSW;
        if (bx < NSW) {
            volatile LAS unsigned* prog = (volatile LAS unsigned*)(lds + MISC_OFF) + 16;
            if (wave < 2) scan_chain_prompt(p, bx >> 4, bx & 15, wave, lane, prog);
            else if (wave == 4 || wave == 5) scan_prefetch(p, prog, bx >> 4, bx & 15, wave - 4, lane);
            STAMP();
        }
        else {
            const int ob = bx - NSW, wid = ob * NWAVES + wave, NW = NOW * NWAVES;
            if (wave & 1) p0_transposes64(p, (LAS float*)(lds + wave * 16384), 1, wid, NW, lane);
            scan_samples(p, wid, NW, lane);
            constexpr int NMIX = NPB * 16 * 8;
            for (int item = ob; item < NMIX; item += NOW) mix_item(p, item, wave, lane);
            for (int row = MP + ob; row < M; row += NOW) mix_naive_row(p, row, tid, NTHR);
            if (!(wave & 1)) p0_transposes64(p, (LAS float*)(lds + wave * 16384), 1, wid, NW, lane);
        }
    }
    xcd_barrier(bar); STAMP();
    { PHASE_IDS(); post_rows(p, gw, NGW, lane); }
    xcd_barrier(bar); STAMP();
    {
        pg8::Gemm g{(const bf16_t*)(ws + WS_OA), (const bf16_t*)(ws + WS_WBA), M, D, 2 * RW}; SliceOrder S; S.init(M, D, 2 * RW, bx, FLAGS(1), p.out, 4);
        EpiMerge E{(const bf16_t*)(ws + WS_ZUG), (bf16_t*)(ws + WS_H)};
        pg8::gemm_phase<EpiMerge, SliceOrder, PG8_ALIGN, PG8_SP2>(lds, g, S, E);
    }
    xcd_barrier(bar); STAMP();
    {
        pg8::Gemm g{(const bf16_t*)(ws + WS_H), (const bf16_t*)(ws + WS_WOUT), M, D, D}; SliceOrder S; S.init(M, D, D, bx, FLAGS(2), (float*)(ws + WS_VN), 4);
        EpiRes1 E{p.in[0], p.in[1], (const float*)(ws + WS_MOD), (bf16_t*)(ws + WS_ZRW)};
        pg8::gemm_phase<EpiRes1, SliceOrder, PG8_ALIGN, PG8_SP2>(lds, g, S, E);
    }
    xcd_barrier(bar); STAMP();
    { PHASE_IDS(); phase_norm<1>(p, gw, NGW, lane); }
    xcd_barrier(bar); STAMP();
    {
        pg8::Gemm g{(const bf16_t*)(ws + WS_H), (const bf16_t*)(ws + WS_WFI), M, 2 * DFF, D}; SliceOrder S; S.init(M, 2 * DFF, D, bx, FLAGS(3), (float*)(ws + WS_VN));
        EpiSwiglu E{(bf16_t*)(ws + WS_ZUG)};
        pg8::gemm_phase<EpiSwiglu, SliceOrder, PG8_ALIGN, PG8_SP2>(lds, g, S, E);
    }
    xcd_barrier(bar); STAMP();
    {
        pg8::Gemm g{(const bf16_t*)(ws + WS_ZUG), (const bf16_t*)(ws + WS_WFO), M, D, DFF}; SliceOrder S; S.init(M, D, DFF, bx, FLAGS(4), (float*)(ws + WS_VN), 4);
        EpiRes2 E{(const float*)(ws + WS_MOD), (bf16_t*)(ws + WS_ZRW)};
        pg8::gemm_phase<EpiRes2, SliceOrder, PG8_ALIGN, PG8_SP2>(lds, g, S, E);
    }
    xcd_barrier(bar); STAMP();
    { PHASE_IDS(); phase_final(p, gw, NGW, lane); }
#ifdef TSGEMM
    if (bx == 0 && threadIdx.x == 0) p.out[0] += (float)(pg8::g_ts[TSB] - pg8::g_ts[TSA]) * (1.0f / (float)TSSCALE);
#endif
#ifdef TSMASK
    STAMP();
    if (bx == 0 && threadIdx.x == 0) {
        unsigned long long tot = 0;
        for (int k = 0; k < nst - 1; ++k) if ((TSMASK >> k) & 1) tot += tsw[k + 1] - tsw[k];
        p.out[0] += (float)tot * (1.0f / (float)TSSCALE);
    }
#endif
}

extern "C" void kernel_launch(void* const* d_in, const int* in_sizes, int n_in, void* d_out, int out_size, void* d_ws, size_t ws_size, hipStream_t stream) {
    static int grid = 0;
    if (grid == 0) {
        if (n_in != 32 || (size_t)out_size != O_END || ws_size < WS_END) { fprintf(stderr, "kernel_launch: unexpected shapes n_in=%d out=%d ws=%zu (need %zu)\n", n_in, out_size, ws_size, (size_t)WS_END); grid = -1; return; }
        int dev = 0, cus = 0, per_cu = 0;
        if (hipGetDevice(&dev) != hipSuccess || hipDeviceGetAttribute(&cus, hipDeviceAttributeMultiprocessorCount, dev) != hipSuccess) { grid = -1; return; }
        if (hipFuncSetAttribute((const void*)mega_fwd, hipFuncAttributeMaxDynamicSharedMemorySize, LDS_BYTES) != hipSuccess) { fprintf(stderr, "kernel_launch: hipFuncSetAttribute failed\n"); grid = -1; return; }
        if (hipOccupancyMaxActiveBlocksPerMultiprocessor(&per_cu, (const void*)mega_fwd, NTHR, LDS_BYTES) != hipSuccess || per_cu < 1) { fprintf(stderr, "kernel_launch: occupancy query says %d blocks per CU\n", per_cu); }
        (void)hipGetLastError();
        grid = cus;
        if (grid != 256) { fprintf(stderr, "kernel_launch: built for 256 CUs (got %d)\n", cus); grid = -1; return; }
        if (grid < 128) { fprintf(stderr, "kernel_launch: this kernel's phase plan needs >= 128 CUs (got %d)\n", cus); grid = -1; return; }
    }
    if (grid < 0) return;
#ifdef TSMASK
    constexpr size_t kZero = CTL_BYTES;
#else
    constexpr size_t kZero = CTL_ZERO_BYTES;
#endif
    if (hipMemsetAsync((char*)d_ws + WS_CTL, 0, kZero, stream) != hipSuccess) { fprintf(stderr, "kernel_launch: memset failed\n"); return; }
    P p{};
    for (int i = 0; i < 32; ++i) p.in[i] = (const float*)d_in[i];
    p.out = (float*)d_out; p.ws = (unsigned char*)d_ws;
    hipLaunchKernelGGL(mega_fwd, dim3(grid), dim3(NTHR), LDS_BYTES, stream, p);
    const hipError_t le = hipPeekAtLastError();
    if (le != hipSuccess) fprintf(stderr, "kernel_launch: launch failed: %s\n", hipGetErrorName(le));
}
```
